# Optimizing an MI355X kernel written in HIP

```python
import jax, jax.numpy as jnp
from jax import lax
import numpy as np

D_MODEL = 4096
BATCH = 1
SEQ = 16384
DEPTH = 4

N_MIXERS = 2
FOX_HEADS = 32
FOX_HEAD_DIM = D_MODEL // FOX_HEADS
Q_BLOCK = 128
HGRN_EXPAND = 128
HGRN_HEADS = D_MODEL // HGRN_EXPAND
HGRN_DK = HGRN_EXPAND
HGRN_DV = D_MODEL // HGRN_HEADS
HGRN_KEY = HGRN_HEADS * HGRN_DK
CHUNK = 64
D_FF = 4 * D_MODEL
N_FOX = (DEPTH + 1) // 2
N_HGRN = DEPTH // 2
FOX_IN = 4 * D_MODEL + FOX_HEADS
HGRN_IN = 2 * HGRN_KEY + 2 * D_MODEL
NORM_EPS = 1e-6

kernel_name = "fox_hgrn2_interleaved_hybrid"


def rms_norm(x, gain):
    xf = x.astype(jnp.float32)
    y = xf * lax.rsqrt(jnp.mean(xf * xf, axis=-1, keepdims=True) + NORM_EPS)
    return (y * gain.astype(jnp.float32)).astype(x.dtype)


def forgetting_attention(q, k, v, log_f):
    B, S, H, Dh = q.shape
    nb = S // Q_BLOCK
    cum = jnp.cumsum(log_f, axis=1).transpose(0, 2, 1)
    kT = k.transpose(0, 2, 1, 3)
    vT = v.transpose(0, 2, 1, 3)
    q_blocks = q.reshape(B, nb, Q_BLOCK, H, Dh).transpose(1, 0, 3, 2, 4)
    c_blocks = cum.reshape(B, H, nb, Q_BLOCK).transpose(2, 0, 1, 3)
    starts = jnp.arange(nb, dtype=jnp.int32) * Q_BLOCK
    k_pos = jnp.arange(S, dtype=jnp.int32)
    scale = Dh ** -0.5

    def one_block(args):
        qb, cb, start = args
        s = jnp.einsum('bhqd,bhkd->bhqk', qb, kT, preferred_element_type=jnp.float32) * scale
        s = s + (cb[..., :, None] - cum[:, :, None, :])
        q_pos = start + jnp.arange(Q_BLOCK, dtype=jnp.int32)
        causal = k_pos[None, :] <= q_pos[:, None]
        p = jax.nn.softmax(jnp.where(causal, s, -jnp.inf), axis=-1)
        return jnp.einsum('bhqk,bhkd->bhqd', p.astype(vT.dtype), vT)

    o = lax.map(one_block, (q_blocks, c_blocks, starts))
    return o.transpose(1, 0, 3, 2, 4).reshape(B, S, H, Dh)


def hgrn2_chunked_scan(q, k, v, log_f):
    B, S, H, Dk = q.shape
    Dv = v.shape[-1]
    nc = S // CHUNK

    def to_chunks(t):
        return t.reshape(B, nc, CHUNK, H, t.shape[-1]).transpose(1, 0, 3, 2, 4)

    causal = jnp.tril(jnp.ones((CHUNK, CHUNK), dtype=bool))[:, :, None]

    def step(state, inp):
        qc, kc, vc, gc = inp
        qf, kf, vf = qc.astype(jnp.float32), kc.astype(jnp.float32), vc.astype(jnp.float32)
        b = jnp.cumsum(gc, axis=2)
        rel = b[:, :, :, None, :] - b[:, :, None, :, :]
        decay = jnp.exp(jnp.where(causal, rel, -jnp.inf))
        scores = jnp.einsum('bhtk,bhsk,bhtsk->bhts', qf, kf, decay)
        o = (jnp.einsum('bhts,bhsv->bhtv', scores, vf)
             + jnp.einsum('bhtk,bhkv->bhtv', qf * jnp.exp(b), state))
        b_last = b[:, :, -1:, :]
        state = (jnp.exp(b_last)[:, :, 0, :, None] * state
                 + jnp.einsum('bhsk,bhsv->bhkv', kf * jnp.exp(b_last - b), vf))
        return state, o

    state0 = jnp.zeros((B, H, Dk, Dv), jnp.float32)
    _, o = lax.scan(step, state0, (to_chunks(q), to_chunks(k), to_chunks(v), to_chunks(log_f)))
    return o.transpose(1, 0, 3, 2, 4).reshape(B, S, H, Dv)


def fox_mixer(h, w_in, w_out, q_gain, k_gain, fgate_bias):
    B, S, _ = h.shape
    proj = h @ w_in
    q, k, v, gate, fz = jnp.split(proj, [D_MODEL, 2 * D_MODEL, 3 * D_MODEL, 4 * D_MODEL], axis=-1)
    shp = (B, S, FOX_HEADS, FOX_HEAD_DIM)
    q = rms_norm(q.reshape(shp), q_gain)
    k = rms_norm(k.reshape(shp), k_gain)
    v = v.reshape(shp)
    log_f = jax.nn.log_sigmoid(fz.astype(jnp.float32) + fgate_bias.astype(jnp.float32))
    o = forgetting_attention(q, k, v, log_f)
    o = o.reshape(B, S, D_MODEL) * jax.nn.sigmoid(gate)
    return o @ w_out


def hgrn2_mixer(h, w_in, w_out, out_gain, lower_bound):
    B, S, _ = h.shape
    proj = h @ w_in
    q, fz, i_in, gate = jnp.split(proj, [HGRN_KEY, 2 * HGRN_KEY, 2 * HGRN_KEY + D_MODEL], axis=-1)
    kshp = (B, S, HGRN_HEADS, HGRN_DK)
    q = jax.nn.silu(q).reshape(kshp)
    fgate = lower_bound + (1.0 - lower_bound) * jax.nn.sigmoid(fz.astype(jnp.float32))
    log_f = jnp.log(fgate).reshape(kshp)
    k = (1.0 - fgate).astype(h.dtype).reshape(kshp)
    v = i_in.reshape(B, S, HGRN_HEADS, HGRN_DV)
    o = hgrn2_chunked_scan(q, k, v, log_f)
    o = rms_norm(o.astype(h.dtype), out_gain).reshape(B, S, D_MODEL) * jax.nn.silu(gate)
    return o @ w_out


def sq_relu_mlp(h, w_up, w_down):
    return jnp.square(jax.nn.relu(h @ w_up)) @ w_down


def setup_inputs(seed: int = 0) -> dict:
    key = jax.random.key(seed)
    ks = jax.random.split(key, 16)
    f32 = jnp.float32

    def normal(k, shape, scale):
        return jax.random.normal(k, shape, f32) * scale

    def gain(k, shape):
        return 1.0 + 0.02 * jax.random.normal(k, shape, f32)

    return {
        "x": normal(ks[0], (BATCH, SEQ, D_MODEL), 1.0),
        "fox_w_in": normal(ks[1], (N_FOX, D_MODEL, FOX_IN), D_MODEL ** -0.5),
        "fox_w_out": normal(ks[2], (N_FOX, D_MODEL, D_MODEL), D_MODEL ** -0.5),
        "fox_q_gain": gain(ks[3], (N_FOX, FOX_HEAD_DIM)),
        "fox_k_gain": gain(ks[4], (N_FOX, FOX_HEAD_DIM)),
        "fox_fgate_bias": jax.random.uniform(ks[5], (N_FOX, FOX_HEADS), f32, 1.0, 4.0),
        "hgrn_w_in": normal(ks[6], (N_HGRN, D_MODEL, HGRN_IN), D_MODEL ** -0.5),
        "hgrn_w_out": normal(ks[7], (N_HGRN, D_MODEL, D_MODEL), D_MODEL ** -0.5),
        "hgrn_out_gain": gain(ks[8], (N_HGRN, HGRN_DV)),
        "hgrn_lb_logits": normal(ks[9], (DEPTH, HGRN_KEY), 0.1),
        "mixer_norm_gain": gain(ks[10], (DEPTH, D_MODEL)),
        "mlp_norm_gain": gain(ks[11], (DEPTH, D_MODEL)),
        "mlp_w_up": normal(ks[12], (DEPTH, D_MODEL, D_FF), D_MODEL ** -0.5),
        "mlp_w_down": normal(ks[13], (DEPTH, D_FF, D_MODEL), D_FF ** -0.5),
        "final_norm_gain": gain(ks[14], (D_MODEL,)),
    }


def reference(x, fox_w_in, fox_w_out, fox_q_gain, fox_k_gain, fox_fgate_bias,
              hgrn_w_in, hgrn_w_out, hgrn_out_gain, hgrn_lb_logits,
              mixer_norm_gain, mlp_norm_gain, mlp_w_up, mlp_w_down, final_norm_gain):
    lb_p = jax.nn.softmax(hgrn_lb_logits.astype(jnp.float32), axis=0)
    lower_bounds = jnp.cumsum(lb_p, axis=0) - lb_p[0]
    h = x
    for i in range(DEPTH):
        j = i // N_MIXERS
        n = rms_norm(h, mixer_norm_gain[i])
        if i % N_MIXERS == 0:
            mix = fox_mixer(n, fox_w_in[j], fox_w_out[j], fox_q_gain[j], fox_k_gain[j], fox_fgate_bias[j])
        else:
            mix = hgrn2_mixer(n, hgrn_w_in[j], hgrn_w_out[j], hgrn_out_gain[j], lower_bounds[i])
        h = h + mix.astype(h.dtype)
        h = h + sq_relu_mlp(rms_norm(h, mlp_norm_gain[i]), mlp_w_up[i], mlp_w_down[i]).astype(h.dtype)
    return rms_norm(h, final_norm_gain)
```

```cpp
#define MK_PER_PHASE 0
#include <hip/hip_runtime.h>
#include <hip/hip_bf16.h>
#include <cstdio>
#include <cstdint>

#ifndef MK_PER_PHASE
#define MK_PER_PHASE 0
#endif

constexpr int SEQ = 16384, DM = 4096, DFF = 16384, NH = 32, DH = 128, DEPTH = 4;
constexpr int FOX_IN = 4 * DM + NH;
constexpr int FOX_INP = 65 * 256;
constexpr int HG_IN = 4 * DM;
constexpr float NORM_EPS = 1e-6f;
constexpr float LOG2E = 1.4426950408889634f;
constexpr float QSCALE = 0.08838834764831845f * LOG2E;

constexpr size_t MiB = 1u << 20;
constexpr size_t WS_CTL = 0, CTL_ZERO_BYTES = 1 * MiB;
constexpr size_t WS_WFIN = 1 * MiB;
constexpr size_t WS_WFOUT = WS_WFIN + 260 * MiB;
constexpr size_t WS_WHIN = WS_WFOUT + 64 * MiB;
constexpr size_t WS_WHOUT = WS_WHIN + 256 * MiB;
constexpr size_t WS_WUP = WS_WHOUT + 64 * MiB;
constexpr size_t WS_WDN = WS_WUP + 512 * MiB;
constexpr size_t WS_H = WS_WDN + 512 * MiB;
constexpr size_t WS_XN = WS_H + 256 * MiB;
constexpr size_t WS_MO = WS_XN + 128 * MiB;
constexpr size_t WS_PROJ = WS_MO + 128 * MiB;
constexpr size_t WS_G = WS_PROJ + 512 * MiB;
constexpr size_t WS_UT = WS_G + 256 * MiB;
constexpr size_t WS_ST = WS_UT + 512 * MiB;
constexpr size_t WS_LOGF = WS_ST + 256 * MiB;
constexpr size_t WS_KB = WS_LOGF + 2 * MiB;
constexpr size_t WS_DEC = WS_KB + 2 * MiB;
constexpr size_t WS_LB = WS_DEC + 4 * MiB;
constexpr size_t WS_END = WS_LB + 1 * MiB;

#define GAS __attribute__((address_space(1)))
#define LAS __attribute__((address_space(3)))
typedef unsigned short bf16;
typedef unsigned v4u __attribute__((ext_vector_type(4)));
typedef unsigned v2u __attribute__((ext_vector_type(2)));
typedef float f32x4 __attribute__((ext_vector_type(4)));
typedef float f32x16 __attribute__((ext_vector_type(16)));
typedef short bf16x8 __attribute__((ext_vector_type(8)));
typedef short s16x4 __attribute__((ext_vector_type(4)));
#define LDS_WAIT() asm volatile("s_waitcnt lgkmcnt(0)" ::: "memory")
#define VM_WAIT() asm volatile("s_waitcnt vmcnt(0)" ::: "memory")
typedef float f32x2_t __attribute__((ext_vector_type(2)));
typedef __bf16 bf16x2_t __attribute__((ext_vector_type(2)));
__device__ __forceinline__ unsigned cvtpk(float lo, float hi) { const f32x2_t v = {lo, hi}; return __builtin_bit_cast(unsigned, __builtin_convertvector(v, bf16x2_t)); }
__device__ __forceinline__ float bflo(unsigned w) { return __uint_as_float(w << 16); }
__device__ __forceinline__ float bfhi(unsigned w) { return __uint_as_float(w & 0xffff0000u); }
__device__ __forceinline__ float bf2f(bf16 b) { return __uint_as_float(((unsigned)b) << 16); }
__device__ __forceinline__ bf16 f2bf(float f) { return (bf16)(cvtpk(f, 0.f) & 0xffffu); }
__device__ __forceinline__ float fexp(float x) { return __builtin_amdgcn_exp2f(x * LOG2E); }
__device__ __forceinline__ float sigmoidf_(float x) { return __builtin_amdgcn_rcpf(1.f + fexp(-x)); }
__device__ __forceinline__ int opaque_tid() { int t = threadIdx.x; asm volatile("" : "+v"(t)); return t; }
namespace pg8 {
#define PG8_LAS __attribute__((address_space(3)))
typedef unsigned short bf16_t;
typedef short bf16x8 __attribute__((ext_vector_type(8)));
typedef float f32x4 __attribute__((ext_vector_type(4)));
typedef unsigned u32x4 __attribute__((ext_vector_type(4)));
constexpr int BM = 256, BK = 64, HALF = 128, HTB = HALF * BK * 2  , STAGE_BYTES = 8 * HTB, NXCD = 8, WGM = 8;

__host__ __device__ __forceinline__ int lds_byte(int r, int c) { const int st = (r >> 4) * 2 + (c >> 5), rr = r & 15, cc = c & 31, ob = rr * 64 + cc * 2; return st * 1024 + (ob ^ (((ob >> 9) & 1) << 5)); }
__host__ __device__ __forceinline__ void stage_rc(int b, int& R, int& C) { const int st = b / 1024, sb = b % 1024, swz = sb ^ (((sb >> 9) & 1) << 5); R = (st >> 1) * 16 + swz / 64; C = (st & 1) * 32 + (swz % 64) / 2; }
__host__ __device__ __forceinline__ int perm32(int rho) { const int n = rho >> 4, i = rho & 15; return 8 * (i >> 2) + 4 * n + (i & 3); }

struct Unit { int pm, pn; };
struct Gemm { const bf16_t* A; const bf16_t* Bt; int M, N, K; };

struct StaticOrder {
    int nM, nN, nwg, G, c;
    __host__ __device__ void init(int M, int N, int G_, int c_) { nM = M / BM; nN = N / BM; nwg = nM * nN; G = G_; c = c_; }
    __host__ __device__ bool next(int i, Unit& u) const {
        const long L = (long)i * G + c; if (L >= nwg) return false;
        int wgid = (int)L; { const int q = nwg / NXCD, r = nwg % NXCD, xcd = wgid % NXCD, off = wgid / NXCD; wgid = (xcd < r ? xcd * (q + 1) : r * (q + 1) + (xcd - r) * q) + off; }
        const int nig = WGM * nN, gid = wgid / nig, fm = gid * WGM, gsz = (nM - fm) < WGM ? (nM - fm) : WGM;
        u.pm = fm + ((wgid % nig) % gsz); u.pn = (wgid % nig) / gsz; return true;
    }
    __device__ __forceinline__ void a_ready(const Unit&) const {}
    __device__ __forceinline__ void done(const Unit&) const {}
};
__device__ __forceinline__ unsigned cvt_pk_bf16(float lo, float hi) { return ::cvtpk(lo, hi); }
__device__ __forceinline__ float sigm(float x) { return __builtin_amdgcn_rcpf(1.f + __builtin_amdgcn_exp2f(-1.4426950408889634f * x)); }

struct EpiRes {
    static constexpr bool PERM = false, AFTER_DRAIN = false;
    const float* base; float* out; int ldc;
    __device__ __forceinline__ void operator()(const f32x4 (&acc)[2][2][4][2], const Unit& u, int wr, int wc, int fr, int fq) const {
        const int row0 = u.pm * BM + wr * 64 + fr, col0 = u.pn * BM + wc * 32 + 4 * fq;
#pragma unroll
        for (int ai = 0; ai < 2; ++ai)
#pragma unroll
            for (int m = 0; m < 4; ++m) { const size_t off = (size_t)(row0 + ai * HALF + m * 16) * ldc + col0;
                f32x4 b[2][2];
#pragma unroll
                for (int bj = 0; bj < 2; ++bj)
#pragma unroll
                    for (int n = 0; n < 2; ++n) b[bj][n] = *(const f32x4*)(base + off + bj * HALF + n * 16);
#pragma unroll
                for (int bj = 0; bj < 2; ++bj)
#pragma unroll
                    for (int n = 0; n < 2; ++n) *(f32x4*)(out + off + bj * HALF + n * 16) = b[bj][n] + acc[ai][bj][m][n];
                asm volatile("" ::: "memory"); }
    }
};
struct EpiSqRelu {
    static constexpr bool PERM = true, AFTER_DRAIN = false;
    bf16_t* O; int ldc;
    __device__ __forceinline__ void operator()(const f32x4 (&acc)[2][2][4][2], const Unit& u, int wr, int wc, int fr, int fq) const {
        const int row0 = u.pm * BM + wr * 64 + fr, col0 = u.pn * BM + wc * 32 + 8 * fq;
#pragma unroll
        for (int ai = 0; ai < 2; ++ai)
#pragma unroll
            for (int m = 0; m < 4; ++m) { bf16_t* rowp = O + (size_t)(row0 + ai * HALF + m * 16) * ldc + col0;
#pragma unroll
                for (int bj = 0; bj < 2; ++bj) { f32x4 v0 = acc[ai][bj][m][0], v1 = acc[ai][bj][m][1];
#pragma unroll
                    for (int j = 0; j < 4; ++j) { const float a = fmaxf(v0[j], 0.f), b = fmaxf(v1[j], 0.f); v0[j] = a * a; v1[j] = b * b; }
                    u32x4 w; w.x = cvt_pk_bf16(v0[0], v0[1]); w.y = cvt_pk_bf16(v0[2], v0[3]); w.z = cvt_pk_bf16(v1[0], v1[1]); w.w = cvt_pk_bf16(v1[2], v1[3]);
                    *(u32x4*)(rowp + bj * HALF) = w; } }
    }
};
struct EpiFox {
    static constexpr bool PERM = true, AFTER_DRAIN = false;
    bf16_t* P; int ldc; float* logf; const float* fbias;
    __device__ __forceinline__ void operator()(const f32x4 (&acc)[2][2][4][2], const Unit& u, int wr, int wc, int fr, int fq) const {
        const int row0 = u.pm * BM + wr * 64 + fr;
        if (u.pn < 64) {
            const int col0 = u.pn * BM + wc * 32 + 8 * fq; const bool gate = u.pn >= 48;
#pragma unroll
            for (int ai = 0; ai < 2; ++ai)
#pragma unroll
                for (int m = 0; m < 4; ++m) { bf16_t* rowp = P + (size_t)(row0 + ai * HALF + m * 16) * ldc + col0;
#pragma unroll
                    for (int bj = 0; bj < 2; ++bj) { f32x4 v0 = acc[ai][bj][m][0], v1 = acc[ai][bj][m][1];
                        if (gate) {
#pragma unroll
                            for (int j = 0; j < 4; ++j) { v0[j] = sigm(v0[j]); v1[j] = sigm(v1[j]); } }
                        u32x4 w; w.x = cvt_pk_bf16(v0[0], v0[1]); w.y = cvt_pk_bf16(v0[2], v0[3]); w.z = cvt_pk_bf16(v1[0], v1[1]); w.w = cvt_pk_bf16(v1[2], v1[3]);
                        *(u32x4*)(rowp + bj * HALF) = w; } }
        } else if (wc == 0) {
            const f32x4 b0 = *(const f32x4*)(fbias + 8 * fq), b1 = *(const f32x4*)(fbias + 8 * fq + 4);
#pragma unroll
            for (int ai = 0; ai < 2; ++ai)
#pragma unroll
                for (int m = 0; m < 4; ++m) { float* rowp = logf + (size_t)(row0 + ai * HALF + m * 16) * 32 + 8 * fq;
                    f32x4 v0 = acc[ai][0][m][0] + b0, v1 = acc[ai][0][m][1] + b1;
#pragma unroll
                    for (int j = 0; j < 4; ++j) { v0[j] = fminf(v0[j], 0.f) - log1pf(expf(-fabsf(v0[j]))); v1[j] = fminf(v1[j], 0.f) - log1pf(expf(-fabsf(v1[j]))); }
                    *(f32x4*)rowp = v0; *(f32x4*)(rowp + 4) = v1; }
        }
    }
};
struct EpiHgrn {
    static constexpr bool PERM = true, AFTER_DRAIN = false;
    bf16_t* P; int ldc; float* G; const float* lb;
    __device__ __forceinline__ void operator()(const f32x4 (&acc)[2][2][4][2], const Unit& u, int wr, int wc, int fr, int fq) const {
        const int row0 = u.pm * BM + wr * 64 + fr, col0 = u.pn * BM + wc * 32 + 8 * fq; const int kind = u.pn >> 4;
        if (kind == 1) {
            const int gc0 = col0 - 4096;
            f32x4 l0[2], l1[2];
#pragma unroll
            for (int bj = 0; bj < 2; ++bj) { l0[bj] = *(const f32x4*)(lb + gc0 + bj * HALF); l1[bj] = *(const f32x4*)(lb + gc0 + bj * HALF + 4); }
#pragma unroll
            for (int ai = 0; ai < 2; ++ai)
#pragma unroll
                for (int m = 0; m < 4; ++m) { const size_t r = (size_t)(row0 + ai * HALF + m * 16); bf16_t* rowp = P + r * ldc + col0; float* gp = G + r * 4096 + gc0;
#pragma unroll
                    for (int bj = 0; bj < 2; ++bj) { f32x4 v0 = acc[ai][bj][m][0], v1 = acc[ai][bj][m][1], g0, g1;
#pragma unroll
                        for (int j = 0; j < 4; ++j) { const float f0 = l0[bj][j] + (1.f - l0[bj][j]) * sigm(v0[j]), f1 = l1[bj][j] + (1.f - l1[bj][j]) * sigm(v1[j]);
                            g0[j] = logf(f0); g1[j] = logf(f1); v0[j] = 1.f - f0; v1[j] = 1.f - f1; }
                        u32x4 w; w.x = cvt_pk_bf16(v0[0], v0[1]); w.y = cvt_pk_bf16(v0[2], v0[3]); w.z = cvt_pk_bf16(v1[0], v1[1]); w.w = cvt_pk_bf16(v1[2], v1[3]);
                        *(u32x4*)(rowp + bj * HALF) = w; *(f32x4*)(gp + bj * HALF) = g0; *(f32x4*)(gp + bj * HALF + 4) = g1; } }
        } else {
            const bool act = kind != 2;
#pragma unroll
            for (int ai = 0; ai < 2; ++ai)
#pragma unroll
                for (int m = 0; m < 4; ++m) { bf16_t* rowp = P + (size_t)(row0 + ai * HALF + m * 16) * ldc + col0;
#pragma unroll
                    for (int bj = 0; bj < 2; ++bj) { f32x4 v0 = acc[ai][bj][m][0], v1 = acc[ai][bj][m][1];
                        if (act) {
#pragma unroll
                            for (int j = 0; j < 4; ++j) { v0[j] = v0[j] * sigm(v0[j]); v1[j] = v1[j] * sigm(v1[j]); } }
                        u32x4 w; w.x = cvt_pk_bf16(v0[0], v0[1]); w.y = cvt_pk_bf16(v0[2], v0[3]); w.z = cvt_pk_bf16(v1[0], v1[1]); w.w = cvt_pk_bf16(v1[2], v1[3]);
                        *(u32x4*)(rowp + bj * HALF) = w; } }
        }
    }
};
template <class Epi, class Sched, bool ALIGN_EPI = false, bool SP2 = false>
__device__ __forceinline__ void gemm_phase(PG8_LAS unsigned char* lds, const Gemm g, const Sched& S, const Epi& E) {
    const int tid = opaque_tid(), wid = __builtin_amdgcn_readfirstlane(tid >> 6), lane = tid & 63, wr = wid >> 2, wc = wid & 3, fr = lane & 15, fq = lane >> 4;
    const int K = g.K, nt = K / BK;
    unsigned voffA[2], voffB[2];
#pragma unroll
    for (int i = 0; i < 2; ++i) { int R, C; stage_rc(tid * 16 + i * 8192, R, C); const int Rb = Epi::PERM ? ((R & ~31) + perm32(R & 31)) : R;
        voffA[i] = (unsigned)(R * K + C) * 2u; voffB[i] = (unsigned)(Rb * K + C) * 2u; }
    const size_t kstep = (size_t)(BK * 2);
    const size_t hstep = (size_t)HALF * K * 2;
    const size_t tstep = 2 * hstep;
    const unsigned ldsw = (unsigned)wid * 1024u;
    const int aoff = lds_byte(wr * 64 + fr, fq * 8), boff = lds_byte(wc * 32 + fr, fq * 8);
#define PG8_SA(b, h) (((b) * 2 + (h)) * HTB)
#define PG8_SB(b, h) ((4 + (b) * 2 + (h)) * HTB)
#define PG8_STAGE(bufoff, gbase, voff) do { _Pragma("unroll") for (int _i = 0; _i < 2; ++_i) \
        __builtin_amdgcn_global_load_lds((const unsigned*)((const char*)(gbase) + (voff)[_i]), (PG8_LAS unsigned*)(lds + (bufoff) + ldsw + _i * 8192), 16, 0, 0); } while (0)
#define PG8_LDA(dst, b, h) do { _Pragma("unroll") for (int m = 0; m < 4; ++m) _Pragma("unroll") for (int k = 0; k < 2; ++k) dst[m][k] = *(const PG8_LAS bf16x8*)(lds + PG8_SA(b, h) + aoff + m * 2048 + k * 1024); } while (0)
#define PG8_LDB(dst, b, h) do { _Pragma("unroll") for (int n = 0; n < 2; ++n) _Pragma("unroll") for (int k = 0; k < 2; ++k) dst[n][k] = *(const PG8_LAS bf16x8*)(lds + PG8_SB(b, h) + boff + n * 2048 + k * 1024); } while (0)
#define PG8_MMA(ai, bj, At, Bt) do { __builtin_amdgcn_s_setprio(1); _Pragma("unroll") for (int m = 0; m < 4; ++m) _Pragma("unroll") for (int n = 0; n < 2; ++n) _Pragma("unroll") for (int k = 0; k < 2; ++k) \
        acc[ai][bj][m][n] = __builtin_amdgcn_mfma_f32_16x16x32_bf16(Bt[n][k], At[m][k], acc[ai][bj][m][n], 0, 0, 0); __builtin_amdgcn_s_setprio(0); } while (0)
#define PG8_WAIT_V(n) asm volatile("s_waitcnt vmcnt(" #n ")" ::: "memory")
#define PG8_WAIT_L(n) asm volatile("s_waitcnt lgkmcnt(" #n ")" ::: "memory")
#define PG8_BAR __builtin_amdgcn_s_barrier()
#define PG8_SCHED __builtin_amdgcn_sched_barrier(0)
    Unit cur, nxt; int ui = 0;
    if (!S.next(0, cur)) return;
    f32x4 acc[2][2][4][2];
#pragma unroll
    for (int a = 0; a < 2; ++a)
#pragma unroll
        for (int b = 0; b < 2; ++b)
#pragma unroll
            for (int m = 0; m < 4; ++m)
#pragma unroll
                for (int n = 0; n < 2; ++n) acc[a][b][m][n] = (f32x4){0.f, 0.f, 0.f, 0.f};
    bf16x8 At[4][2], B0[2][2], B1[2][2];
    const char* cA = (const char*)g.A + (size_t)cur.pm * tstep; const char* cB = (const char*)g.Bt + (size_t)cur.pn * tstep;
    S.a_ready(cur);
    if constexpr (SP2) {
        PG8_STAGE(PG8_SB(0, 0), cB, voffB); PG8_STAGE(PG8_SB(0, 1), cB + hstep, voffB); PG8_STAGE(PG8_SA(0, 0), cA, voffA); PG8_STAGE(PG8_SA(0, 1), cA + hstep, voffA);
        if (wr == 1) PG8_BAR;
        PG8_WAIT_V(2); PG8_BAR;
        PG8_STAGE(PG8_SB(1, 0), cB + kstep, voffB); PG8_STAGE(PG8_SA(1, 0), cA + kstep, voffA); PG8_STAGE(PG8_SB(1, 1), cB + hstep + kstep, voffB);
        PG8_WAIT_V(6); PG8_BAR;
    } else {
        PG8_STAGE(PG8_SB(0, 0), cB, voffB); PG8_STAGE(PG8_SA(0, 0), cA, voffA); PG8_STAGE(PG8_SB(0, 1), cB + hstep, voffB); PG8_STAGE(PG8_SA(0, 1), cA + hstep, voffA);
        if (wr == 1) PG8_BAR;
        PG8_WAIT_V(4); PG8_BAR;
        PG8_STAGE(PG8_SB(1, 0), cB + kstep, voffB); PG8_STAGE(PG8_SA(1, 0), cA + kstep, voffA); PG8_STAGE(PG8_SB(1, 1), cB + hstep + kstep, voffB);
        PG8_WAIT_V(6); PG8_BAR;
    }
    for (;;) {
        const bool has_next = S.next(ui + 1, nxt);
        const char* nA = has_next ? (const char*)g.A + (size_t)nxt.pm * tstep : cA; const char* nB = has_next ? (const char*)g.Bt + (size_t)nxt.pn * tstep : cB;
        for (int t = 0; t < nt; t += 2) {
            const bool last = (t == nt - 2);
            const char* a1 = cA + (size_t)(t + 1) * kstep;
            const char* a2 = last ? nA : cA + (size_t)(t + 2) * kstep; const char* b2 = last ? nB : cB + (size_t)(t + 2) * kstep;
            const char* a3 = a2 + kstep; const char* b3 = b2 + kstep;
            if (last && has_next) S.a_ready(nxt);
            if constexpr (SP2) {
            PG8_LDB(B0, 0, 0); PG8_LDB(B1, 0, 1); PG8_SCHED; PG8_LDA(At, 0, 0); PG8_STAGE(PG8_SA(1, 1), a1 + hstep, voffA);
            PG8_WAIT_V(8); PG8_WAIT_L(0); PG8_BAR; PG8_MMA(0, 0, At, B0); PG8_MMA(0, 1, At, B1); PG8_BAR; PG8_SCHED;
            PG8_LDA(At, 0, 1); PG8_STAGE(PG8_SB(0, 0), b2, voffB); PG8_STAGE(PG8_SB(0, 1), b2 + hstep, voffB); PG8_STAGE(PG8_SA(0, 0), a2, voffA);
            PG8_WAIT_V(8); PG8_WAIT_L(0); PG8_BAR; PG8_MMA(1, 0, At, B0); PG8_MMA(1, 1, At, B1); PG8_BAR; PG8_SCHED;
            PG8_LDB(B0, 1, 0); PG8_LDB(B1, 1, 1); PG8_SCHED; PG8_LDA(At, 1, 0); PG8_STAGE(PG8_SA(0, 1), a2 + hstep, voffA);
            PG8_WAIT_V(8); PG8_WAIT_L(0); PG8_BAR; PG8_MMA(0, 0, At, B0); PG8_MMA(0, 1, At, B1); PG8_BAR; PG8_SCHED;
            PG8_LDA(At, 1, 1); PG8_STAGE(PG8_SB(1, 0), b3, voffB); PG8_STAGE(PG8_SB(1, 1), b3 + hstep, voffB); PG8_STAGE(PG8_SA(1, 0), a3, voffA);
            PG8_WAIT_V(8); PG8_WAIT_L(0); PG8_BAR; PG8_MMA(1, 0, At, B0); PG8_MMA(1, 1, At, B1); PG8_BAR; PG8_SCHED;
            } else {
            PG8_LDB(B0, 0, 0); PG8_SCHED; PG8_LDA(At, 0, 0); PG8_STAGE(PG8_SA(1, 1), a1 + hstep, voffA);
            PG8_WAIT_L(8); PG8_BAR; PG8_WAIT_L(0); PG8_MMA(0, 0, At, B0); PG8_BAR; PG8_SCHED;
            PG8_LDB(B1, 0, 1); PG8_STAGE(PG8_SB(0, 0), b2, voffB);
            PG8_BAR; PG8_WAIT_L(0); PG8_MMA(0, 1, At, B1); PG8_BAR;
            PG8_LDA(At, 0, 1); PG8_STAGE(PG8_SA(0, 0), a2, voffA);
            PG8_BAR; PG8_WAIT_L(0); PG8_MMA(1, 0, At, B0); PG8_BAR; PG8_SCHED;
            PG8_STAGE(PG8_SB(0, 1), b2 + hstep, voffB);
            PG8_WAIT_V(6); PG8_BAR; PG8_MMA(1, 1, At, B1); PG8_BAR;
            PG8_LDB(B0, 1, 0); PG8_SCHED; PG8_LDA(At, 1, 0); PG8_STAGE(PG8_SA(0, 1), a2 + hstep, voffA);
            PG8_WAIT_L(8); PG8_BAR; PG8_WAIT_L(0); PG8_MMA(0, 0, At, B0); PG8_BAR; PG8_SCHED;
            PG8_LDB(B1, 1, 1); PG8_STAGE(PG8_SB(1, 0), b3, voffB);
            PG8_BAR; PG8_WAIT_L(0); PG8_MMA(0, 1, At, B1); PG8_BAR;
            PG8_LDA(At, 1, 1); PG8_STAGE(PG8_SA(1, 0), a3, voffA);
            PG8_BAR; PG8_WAIT_L(0); PG8_MMA(1, 0, At, B0); PG8_BAR; PG8_SCHED;
            PG8_STAGE(PG8_SB(1, 1), b3 + hstep, voffB);
            PG8_WAIT_V(6); PG8_BAR; PG8_MMA(1, 1, At, B1); PG8_BAR;
            }
        }
        if constexpr (ALIGN_EPI) { if (wr == 0) PG8_BAR; }
        if constexpr (!Epi::AFTER_DRAIN) { E(acc, cur, wr, wc, fr, fq); S.done(cur); }
        if (!has_next) break;
#pragma unroll
        for (int a = 0; a < 2; ++a)
#pragma unroll
            for (int b = 0; b < 2; ++b)
#pragma unroll
                for (int m = 0; m < 4; ++m)
#pragma unroll
                    for (int n = 0; n < 2; ++n) acc[a][b][m][n] = (f32x4){0.f, 0.f, 0.f, 0.f};
        cur = nxt; cA = nA; cB = nB; ++ui;
        if constexpr (ALIGN_EPI) { if (wr == 1) PG8_BAR; }
    }
    PG8_WAIT_V(0);
    if constexpr (!ALIGN_EPI) { if (wr == 0) PG8_BAR; }
    PG8_BAR;
    if constexpr (Epi::AFTER_DRAIN) { E.fused(acc, cur, wr, wc, fr, fq, lds, wid, lane); S.done(cur); }
#undef PG8_SA
#undef PG8_SB
#undef PG8_STAGE
#undef PG8_LDA
#undef PG8_LDB
#undef PG8_MMA
#undef PG8_WAIT_V
#undef PG8_WAIT_L
#undef PG8_BAR
#undef PG8_SCHED
}
}
#define XB_TMO      128
#define XB_XCNT(j)  (256  + 64 * (j))
#define XB_XSUB(j)  (1280 + 64 * (j))
#define XB_XGEN(j)  (2304 + 64 * (j))
#define XB_TOP      3328
#define XB_TOPGEN   3392
#define XCD_BAR_WORDS 3456
#define XB_SPIN_CAP (1u << 18)
#define LAS __attribute__((address_space(3)))

__device__ __forceinline__ unsigned xb_ld(unsigned* p)              { return __hip_atomic_load(p, __ATOMIC_RELAXED, __HIP_MEMORY_SCOPE_AGENT); }
__device__ __forceinline__ unsigned xb_add(unsigned* p, unsigned v) { return __hip_atomic_fetch_add(p, v, __ATOMIC_RELAXED, __HIP_MEMORY_SCOPE_AGENT); }
__device__ __forceinline__ unsigned xb_xcc_id() { return (unsigned)__builtin_amdgcn_s_getreg((3 << 11) | 20) & 0xFu; }
#define XB_SPIN(cond, bar) do { unsigned _sp = 0; while (cond) { __builtin_amdgcn_s_sleep(1); \
    if ((++_sp & 255u) == 0u) { if (xb_ld(&(bar)[XB_TMO])) break; if (_sp > XB_SPIN_CAP) { atomicAdd(&(bar)[XB_TMO], 1u); break; } } } } while (0)

struct XcdBarrier {
    unsigned* bar; unsigned x;
    volatile LAS unsigned* st;
};

__device__ __forceinline__ XcdBarrier xcd_barrier_post(unsigned* bar, volatile LAS unsigned* st) {
    XcdBarrier b; b.bar = bar; b.x = xb_xcc_id(); b.st = st;
    if (threadIdx.x == 0) (void)xb_add(&bar[XB_XCNT(b.x)], 1u);
    return b;
}
__device__ __forceinline__ void xcd_barrier_complete(unsigned* bar, unsigned x, unsigned& nloc, unsigned& nx) {
    const unsigned G = gridDim.x * gridDim.y * gridDim.z;
    unsigned sum, cnt, mine, sp = 0u;
    for (;;) {
        sum = 0u; cnt = 0u; mine = 0u;
#pragma unroll
        for (unsigned j = 0; j < 16; ++j) { const unsigned c = xb_ld(&bar[XB_XCNT(j)]); sum += c; cnt += (c > 0u) ? 1u : 0u; mine = (j == x) ? c : mine; }
        if (sum == G) break;
        __builtin_amdgcn_s_sleep(1);
        if ((++sp & 255u) == 0u) { if (xb_ld(&bar[XB_TMO])) break; if (sp > XB_SPIN_CAP) { atomicAdd(&bar[XB_TMO], 1u); break; } }
    }
    nloc = mine > 0u ? mine : 1u; nx = cnt > 0u ? cnt : 1u;
}

__device__ __forceinline__ void xcd_barrier(const XcdBarrier& b) {
    asm volatile("s_waitcnt vmcnt(0)" ::: "memory");
    __syncthreads();
    if (threadIdx.x == 0) {
        unsigned* bar = b.bar;
        __builtin_amdgcn_s_waitcnt(0);
        unsigned nloc = b.st[0], nx = b.st[1];
        if (nloc == 0u) { xcd_barrier_complete(bar, b.x, nloc, nx); b.st[0] = nloc; b.st[1] = nx; }
        const unsigned old = xb_add(&bar[XB_XSUB(b.x)], 1u);
        const unsigned gen = old / nloc;
        if (old + 1u == (gen + 1u) * nloc) {
            __builtin_amdgcn_fence(__ATOMIC_RELEASE, "agent");
            asm volatile("s_waitcnt vmcnt(0)" ::: "memory");
            const unsigned og = xb_add(&bar[XB_TOP], 1u);
            const unsigned tg = og / nx;
            if (og + 1u == (tg + 1u) * nx) xb_add(&bar[XB_TOPGEN], 1u);
            else XB_SPIN(xb_ld(&bar[XB_TOPGEN]) == tg, bar);
            __builtin_amdgcn_fence(__ATOMIC_ACQUIRE, "agent");
            xb_add(&bar[XB_XGEN(b.x)], 1u);
            asm volatile("s_waitcnt vmcnt(0)" ::: "memory");
        } else {
            XB_SPIN(xb_ld(&bar[XB_XGEN(b.x)]) == gen, bar);
            __builtin_amdgcn_fence(__ATOMIC_ACQUIRE, "agent");
            asm volatile("s_waitcnt vmcnt(0)" ::: "memory");
        }
    }
    __syncthreads();
}
constexpr int NWAVES = 8;
__device__ __forceinline__ float wave_sum(float v) {
#pragma unroll
    for (int o = 1; o < 64; o <<= 1) v += __shfl_xor(v, o);
    return v;
}
__device__ __forceinline__ void transpose_item(const float* W, int K, int N, bf16* WT, LAS float* scr, int item, int lane) {
    const int nblk = N / 32, kb = item / nblk, nb = item % nblk, k0 = 64 * kb, n0 = 32 * nb;
#pragma unroll 8
    for (int i = 0; i < 32; ++i) { const int kk = 2 * i + (lane >> 5); scr[kk * 33 + (lane & 31)] = W[(size_t)(k0 + kk) * N + n0 + (lane & 31)]; }
    LDS_WAIT(); asm volatile("" ::: "memory");
    const int c = lane & 7;
#pragma unroll
    for (int j = 0; j < 4; ++j) { const int n = (lane >> 3) + 8 * j; const LAS float* s = scr + (8 * c) * 33 + n;
        v4u o; o.x = cvtpk(s[0 * 33], s[1 * 33]); o.y = cvtpk(s[2 * 33], s[3 * 33]); o.z = cvtpk(s[4 * 33], s[5 * 33]); o.w = cvtpk(s[6 * 33], s[7 * 33]);
        *(v4u*)(WT + (size_t)(n0 + n) * K + k0 + 8 * c) = o; }
    LDS_WAIT(); asm volatile("" ::: "memory");
}
__device__ __forceinline__ void transpose_matrix(const float* W, int K, int N, bf16* WT, LAS float* scr, int gw, int ngw, int lane) {
    const int nitems = (K / 64) * (N / 32);
    for (int it = gw; it < nitems; it += ngw) transpose_item(W, K, N, WT, scr, it, lane);
}
struct ProArgs { const float* fox_w_in; const float* fox_w_out; const float* hgrn_w_in; const float* hgrn_w_out; const float* up; const float* down; const float* lb_logits; };
__device__ __forceinline__ void prologue_phase(LAS unsigned char* lds, unsigned char* ws, const ProArgs& a, int vcu, int G) {
    const int tid = opaque_tid(), lane = tid & 63, wave = tid >> 6;
    LAS float* scr = (LAS float*)(lds + wave * 16384);
    const int gw = vcu * NWAVES + wave, ngw = G * NWAVES;
    for (int j = 0; j < 2; ++j) {
        transpose_matrix(a.fox_w_in + (size_t)j * DM * FOX_IN, DM, FOX_IN, (bf16*)(ws + WS_WFIN) + (size_t)j * FOX_INP * DM, scr, gw, ngw, lane);
        transpose_matrix(a.fox_w_out + (size_t)j * DM * DM, DM, DM, (bf16*)(ws + WS_WFOUT) + (size_t)j * DM * DM, scr, gw, ngw, lane);
        transpose_matrix(a.hgrn_w_in + (size_t)j * DM * HG_IN, DM, HG_IN, (bf16*)(ws + WS_WHIN) + (size_t)j * HG_IN * DM, scr, gw, ngw, lane);
        transpose_matrix(a.hgrn_w_out + (size_t)j * DM * DM, DM, DM, (bf16*)(ws + WS_WHOUT) + (size_t)j * DM * DM, scr, gw, ngw, lane);
        { v4u* z = (v4u*)((bf16*)(ws + WS_WFIN) + (size_t)j * FOX_INP * DM + (size_t)FOX_IN * DM); const size_t n16 = (size_t)(FOX_INP - FOX_IN) * DM * 2 / 16;
          for (size_t i = (size_t)(vcu * 512 + tid); i < n16; i += (size_t)G * 512) z[i] = (v4u){0u, 0u, 0u, 0u}; }
    }
    for (int j = 0; j < 4; ++j) {
        transpose_matrix(a.up + (size_t)j * DM * DFF, DM, DFF, (bf16*)(ws + WS_WUP) + (size_t)j * DFF * DM, scr, gw, ngw, lane);
        transpose_matrix(a.down + (size_t)j * DFF * DM, DFF, DM, (bf16*)(ws + WS_WDN) + (size_t)j * DM * DFF, scr, gw, ngw, lane);
    }
    for (int c = vcu * 512 + tid; c < DM; c += G * 512) {
        float l[4], mx = -1e30f; for (int i = 0; i < 4; ++i) { l[i] = a.lb_logits[i * DM + c]; mx = fmaxf(mx, l[i]); }
        float s = 0.f; for (int i = 0; i < 4; ++i) { l[i] = expf(l[i] - mx); s += l[i]; }
        float* LB = (float*)(ws + WS_LB); float cum = 0.f; const float p0 = l[0] / s;
        for (int i = 0; i < 4; ++i) { cum += l[i] / s; LB[i * DM + c] = cum - p0; }
    }
}
template <bool TO_F32>
__device__ __forceinline__ void rms_phase(const float* src, const float* gain, void* dst, int vcu, int G) {
    const int tid = opaque_tid(), lane = tid & 63, wave = tid >> 6;
    const int gw = vcu * NWAVES + wave, ngw = G * NWAVES;
    for (int row = gw; row < SEQ; row += ngw) {
        const f32x4* xr = (const f32x4*)(src + (size_t)row * DM) + lane;
        f32x4 v[16]; float ss = 0.f;
#pragma unroll
        for (int j = 0; j < 16; ++j) { v[j] = xr[64 * j]; ss += (v[j].x * v[j].x + v[j].y * v[j].y) + (v[j].z * v[j].z + v[j].w * v[j].w); }
        const float rstd = rsqrtf(wave_sum(ss) * (1.f / DM) + NORM_EPS);
        const f32x4* gr = (const f32x4*)gain + lane;
#pragma unroll
        for (int j = 0; j < 16; ++j) { const f32x4 g = gr[64 * j]; const f32x4 o = v[j] * rstd * g;
            if constexpr (TO_F32) ((f32x4*)((float*)dst + (size_t)row * DM) + lane)[64 * j] = o;
            else { v2u w; w.x = cvtpk(o.x, o.y); w.y = cvtpk(o.z, o.w); ((v2u*)((bf16*)dst + (size_t)row * DM) + lane)[64 * j] = w; } }
    }
}
__device__ __forceinline__ void fox_thin_phase(LAS unsigned char* lds, bf16* PROJ, const float* LOGF, float* KB, const float* qg, const float* kg, int vcu, int G) {
    const int tid = opaque_tid(), lane = tid & 63, wave = tid >> 6;
    LAS float* red = (LAS float*)lds;
    LAS float* pre = red + 64 * 32;
    for (int blk = vcu; blk < SEQ / 64; blk += G) {
        const int r0 = blk * 64;
        { const int h4 = tid & 7, part = tid >> 3; f32x4 a = {0.f, 0.f, 0.f, 0.f};
          for (int r = part; r < r0; r += 64) a += *(const f32x4*)(LOGF + (size_t)r * 32 + 4 * h4);
          *(LAS f32x4*)(red + part * 32 + 4 * h4) = a; }
        __syncthreads();
        if (tid < 32) { float s = 0.f; for (int p = 0; p < 64; ++p) s += red[p * 32 + tid]; pre[tid] = s; }
        __syncthreads();
        if (tid < 32) { float c = pre[tid];
            for (int r = 0; r < 64; ++r) { c += LOGF[(size_t)(r0 + r) * 32 + tid]; KB[(size_t)tid * SEQ + r0 + r] = -c * LOG2E; } }
        const int sub = lane >> 4, l16 = lane & 15;
        f32x4 gq0 = *(const f32x4*)(qg + 8 * l16) * QSCALE, gq1 = *(const f32x4*)(qg + 8 * l16 + 4) * QSCALE, gk0 = *(const f32x4*)(kg + 8 * l16), gk1 = *(const f32x4*)(kg + 8 * l16 + 4);
        for (int it = wave; it < 64 * 16; it += NWAVES) {
            const int row = it >> 4, vec = (it & 15) * 4 + sub;
            v4u* p = (v4u*)(PROJ + (size_t)(r0 + row) * 16384 + vec * 128 + 8 * l16);
            const v4u w = *p;
            float x[8] = {bflo(w.x), bfhi(w.x), bflo(w.y), bfhi(w.y), bflo(w.z), bfhi(w.z), bflo(w.w), bfhi(w.w)};
            float ss = 0.f;
#pragma unroll
            for (int j = 0; j < 8; ++j) ss += x[j] * x[j];
            ss += __shfl_xor(ss, 1); ss += __shfl_xor(ss, 2); ss += __shfl_xor(ss, 4); ss += __shfl_xor(ss, 8);
            const float rstd = rsqrtf(ss * (1.f / 128.f) + NORM_EPS);
            const bool isq = vec < 32; const f32x4 g0 = isq ? gq0 : gk0, g1 = isq ? gq1 : gk1;
            v4u o; o.x = cvtpk(x[0] * rstd * g0.x, x[1] * rstd * g0.y); o.y = cvtpk(x[2] * rstd * g0.z, x[3] * rstd * g0.w);
            o.z = cvtpk(x[4] * rstd * g1.x, x[5] * rstd * g1.y); o.w = cvtpk(x[6] * rstd * g1.z, x[7] * rstd * g1.w);
            *p = o;
        }
        __syncthreads();
    }
}
namespace fa {
constexpr int D = 128, NW = 8, QBLK = 32, KVBLK = 64, QB = NW * QBLK;
constexpr int LDQ = 16384, LDO = 4096;
constexpr int SHM_V = KVBLK * D * 2, SHM_K = KVBLK * D * 2;
constexpr int OFF_WS = 2 * SHM_V + 2 * SHM_K, OFF_KB = OFF_WS + NW * 64 * 4;
constexpr int LDS_BYTES = OFF_KB + 2 * 64 * 4;
constexpr float THR2 = 11.5f;
#define KSWZ(row, colB) ((row) * 256 + ((colB) ^ (((row) & 7) << 4)))
#define SBAR() __builtin_amdgcn_sched_barrier(0)
__device__ __forceinline__ int v_st(int k, int c) { const int kk = (k & ~0xC) | ((k & 4) << 1) | ((k & 8) >> 1); return ((kk >> 3) * 4 + (c >> 5)) * 512 + ((kk & 7) * 32 + (c & 31)) * 2; }
__device__ __forceinline__ int v_rd_base(int lane) { return ((lane & 3) << 3) | (((lane >> 2) & 3) << 6) | (((lane >> 4) & 1) << 5) | (((lane >> 5) & 1) << 8); }
constexpr int v_rd_off(int d0, int ks, int half) { return d0 * 512 + ks * 4096 + half * 2048; }
__device__ __forceinline__ int crow(int r, int hi) { return (r & 3) + 8 * (r >> 2) + 4 * hi; }
__device__ __forceinline__ bf16x8 ld8(const bf16* p) { return *reinterpret_cast<const bf16x8*>(p); }
__device__ __forceinline__ void mask_tile(f32x16& p0, f32x16& p1, int dq) {
    const float NEG = -__builtin_inff();
#pragma unroll
    for (int r = 0; r < 16; ++r) {
        const int c = (r & 3) + 8 * (r >> 2);
        if (dq - c < 0) p0[r] = NEG;
        if (dq - c - 32 < 0) p1[r] = NEG;
    }
}
__device__ __forceinline__ void partialSM(f32x16& p0, f32x16& p1, float& m_reg, float& mn, float& alpha) {
    float pmax = p0[0];
#pragma unroll
    for (int r = 1; r < 16; ++r) pmax = fmaxf(pmax, p0[r]);
#pragma unroll
    for (int r = 0; r < 16; ++r) pmax = fmaxf(pmax, p1[r]);
    { auto rr = __builtin_amdgcn_permlane32_swap(__float_as_uint(pmax), __float_as_uint(pmax), false, false);
      pmax = fmaxf(__uint_as_float(rr[0]), __uint_as_float(rr[1])); }
    if (__builtin_expect(__all(pmax - m_reg <= THR2), 1)) { mn = m_reg; alpha = 1.f; }
    else { mn = fmaxf(m_reg, pmax); alpha = __builtin_amdgcn_exp2f(m_reg - mn); m_reg = mn; }
#pragma unroll
    for (int r = 0; r < 16; ++r) p0[r] = p0[r] - mn;
#pragma unroll
    for (int r = 0; r < 16; ++r) p1[r] = p1[r] - mn;
#pragma unroll
    for (int r = 0; r < 16; ++r) p0[r] = __builtin_amdgcn_exp2f(p0[r]);
}
__device__ __forceinline__ void finishSM(f32x16& p0, f32x16& p1, float alpha, float& l_reg, bf16x8& pa0, bf16x8& pa1, bf16x8& pa2, bf16x8& pa3) {
#pragma unroll
    for (int r = 0; r < 16; ++r) p1[r] = __builtin_amdgcn_exp2f(p1[r]);
    float ps = 0;
#pragma unroll
    for (int r = 0; r < 16; ++r) ps += p0[r];
#pragma unroll
    for (int r = 0; r < 16; ++r) ps += p1[r];
    { auto rr = __builtin_amdgcn_permlane32_swap(__float_as_uint(ps), __float_as_uint(ps), false, false);
      ps = __uint_as_float(rr[0]) + __uint_as_float(rr[1]); }
    l_reg = l_reg * alpha + ps;
#define PK4(P, B_, OUT) do { unsigned a0 = cvtpk(P[B_+0], P[B_+1]), a1 = cvtpk(P[B_+2], P[B_+3]);                          \
        unsigned b0 = cvtpk(P[B_+4], P[B_+5]), b1 = cvtpk(P[B_+6], P[B_+7]);                                             \
        auto r0 = __builtin_amdgcn_permlane32_swap(a0, b0, false, false); auto r1 = __builtin_amdgcn_permlane32_swap(a1, b1, false, false); \
        v4u w = {r0[0], r1[0], r0[1], r1[1]}; OUT = *reinterpret_cast<bf16x8*>(&w); } while (0)
    PK4(p0, 0, pa0); PK4(p0, 8, pa1); PK4(p1, 0, pa2); PK4(p1, 8, pa3);
#undef PK4
}
template <int KB>
__device__ __forceinline__ void qkt(f32x16& p0, f32x16& p1, const char* K_lds, const float* kbl, int r32, int hi, const bf16x8* qr) {
#ifdef X_NOBIAS
    p0 = f32x16{}; p1 = f32x16{};
#else
    { const float* kb = kbl + KB * 64 + 4 * hi;
      const f32x4 a0 = *(const f32x4*)(kb), a1 = *(const f32x4*)(kb + 8), a2 = *(const f32x4*)(kb + 16), a3 = *(const f32x4*)(kb + 24);
      const f32x4 b0 = *(const f32x4*)(kb + 32), b1 = *(const f32x4*)(kb + 40), b2 = *(const f32x4*)(kb + 48), b3 = *(const f32x4*)(kb + 56);
      p0 = f32x16{a0[0], a0[1], a0[2], a0[3], a1[0], a1[1], a1[2], a1[3], a2[0], a2[1], a2[2], a2[3], a3[0], a3[1], a3[2], a3[3]};
      p1 = f32x16{b0[0], b0[1], b0[2], b0[3], b1[0], b1[1], b1[2], b1[3], b2[0], b2[1], b2[2], b2[3], b3[0], b3[1], b3[2], b3[3]}; }
#endif
    const char* kb4[4];
#pragma unroll
    for (int dd = 0; dd < 4; ++dd) kb4[dd] = K_lds + KB * SHM_K + KSWZ(r32, (dd * 16 + hi * 8) * 2);
#pragma unroll
    for (int d0 = 0; d0 < 8; ++d0) { const char* a = kb4[d0 & 3] + (d0 >> 2) * 128;
        bf16x8 b0 = *reinterpret_cast<const bf16x8*>(a);
        bf16x8 b1 = *reinterpret_cast<const bf16x8*>(a + 32 * 256);
        p0 = __builtin_amdgcn_mfma_f32_32x32x16_bf16(b0, qr[d0], p0, 0, 0, 0);
        p1 = __builtin_amdgcn_mfma_f32_32x32x16_bf16(b1, qr[d0], p1, 0, 0, 0); }
}
template <int VB>
__device__ __forceinline__ void pv_tile(f32x16* o, int vb0, bf16x8 pa0, bf16x8 pa1, bf16x8 pa2, bf16x8 pa3) {
#define TRRD(dst, off) asm volatile("ds_read_b64_tr_b16 %0, %1 offset:%2" : "=&v"(dst) : "v"(vb0), "i"(off) : "memory")
#define PV_D0(d0) do { s16x4 l0, l1, l2, l3, h0, h1, h2, h3; constexpr int b_ = VB * SHM_V + v_rd_off(d0, 0, 0); \
        TRRD(l0, b_); TRRD(h0, b_ + 2048); TRRD(l1, b_ + 4096); TRRD(h1, b_ + 6144); TRRD(l2, b_ + 8192); TRRD(h2, b_ + 10240); TRRD(l3, b_ + 12288); TRRD(h3, b_ + 14336); \
        asm volatile("s_waitcnt lgkmcnt(0)" ::: "memory"); SBAR();   \
        o[d0] = __builtin_amdgcn_mfma_f32_32x32x16_bf16(pa0, (bf16x8){l0[0], l0[1], l0[2], l0[3], h0[0], h0[1], h0[2], h0[3]}, o[d0], 0, 0, 0);   \
        o[d0] = __builtin_amdgcn_mfma_f32_32x32x16_bf16(pa1, (bf16x8){l1[0], l1[1], l1[2], l1[3], h1[0], h1[1], h1[2], h1[3]}, o[d0], 0, 0, 0);   \
        o[d0] = __builtin_amdgcn_mfma_f32_32x32x16_bf16(pa2, (bf16x8){l2[0], l2[1], l2[2], l2[3], h2[0], h2[1], h2[2], h2[3]}, o[d0], 0, 0, 0);   \
        o[d0] = __builtin_amdgcn_mfma_f32_32x32x16_bf16(pa3, (bf16x8){l3[0], l3[1], l3[2], l3[3], h3[0], h3[1], h3[2], h3[3]}, o[d0], 0, 0, 0); } while (0)
    PV_D0(0); PV_D0(1); PV_D0(2); PV_D0(3);
#undef PV_D0
#undef TRRD
}
struct BlockRef { const bf16* Q; const bf16* K; const bf16* V; const float* KBp; const bf16* G; bf16* O; int P0; };
struct Seam { bf16x8 qr[8]; bf16x8 st_v0, st_v1, st_k0, st_k1; float st_b; };
#define ROWP(p, k0, rr) ((const char*)(p) + (size_t)((k0) + (rr)) * (LDQ * 2))
#define LD8V(base, off) (*reinterpret_cast<const bf16x8*>((base) + (off)))
#define VMW() asm volatile("s_waitcnt vmcnt(0)" ::: "memory")
#define VMWN(n) asm volatile("s_waitcnt vmcnt(%0)" :: "i"(n) : "memory")
#define SLOAD_H(Kp, Vp, Bp, k0) do { S.st_v0 = LD8V(ROWP(Vp, k0, 0), voff); S.st_v1 = LD8V(ROWP(Vp, k0, 32), voff);              \
                         S.st_k0 = LD8V(ROWP(Kp, k0, 0), voff); S.st_k1 = LD8V(ROWP(Kp, k0, 32), voff); \
                         if (tid < 64) S.st_b = *(const float*)((const char*)((Bp) + (k0)) + (unsigned)(tid * 4)); } while (0)
#define SWRITE_HK(bf) do { *(bf16x8*)(K_lds + (bf) * SHM_K + kws) = S.st_k0; *(bf16x8*)(K_lds + (bf) * SHM_K + kws + 32 * 256) = S.st_k1; if (tid < 64) kbl[(bf) * 64 + tid] = S.st_b; } while (0)
#define SWRITE_HV(bf) do { *(bf16x8*)(V_lds + (bf) * SHM_V + vst0) = S.st_v0; *(bf16x8*)(V_lds + (bf) * SHM_V + vst1) = S.st_v1; } while (0)
#define SWRITE_H(bf) do { SWRITE_HV(bf); SWRITE_HK(bf); } while (0)
__device__ __forceinline__ void fox_prime(const BlockRef& cur, char* lds, Seam& S) {
    const int tid = opaque_tid(), wid = __builtin_amdgcn_readfirstlane(tid >> 6), lane = tid & 63, r32 = lane & 31, hi = lane >> 5;
    const int sr = tid >> 4, sc = (tid & 15) * 8, kws = KSWZ(sr, sc * 2); char* K_lds = lds + 2 * SHM_V; float* kbl = (float*)(lds + OFF_KB);
    const unsigned voff = (unsigned)(sr * LDQ + sc) * 2u, qoff = (unsigned)(r32 * LDQ + hi * 8) * 2u;
    { const char* qb_ = (const char*)(cur.Q + (size_t)(wid * QBLK) * LDQ);
#pragma unroll
      for (int d0 = 0; d0 < 8; ++d0) S.qr[d0] = LD8V(qb_ + d0 * 32, qoff); }
    SLOAD_H(cur.K, cur.V, cur.KBp, 0); VMW(); SWRITE_HK(0);
    __syncthreads();
}
__device__ __forceinline__ void fox_block(const BlockRef& cur, const BlockRef& nxt, char* lds, Seam& S) {
    const int tid = opaque_tid(), wid = __builtin_amdgcn_readfirstlane(tid >> 6), lane = tid & 63, r32 = lane & 31, hi = lane >> 5;
    const int NT = (cur.P0 + QB - 1) / KVBLK + 1;
    const int qlo = cur.P0 + wid * QBLK, qm = qlo + r32 - 4 * hi;
    char* V_lds = lds; char* K_lds = lds + 2 * SHM_V; float* kbl = (float*)(lds + OFF_KB);
    float* ws = (float*)(lds + OFF_WS) + wid * 64; float* li_l = ws, * al_l = ws + 32;
    float m_reg = -1e30f, l_reg = 0; f32x16 o[4] = {};
    const int sr = tid >> 4, sc = (tid & 15) * 8, vst0 = v_st(sr, sc), vst1 = v_st(32 + sr, sc), kws = KSWZ(sr, sc * 2);
    const unsigned voff = (unsigned)(sr * LDQ + sc) * 2u, qoff = (unsigned)(r32 * LDQ + hi * 8) * 2u;
    const int vb0 = (int)(uintptr_t)V_lds + v_rd_base(lane);
    const bf16* Kh = cur.K; const bf16* Vh = cur.V; const float* Bh = cur.KBp;
#define RESC(a) do { if (__any((a) < 1.f)) { if (hi == 0) al_l[r32] = (a); asm volatile("s_waitcnt lgkmcnt(0)" ::: "memory");              \
                     for (int d_ = 0; d_ < 4; ++d_) for (int r = 0; r < 16; ++r) o[d_][r] *= al_l[crow(r, hi)]; } } while (0)
#define KBASE(t) ((t) * KVBLK)
#define MASKT(P0_, P1_, t) do { const int kb_ = KBASE(t); if (kb_ + KVBLK - 1 > qlo) mask_tile(P0_, P1_, qm - kb_); } while (0)
    constexpr int NQL = 8;
#define SEAM_K0() do { VMWN(NQL); SWRITE_HK(0); SBAR(); } while (0)
    f32x16 pA0, pA1, pB0, pB1; float mnA, mnB, alA, alB; bf16x8 pa0, pa1, pa2, pa3;
    SWRITE_HV(0); SBAR();
    if (NT > 1) { SLOAD_H(Kh, Vh, Bh, KBASE(1)); }
    SBAR(); qkt<0>(pA0, pA1, K_lds, kbl, r32, hi, S.qr);
    MASKT(pA0, pA1, 0); partialSM(pA0, pA1, m_reg, mnA, alA);
    if (NT > 1) { VMW(); SWRITE_H(1); }
    __syncthreads();
#define HALF_STEP(PX0, PX1, mnX, alX, PY0, PY1, alY, t, KB, VB, SB) do {                                                      \
        SBAR(); qkt<KB>(PX0, PX1, K_lds, kbl, r32, hi, S.qr);                                             \
        finishSM(PY0, PY1, alY, l_reg, pa0, pa1, pa2, pa3); SBAR();                                                           \
        if ((t) + 1 < NT) { SLOAD_H(Kh, Vh, Bh, KBASE((t) + 1)); SBAR(); }                                               \
        pv_tile<VB>(o, vb0, pa0, pa1, pa2, pa3); MASKT(PX0, PX1, (t)); partialSM(PX0, PX1, m_reg, mnX, alX);                                        \
        __syncthreads();                                                                                                      \
        if ((t) + 1 < NT) { VMW(); SWRITE_H(SB); }                                                                          \
        RESC(alX); __syncthreads(); } while (0)
    for (int t = 1; t + 1 < NT; t += 2) {
        HALF_STEP(pB0, pB1, mnB, alB, pA0, pA1, alA, t, 1, 0, 0);
        HALF_STEP(pA0, pA1, mnA, alA, pB0, pB1, alB, t + 1, 0, 1, 1);
    }
    const bool even = (NT & 1) == 0;
    if (even) { SBAR(); qkt<1>(pB0, pB1, K_lds, kbl, r32, hi, S.qr); SBAR(); }
    SLOAD_H(nxt.K, nxt.V, nxt.KBp, 0); SBAR();
    { const char* qb_ = (const char*)(nxt.Q + (size_t)(wid * QBLK) * LDQ);
#pragma unroll
      for (int d0 = 0; d0 < 8; ++d0) S.qr[d0] = LD8V(qb_ + d0 * 32, qoff); }
    SBAR();
    finishSM(pA0, pA1, alA, l_reg, pa0, pa1, pa2, pa3); SBAR();
    pv_tile<0>(o, vb0, pa0, pa1, pa2, pa3);
    if (even) { MASKT(pB0, pB1, NT - 1); partialSM(pB0, pB1, m_reg, mnB, alB); __syncthreads(); RESC(alB);
        finishSM(pB0, pB1, alB, l_reg, pa0, pa1, pa2, pa3); SBAR(); pv_tile<1>(o, vb0, pa0, pa1, pa2, pa3); }
    SBAR(); SEAM_K0();
    if (hi == 0) li_l[r32] = l_reg; asm volatile("s_waitcnt lgkmcnt(0)" ::: "memory");
    float rli[16];
#pragma unroll
    for (int r = 0; r < 16; ++r) rli[r] = __builtin_amdgcn_rcpf(li_l[crow(r, hi)]);
    const char* Ob = (const char*)(cur.O + (size_t)(wid * QBLK) * LDO); const char* Gb = (const char*)(cur.G + (size_t)(wid * QBLK) * LDQ);
    const unsigned voffO = (unsigned)((4 * hi) * LDO + r32) * 2u, voffG = (unsigned)((4 * hi) * LDQ + r32) * 2u;
#pragma unroll
    for (int r = 0; r < 16; ++r) { const int rc = (r & 3) + 8 * (r >> 2);
        const char* Or = Ob + (size_t)rc * LDO * 2; const char* Gr = Gb + (size_t)rc * LDQ * 2;
#pragma unroll
        for (int d0 = 0; d0 < 4; ++d0) { const float v = o[d0][r] * rli[r]; const float vn = __shfl_xor(v, 1);
#ifdef X_NOGATE
            if ((r32 & 1) == 0) { *(unsigned*)(Or + d0 * 64 + voffO) = cvtpk(v, vn); } }
#else
            if ((r32 & 1) == 0) { const unsigned g2 = *(const unsigned*)(Gr + d0 * 64 + voffG);
                *(unsigned*)(Or + d0 * 64 + voffO) = cvtpk(v * bflo(g2), vn * bfhi(g2)); } }
#endif
        if ((r & 3) == 3) asm volatile("" ::: "memory"); }
    __syncthreads();
#undef RESC
#undef KBASE
#undef MASKT
#undef SEAM_K0
#undef HALF_STEP
}
#undef ROWP
#undef LD8V
#undef VMWN
#undef SLOAD_H
#undef SWRITE_HK
#undef SWRITE_HV
#undef SWRITE_H
__device__ __forceinline__ BlockRef mk_ref(const bf16* PROJ, const float* KBg, bf16* MO, int bh, int qb) {
    BlockRef r; r.Q = PROJ + (size_t)(qb * QB) * LDQ + bh * D; r.K = PROJ + 4096 + bh * D; r.V = PROJ + 8192 + bh * D; r.KBp = KBg + (size_t)bh * SEQ;
    r.G = PROJ + (size_t)(qb * QB) * LDQ + 12288 + bh * D; r.O = MO + (size_t)(qb * QB) * LDO + bh * D; r.P0 = qb * QB; return r;
}
__device__ __forceinline__ void decode(int L, int& bh, int& q0, int& q1) { const int xcd = L & 7, k = L >> 3, gi = k >> 5, x = k & 31; bh = gi * 8 + xcd; q0 = x; q1 = 63 - x; }
__device__ __forceinline__ void attn_phase(char* lds, const bf16* PROJ, const float* KBg, bf16* MO, int c, int G) {
    constexpr int total = 32 * 32;
    int L = c; if (L >= total) return;
    int bh, q0, q1; decode(L, bh, q0, q1); int pass = 0;
    BlockRef cur = mk_ref(PROJ, KBg, MO, bh, q0);
    Seam S;
    fox_prime(cur, lds, S);
    for (;;) {
        const bool more_pass = pass == 0, more_item = L + G < total, last = !more_pass && !more_item;
        int bhn = bh, q0n = q0, q1n = q1, passn = pass + 1, Ln = L;
        if (!more_pass) { passn = 0; Ln = more_item ? L + G : L; decode(Ln, bhn, q0n, q1n); }
        const BlockRef nxt = last ? cur : mk_ref(PROJ, KBg, MO, bhn, passn ? q1n : q0n);
        fox_block(cur, nxt, lds, S);
        if (last) break;
        cur = nxt; bh = bhn; q0 = q0n; q1 = q1n; pass = passn; L = Ln;
    }
}
#undef VMW
}
namespace hg {
constexpr int CH = 64, NCH = SEQ / CH;
constexpr int PK = 144;
constexpr int PQ = 272;
__device__ __forceinline__ f32x4 mma(bf16x8 bfrag, bf16x8 afrag, f32x4 acc) { return __builtin_amdgcn_mfma_f32_16x16x32_bf16(bfrag, afrag, acc, 0, 0, 0); }
__device__ __forceinline__ bf16x8 ldsfrag(const LAS unsigned char* base, int row, int pitch, int kbyte) { return *(const LAS bf16x8*)(base + row * pitch + kbyte); }

__device__ __forceinline__ void b1_phase(LAS unsigned char* lds, const bf16* PROJ, const float* Gg, float* UT, float* DEC, int vcu, int G) {
    const int tid = opaque_tid(), lane = tid & 63, wave = __builtin_amdgcn_readfirstlane(tid >> 6), col = tid & 127, sg = tid >> 7, r = lane & 15, q = lane >> 4;
    LAS unsigned char* KT = lds;
    LAS unsigned char* VT = lds + 128 * PK;
    LAS float* segtot = (LAS float*)(lds + 2 * 128 * PK);
    for (int u = vcu; u < NCH * NH; u += G) {
        const int c = u >> 5, h = u & 31; const int row0 = c * CH + 16 * sg;
        float b[16];
#pragma unroll
        for (int j = 0; j < 16; ++j) b[j] = Gg[(size_t)(row0 + j) * DM + h * DH + col];
        unsigned short kk[16], vv[16];
#pragma unroll
        for (int j = 0; j < 16; ++j) { kk[j] = PROJ[(size_t)(row0 + j) * 16384 + 4096 + h * DH + col]; vv[j] = PROJ[(size_t)(row0 + j) * 16384 + 8192 + h * DH + col]; }
#pragma unroll
        for (int j = 1; j < 16; ++j) b[j] += b[j - 1];
        segtot[sg * 128 + col] = b[15];
        __syncthreads();
        float off = 0.f, total = 0.f;
#pragma unroll
        for (int s2 = 0; s2 < 4; ++s2) { const float t = segtot[s2 * 128 + col]; total += t; if (s2 < sg) off += t; }
        const float rem = total - off;
        unsigned kw[8], vw[8];
#pragma unroll
        for (int j = 0; j < 8; ++j) { kw[j] = cvtpk(bf2f(kk[2 * j]) * fexp(rem - b[2 * j]), bf2f(kk[2 * j + 1]) * fexp(rem - b[2 * j + 1])); vw[j] = (unsigned)vv[2 * j] | ((unsigned)vv[2 * j + 1] << 16); }
        *(LAS v4u*)(KT + col * PK + 32 * sg) = (v4u){kw[0], kw[1], kw[2], kw[3]}; *(LAS v4u*)(KT + col * PK + 32 * sg + 16) = (v4u){kw[4], kw[5], kw[6], kw[7]};
        *(LAS v4u*)(VT + col * PK + 32 * sg) = (v4u){vw[0], vw[1], vw[2], vw[3]}; *(LAS v4u*)(VT + col * PK + 32 * sg + 16) = (v4u){vw[4], vw[5], vw[6], vw[7]};
        if (sg == 0) DEC[(size_t)u * 128 + col] = fexp(total);
        __syncthreads();
        const bf16x8 a0 = ldsfrag(VT, 16 * wave + r, PK, 16 * q), a1 = ldsfrag(VT, 16 * wave + r, PK, 64 + 16 * q);
        float* up = UT + ((size_t)u * 128 + 16 * wave + r) * 128 + 4 * q;
#pragma unroll
        for (int nt = 0; nt < 8; ++nt) { f32x4 acc = {0.f, 0.f, 0.f, 0.f};
            acc = mma(ldsfrag(KT, 16 * nt + r, PK, 16 * q), a0, acc); acc = mma(ldsfrag(KT, 16 * nt + r, PK, 64 + 16 * q), a1, acc);
            *(f32x4*)(up + 16 * nt) = acc; }
        __syncthreads();
    }
}
__device__ __forceinline__ void b2_phase(const float* UT, const float* DEC, bf16* ST, int vcu, int G) {
    for (int gid = vcu * 512 + opaque_tid(); gid < NH * 128 * 32; gid += G * 512) {
        const int h = gid >> 12, dv = (gid >> 5) & 127, dk4 = (gid & 31) * 4;
        f32x4 st = {0.f, 0.f, 0.f, 0.f};
        const size_t eo = ((size_t)h * 128 + dv) * 128 + dk4, estep = (size_t)NH * 128 * 128;
        const size_t dofs = (size_t)h * 128 + dk4, dstep = (size_t)NH * 128;
#pragma unroll 8
        for (int c = 0; c < NCH; ++c) {
            const f32x4 uu = *(const f32x4*)(UT + eo + c * estep); const f32x4 dd = *(const f32x4*)(DEC + dofs + c * dstep);
            v2u w; w.x = cvtpk(st.x, st.y); w.y = cvtpk(st.z, st.w); *(v2u*)(ST + eo + c * estep) = w;
            st = dd * st + uu;
        }
    }
}
constexpr int B3_QT = 0, B3_QH = B3_QT + 64 * PQ, B3_KH = B3_QH + 64 * PQ  , B3_VT = B3_KH + 160 * PQ, B3_P = B3_VT + 128 * PK, B3_SEG = B3_P + 64 * PK, B3_RS = B3_SEG + 2048, B3_END = B3_RS + 512;
__device__ __forceinline__ int kh_base(int I) { return 16 * (I * (I + 1) / 2); }
__device__ __forceinline__ void b3_phase(LAS unsigned char* lds, const bf16* PROJ, const float* Gg, const bf16* ST, const float* ogain, bf16* MO, int vcu, int G) {
    const int tid = opaque_tid(), lane = tid & 63, wave = __builtin_amdgcn_readfirstlane(tid >> 6), col = tid & 127, sg = tid >> 7, r = lane & 15, q = lane >> 4;
    LAS unsigned char* QT = lds + B3_QT; LAS unsigned char* QH = lds + B3_QH; LAS unsigned char* KH = lds + B3_KH; LAS unsigned char* VT = lds + B3_VT; LAS unsigned char* PP = lds + B3_P;
    LAS float* segtot = (LAS float*)(lds + B3_SEG); LAS float* rs = (LAS float*)(lds + B3_RS);
    for (int u = vcu; u < NCH * NH; u += G) {
        const int c = u >> 5, h = u & 31; const int row0 = c * CH + 16 * sg;
        float b[16];
#pragma unroll
        for (int j = 0; j < 16; ++j) b[j] = Gg[(size_t)(row0 + j) * DM + h * DH + col];
        unsigned short qq[16], kk[16], vv[16];
#pragma unroll
        for (int j = 0; j < 16; ++j) { const bf16* p = PROJ + (size_t)(row0 + j) * 16384 + h * DH + col; qq[j] = p[0]; kk[j] = p[4096]; vv[j] = p[8192]; }
#pragma unroll
        for (int j = 1; j < 16; ++j) b[j] += b[j - 1];
        segtot[sg * 128 + col] = b[15];
        __syncthreads();
        float st[4];
#pragma unroll
        for (int s2 = 0; s2 < 4; ++s2) st[s2] = segtot[s2 * 128 + col];
        float off = 0.f;
#pragma unroll
        for (int s2 = 0; s2 < 4; ++s2) if (s2 < sg) off += st[s2];
#pragma unroll
        for (int j = 0; j < 16; ++j) { const float qf = bf2f(qq[j]);
            *(LAS bf16*)(QT + (16 * sg + j) * PQ + 2 * col) = f2bf(qf * fexp(off + b[j]));
            *(LAS bf16*)(QH + (16 * sg + j) * PQ + 2 * col) = f2bf(qf * fexp(b[j])); }
        { float d = 0.f;
#pragma unroll
          for (int I = 0; I < 4; ++I) { if (I >= sg) {
#pragma unroll
                for (int j = 0; j < 16; ++j) *(LAS bf16*)(KH + (kh_base(I) + 16 * sg + j) * PQ + 2 * col) = f2bf(bf2f(kk[j]) * fexp(d - b[j]));
                d += st[I]; } } }
        { unsigned vw[8];
#pragma unroll
          for (int j = 0; j < 8; ++j) vw[j] = (unsigned)vv[2 * j] | ((unsigned)vv[2 * j + 1] << 16);
          *(LAS v4u*)(VT + col * PK + 32 * sg) = (v4u){vw[0], vw[1], vw[2], vw[3]}; *(LAS v4u*)(VT + col * PK + 32 * sg + 16) = (v4u){vw[4], vw[5], vw[6], vw[7]}; }
        __syncthreads();
#pragma unroll
        for (int tt = 0; tt < 2; ++tt) { const int tile = wave * 2 + tt, I = tile >> 2, J = tile & 3;
            f32x4 acc = {0.f, 0.f, 0.f, 0.f};
            if (J <= I) {
#pragma unroll
                for (int ks = 0; ks < 4; ++ks) acc = mma(ldsfrag(KH, kh_base(I) + 16 * J + r, PQ, 64 * ks + 16 * q), ldsfrag(QH, 16 * I + r, PQ, 64 * ks + 16 * q), acc);
                if (J == I) {
#pragma unroll
                    for (int i = 0; i < 4; ++i) if (4 * q + i > r) acc[i] = 0.f; }
            }
            v2u w; w.x = cvtpk(acc[0], acc[1]); w.y = cvtpk(acc[2], acc[3]);
            *(LAS v2u*)(PP + (16 * I + r) * PK + (16 * J + 4 * q) * 2) = w; }
        __syncthreads();
        const int mt = wave & 3, nh = wave >> 2;
        f32x4 acc[4];
        const bf16x8 pa0 = ldsfrag(PP, 16 * mt + r, PK, 16 * q), pa1 = ldsfrag(PP, 16 * mt + r, PK, 64 + 16 * q);
        bf16x8 qa[4];
#pragma unroll
        for (int ks = 0; ks < 4; ++ks) qa[ks] = ldsfrag(QT, 16 * mt + r, PQ, 64 * ks + 16 * q);
        const bf16* stp = ST + ((size_t)u * 128 + 64 * nh + r) * 128 + 8 * q;
#pragma unroll
        for (int nt = 0; nt < 4; ++nt) { f32x4 a = {0.f, 0.f, 0.f, 0.f};
            a = mma(ldsfrag(VT, 64 * nh + 16 * nt + r, PK, 16 * q), pa0, a); a = mma(ldsfrag(VT, 64 * nh + 16 * nt + r, PK, 64 + 16 * q), pa1, a);
#pragma unroll
            for (int ks = 0; ks < 4; ++ks) a = mma(*(const bf16x8*)(stp + (size_t)(16 * nt) * 128 + 32 * ks), qa[ks], a);
            acc[nt] = a; }
        float ss = 0.f;
#pragma unroll
        for (int nt = 0; nt < 4; ++nt) ss += (acc[nt][0] * acc[nt][0] + acc[nt][1] * acc[nt][1]) + (acc[nt][2] * acc[nt][2] + acc[nt][3] * acc[nt][3]);
        ss += __shfl_xor(ss, 16); ss += __shfl_xor(ss, 32);
        if (q == 0) rs[nh * 64 + 16 * mt + r] = ss;
        __syncthreads();
        const float rstd = rsqrtf((rs[16 * mt + r] + rs[64 + 16 * mt + r]) * (1.f / 128.f) + NORM_EPS);
        const size_t orow = (size_t)(c * CH + 16 * mt + r);
#pragma unroll
        for (int nt = 0; nt < 4; ++nt) { const int dv = 64 * nh + 16 * nt + 4 * q;
            const f32x4 g = *(const f32x4*)(ogain + dv); const v2u gt = *(const v2u*)(PROJ + orow * 16384 + 12288 + h * DH + dv);
            v2u w; w.x = cvtpk(acc[nt][0] * rstd * g.x * bflo(gt.x), acc[nt][1] * rstd * g.y * bfhi(gt.x)); w.y = cvtpk(acc[nt][2] * rstd * g.z * bflo(gt.y), acc[nt][3] * rstd * g.w * bfhi(gt.y));
            *(v2u*)(MO + orow * DM + h * DH + dv) = w; }
        __syncthreads();
    }
}
}
constexpr int RING_BYTES = 131072;
constexpr int MISC_OFF = RING_BYTES + 320;
constexpr int LDS_BYTES = 147456;
constexpr int CW_BAR = 4096;
static_assert(fa::LDS_BYTES <= RING_BYTES && hg::B3_END <= RING_BYTES, "phase scratch fits the ring region");
static_assert(WS_END <= (size_t)4096 * MiB, "workspace map");

constexpr int PH_FINAL = 49, PH_END = 50;
struct Args { const float* in[15]; float* out; unsigned char* ws; int ph_lo, ph_hi; };
static_assert(sizeof(Args) == 15 * 8 + 8 + 8 + 4 + 4, "Args has no padding bytes");

__global__ void __launch_bounds__(NWAVES * 64, 2) trunk_fwd(Args args) {
    extern __shared__ __attribute__((aligned(16))) unsigned char lds_raw[];
    LAS unsigned char* lds = (LAS unsigned char*)lds_raw;
    volatile LAS unsigned* MISC = (volatile LAS unsigned*)(lds + MISC_OFF);
    const int tid = threadIdx.x;
    const int G = gridDim.x, bx = blockIdx.x;
    const int vcu = (G % 8 == 0) ? (bx % 8) * (G / 8) + bx / 8 : bx;
    unsigned char* ws = args.ws;
    for (int u = tid; u < (LDS_BYTES - RING_BYTES) / 4; u += NWAVES * 64) ((LAS unsigned*)(lds + RING_BYTES))[u] = 0u;
    __syncthreads();
    const int lo = args.ph_lo, hi = args.ph_hi;
#if MK_PER_PHASE
#define GRID_BAR(p) do { } while (0)
#else
    XcdBarrier bar = xcd_barrier_post((unsigned*)(ws + WS_CTL) + CW_BAR, MISC + 8);
#define GRID_BAR(p) do { if ((p) + 1 < hi) xcd_barrier(bar); } while (0)
#endif
#ifndef ONLY_SITE
#define ONLY_SITE -1
#endif
#define EN(s) (ONLY_SITE == -1 || ONLY_SITE == (s))
#define IN(k) (lo <= (k) && (k) < hi)
    const float* x = args.in[0];
    float* Hb = (float*)(ws + WS_H); bf16* XN = (bf16*)(ws + WS_XN); bf16* MO = (bf16*)(ws + WS_MO); bf16* PROJ = (bf16*)(ws + WS_PROJ);
    float* Gg = (float*)(ws + WS_G); float* UT = (float*)(ws + WS_UT); bf16* ST = (bf16*)(ws + WS_ST);
    float* LOGF = (float*)(ws + WS_LOGF); float* KB = (float*)(ws + WS_KB); float* DEC = (float*)(ws + WS_DEC); const float* LB = (const float*)(ws + WS_LB);

    if (EN(0) && IN(0)) {
        ProArgs pa{args.in[1], args.in[2], args.in[6], args.in[7], args.in[12], args.in[13], args.in[9]};
        prologue_phase(lds, ws, pa, vcu, G);
        GRID_BAR(0);
    }
    for (int L = 0; L < DEPTH; ++L) {
        const int pb = 1 + 12 * L, j = L >> 1; const bool fox = (L & 1) == 0;
        const float* hsrc = (L == 0) ? x : Hb;
        if (EN(1) && IN(pb + 0)) { rms_phase<false>(hsrc, args.in[10] + (size_t)L * DM, XN, vcu, G); GRID_BAR(pb + 0); }
        if (fox) {
            if (EN(2) && IN(pb + 1)) {
                pg8::Gemm g{XN, (const bf16*)(ws + WS_WFIN) + (size_t)j * FOX_INP * DM, SEQ, FOX_INP, DM}; pg8::StaticOrder S; S.init(SEQ, FOX_INP, G, bx);
                pg8::EpiFox E{PROJ, 16384, LOGF, args.in[5] + j * NH};
                pg8::gemm_phase<pg8::EpiFox, pg8::StaticOrder, true, true>(lds, g, S, E);
                GRID_BAR(pb + 1);
            }
            if (EN(3) && IN(pb + 2)) { fox_thin_phase(lds, PROJ, LOGF, KB, args.in[3] + j * DH, args.in[4] + j * DH, vcu, G); GRID_BAR(pb + 2); }
            if (EN(4) && IN(pb + 3)) { fa::attn_phase((char*)lds_raw, PROJ, KB, MO, bx, G); GRID_BAR(pb + 3); }
        } else {
            if (EN(5) && IN(pb + 1)) {
                pg8::Gemm g{XN, (const bf16*)(ws + WS_WHIN) + (size_t)j * HG_IN * DM, SEQ, HG_IN, DM}; pg8::StaticOrder S; S.init(SEQ, HG_IN, G, bx);
                pg8::EpiHgrn E{PROJ, 16384, Gg, LB + (size_t)L * DM};
                pg8::gemm_phase<pg8::EpiHgrn, pg8::StaticOrder, true, true>(lds, g, S, E);
                GRID_BAR(pb + 1);
            }
            if (EN(6) && IN(pb + 2)) { hg::b1_phase(lds, PROJ, Gg, UT, DEC, vcu, G); GRID_BAR(pb + 2); }
            if (EN(7) && IN(pb + 3)) { hg::b2_phase(UT, DEC, ST, vcu, G); GRID_BAR(pb + 3); }
            if (EN(8) && IN(pb + 4)) { hg::b3_phase(lds, PROJ, Gg, ST, args.in[8] + j * DH, MO, vcu, G); GRID_BAR(pb + 4); }
        }
        if (EN(9) && IN(pb + 5)) {
            const bf16* W = fox ? (const bf16*)(ws + WS_WFOUT) + (size_t)j * DM * DM : (const bf16*)(ws + WS_WHOUT) + (size_t)j * DM * DM;
            pg8::Gemm g{MO, W, SEQ, DM, DM}; pg8::StaticOrder S; S.init(SEQ, DM, G, bx);
            pg8::EpiRes E{hsrc, Hb, DM};
            pg8::gemm_phase<pg8::EpiRes, pg8::StaticOrder, true, true>(lds, g, S, E);
            GRID_BAR(pb + 5);
        }
        if (EN(10) && IN(pb + 6)) { rms_phase<false>(Hb, args.in[11] + (size_t)L * DM, XN, vcu, G); GRID_BAR(pb + 6); }
        if (EN(11) && IN(pb + 7)) {
            pg8::Gemm g{XN, (const bf16*)(ws + WS_WUP) + (size_t)L * DFF * DM, SEQ, DFF, DM}; pg8::StaticOrder S; S.init(SEQ, DFF, G, bx);
            pg8::EpiSqRelu E{PROJ, DFF};
            pg8::gemm_phase<pg8::EpiSqRelu, pg8::StaticOrder, true, true>(lds, g, S, E);
            GRID_BAR(pb + 7);
        }
        if (EN(12) && IN(pb + 8)) {
            pg8::Gemm g{PROJ, (const bf16*)(ws + WS_WDN) + (size_t)L * DM * DFF, SEQ, DM, DFF}; pg8::StaticOrder S; S.init(SEQ, DM, G, bx);
            pg8::EpiRes E{Hb, Hb, DM};
            pg8::gemm_phase<pg8::EpiRes, pg8::StaticOrder, true, true>(lds, g, S, E);
            GRID_BAR(pb + 8);
        }
    }
    if (EN(13) && IN(PH_FINAL)) rms_phase<true>(Hb, args.in[14], args.out, vcu, G);
#undef IN
#undef GRID_BAR
}

extern "C" void kernel_launch(void* const* d_in, const int* in_sizes, int n_in, void* d_out, int out_size, void* d_ws, size_t ws_size, hipStream_t stream) {
    static int grid = 0;
    if (grid == 0) {
        if (n_in != 15 || in_sizes[0] != SEQ * DM || out_size != SEQ * DM || ws_size < WS_END) { fprintf(stderr, "kernel_launch: unexpected shapes (n_in %d, in0 %d, out %d, ws %zu < %zu)\n", n_in, n_in > 0 ? in_sizes[0] : -1, out_size, ws_size, (size_t)WS_END); grid = -1; return; }
        int dev = 0, cus = 0, per_cu = 0;
        if (hipGetDevice(&dev) != hipSuccess || hipDeviceGetAttribute(&cus, hipDeviceAttributeMultiprocessorCount, dev) != hipSuccess) { grid = -1; return; }
        if (hipFuncSetAttribute((const void*)trunk_fwd, hipFuncAttributeMaxDynamicSharedMemorySize, LDS_BYTES) != hipSuccess) { fprintf(stderr, "kernel_launch: hipFuncSetAttribute failed\n"); grid = -1; return; }
        if (hipOccupancyMaxActiveBlocksPerMultiprocessor(&per_cu, (const void*)trunk_fwd, NWAVES * 64, LDS_BYTES) != hipSuccess || per_cu < 1) fprintf(stderr, "kernel_launch: occupancy query says %d\n", per_cu);
        (void)hipGetLastError();
        grid = cus;
    }
    if (grid < 0) return;
    if (hipMemsetAsync((char*)d_ws + WS_CTL, 0, CTL_ZERO_BYTES, stream) != hipSuccess) return;
    Args a{};
    for (int i = 0; i < 15; ++i) a.in[i] = (const float*)d_in[i];
    a.out = (float*)d_out; a.ws = (unsigned char*)d_ws;
#if MK_PER_PHASE
    for (int p = 0; p < PH_END; ++p) {
        bool valid = (p == 0) || (p == PH_FINAL);
        if (p >= 1 && p < PH_FINAL) { const int L = (p - 1) / 12, k = (p - 1) % 12; const bool fox = (L & 1) == 0; valid = (k <= 3) || (k == 4 && !fox) || (k >= 5 && k <= 8); }
        if (!valid) continue;
        a.ph_lo = p; a.ph_hi = p + 1;
        hipLaunchKernelGGL(trunk_fwd, dim3(grid), dim3(NWAVES * 64), LDS_BYTES, stream, a);
    }
#else
    a.ph_lo = 0; a.ph_hi = PH_END;
    hipLaunchKernelGGL(trunk_fwd, dim3(grid), dim3(NWAVES * 64), LDS_BYTES, stream, a);
#endif
}
```

```cpp
#define MK_PER_PHASE 0
#define DUP_SITE -1
#include <hip/hip_runtime.h>
#include <hip/hip_bf16.h>
#include <cstdio>
#include <cstdint>

#ifndef MK_PER_PHASE
#define MK_PER_PHASE 0
#endif

constexpr int SEQ = 16384, DM = 4096, DFF = 16384, NH = 32, DH = 128, DEPTH = 4;
constexpr int FOX_IN = 4 * DM + NH;
constexpr int FOX_INP = 65 * 256;
constexpr int HG_IN = 4 * DM;
constexpr float NORM_EPS = 1e-6f;
constexpr float LOG2E = 1.4426950408889634f;
constexpr float QSCALE = 0.08838834764831845f * LOG2E;

constexpr size_t MiB = 1u << 20;
constexpr size_t WS_CTL = 0, CTL_ZERO_BYTES = 1 * MiB;
constexpr size_t WS_WFIN = 1 * MiB;
constexpr size_t WS_WFOUT = WS_WFIN + 260 * MiB;
constexpr size_t WS_WHIN = WS_WFOUT + 64 * MiB;
constexpr size_t WS_WHOUT = WS_WHIN + 256 * MiB;
constexpr size_t WS_WUP = WS_WHOUT + 64 * MiB;
constexpr size_t WS_WDN = WS_WUP + 512 * MiB;
constexpr size_t WS_H = WS_WDN + 512 * MiB;
constexpr size_t WS_XN = WS_H + 256 * MiB;
constexpr size_t WS_MO = WS_XN + 128 * MiB;
constexpr size_t WS_PROJ = WS_MO + 128 * MiB;
constexpr size_t WS_G = WS_PROJ + 512 * MiB;
constexpr size_t WS_UT = WS_G + 256 * MiB;
constexpr size_t WS_ST = WS_UT + 512 * MiB;
constexpr size_t WS_LOGF = WS_ST + 256 * MiB;
constexpr size_t WS_KB = WS_LOGF + 2 * MiB;
constexpr size_t WS_DEC = WS_KB + 2 * MiB;
constexpr size_t WS_LB = WS_DEC + 4 * MiB;
constexpr size_t WS_END = WS_LB + 1 * MiB;

#define GAS __attribute__((address_space(1)))
#define LAS __attribute__((address_space(3)))
typedef unsigned short bf16;
typedef unsigned v4u __attribute__((ext_vector_type(4)));
typedef unsigned v2u __attribute__((ext_vector_type(2)));
typedef float f32x4 __attribute__((ext_vector_type(4)));
typedef float f32x16 __attribute__((ext_vector_type(16)));
typedef short bf16x8 __attribute__((ext_vector_type(8)));
typedef short s16x4 __attribute__((ext_vector_type(4)));
#define LDS_WAIT() asm volatile("s_waitcnt lgkmcnt(0)" ::: "memory")
#define VM_WAIT() asm volatile("s_waitcnt vmcnt(0)" ::: "memory")
typedef float f32x2_t __attribute__((ext_vector_type(2)));
typedef __bf16 bf16x2_t __attribute__((ext_vector_type(2)));
__device__ __forceinline__ unsigned cvtpk(float lo, float hi) { const f32x2_t v = {lo, hi}; return __builtin_bit_cast(unsigned, __builtin_convertvector(v, bf16x2_t)); }
__device__ __forceinline__ float bflo(unsigned w) { return __uint_as_float(w << 16); }
__device__ __forceinline__ float bfhi(unsigned w) { return __uint_as_float(w & 0xffff0000u); }
__device__ __forceinline__ float bf2f(bf16 b) { return __uint_as_float(((unsigned)b) << 16); }
__device__ __forceinline__ bf16 f2bf(float f) { return (bf16)(cvtpk(f, 0.f) & 0xffffu); }
__device__ __forceinline__ float fexp(float x) { return __builtin_amdgcn_exp2f(x * LOG2E); }
__device__ __forceinline__ float sigmoidf_(float x) { return __builtin_amdgcn_rcpf(1.f + fexp(-x)); }
__device__ __forceinline__ int opaque_tid() { int t = threadIdx.x; asm volatile("" : "+v"(t)); return t; }
__device__ __forceinline__ float shx(float v, int o, int lane) { return __int_as_float(__builtin_amdgcn_ds_bpermute((lane ^ o) << 2, __float_as_int(v))); }
namespace pg8 {
#define PG8_LAS __attribute__((address_space(3)))
typedef unsigned short bf16_t;
typedef short bf16x8 __attribute__((ext_vector_type(8)));
typedef float f32x4 __attribute__((ext_vector_type(4)));
typedef unsigned u32x4 __attribute__((ext_vector_type(4)));
constexpr int BM = 256, BK = 64, HALF = 128, HTB = HALF * BK * 2  , STAGE_BYTES = 8 * HTB, NXCD = 8, WGM = 8;

__host__ __device__ __forceinline__ int lds_byte(int r, int c) { const int st = (r >> 4) * 2 + (c >> 5), rr = r & 15, cc = c & 31, ob = rr * 64 + cc * 2; return st * 1024 + (ob ^ (((ob >> 9) & 1) << 5)); }
__host__ __device__ __forceinline__ void stage_rc(int b, int& R, int& C) { const int st = b / 1024, sb = b % 1024, swz = sb ^ (((sb >> 9) & 1) << 5); R = (st >> 1) * 16 + swz / 64; C = (st & 1) * 32 + (swz % 64) / 2; }
__host__ __device__ __forceinline__ int perm32(int rho) { const int n = rho >> 4, i = rho & 15; return 8 * (i >> 2) + 4 * n + (i & 3); }

struct Unit { int pm, pn; };
struct Gemm { const bf16_t* A; const bf16_t* Bt; int M, N, K; };

struct StaticOrder {
    int nM, nN, nwg, G, c;
    __host__ __device__ void init(int M, int N, int G_, int c_) { nM = M / BM; nN = N / BM; nwg = nM * nN; G = G_; c = c_; }
    __host__ __device__ bool next(int i, Unit& u) const {
        const long L = (long)i * G + c; if (L >= nwg) return false;
        int wgid = (int)L; { const int q = nwg / NXCD, r = nwg % NXCD, xcd = wgid % NXCD, off = wgid / NXCD; wgid = (xcd < r ? xcd * (q + 1) : r * (q + 1) + (xcd - r) * q) + off; }
        const int nig = WGM * nN, gid = wgid / nig, fm = gid * WGM, gsz = (nM - fm) < WGM ? (nM - fm) : WGM;
        u.pm = fm + ((wgid % nig) % gsz); u.pn = (wgid % nig) / gsz; return true;
    }
    __device__ __forceinline__ void a_ready(const Unit&) const {}
    __device__ __forceinline__ void done(const Unit&) const {}
};
__device__ __forceinline__ unsigned cvt_pk_bf16(float lo, float hi) { return ::cvtpk(lo, hi); }
__device__ __forceinline__ float sigm(float x) { return __builtin_amdgcn_rcpf(1.f + __builtin_amdgcn_exp2f(-1.4426950408889634f * x)); }

struct EpiRes {
    static constexpr bool PERM = false, AFTER_DRAIN = false;
    const float* base; float* out; int ldc;
    __device__ __forceinline__ void operator()(const f32x4 (&acc)[2][2][4][2], const Unit& u, int wr, int wc, int fr, int fq) const {
        const int row0 = u.pm * BM + wr * 64 + fr, col0 = u.pn * BM + wc * 32 + 4 * fq;
#pragma unroll
        for (int ai = 0; ai < 2; ++ai)
#pragma unroll
            for (int m = 0; m < 4; ++m) { const size_t off = (size_t)(row0 + ai * HALF + m * 16) * ldc + col0;
                f32x4 b[2][2];
#pragma unroll
                for (int bj = 0; bj < 2; ++bj)
#pragma unroll
                    for (int n = 0; n < 2; ++n) b[bj][n] = *(const f32x4*)(base + off + bj * HALF + n * 16);
#pragma unroll
                for (int bj = 0; bj < 2; ++bj)
#pragma unroll
                    for (int n = 0; n < 2; ++n) *(f32x4*)(out + off + bj * HALF + n * 16) = b[bj][n] + acc[ai][bj][m][n];
                asm volatile("" ::: "memory"); }
    }
};
struct EpiSqRelu {
    static constexpr bool PERM = true, AFTER_DRAIN = false;
    bf16_t* O; int ldc;
    __device__ __forceinline__ void operator()(const f32x4 (&acc)[2][2][4][2], const Unit& u, int wr, int wc, int fr, int fq) const {
        const int row0 = u.pm * BM + wr * 64 + fr, col0 = u.pn * BM + wc * 32 + 8 * fq;
#pragma unroll
        for (int ai = 0; ai < 2; ++ai)
#pragma unroll
            for (int m = 0; m < 4; ++m) { bf16_t* rowp = O + (size_t)(row0 + ai * HALF + m * 16) * ldc + col0;
#pragma unroll
                for (int bj = 0; bj < 2; ++bj) { f32x4 v0 = acc[ai][bj][m][0], v1 = acc[ai][bj][m][1];
#pragma unroll
                    for (int j = 0; j < 4; ++j) { const float a = fmaxf(v0[j], 0.f), b = fmaxf(v1[j], 0.f); v0[j] = a * a; v1[j] = b * b; }
                    u32x4 w; w.x = cvt_pk_bf16(v0[0], v0[1]); w.y = cvt_pk_bf16(v0[2], v0[3]); w.z = cvt_pk_bf16(v1[0], v1[1]); w.w = cvt_pk_bf16(v1[2], v1[3]);
                    *(u32x4*)(rowp + bj * HALF) = w; } }
    }
};
struct EpiFox {
    static constexpr bool PERM = true, AFTER_DRAIN = false;
    bf16_t* P; int ldc; float* logf; const float* fbias;
    __device__ __forceinline__ void operator()(const f32x4 (&acc)[2][2][4][2], const Unit& u, int wr, int wc, int fr, int fq) const {
        const int row0 = u.pm * BM + wr * 64 + fr;
        if (u.pn < 64) {
            const int col0 = u.pn * BM + wc * 32 + 8 * fq; const bool gate = u.pn >= 48;
#pragma unroll
            for (int ai = 0; ai < 2; ++ai)
#pragma unroll
                for (int m = 0; m < 4; ++m) { bf16_t* rowp = P + (size_t)(row0 + ai * HALF + m * 16) * ldc + col0;
#pragma unroll
                    for (int bj = 0; bj < 2; ++bj) { f32x4 v0 = acc[ai][bj][m][0], v1 = acc[ai][bj][m][1];
                        if (gate) {
#pragma unroll
                            for (int j = 0; j < 4; ++j) { v0[j] = sigm(v0[j]); v1[j] = sigm(v1[j]); } }
                        u32x4 w; w.x = cvt_pk_bf16(v0[0], v0[1]); w.y = cvt_pk_bf16(v0[2], v0[3]); w.z = cvt_pk_bf16(v1[0], v1[1]); w.w = cvt_pk_bf16(v1[2], v1[3]);
                        *(u32x4*)(rowp + bj * HALF) = w; } }
        } else if (wc == 0) {
            const f32x4 b0 = *(const f32x4*)(fbias + 8 * fq), b1 = *(const f32x4*)(fbias + 8 * fq + 4);
#pragma unroll
            for (int ai = 0; ai < 2; ++ai)
#pragma unroll
                for (int m = 0; m < 4; ++m) { float* rowp = logf + (size_t)(row0 + ai * HALF + m * 16) * 32 + 8 * fq;
                    f32x4 v0 = acc[ai][0][m][0] + b0, v1 = acc[ai][0][m][1] + b1;
#pragma unroll
                    for (int j = 0; j < 4; ++j) { v0[j] = fminf(v0[j], 0.f) - log1pf(expf(-fabsf(v0[j]))); v1[j] = fminf(v1[j], 0.f) - log1pf(expf(-fabsf(v1[j]))); }
                    *(f32x4*)rowp = v0; *(f32x4*)(rowp + 4) = v1; }
        }
    }
};
struct EpiHgrn {
    static constexpr bool PERM = true, AFTER_DRAIN = false;
    bf16_t* P; int ldc; float* G; const float* lb;
    __device__ __forceinline__ void operator()(const f32x4 (&acc)[2][2][4][2], const Unit& u, int wr, int wc, int fr, int fq) const {
        const int row0 = u.pm * BM + wr * 64 + fr, col0 = u.pn * BM + wc * 32 + 8 * fq; const int kind = u.pn >> 4;
        if (kind == 1) {
            const int gc0 = col0 - 4096;
            f32x4 l0[2], l1[2];
#pragma unroll
            for (int bj = 0; bj < 2; ++bj) { l0[bj] = *(const f32x4*)(lb + gc0 + bj * HALF); l1[bj] = *(const f32x4*)(lb + gc0 + bj * HALF + 4); }
#pragma unroll
            for (int ai = 0; ai < 2; ++ai)
#pragma unroll
                for (int m = 0; m < 4; ++m) { const size_t r = (size_t)(row0 + ai * HALF + m * 16); bf16_t* rowp = P + r * ldc + col0; float* gp = G + r * 4096 + gc0;
#pragma unroll
                    for (int bj = 0; bj < 2; ++bj) { f32x4 v0 = acc[ai][bj][m][0], v1 = acc[ai][bj][m][1], g0, g1;
#pragma unroll
                        for (int j = 0; j < 4; ++j) { const float f0 = l0[bj][j] + (1.f - l0[bj][j]) * sigm(v0[j]), f1 = l1[bj][j] + (1.f - l1[bj][j]) * sigm(v1[j]);
                            g0[j] = logf(f0); g1[j] = logf(f1); v0[j] = 1.f - f0; v1[j] = 1.f - f1; }
                        u32x4 w; w.x = cvt_pk_bf16(v0[0], v0[1]); w.y = cvt_pk_bf16(v0[2], v0[3]); w.z = cvt_pk_bf16(v1[0], v1[1]); w.w = cvt_pk_bf16(v1[2], v1[3]);
                        *(u32x4*)(rowp + bj * HALF) = w; *(f32x4*)(gp + bj * HALF) = g0; *(f32x4*)(gp + bj * HALF + 4) = g1; } }
        } else {
            const bool act = kind != 2;
#pragma unroll
            for (int ai = 0; ai < 2; ++ai)
#pragma unroll
                for (int m = 0; m < 4; ++m) { bf16_t* rowp = P + (size_t)(row0 + ai * HALF + m * 16) * ldc + col0;
#pragma unroll
                    for (int bj = 0; bj < 2; ++bj) { f32x4 v0 = acc[ai][bj][m][0], v1 = acc[ai][bj][m][1];
                        if (act) {
#pragma unroll
                            for (int j = 0; j < 4; ++j) { v0[j] = v0[j] * sigm(v0[j]); v1[j] = v1[j] * sigm(v1[j]); } }
                        u32x4 w; w.x = cvt_pk_bf16(v0[0], v0[1]); w.y = cvt_pk_bf16(v0[2], v0[3]); w.z = cvt_pk_bf16(v1[0], v1[1]); w.w = cvt_pk_bf16(v1[2], v1[3]);
                        *(u32x4*)(rowp + bj * HALF) = w; } }
        }
    }
};
template <class Epi, class Sched, bool ALIGN_EPI = false, bool SP2 = false>
__device__ __forceinline__ void gemm_phase(PG8_LAS unsigned char* lds, const Gemm g, const Sched& S, const Epi& E) {
    const int tid = opaque_tid(), wid = __builtin_amdgcn_readfirstlane(tid >> 6), lane = tid & 63, wr = wid >> 2, wc = wid & 3, fr = lane & 15, fq = lane >> 4;
    const int K = g.K, nt = K / BK;
    unsigned voffA[2], voffB[2];
#pragma unroll
    for (int i = 0; i < 2; ++i) { int R, C; stage_rc(tid * 16 + i * 8192, R, C); const int Rb = Epi::PERM ? ((R & ~31) + perm32(R & 31)) : R;
        voffA[i] = (unsigned)(R * K + C) * 2u; voffB[i] = (unsigned)(Rb * K + C) * 2u; }
    const size_t kstep = (size_t)(BK * 2);
    const size_t hstep = (size_t)HALF * K * 2;
    const size_t tstep = 2 * hstep;
    const unsigned ldsw = (unsigned)wid * 1024u;
    const int aoff = lds_byte(wr * 64 + fr, fq * 8), boff = lds_byte(wc * 32 + fr, fq * 8);
#define PG8_SA(b, h) (((b) * 2 + (h)) * HTB)
#define PG8_SB(b, h) ((4 + (b) * 2 + (h)) * HTB)
#define PG8_STAGE(bufoff, gbase, voff) do { _Pragma("unroll") for (int _i = 0; _i < 2; ++_i) \
        __builtin_amdgcn_global_load_lds((const unsigned*)((const char*)(gbase) + (voff)[_i]), (PG8_LAS unsigned*)(lds + (bufoff) + ldsw + _i * 8192), 16, 0, 0); } while (0)
#define PG8_LDA(dst, b, h) do { _Pragma("unroll") for (int m = 0; m < 4; ++m) _Pragma("unroll") for (int k = 0; k < 2; ++k) dst[m][k] = *(const PG8_LAS bf16x8*)(lds + PG8_SA(b, h) + aoff + m * 2048 + k * 1024); } while (0)
#define PG8_LDB(dst, b, h) do { _Pragma("unroll") for (int n = 0; n < 2; ++n) _Pragma("unroll") for (int k = 0; k < 2; ++k) dst[n][k] = *(const PG8_LAS bf16x8*)(lds + PG8_SB(b, h) + boff + n * 2048 + k * 1024); } while (0)
#define PG8_MMA(ai, bj, At, Bt) do { __builtin_amdgcn_s_setprio(1); _Pragma("unroll") for (int m = 0; m < 4; ++m) _Pragma("unroll") for (int n = 0; n < 2; ++n) _Pragma("unroll") for (int k = 0; k < 2; ++k) \
        acc[ai][bj][m][n] = __builtin_amdgcn_mfma_f32_16x16x32_bf16(Bt[n][k], At[m][k], acc[ai][bj][m][n], 0, 0, 0); __builtin_amdgcn_s_setprio(0); } while (0)
#define PG8_WAIT_V(n) asm volatile("s_waitcnt vmcnt(" #n ")" ::: "memory")
#define PG8_WAIT_L(n) asm volatile("s_waitcnt lgkmcnt(" #n ")" ::: "memory")
#define PG8_BAR __builtin_amdgcn_s_barrier()
#define PG8_SCHED __builtin_amdgcn_sched_barrier(0)
    Unit cur, nxt; int ui = 0;
    if (!S.next(0, cur)) return;
    f32x4 acc[2][2][4][2];
#pragma unroll
    for (int a = 0; a < 2; ++a)
#pragma unroll
        for (int b = 0; b < 2; ++b)
#pragma unroll
            for (int m = 0; m < 4; ++m)
#pragma unroll
                for (int n = 0; n < 2; ++n) acc[a][b][m][n] = (f32x4){0.f, 0.f, 0.f, 0.f};
    bf16x8 At[4][2], B0[2][2], B1[2][2];
    const char* cA = (const char*)g.A + (size_t)cur.pm * tstep; const char* cB = (const char*)g.Bt + (size_t)cur.pn * tstep;
    S.a_ready(cur);
    if constexpr (SP2) {
        PG8_STAGE(PG8_SB(0, 0), cB, voffB); PG8_STAGE(PG8_SB(0, 1), cB + hstep, voffB); PG8_STAGE(PG8_SA(0, 0), cA, voffA); PG8_STAGE(PG8_SA(0, 1), cA + hstep, voffA);
        if (wr == 1) PG8_BAR;
        PG8_WAIT_V(2); PG8_BAR;
        PG8_STAGE(PG8_SB(1, 0), cB + kstep, voffB); PG8_STAGE(PG8_SA(1, 0), cA + kstep, voffA); PG8_STAGE(PG8_SB(1, 1), cB + hstep + kstep, voffB);
        PG8_WAIT_V(6); PG8_BAR;
    } else {
        PG8_STAGE(PG8_SB(0, 0), cB, voffB); PG8_STAGE(PG8_SA(0, 0), cA, voffA); PG8_STAGE(PG8_SB(0, 1), cB + hstep, voffB); PG8_STAGE(PG8_SA(0, 1), cA + hstep, voffA);
        if (wr == 1) PG8_BAR;
        PG8_WAIT_V(4); PG8_BAR;
        PG8_STAGE(PG8_SB(1, 0), cB + kstep, voffB); PG8_STAGE(PG8_SA(1, 0), cA + kstep, voffA); PG8_STAGE(PG8_SB(1, 1), cB + hstep + kstep, voffB);
        PG8_WAIT_V(6); PG8_BAR;
    }
    for (;;) {
        const bool has_next = S.next(ui + 1, nxt);
        const char* nA = has_next ? (const char*)g.A + (size_t)nxt.pm * tstep : cA; const char* nB = has_next ? (const char*)g.Bt + (size_t)nxt.pn * tstep : cB;
        for (int t = 0; t < nt; t += 2) {
            const bool last = (t == nt - 2);
            const char* a1 = cA + (size_t)(t + 1) * kstep;
            const char* a2 = last ? nA : cA + (size_t)(t + 2) * kstep; const char* b2 = last ? nB : cB + (size_t)(t + 2) * kstep;
            const char* a3 = a2 + kstep; const char* b3 = b2 + kstep;
            if (last && has_next) S.a_ready(nxt);
            if constexpr (SP2) {
            PG8_LDB(B0, 0, 0); PG8_LDB(B1, 0, 1); PG8_SCHED; PG8_LDA(At, 0, 0); PG8_STAGE(PG8_SA(1, 1), a1 + hstep, voffA);
            PG8_WAIT_V(8); PG8_WAIT_L(0); PG8_BAR; PG8_MMA(0, 0, At, B0); PG8_MMA(0, 1, At, B1); PG8_BAR; PG8_SCHED;
            PG8_LDA(At, 0, 1); PG8_STAGE(PG8_SB(0, 0), b2, voffB); PG8_STAGE(PG8_SB(0, 1), b2 + hstep, voffB); PG8_STAGE(PG8_SA(0, 0), a2, voffA);
            PG8_WAIT_V(8); PG8_WAIT_L(0); PG8_BAR; PG8_MMA(1, 0, At, B0); PG8_MMA(1, 1, At, B1); PG8_BAR; PG8_SCHED;
            PG8_LDB(B0, 1, 0); PG8_LDB(B1, 1, 1); PG8_SCHED; PG8_LDA(At, 1, 0); PG8_STAGE(PG8_SA(0, 1), a2 + hstep, voffA);
            PG8_WAIT_V(8); PG8_WAIT_L(0); PG8_BAR; PG8_MMA(0, 0, At, B0); PG8_MMA(0, 1, At, B1); PG8_BAR; PG8_SCHED;
            PG8_LDA(At, 1, 1); PG8_STAGE(PG8_SB(1, 0), b3, voffB); PG8_STAGE(PG8_SB(1, 1), b3 + hstep, voffB); PG8_STAGE(PG8_SA(1, 0), a3, voffA);
            PG8_WAIT_V(8); PG8_WAIT_L(0); PG8_BAR; PG8_MMA(1, 0, At, B0); PG8_MMA(1, 1, At, B1); PG8_BAR; PG8_SCHED;
            } else {
            PG8_LDB(B0, 0, 0); PG8_SCHED; PG8_LDA(At, 0, 0); PG8_STAGE(PG8_SA(1, 1), a1 + hstep, voffA);
            PG8_WAIT_L(8); PG8_BAR; PG8_WAIT_L(0); PG8_MMA(0, 0, At, B0); PG8_BAR; PG8_SCHED;
            PG8_LDB(B1, 0, 1); PG8_STAGE(PG8_SB(0, 0), b2, voffB);
            PG8_BAR; PG8_WAIT_L(0); PG8_MMA(0, 1, At, B1); PG8_BAR;
            PG8_LDA(At, 0, 1); PG8_STAGE(PG8_SA(0, 0), a2, voffA);
            PG8_BAR; PG8_WAIT_L(0); PG8_MMA(1, 0, At, B0); PG8_BAR; PG8_SCHED;
            PG8_STAGE(PG8_SB(0, 1), b2 + hstep, voffB);
            PG8_WAIT_V(6); PG8_BAR; PG8_MMA(1, 1, At, B1); PG8_BAR;
            PG8_LDB(B0, 1, 0); PG8_SCHED; PG8_LDA(At, 1, 0); PG8_STAGE(PG8_SA(0, 1), a2 + hstep, voffA);
            PG8_WAIT_L(8); PG8_BAR; PG8_WAIT_L(0); PG8_MMA(0, 0, At, B0); PG8_BAR; PG8_SCHED;
            PG8_LDB(B1, 1, 1); PG8_STAGE(PG8_SB(1, 0), b3, voffB);
            PG8_BAR; PG8_WAIT_L(0); PG8_MMA(0, 1, At, B1); PG8_BAR;
            PG8_LDA(At, 1, 1); PG8_STAGE(PG8_SA(1, 0), a3, voffA);
            PG8_BAR; PG8_WAIT_L(0); PG8_MMA(1, 0, At, B0); PG8_BAR; PG8_SCHED;
            PG8_STAGE(PG8_SB(1, 1), b3 + hstep, voffB);
            PG8_WAIT_V(6); PG8_BAR; PG8_MMA(1, 1, At, B1); PG8_BAR;
            }
        }
        if constexpr (ALIGN_EPI) { if (wr == 0) PG8_BAR; }
        if constexpr (!Epi::AFTER_DRAIN) { E(acc, cur, wr, wc, fr, fq); S.done(cur); }
        if (!has_next) break;
#pragma unroll
        for (int a = 0; a < 2; ++a)
#pragma unroll
            for (int b = 0; b < 2; ++b)
#pragma unroll
                for (int m = 0; m < 4; ++m)
#pragma unroll
                    for (int n = 0; n < 2; ++n) acc[a][b][m][n] = (f32x4){0.f, 0.f, 0.f, 0.f};
        cur = nxt; cA = nA; cB = nB; ++ui;
        if constexpr (ALIGN_EPI) { if (wr == 1) PG8_BAR; }
    }
    PG8_WAIT_V(0);
    if constexpr (!ALIGN_EPI) { if (wr == 0) PG8_BAR; }
    PG8_BAR;
    if constexpr (Epi::AFTER_DRAIN) { E.fused(acc, cur, wr, wc, fr, fq, lds, wid, lane); S.done(cur); }
#undef PG8_SA
#undef PG8_SB
#undef PG8_STAGE
#undef PG8_LDA
#undef PG8_LDB
#undef PG8_MMA
#undef PG8_WAIT_V
#undef PG8_WAIT_L
#undef PG8_BAR
#undef PG8_SCHED
}
}
#define XB_TMO      128
#define XB_XCNT(j)  (256  + 64 * (j))
#define XB_XSUB(j)  (1280 + 64 * (j))
#define XB_XGEN(j)  (2304 + 64 * (j))
#define XB_TOP      3328
#define XB_TOPGEN   3392
#define XCD_BAR_WORDS 3456
#define XB_SPIN_CAP (1u << 18)
#define LAS __attribute__((address_space(3)))

__device__ __forceinline__ unsigned xb_ld(unsigned* p)              { return __hip_atomic_load(p, __ATOMIC_RELAXED, __HIP_MEMORY_SCOPE_AGENT); }
__device__ __forceinline__ unsigned xb_add(unsigned* p, unsigned v) { return __hip_atomic_fetch_add(p, v, __ATOMIC_RELAXED, __HIP_MEMORY_SCOPE_AGENT); }
__device__ __forceinline__ unsigned xb_xcc_id() { return (unsigned)__builtin_amdgcn_s_getreg((3 << 11) | 20) & 0xFu; }
#define XB_SPIN(cond, bar) do { unsigned _sp = 0; while (cond) { __builtin_amdgcn_s_sleep(1); \
    if ((++_sp & 255u) == 0u) { if (xb_ld(&(bar)[XB_TMO])) break; if (_sp > XB_SPIN_CAP) { atomicAdd(&(bar)[XB_TMO], 1u); break; } } } } while (0)

struct XcdBarrier {
    unsigned* bar; unsigned x;
    volatile LAS unsigned* st;
};

__device__ __forceinline__ XcdBarrier xcd_barrier_post(unsigned* bar, volatile LAS unsigned* st) {
    XcdBarrier b; b.bar = bar; b.x = xb_xcc_id(); b.st = st;
    if (threadIdx.x == 0) (void)xb_add(&bar[XB_XCNT(b.x)], 1u);
    return b;
}
__device__ __forceinline__ void xcd_barrier_complete(unsigned* bar, unsigned x, unsigned& nloc, unsigned& nx) {
    const unsigned G = gridDim.x * gridDim.y * gridDim.z;
    unsigned sum, cnt, mine, sp = 0u;
    for (;;) {
        sum = 0u; cnt = 0u; mine = 0u;
#pragma unroll
        for (unsigned j = 0; j < 16; ++j) { const unsigned c = xb_ld(&bar[XB_XCNT(j)]); sum += c; cnt += (c > 0u) ? 1u : 0u; mine = (j == x) ? c : mine; }
        if (sum == G) break;
        __builtin_amdgcn_s_sleep(1);
        if ((++sp & 255u) == 0u) { if (xb_ld(&bar[XB_TMO])) break; if (sp > XB_SPIN_CAP) { atomicAdd(&bar[XB_TMO], 1u); break; } }
    }
    nloc = mine > 0u ? mine : 1u; nx = cnt > 0u ? cnt : 1u;
}

__device__ __forceinline__ void xcd_barrier(const XcdBarrier& b) {
    asm volatile("s_waitcnt vmcnt(0)" ::: "memory");
    __syncthreads();
    if (threadIdx.x == 0) {
        unsigned* bar = b.bar;
        __builtin_amdgcn_s_waitcnt(0);
        unsigned nloc = b.st[0], nx = b.st[1];
        if (nloc == 0u) { xcd_barrier_complete(bar, b.x, nloc, nx); b.st[0] = nloc; b.st[1] = nx; }
        const unsigned old = xb_add(&bar[XB_XSUB(b.x)], 1u);
        const unsigned gen = old / nloc;
        if (old + 1u == (gen + 1u) * nloc) {
            __builtin_amdgcn_fence(__ATOMIC_RELEASE, "agent");
            asm volatile("s_waitcnt vmcnt(0)" ::: "memory");
            const unsigned og = xb_add(&bar[XB_TOP], 1u);
            const unsigned tg = og / nx;
            if (og + 1u == (tg + 1u) * nx) xb_add(&bar[XB_TOPGEN], 1u);
            else XB_SPIN(xb_ld(&bar[XB_TOPGEN]) == tg, bar);
            __builtin_amdgcn_fence(__ATOMIC_ACQUIRE, "agent");
            xb_add(&bar[XB_XGEN(b.x)], 1u);
            asm volatile("s_waitcnt vmcnt(0)" ::: "memory");
        } else {
            XB_SPIN(xb_ld(&bar[XB_XGEN(b.x)]) == gen, bar);
            __builtin_amdgcn_fence(__ATOMIC_ACQUIRE, "agent");
            asm volatile("s_waitcnt vmcnt(0)" ::: "memory");
        }
    }
    __syncthreads();
}
constexpr int NWAVES = 8;
__device__ __forceinline__ float wave_sum(float v, int lane) {
#pragma unroll
    for (int o = 1; o < 64; o <<= 1) v += shx(v, o, lane);
    return v;
}
__device__ __forceinline__ void transpose_item(const float* W, int K, int N, bf16* WT, LAS float* scr, int item, int lane) {
    const int nblk = N / 32, kb = item / nblk, nb = item % nblk, k0 = 64 * kb, n0 = 32 * nb;
#pragma unroll 8
    for (int i = 0; i < 32; ++i) { const int kk = 2 * i + (lane >> 5); scr[kk * 33 + (lane & 31)] = W[(size_t)(k0 + kk) * N + n0 + (lane & 31)]; }
    LDS_WAIT(); asm volatile("" ::: "memory");
    const int c = lane & 7;
#pragma unroll
    for (int j = 0; j < 4; ++j) { const int n = (lane >> 3) + 8 * j; const LAS float* s = scr + (8 * c) * 33 + n;
        v4u o; o.x = cvtpk(s[0 * 33], s[1 * 33]); o.y = cvtpk(s[2 * 33], s[3 * 33]); o.z = cvtpk(s[4 * 33], s[5 * 33]); o.w = cvtpk(s[6 * 33], s[7 * 33]);
        *(v4u*)(WT + (size_t)(n0 + n) * K + k0 + 8 * c) = o; }
    LDS_WAIT(); asm volatile("" ::: "memory");
}
__device__ __forceinline__ void transpose_matrix(const float* W, int K, int N, bf16* WT, LAS float* scr, int gw, int ngw, int lane) {
    const int nitems = (K / 64) * (N / 32);
    for (int it = gw; it < nitems; it += ngw) transpose_item(W, K, N, WT, scr, it, lane);
}
struct ProArgs { const float* fox_w_in; const float* fox_w_out; const float* hgrn_w_in; const float* hgrn_w_out; const float* up; const float* down; const float* lb_logits; };
__device__ __forceinline__ void prologue_phase(LAS unsigned char* lds, unsigned char* ws, const ProArgs& a, int vcu, int G) {
    const int tid = opaque_tid(), lane = tid & 63, wave = tid >> 6;
    LAS float* scr = (LAS float*)(lds + wave * 16384);
    const int gw = vcu * NWAVES + wave, ngw = G * NWAVES;
    for (int j = 0; j < 2; ++j) {
        transpose_matrix(a.fox_w_in + (size_t)j * DM * FOX_IN, DM, FOX_IN, (bf16*)(ws + WS_WFIN) + (size_t)j * FOX_INP * DM, scr, gw, ngw, lane);
        transpose_matrix(a.fox_w_out + (size_t)j * DM * DM, DM, DM, (bf16*)(ws + WS_WFOUT) + (size_t)j * DM * DM, scr, gw, ngw, lane);
        transpose_matrix(a.hgrn_w_in + (size_t)j * DM * HG_IN, DM, HG_IN, (bf16*)(ws + WS_WHIN) + (size_t)j * HG_IN * DM, scr, gw, ngw, lane);
        transpose_matrix(a.hgrn_w_out + (size_t)j * DM * DM, DM, DM, (bf16*)(ws + WS_WHOUT) + (size_t)j * DM * DM, scr, gw, ngw, lane);
        { v4u* z = (v4u*)((bf16*)(ws + WS_WFIN) + (size_t)j * FOX_INP * DM + (size_t)FOX_IN * DM); const size_t n16 = (size_t)(FOX_INP - FOX_IN) * DM * 2 / 16;
          for (size_t i = (size_t)(vcu * 512 + tid); i < n16; i += (size_t)G * 512) z[i] = (v4u){0u, 0u, 0u, 0u}; }
    }
    for (int j = 0; j < 4; ++j) {
        transpose_matrix(a.up + (size_t)j * DM * DFF, DM, DFF, (bf16*)(ws + WS_WUP) + (size_t)j * DFF * DM, scr, gw, ngw, lane);
        transpose_matrix(a.down + (size_t)j * DFF * DM, DFF, DM, (bf16*)(ws + WS_WDN) + (size_t)j * DM * DFF, scr, gw, ngw, lane);
    }
    for (int c = vcu * 512 + tid; c < DM; c += G * 512) {
        float l[4], mx = -1e30f; for (int i = 0; i < 4; ++i) { l[i] = a.lb_logits[i * DM + c]; mx = fmaxf(mx, l[i]); }
        float s = 0.f; for (int i = 0; i < 4; ++i) { l[i] = expf(l[i] - mx); s += l[i]; }
        float* LB = (float*)(ws + WS_LB); float cum = 0.f; const float p0 = l[0] / s;
        for (int i = 0; i < 4; ++i) { cum += l[i] / s; LB[i * DM + c] = cum - p0; }
    }
}
template <bool TO_F32>
__device__ __forceinline__ void rms_phase(const float* src, const float* gain, void* dst, int vcu, int G) {
    const int tid = opaque_tid(), lane = tid & 63, wave = tid >> 6;
    const int gw = vcu * NWAVES + wave, ngw = G * NWAVES;
    for (int row = gw; row < SEQ; row += ngw) {
        const f32x4* xr = (const f32x4*)(src + (size_t)row * DM) + lane;
        f32x4 v[16]; float ss = 0.f;
#pragma unroll
        for (int j = 0; j < 16; ++j) { v[j] = xr[64 * j]; ss += (v[j].x * v[j].x + v[j].y * v[j].y) + (v[j].z * v[j].z + v[j].w * v[j].w); }
        const float rstd = rsqrtf(wave_sum(ss, lane) * (1.f / DM) + NORM_EPS);
        const f32x4* gr = (const f32x4*)gain + lane;
#pragma unroll
        for (int j = 0; j < 16; ++j) { const f32x4 g = gr[64 * j]; const f32x4 o = v[j] * rstd * g;
            if constexpr (TO_F32) ((f32x4*)((float*)dst + (size_t)row * DM) + lane)[64 * j] = o;
            else { v2u w; w.x = cvtpk(o.x, o.y); w.y = cvtpk(o.z, o.w); ((v2u*)((bf16*)dst + (size_t)row * DM) + lane)[64 * j] = w; } }
    }
}
__device__ __forceinline__ void fox_thin_phase(LAS unsigned char* lds, bf16* PROJ, const float* LOGF, float* KB, const float* qg, const float* kg, int vcu, int G) {
    const int tid = opaque_tid(), lane = tid & 63, wave = tid >> 6;
    LAS float* red = (LAS float*)lds;
    LAS float* pre = red + 64 * 32;
    for (int blk = vcu; blk < SEQ / 64; blk += G) {
        const int r0 = blk * 64;
        { const int h4 = tid & 7, part = tid >> 3; f32x4 a = {0.f, 0.f, 0.f, 0.f};
          for (int r = part; r < r0; r += 64) a += *(const f32x4*)(LOGF + (size_t)r * 32 + 4 * h4);
          *(LAS f32x4*)(red + part * 32 + 4 * h4) = a; }
        __syncthreads();
        if (tid < 32) { float s = 0.f; for (int p = 0; p < 64; ++p) s += red[p * 32 + tid]; pre[tid] = s; }
        __syncthreads();
        if (tid < 32) { float c = pre[tid];
            for (int r = 0; r < 64; ++r) { c += LOGF[(size_t)(r0 + r) * 32 + tid]; KB[(size_t)tid * SEQ + r0 + r] = -c * LOG2E; } }
        const int sub = lane >> 4, l16 = lane & 15;
        f32x4 gq0 = *(const f32x4*)(qg + 8 * l16) * QSCALE, gq1 = *(const f32x4*)(qg + 8 * l16 + 4) * QSCALE, gk0 = *(const f32x4*)(kg + 8 * l16), gk1 = *(const f32x4*)(kg + 8 * l16 + 4);
        for (int it = wave; it < 64 * 16; it += NWAVES) {
            const int row = it >> 4, vec = (it & 15) * 4 + sub;
            v4u* p = (v4u*)(PROJ + (size_t)(r0 + row) * 16384 + vec * 128 + 8 * l16);
            const v4u w = *p;
            float x[8] = {bflo(w.x), bfhi(w.x), bflo(w.y), bfhi(w.y), bflo(w.z), bfhi(w.z), bflo(w.w), bfhi(w.w)};
            float ss = 0.f;
#pragma unroll
            for (int j = 0; j < 8; ++j) ss += x[j] * x[j];
            ss += shx(ss, 1, lane); ss += shx(ss, 2, lane); ss += shx(ss, 4, lane); ss += shx(ss, 8, lane);
            const float rstd = rsqrtf(ss * (1.f / 128.f) + NORM_EPS);
            const bool isq = vec < 32; const f32x4 g0 = isq ? gq0 : gk0, g1 = isq ? gq1 : gk1;
            v4u o; o.x = cvtpk(x[0] * rstd * g0.x, x[1] * rstd * g0.y); o.y = cvtpk(x[2] * rstd * g0.z, x[3] * rstd * g0.w);
            o.z = cvtpk(x[4] * rstd * g1.x, x[5] * rstd * g1.y); o.w = cvtpk(x[6] * rstd * g1.z, x[7] * rstd * g1.w);
            *p = o;
        }
        __syncthreads();
    }
}
__device__ __forceinline__ void jl_phase(LAS unsigned char* lds, const float* KB, const float* qg, const float* kg, int* JL, int vcu, int G) {
    const int tid = opaque_tid(), lane = tid & 63, wave = tid >> 6;
    LAS int* cnt = (LAS int*)lds;
    float gq = fmaxf(fabsf(qg[lane]), fabsf(qg[lane + 64])), gk = fmaxf(fabsf(kg[lane]), fabsf(kg[lane + 64]));
#pragma unroll
    for (int o = 1; o < 64; o <<= 1) { gq = fmaxf(gq, shx(gq, o, lane)); gk = fmaxf(gk, shx(gk, o, lane)); }
    const float TH = 160.f + 2.f * (128.f * gq * gk * QSCALE * 1.02f);
    for (int id = vcu; id < 2048; id += G) {
        const int h = id & 31, qb = 63 - (id >> 5);
        const float* kb = KB + (size_t)h * SEQ;
        const float lim = kb[qb * 256] - TH;
        const bool pred = (tid < 4 * qb) && (kb[64 * tid + 63] < lim);
        const unsigned long long bal = __ballot(pred);
        if (lane == 0) cnt[wave] = __popcll(bal);
        __syncthreads();
        if (tid == 0) { int s = 0; for (int w = 0; w < 8; ++w) s += cnt[w]; JL[id] = s; }
        __syncthreads();
    }
}
namespace fa {
constexpr int D = 128, NW = 8, QBLK = 32, KVBLK = 64, QB = NW * QBLK;
constexpr int LDQ = 16384, LDO = 4096;
constexpr int SHM_V = KVBLK * D * 2, SHM_K = KVBLK * D * 2;
constexpr int OFF_WS = 2 * SHM_V + 2 * SHM_K, OFF_KB = OFF_WS + NW * 64 * 4;
constexpr int LDS_BYTES = OFF_KB + 2 * 64 * 4;
constexpr float THR2 = 11.5f;
#define KSWZ(row, colB) ((row) * 256 + ((colB) ^ (((row) & 7) << 4)))
#define SBAR() __builtin_amdgcn_sched_barrier(0)
__device__ __forceinline__ int v_st(int k, int c) { const int kk = (k & ~0xC) | ((k & 4) << 1) | ((k & 8) >> 1); return ((kk >> 3) * 4 + (c >> 5)) * 512 + ((kk & 7) * 32 + (c & 31)) * 2; }
__device__ __forceinline__ int v_rd_base(int lane) { return ((lane & 3) << 3) | (((lane >> 2) & 3) << 6) | (((lane >> 4) & 1) << 5) | (((lane >> 5) & 1) << 8); }
constexpr int v_rd_off(int d0, int ks, int half) { return d0 * 512 + ks * 4096 + half * 2048; }
__device__ __forceinline__ int crow(int r, int hi) { return (r & 3) + 8 * (r >> 2) + 4 * hi; }
__device__ __forceinline__ bf16x8 ld8(const bf16* p) { return *reinterpret_cast<const bf16x8*>(p); }
__device__ __forceinline__ void mask_tile(f32x16& p0, f32x16& p1, int dq) {
    const float NEG = -__builtin_inff();
#pragma unroll
    for (int r = 0; r < 16; ++r) {
        const int c = (r & 3) + 8 * (r >> 2);
        if (dq - c < 0) p0[r] = NEG;
        if (dq - c - 32 < 0) p1[r] = NEG;
    }
}
__device__ __forceinline__ void partialSM(f32x16& p0, f32x16& p1, float& m_reg, float& mn, float& alpha) {
    float pmax = p0[0];
#pragma unroll
    for (int r = 1; r < 16; ++r) pmax = fmaxf(pmax, p0[r]);
#pragma unroll
    for (int r = 0; r < 16; ++r) pmax = fmaxf(pmax, p1[r]);
    { auto rr = __builtin_amdgcn_permlane32_swap(__float_as_uint(pmax), __float_as_uint(pmax), false, false);
      pmax = fmaxf(__uint_as_float(rr[0]), __uint_as_float(rr[1])); }
    if (__builtin_expect(__all(pmax - m_reg <= THR2), 1)) { mn = m_reg; alpha = 1.f; }
    else { mn = fmaxf(m_reg, pmax); alpha = __builtin_amdgcn_exp2f(m_reg - mn); m_reg = mn; }
#pragma unroll
    for (int r = 0; r < 16; ++r) p0[r] = p0[r] - mn;
#pragma unroll
    for (int r = 0; r < 16; ++r) p1[r] = p1[r] - mn;
#pragma unroll
    for (int r = 0; r < 16; ++r) p0[r] = __builtin_amdgcn_exp2f(p0[r]);
}
__device__ __forceinline__ void finishSM(f32x16& p0, f32x16& p1, float alpha, float& l_reg, bf16x8& pa0, bf16x8& pa1, bf16x8& pa2, bf16x8& pa3) {
#pragma unroll
    for (int r = 0; r < 16; ++r) p1[r] = __builtin_amdgcn_exp2f(p1[r]);
    float ps = 0;
#pragma unroll
    for (int r = 0; r < 16; ++r) ps += p0[r];
#pragma unroll
    for (int r = 0; r < 16; ++r) ps += p1[r];
    { auto rr = __builtin_amdgcn_permlane32_swap(__float_as_uint(ps), __float_as_uint(ps), false, false);
      ps = __uint_as_float(rr[0]) + __uint_as_float(rr[1]); }
    l_reg = l_reg * alpha + ps;
#define PK4(P, B_, OUT) do { unsigned a0 = cvtpk(P[B_+0], P[B_+1]), a1 = cvtpk(P[B_+2], P[B_+3]);                          \
        unsigned b0 = cvtpk(P[B_+4], P[B_+5]), b1 = cvtpk(P[B_+6], P[B_+7]);                                             \
        auto r0 = __builtin_amdgcn_permlane32_swap(a0, b0, false, false); auto r1 = __builtin_amdgcn_permlane32_swap(a1, b1, false, false); \
        v4u w = {r0[0], r1[0], r0[1], r1[1]}; OUT = *reinterpret_cast<bf16x8*>(&w); } while (0)
    PK4(p0, 0, pa0); PK4(p0, 8, pa1); PK4(p1, 0, pa2); PK4(p1, 8, pa3);
#undef PK4
}
template <int KB>
__device__ __forceinline__ void qkt(f32x16& p0, f32x16& p1, const char* K_lds, const float* kbl, int r32, int hi, const bf16x8* qr) {
#ifdef X_NOBIAS
    p0 = f32x16{}; p1 = f32x16{};
#else
    { const float* kb = kbl + KB * 64 + 4 * hi;
      const f32x4 a0 = *(const f32x4*)(kb), a1 = *(const f32x4*)(kb + 8), a2 = *(const f32x4*)(kb + 16), a3 = *(const f32x4*)(kb + 24);
      const f32x4 b0 = *(const f32x4*)(kb + 32), b1 = *(const f32x4*)(kb + 40), b2 = *(const f32x4*)(kb + 48), b3 = *(const f32x4*)(kb + 56);
      p0 = f32x16{a0[0], a0[1], a0[2], a0[3], a1[0], a1[1], a1[2], a1[3], a2[0], a2[1], a2[2], a2[3], a3[0], a3[1], a3[2], a3[3]};
      p1 = f32x16{b0[0], b0[1], b0[2], b0[3], b1[0], b1[1], b1[2], b1[3], b2[0], b2[1], b2[2], b2[3], b3[0], b3[1], b3[2], b3[3]}; }
#endif
    const char* kb4[4];
#pragma unroll
    for (int dd = 0; dd < 4; ++dd) kb4[dd] = K_lds + KB * SHM_K + KSWZ(r32, (dd * 16 + hi * 8) * 2);
#pragma unroll
    for (int d0 = 0; d0 < 8; ++d0) { const char* a = kb4[d0 & 3] + (d0 >> 2) * 128;
        bf16x8 b0 = *reinterpret_cast<const bf16x8*>(a);
        bf16x8 b1 = *reinterpret_cast<const bf16x8*>(a + 32 * 256);
        p0 = __builtin_amdgcn_mfma_f32_32x32x16_bf16(b0, qr[d0], p0, 0, 0, 0);
        p1 = __builtin_amdgcn_mfma_f32_32x32x16_bf16(b1, qr[d0], p1, 0, 0, 0); }
}
template <int VB>
__device__ __forceinline__ void pv_tile(f32x16* o, int vb0, bf16x8 pa0, bf16x8 pa1, bf16x8 pa2, bf16x8 pa3) {
#define TRRD(dst, off) asm volatile("ds_read_b64_tr_b16 %0, %1 offset:%2" : "=&v"(dst) : "v"(vb0), "i"(off) : "memory")
#define PV_D0(d0) do { s16x4 l0, l1, l2, l3, h0, h1, h2, h3; constexpr int b_ = VB * SHM_V + v_rd_off(d0, 0, 0); \
        TRRD(l0, b_); TRRD(h0, b_ + 2048); TRRD(l1, b_ + 4096); TRRD(h1, b_ + 6144); TRRD(l2, b_ + 8192); TRRD(h2, b_ + 10240); TRRD(l3, b_ + 12288); TRRD(h3, b_ + 14336); \
        asm volatile("s_waitcnt lgkmcnt(0)" ::: "memory"); SBAR();   \
        o[d0] = __builtin_amdgcn_mfma_f32_32x32x16_bf16(pa0, (bf16x8){l0[0], l0[1], l0[2], l0[3], h0[0], h0[1], h0[2], h0[3]}, o[d0], 0, 0, 0);   \
        o[d0] = __builtin_amdgcn_mfma_f32_32x32x16_bf16(pa1, (bf16x8){l1[0], l1[1], l1[2], l1[3], h1[0], h1[1], h1[2], h1[3]}, o[d0], 0, 0, 0);   \
        o[d0] = __builtin_amdgcn_mfma_f32_32x32x16_bf16(pa2, (bf16x8){l2[0], l2[1], l2[2], l2[3], h2[0], h2[1], h2[2], h2[3]}, o[d0], 0, 0, 0);   \
        o[d0] = __builtin_amdgcn_mfma_f32_32x32x16_bf16(pa3, (bf16x8){l3[0], l3[1], l3[2], l3[3], h3[0], h3[1], h3[2], h3[3]}, o[d0], 0, 0, 0); } while (0)
    PV_D0(0); PV_D0(1); PV_D0(2); PV_D0(3);
#undef PV_D0
#undef TRRD
}
struct BlockRef { const bf16* Q; const bf16* K; const bf16* V; const float* KBp; const bf16* G; bf16* O; int P0; int j0; };
struct Seam { bf16x8 qr[8]; bf16x8 st_v0, st_v1, st_k0, st_k1; float st_b; };
#define ROWP(p, k0, rr) ((const char*)(p) + (size_t)((k0) + (rr)) * (LDQ * 2))
#define LD8V(base, off) (*reinterpret_cast<const bf16x8*>((base) + (off)))
#define VMW() asm volatile("s_waitcnt vmcnt(0)" ::: "memory")
#define VMWN(n) asm volatile("s_waitcnt vmcnt(%0)" :: "i"(n) : "memory")
#define SLOAD_H(Kp, Vp, Bp, k0) do { S.st_v0 = LD8V(ROWP(Vp, k0, 0), voff); S.st_v1 = LD8V(ROWP(Vp, k0, 32), voff);              \
                         S.st_k0 = LD8V(ROWP(Kp, k0, 0), voff); S.st_k1 = LD8V(ROWP(Kp, k0, 32), voff); \
                         if (tid < 64) S.st_b = *(const float*)((const char*)((Bp) + (k0)) + (unsigned)(tid * 4)); } while (0)
#define SWRITE_HK(bf) do { *(bf16x8*)(K_lds + (bf) * SHM_K + kws) = S.st_k0; *(bf16x8*)(K_lds + (bf) * SHM_K + kws + 32 * 256) = S.st_k1; if (tid < 64) kbl[(bf) * 64 + tid] = S.st_b; } while (0)
#define SWRITE_HV(bf) do { *(bf16x8*)(V_lds + (bf) * SHM_V + vst0) = S.st_v0; *(bf16x8*)(V_lds + (bf) * SHM_V + vst1) = S.st_v1; } while (0)
#define SWRITE_H(bf) do { SWRITE_HV(bf); SWRITE_HK(bf); } while (0)
__device__ __forceinline__ void fox_prime(const BlockRef& cur, char* lds, Seam& S) {
    const int tid = opaque_tid(), wid = __builtin_amdgcn_readfirstlane(tid >> 6), lane = tid & 63, r32 = lane & 31, hi = lane >> 5;
    const int sr = tid >> 4, sc = (tid & 15) * 8, kws = KSWZ(sr, sc * 2); char* K_lds = lds + 2 * SHM_V; float* kbl = (float*)(lds + OFF_KB);
    const unsigned voff = (unsigned)(sr * LDQ + sc) * 2u, qoff = (unsigned)(r32 * LDQ + hi * 8) * 2u;
    { const char* qb_ = (const char*)(cur.Q + (size_t)(wid * QBLK) * LDQ);
#pragma unroll
      for (int d0 = 0; d0 < 8; ++d0) S.qr[d0] = LD8V(qb_ + d0 * 32, qoff); }
    SLOAD_H(cur.K, cur.V, cur.KBp, cur.j0 * KVBLK); VMW(); SWRITE_HK(0);
    __syncthreads();
}
__device__ __forceinline__ void fox_block(const BlockRef& cur, const BlockRef& nxt, char* lds, Seam& S) {
    const int tid = opaque_tid(), wid = __builtin_amdgcn_readfirstlane(tid >> 6), lane = tid & 63, r32 = lane & 31, hi = lane >> 5;
    const int j_lo = cur.j0, NT = (cur.P0 + QB - 1) / KVBLK + 1 - j_lo;
    const int qlo = cur.P0 + wid * QBLK, qm = qlo + r32 - 4 * hi;
    char* V_lds = lds; char* K_lds = lds + 2 * SHM_V; float* kbl = (float*)(lds + OFF_KB);
    float* ws = (float*)(lds + OFF_WS) + wid * 64; float* li_l = ws, * al_l = ws + 32;
    float m_reg = -1e30f, l_reg = 0; f32x16 o[4] = {};
    const int sr = tid >> 4, sc = (tid & 15) * 8, vst0 = v_st(sr, sc), vst1 = v_st(32 + sr, sc), kws = KSWZ(sr, sc * 2);
    const unsigned voff = (unsigned)(sr * LDQ + sc) * 2u, qoff = (unsigned)(r32 * LDQ + hi * 8) * 2u;
    const int vb0 = (int)(uintptr_t)V_lds + v_rd_base(lane);
    const bf16* Kh = cur.K; const bf16* Vh = cur.V; const float* Bh = cur.KBp;
#define RESC(a) do { if (__any((a) < 1.f)) { if (hi == 0) al_l[r32] = (a); asm volatile("s_waitcnt lgkmcnt(0)" ::: "memory");              \
                     for (int d_ = 0; d_ < 4; ++d_) for (int r = 0; r < 16; ++r) o[d_][r] *= al_l[crow(r, hi)]; } } while (0)
#define KBASE(t) ((j_lo + (t)) * KVBLK)
#define MASKT(P0_, P1_, t) do { const int kb_ = KBASE(t); if (kb_ + KVBLK - 1 > qlo) mask_tile(P0_, P1_, qm - kb_); } while (0)
    constexpr int NQL = 8;
#define SEAM_K0() do { VMWN(NQL); SWRITE_HK(0); SBAR(); } while (0)
    f32x16 pA0, pA1, pB0, pB1; float mnA, mnB, alA, alB; bf16x8 pa0, pa1, pa2, pa3;
    SWRITE_HV(0); SBAR();
    if (NT > 1) { SLOAD_H(Kh, Vh, Bh, KBASE(1)); }
    SBAR(); qkt<0>(pA0, pA1, K_lds, kbl, r32, hi, S.qr);
    MASKT(pA0, pA1, 0); partialSM(pA0, pA1, m_reg, mnA, alA);
    if (NT > 1) { VMW(); SWRITE_H(1); }
    __syncthreads();
#define HALF_STEP(PX0, PX1, mnX, alX, PY0, PY1, alY, t, KB, VB, SB) do {                                                      \
        SBAR(); qkt<KB>(PX0, PX1, K_lds, kbl, r32, hi, S.qr);                                             \
        finishSM(PY0, PY1, alY, l_reg, pa0, pa1, pa2, pa3); SBAR();                                                           \
        if ((t) + 1 < NT) { SLOAD_H(Kh, Vh, Bh, KBASE((t) + 1)); SBAR(); }                                               \
        pv_tile<VB>(o, vb0, pa0, pa1, pa2, pa3); MASKT(PX0, PX1, (t)); partialSM(PX0, PX1, m_reg, mnX, alX);                                        \
        __syncthreads();                                                                                                      \
        if ((t) + 1 < NT) { VMW(); SWRITE_H(SB); }                                                                          \
        RESC(alX); __syncthreads(); } while (0)
    for (int t = 1; t + 1 < NT; t += 2) {
        HALF_STEP(pB0, pB1, mnB, alB, pA0, pA1, alA, t, 1, 0, 0);
        HALF_STEP(pA0, pA1, mnA, alA, pB0, pB1, alB, t + 1, 0, 1, 1);
    }
    const bool even = (NT & 1) == 0;
    if (even) { SBAR(); qkt<1>(pB0, pB1, K_lds, kbl, r32, hi, S.qr); SBAR(); }
    SLOAD_H(nxt.K, nxt.V, nxt.KBp, nxt.j0 * KVBLK); SBAR();
    { const char* qb_ = (const char*)(nxt.Q + (size_t)(wid * QBLK) * LDQ);
#pragma unroll
      for (int d0 = 0; d0 < 8; ++d0) S.qr[d0] = LD8V(qb_ + d0 * 32, qoff); }
    SBAR();
    finishSM(pA0, pA1, alA, l_reg, pa0, pa1, pa2, pa3); SBAR();
    pv_tile<0>(o, vb0, pa0, pa1, pa2, pa3);
    if (even) { MASKT(pB0, pB1, NT - 1); partialSM(pB0, pB1, m_reg, mnB, alB); __syncthreads(); RESC(alB);
        finishSM(pB0, pB1, alB, l_reg, pa0, pa1, pa2, pa3); SBAR(); pv_tile<1>(o, vb0, pa0, pa1, pa2, pa3); }
    SBAR(); SEAM_K0();
    if (hi == 0) li_l[r32] = l_reg; asm volatile("s_waitcnt lgkmcnt(0)" ::: "memory");
    float rli[16];
#pragma unroll
    for (int r = 0; r < 16; ++r) rli[r] = __builtin_amdgcn_rcpf(li_l[crow(r, hi)]);
    const char* Ob = (const char*)(cur.O + (size_t)(wid * QBLK) * LDO); const char* Gb = (const char*)(cur.G + (size_t)(wid * QBLK) * LDQ);
    const unsigned voffO = (unsigned)((4 * hi) * LDO + r32) * 2u, voffG = (unsigned)((4 * hi) * LDQ + r32) * 2u;
#pragma unroll
    for (int r = 0; r < 16; ++r) { const int rc = (r & 3) + 8 * (r >> 2);
        const char* Or = Ob + (size_t)rc * LDO * 2; const char* Gr = Gb + (size_t)rc * LDQ * 2;
#pragma unroll
        for (int d0 = 0; d0 < 4; ++d0) { const float v = o[d0][r] * rli[r]; const float vn = shx(v, 1, lane);
#ifdef X_NOGATE
            if ((r32 & 1) == 0) { *(unsigned*)(Or + d0 * 64 + voffO) = cvtpk(v, vn); } }
#else
            if ((r32 & 1) == 0) { const unsigned g2 = *(const unsigned*)(Gr + d0 * 64 + voffG);
                *(unsigned*)(Or + d0 * 64 + voffO) = cvtpk(v * bflo(g2), vn * bfhi(g2)); } }
#endif
        if ((r & 3) == 3) asm volatile("" ::: "memory"); }
    __syncthreads();
#undef RESC
#undef KBASE
#undef MASKT
#undef SEAM_K0
#undef HALF_STEP
}
#undef ROWP
#undef LD8V
#undef VMWN
#undef SLOAD_H
#undef SWRITE_HK
#undef SWRITE_HV
#undef SWRITE_H
__device__ __forceinline__ BlockRef mk_ref(const bf16* PROJ, const float* KBg, bf16* MO, const int* JL, int id) {
    const int bh = id & 31, qb = 63 - (id >> 5);
    BlockRef r; r.Q = PROJ + (size_t)(qb * QB) * LDQ + bh * D; r.K = PROJ + 4096 + bh * D; r.V = PROJ + 8192 + bh * D; r.KBp = KBg + (size_t)bh * SEQ;
    r.G = PROJ + (size_t)(qb * QB) * LDQ + 12288 + bh * D; r.O = MO + (size_t)(qb * QB) * LDO + bh * D; r.P0 = qb * QB; r.j0 = JL[id]; return r;
}
__device__ __forceinline__ void attn_phase(char* lds, const bf16* PROJ, const float* KBg, bf16* MO, const int* JL, unsigned* qctr) {
    constexpr int total = 32 * 64;
    const int tid = opaque_tid();
    volatile int* slot = (volatile int*)(lds + LDS_BYTES);
    if (tid == 0) slot[0] = (int)__hip_atomic_fetch_add(qctr, 1u, __ATOMIC_RELAXED, __HIP_MEMORY_SCOPE_AGENT);
    __syncthreads();
    int id = __builtin_amdgcn_readfirstlane(slot[0]);
    if (id >= total) return;
    BlockRef cur = mk_ref(PROJ, KBg, MO, JL, id);
    Seam S;
    fox_prime(cur, lds, S);
    for (;;) {
        if (tid == 0) slot[1] = (int)__hip_atomic_fetch_add(qctr, 1u, __ATOMIC_RELAXED, __HIP_MEMORY_SCOPE_AGENT);
        __syncthreads();
        const int idn = __builtin_amdgcn_readfirstlane(slot[1]);
        const bool last = idn >= total;
        const BlockRef nxt = last ? cur : mk_ref(PROJ, KBg, MO, JL, idn);
        fox_block(cur, nxt, lds, S);
        if (last) break;
        cur = nxt;
    }
}
#undef VMW
}
namespace hg {
constexpr int CH = 64, NCH = SEQ / CH;
constexpr int PK = 144;
constexpr int PQ = 272;
__device__ __forceinline__ f32x4 mma(bf16x8 bfrag, bf16x8 afrag, f32x4 acc) { return __builtin_amdgcn_mfma_f32_16x16x32_bf16(bfrag, afrag, acc, 0, 0, 0); }
__device__ __forceinline__ bf16x8 ldsfrag(const LAS unsigned char* base, int row, int pitch, int kbyte) { return *(const LAS bf16x8*)(base + row * pitch + kbyte); }

__device__ __forceinline__ void b1_phase(LAS unsigned char* lds, const bf16* PROJ, const float* Gg, float* UT, float* DEC, int vcu, int G) {
    const int tid = opaque_tid(), lane = tid & 63, wave = __builtin_amdgcn_readfirstlane(tid >> 6), col = tid & 127, sg = tid >> 7, r = lane & 15, q = lane >> 4;
    LAS unsigned char* KT = lds;
    LAS unsigned char* VT = lds + 128 * PK;
    LAS float* segtot = (LAS float*)(lds + 2 * 128 * PK);
    for (int u = vcu; u < NCH * NH; u += G) {
        const int c = u >> 5, h = u & 31; const int row0 = c * CH + 16 * sg;
        float b[16];
#pragma unroll
        for (int j = 0; j < 16; ++j) b[j] = Gg[(size_t)(row0 + j) * DM + h * DH + col];
        unsigned short kk[16], vv[16];
#pragma unroll
        for (int j = 0; j < 16; ++j) { kk[j] = PROJ[(size_t)(row0 + j) * 16384 + 4096 + h * DH + col]; vv[j] = PROJ[(size_t)(row0 + j) * 16384 + 8192 + h * DH + col]; }
#pragma unroll
        for (int j = 1; j < 16; ++j) b[j] += b[j - 1];
        segtot[sg * 128 + col] = b[15];
        __syncthreads();
        float off = 0.f, total = 0.f;
#pragma unroll
        for (int s2 = 0; s2 < 4; ++s2) { const float t = segtot[s2 * 128 + col]; total += t; if (s2 < sg) off += t; }
        const float rem = total - off;
        unsigned kw[8], vw[8];
#pragma unroll
        for (int j = 0; j < 8; ++j) { kw[j] = cvtpk(bf2f(kk[2 * j]) * fexp(rem - b[2 * j]), bf2f(kk[2 * j + 1]) * fexp(rem - b[2 * j + 1])); vw[j] = (unsigned)vv[2 * j] | ((unsigned)vv[2 * j + 1] << 16); }
        *(LAS v4u*)(KT + col * PK + 32 * sg) = (v4u){kw[0], kw[1], kw[2], kw[3]}; *(LAS v4u*)(KT + col * PK + 32 * sg + 16) = (v4u){kw[4], kw[5], kw[6], kw[7]};
        *(LAS v4u*)(VT + col * PK + 32 * sg) = (v4u){vw[0], vw[1], vw[2], vw[3]}; *(LAS v4u*)(VT + col * PK + 32 * sg + 16) = (v4u){vw[4], vw[5], vw[6], vw[7]};
        if (sg == 0) DEC[(size_t)u * 128 + col] = fexp(total);
        __syncthreads();
        const bf16x8 a0 = ldsfrag(VT, 16 * wave + r, PK, 16 * q), a1 = ldsfrag(VT, 16 * wave + r, PK, 64 + 16 * q);
        float* up = UT + ((size_t)u * 128 + 16 * wave + r) * 128 + 4 * q;
#pragma unroll
        for (int nt = 0; nt < 8; ++nt) { f32x4 acc = {0.f, 0.f, 0.f, 0.f};
            acc = mma(ldsfrag(KT, 16 * nt + r, PK, 16 * q), a0, acc); acc = mma(ldsfrag(KT, 16 * nt + r, PK, 64 + 16 * q), a1, acc);
            *(f32x4*)(up + 16 * nt) = acc; }
        __syncthreads();
    }
}
__device__ __forceinline__ void b2_phase(const float* UT, const float* DEC, bf16* ST, int vcu, int G) {
    for (int gid = vcu * 512 + opaque_tid(); gid < NH * 128 * 32; gid += G * 512) {
        const int h = gid >> 12, dv = (gid >> 5) & 127, dk4 = (gid & 31) * 4;
        f32x4 st = {0.f, 0.f, 0.f, 0.f};
        const size_t eo = ((size_t)h * 128 + dv) * 128 + dk4, estep = (size_t)NH * 128 * 128;
        const size_t dofs = (size_t)h * 128 + dk4, dstep = (size_t)NH * 128;
#pragma unroll 8
        for (int c = 0; c < NCH; ++c) {
            const f32x4 uu = *(const f32x4*)(UT + eo + c * estep); const f32x4 dd = *(const f32x4*)(DEC + dofs + c * dstep);
            v2u w; w.x = cvtpk(st.x, st.y); w.y = cvtpk(st.z, st.w); *(v2u*)(ST + eo + c * estep) = w;
            st = dd * st + uu;
        }
    }
}
constexpr int B3_QT = 0, B3_QH = B3_QT + 64 * PQ, B3_KH = B3_QH + 64 * PQ  , B3_VT = B3_KH + 160 * PQ, B3_P = B3_VT + 128 * PK, B3_SEG = B3_P + 64 * PK, B3_RS = B3_SEG + 2048, B3_END = B3_RS + 512;
__device__ __forceinline__ int kh_base(int I) { return 16 * (I * (I + 1) / 2); }
__device__ __forceinline__ void b3_phase(LAS unsigned char* lds, const bf16* PROJ, const float* Gg, const bf16* ST, const float* ogain, bf16* MO, int vcu, int G) {
    const int tid = opaque_tid(), lane = tid & 63, wave = __builtin_amdgcn_readfirstlane(tid >> 6), col = tid & 127, sg = tid >> 7, r = lane & 15, q = lane >> 4;
    LAS unsigned char* QT = lds + B3_QT; LAS unsigned char* QH = lds + B3_QH; LAS unsigned char* KH = lds + B3_KH; LAS unsigned char* VT = lds + B3_VT; LAS unsigned char* PP = lds + B3_P;
    LAS float* segtot = (LAS float*)(lds + B3_SEG); LAS float* rs = (LAS float*)(lds + B3_RS);
    for (int u = vcu; u < NCH * NH; u += G) {
        const int c = u >> 5, h = u & 31; const int row0 = c * CH + 16 * sg;
        float b[16];
#pragma unroll
        for (int j = 0; j < 16; ++j) b[j] = Gg[(size_t)(row0 + j) * DM + h * DH + col];
        unsigned short qq[16], kk[16], vv[16];
#pragma unroll
        for (int j = 0; j < 16; ++j) { const bf16* p = PROJ + (size_t)(row0 + j) * 16384 + h * DH + col; qq[j] = p[0]; kk[j] = p[4096]; vv[j] = p[8192]; }
#pragma unroll
        for (int j = 1; j < 16; ++j) b[j] += b[j - 1];
        segtot[sg * 128 + col] = b[15];
        __syncthreads();
        float st[4];
#pragma unroll
        for (int s2 = 0; s2 < 4; ++s2) st[s2] = segtot[s2 * 128 + col];
        float off = 0.f;
#pragma unroll
        for (int s2 = 0; s2 < 4; ++s2) if (s2 < sg) off += st[s2];
#pragma unroll
        for (int j = 0; j < 16; ++j) { const float qf = bf2f(qq[j]);
            *(LAS bf16*)(QT + (16 * sg + j) * PQ + 2 * col) = f2bf(qf * fexp(off + b[j]));
            *(LAS bf16*)(QH + (16 * sg + j) * PQ + 2 * col) = f2bf(qf * fexp(b[j])); }
        { float d = 0.f;
#pragma unroll
          for (int I = 0; I < 4; ++I) { if (I >= sg) {
#pragma unroll
                for (int j = 0; j < 16; ++j) *(LAS bf16*)(KH + (kh_base(I) + 16 * sg + j) * PQ + 2 * col) = f2bf(bf2f(kk[j]) * fexp(d - b[j]));
                d += st[I]; } } }
        { unsigned vw[8];
#pragma unroll
          for (int j = 0; j < 8; ++j) vw[j] = (unsigned)vv[2 * j] | ((unsigned)vv[2 * j + 1] << 16);
          *(LAS v4u*)(VT + col * PK + 32 * sg) = (v4u){vw[0], vw[1], vw[2], vw[3]}; *(LAS v4u*)(VT + col * PK + 32 * sg + 16) = (v4u){vw[4], vw[5], vw[6], vw[7]}; }
        __syncthreads();
#pragma unroll
        for (int tt = 0; tt < 2; ++tt) { const int tile = wave * 2 + tt, I = tile >> 2, J = tile & 3;
            f32x4 acc = {0.f, 0.f, 0.f, 0.f};
            if (J <= I) {
#pragma unroll
                for (int ks = 0; ks < 4; ++ks) acc = mma(ldsfrag(KH, kh_base(I) + 16 * J + r, PQ, 64 * ks + 16 * q), ldsfrag(QH, 16 * I + r, PQ, 64 * ks + 16 * q), acc);
                if (J == I) {
#pragma unroll
                    for (int i = 0; i < 4; ++i) if (4 * q + i > r) acc[i] = 0.f; }
            }
            v2u w; w.x = cvtpk(acc[0], acc[1]); w.y = cvtpk(acc[2], acc[3]);
            *(LAS v2u*)(PP + (16 * I + r) * PK + (16 * J + 4 * q) * 2) = w; }
        __syncthreads();
        const int mt = wave & 3, nh = wave >> 2;
        f32x4 acc[4];
        const bf16x8 pa0 = ldsfrag(PP, 16 * mt + r, PK, 16 * q), pa1 = ldsfrag(PP, 16 * mt + r, PK, 64 + 16 * q);
        bf16x8 qa[4];
#pragma unroll
        for (int ks = 0; ks < 4; ++ks) qa[ks] = ldsfrag(QT, 16 * mt + r, PQ, 64 * ks + 16 * q);
        const bf16* stp = ST + ((size_t)u * 128 + 64 * nh + r) * 128 + 8 * q;
#pragma unroll
        for (int nt = 0; nt < 4; ++nt) { f32x4 a = {0.f, 0.f, 0.f, 0.f};
            a = mma(ldsfrag(VT, 64 * nh + 16 * nt + r, PK, 16 * q), pa0, a); a = mma(ldsfrag(VT, 64 * nh + 16 * nt + r, PK, 64 + 16 * q), pa1, a);
#pragma unroll
            for (int ks = 0; ks < 4; ++ks) a = mma(*(const bf16x8*)(stp + (size_t)(16 * nt) * 128 + 32 * ks), qa[ks], a);
            acc[nt] = a; }
        float ss = 0.f;
#pragma unroll
        for (int nt = 0; nt < 4; ++nt) ss += (acc[nt][0] * acc[nt][0] + acc[nt][1] * acc[nt][1]) + (acc[nt][2] * acc[nt][2] + acc[nt][3] * acc[nt][3]);
        ss += shx(ss, 16, lane); ss += shx(ss, 32, lane);
        if (q == 0) rs[nh * 64 + 16 * mt + r] = ss;
        __syncthreads();
        const float rstd = rsqrtf((rs[16 * mt + r] + rs[64 + 16 * mt + r]) * (1.f / 128.f) + NORM_EPS);
        const size_t orow = (size_t)(c * CH + 16 * mt + r);
#pragma unroll
        for (int nt = 0; nt < 4; ++nt) { const int dv = 64 * nh + 16 * nt + 4 * q;
            const f32x4 g = *(const f32x4*)(ogain + dv); const v2u gt = *(const v2u*)(PROJ + orow * 16384 + 12288 + h * DH + dv);
            v2u w; w.x = cvtpk(acc[nt][0] * rstd * g.x * bflo(gt.x), acc[nt][1] * rstd * g.y * bfhi(gt.x)); w.y = cvtpk(acc[nt][2] * rstd * g.z * bflo(gt.y), acc[nt][3] * rstd * g.w * bfhi(gt.y));
            *(v2u*)(MO + orow * DM + h * DH + dv) = w; }
        __syncthreads();
    }
}
}
constexpr int RING_BYTES = 131072;
constexpr int MISC_OFF = RING_BYTES + 320;
constexpr int LDS_BYTES = 147456;
constexpr int CW_BAR = 4096;
constexpr int CW_Q = 8192;
static_assert(fa::LDS_BYTES + 16 <= RING_BYTES && hg::B3_END <= RING_BYTES, "phase scratch fits the ring region");
static_assert(WS_END <= (size_t)4096 * MiB, "workspace map");

constexpr int PH_FINAL = 49, PH_END = 50;
struct Args { const float* in[15]; float* out; unsigned char* ws; int ph_lo, ph_hi; };
static_assert(sizeof(Args) == 15 * 8 + 8 + 8 + 4 + 4, "Args has no padding bytes");

__global__ void __launch_bounds__(NWAVES * 64, 2) trunk_fwd(Args args) {
    extern __shared__ __attribute__((aligned(16))) unsigned char lds_raw[];
    LAS unsigned char* lds = (LAS unsigned char*)lds_raw;
    volatile LAS unsigned* MISC = (volatile LAS unsigned*)(lds + MISC_OFF);
    const int tid = threadIdx.x;
    const int G = gridDim.x, bx = blockIdx.x;
    const int vcu = (G % 8 == 0) ? (bx % 8) * (G / 8) + bx / 8 : bx;
    unsigned char* ws = args.ws;
    for (int u = tid; u < (LDS_BYTES - RING_BYTES) / 4; u += NWAVES * 64) ((LAS unsigned*)(lds + RING_BYTES))[u] = 0u;
    __syncthreads();
    const int lo = args.ph_lo, hi = args.ph_hi;
#if MK_PER_PHASE
#define GRID_BAR(p) do { } while (0)
#else
    XcdBarrier bar = xcd_barrier_post((unsigned*)(ws + WS_CTL) + CW_BAR, MISC + 8);
#define GRID_BAR(p) do { if ((p) + 1 < hi) xcd_barrier(bar); } while (0)
#endif
#ifndef ONLY_SITE
#define ONLY_SITE -1
#endif
#define EN(s) (ONLY_SITE == -1 || ONLY_SITE == (s))
#ifndef DUP_SITE
#define DUP_SITE -1
#endif
#define DUP(s) (DUP_SITE == (s))
#define IN(k) (lo <= (k) && (k) < hi)
    const float* x = args.in[0];
    float* Hb = (float*)(ws + WS_H); bf16* XN = (bf16*)(ws + WS_XN); bf16* MO = (bf16*)(ws + WS_MO); bf16* PROJ = (bf16*)(ws + WS_PROJ);
    float* Gg = (float*)(ws + WS_G); float* UT = (float*)(ws + WS_UT); bf16* ST = (bf16*)(ws + WS_ST);
    float* LOGF = (float*)(ws + WS_LOGF); float* KB = (float*)(ws + WS_KB); float* DEC = (float*)(ws + WS_DEC); const float* LB = (const float*)(ws + WS_LB); int* JL = (int*)(ws + WS_LB + 512 * 1024);

    if (EN(0) && IN(0)) {
        ProArgs pa{args.in[1], args.in[2], args.in[6], args.in[7], args.in[12], args.in[13], args.in[9]};
        prologue_phase(lds, ws, pa, vcu, G);
        GRID_BAR(0);
        if (DUP(0)) { prologue_phase(lds, ws, pa, vcu, G); GRID_BAR(0); }
    }
    for (int L = 0; L < DEPTH; ++L) {
        const int pb = 1 + 12 * L, j = L >> 1; const bool fox = (L & 1) == 0;
        const float* hsrc = (L == 0) ? x : Hb;
        if (EN(1) && IN(pb + 0)) { rms_phase<false>(hsrc, args.in[10] + (size_t)L * DM, XN, vcu, G); GRID_BAR(pb + 0); if (DUP(1)) { rms_phase<false>(hsrc, args.in[10] + (size_t)L * DM, XN, vcu, G); GRID_BAR(pb + 0); } }
        if (fox) {
            if (EN(2) && IN(pb + 1)) {
                pg8::Gemm g{XN, (const bf16*)(ws + WS_WFIN) + (size_t)j * FOX_INP * DM, SEQ, FOX_INP, DM}; pg8::StaticOrder S; S.init(SEQ, FOX_INP, G, bx);
                pg8::EpiFox E{PROJ, 16384, LOGF, args.in[5] + j * NH};
                pg8::gemm_phase<pg8::EpiFox, pg8::StaticOrder, true, true>(lds, g, S, E);
                GRID_BAR(pb + 1);
            }
            if (EN(3) && IN(pb + 2)) { fox_thin_phase(lds, PROJ, LOGF, KB, args.in[3] + j * DH, args.in[4] + j * DH, vcu, G); GRID_BAR(pb + 2); }
            if (EN(14) && IN(pb + 3)) { jl_phase(lds, KB, args.in[3] + j * DH, args.in[4] + j * DH, JL, vcu, G); GRID_BAR(pb + 3); }
            if (EN(4) && IN(pb + 4)) { fa::attn_phase((char*)lds_raw, PROJ, KB, MO, JL, (unsigned*)(ws + WS_CTL) + CW_Q + 64 * j); GRID_BAR(pb + 4); }
        } else {
            if (EN(5) && IN(pb + 1)) {
                pg8::Gemm g{XN, (const bf16*)(ws + WS_WHIN) + (size_t)j * HG_IN * DM, SEQ, HG_IN, DM}; pg8::StaticOrder S; S.init(SEQ, HG_IN, G, bx);
                pg8::EpiHgrn E{PROJ, 16384, Gg, LB + (size_t)L * DM};
                pg8::gemm_phase<pg8::EpiHgrn, pg8::StaticOrder, true, true>(lds, g, S, E);
                GRID_BAR(pb + 1);
            }
            if (EN(6) && IN(pb + 2)) { hg::b1_phase(lds, PROJ, Gg, UT, DEC, vcu, G); GRID_BAR(pb + 2); }
            if (EN(7) && IN(pb + 3)) { hg::b2_phase(UT, DEC, ST, vcu, G); GRID_BAR(pb + 3); }
            if (EN(8) && IN(pb + 4)) { hg::b3_phase(lds, PROJ, Gg, ST, args.in[8] + j * DH, MO, vcu, G); GRID_BAR(pb + 4); }
            if (DUP(6)) { hg::b1_phase(lds, PROJ, Gg, UT, DEC, vcu, G); GRID_BAR(pb + 2); hg::b2_phase(UT, DEC, ST, vcu, G); GRID_BAR(pb + 3); hg::b3_phase(lds, PROJ, Gg, ST, args.in[8] + j * DH, MO, vcu, G); GRID_BAR(pb + 4); }
        }
        if (EN(9) && IN(pb + 5)) {
            const bf16* W = fox ? (const bf16*)(ws + WS_WFOUT) + (size_t)j * DM * DM : (const bf16*)(ws + WS_WHOUT) + (size_t)j * DM * DM;
            pg8::Gemm g{MO, W, SEQ, DM, DM}; pg8::StaticOrder S; S.init(SEQ, DM, G, bx);
            pg8::EpiRes E{hsrc, Hb, DM};
            pg8::gemm_phase<pg8::EpiRes, pg8::StaticOrder, true, true>(lds, g, S, E);
            GRID_BAR(pb + 5);
        }
        if (EN(10) && IN(pb + 6)) { rms_phase<false>(Hb, args.in[11] + (size_t)L * DM, XN, vcu, G); GRID_BAR(pb + 6); if (DUP(1)) { rms_phase<false>(Hb, args.in[11] + (size_t)L * DM, XN, vcu, G); GRID_BAR(pb + 6); } }
        if (EN(11) && IN(pb + 7)) {
            pg8::Gemm g{XN, (const bf16*)(ws + WS_WUP) + (size_t)L * DFF * DM, SEQ, DFF, DM}; pg8::StaticOrder S; S.init(SEQ, DFF, G, bx);
            pg8::EpiSqRelu E{PROJ, DFF};
            pg8::gemm_phase<pg8::EpiSqRelu, pg8::StaticOrder, true, true>(lds, g, S, E);
            GRID_BAR(pb + 7);
            if (DUP(11)) { pg8::gemm_phase<pg8::EpiSqRelu, pg8::StaticOrder, true, true>(lds, g, S, E); GRID_BAR(pb + 7); }
        }
        if (EN(12) && IN(pb + 8)) {
            pg8::Gemm g{PROJ, (const bf16*)(ws + WS_WDN) + (size_t)L * DM * DFF, SEQ, DM, DFF}; pg8::StaticOrder S; S.init(SEQ, DM, G, bx);
            pg8::EpiRes E{Hb, Hb, DM};
            pg8::gemm_phase<pg8::EpiRes, pg8::StaticOrder, true, true>(lds, g, S, E);
            GRID_BAR(pb + 8);
        }
    }
    if (EN(13) && IN(PH_FINAL)) rms_phase<true>(Hb, args.in[14], args.out, vcu, G);
#undef IN
#undef GRID_BAR
}

extern "C" void kernel_launch(void* const* d_in, const int* in_sizes, int n_in, void* d_out, int out_size, void* d_ws, size_t ws_size, hipStream_t stream) {
    static int grid = 0;
    if (grid == 0) {
        if (n_in != 15 || in_sizes[0] != SEQ * DM || out_size != SEQ * DM || ws_size < WS_END) { fprintf(stderr, "kernel_launch: unexpected shapes (n_in %d, in0 %d, out %d, ws %zu < %zu)\n", n_in, n_in > 0 ? in_sizes[0] : -1, out_size, ws_size, (size_t)WS_END); grid = -1; return; }
        int dev = 0, cus = 0, per_cu = 0;
        if (hipGetDevice(&dev) != hipSuccess || hipDeviceGetAttribute(&cus, hipDeviceAttributeMultiprocessorCount, dev) != hipSuccess) { grid = -1; return; }
        if (hipFuncSetAttribute((const void*)trunk_fwd, hipFuncAttributeMaxDynamicSharedMemorySize, LDS_BYTES) != hipSuccess) { fprintf(stderr, "kernel_launch: hipFuncSetAttribute failed\n"); grid = -1; return; }
        if (hipOccupancyMaxActiveBlocksPerMultiprocessor(&per_cu, (const void*)trunk_fwd, NWAVES * 64, LDS_BYTES) != hipSuccess || per_cu < 1) fprintf(stderr, "kernel_launch: occupancy query says %d\n", per_cu);
        (void)hipGetLastError();
        grid = cus;
    }
    if (grid < 0) return;
    if (hipMemsetAsync((char*)d_ws + WS_CTL, 0, CTL_ZERO_BYTES, stream) != hipSuccess) return;
    Args a{};
    for (int i = 0; i < 15; ++i) a.in[i] = (const float*)d_in[i];
    a.out = (float*)d_out; a.ws = (unsigned char*)d_ws;
#if MK_PER_PHASE
    for (int p = 0; p < PH_END; ++p) {
        bool valid = (p == 0) || (p == PH_FINAL);
        if (p >= 1 && p < PH_FINAL) { const int L = (p - 1) / 12, k = (p - 1) % 12; const bool fox = (L & 1) == 0; valid = (k <= 8); }
        if (!valid) continue;
        a.ph_lo = p; a.ph_hi = p + 1;
        hipLaunchKernelGGL(trunk_fwd, dim3(grid), dim3(NWAVES * 64), LDS_BYTES, stream, a);
    }
#else
    a.ph_lo = 0; a.ph_hi = PH_END;
    hipLaunchKernelGGL(trunk_fwd, dim3(grid), dim3(NWAVES * 64), LDS_BYTES, stream, a);
#endif
}
```

```cpp
#define MK_PER_PHASE 0
#define DUP_SITE -1
#include <hip/hip_runtime.h>
#include <hip/hip_bf16.h>
#include <cstdio>
#include <cstdint>

#ifndef MK_PER_PHASE
#define MK_PER_PHASE 0
#endif

constexpr int SEQ = 16384, DM = 4096, DFF = 16384, NH = 32, DH = 128, DEPTH = 4;
constexpr int FOX_IN = 4 * DM + NH;
constexpr int FOX_INP = 65 * 256;
constexpr int HG_IN = 4 * DM;
constexpr float NORM_EPS = 1e-6f;
constexpr float LOG2E = 1.4426950408889634f;
constexpr float QSCALE = 0.08838834764831845f * LOG2E;

constexpr size_t MiB = 1u << 20;
constexpr size_t WS_CTL = 0, CTL_ZERO_BYTES = 1 * MiB;
constexpr size_t WS_WFIN = 1 * MiB;
constexpr size_t WS_WFOUT = WS_WFIN + 260 * MiB;
constexpr size_t WS_WHIN = WS_WFOUT + 64 * MiB;
constexpr size_t WS_WHOUT = WS_WHIN + 256 * MiB;
constexpr size_t WS_WUP = WS_WHOUT + 64 * MiB;
constexpr size_t WS_WDN = WS_WUP + 512 * MiB;
constexpr size_t WS_H = WS_WDN + 512 * MiB;
constexpr size_t WS_XN = WS_H + 256 * MiB;
constexpr size_t WS_MO = WS_XN + 128 * MiB;
constexpr size_t WS_PROJ = WS_MO + 128 * MiB;
constexpr size_t WS_G = WS_PROJ + 512 * MiB;
constexpr size_t WS_UT = WS_G + 256 * MiB;
constexpr size_t WS_ST = WS_UT + 512 * MiB;
constexpr size_t WS_LOGF = WS_ST + 256 * MiB;
constexpr size_t WS_KB = WS_LOGF + 2 * MiB;
constexpr size_t WS_DEC = WS_KB + 2 * MiB;
constexpr size_t WS_LB = WS_DEC + 4 * MiB;
constexpr size_t WS_END = WS_LB + 1 * MiB;

#define GAS __attribute__((address_space(1)))
#define LAS __attribute__((address_space(3)))
typedef unsigned short bf16;
typedef unsigned v4u __attribute__((ext_vector_type(4)));
typedef unsigned v2u __attribute__((ext_vector_type(2)));
typedef float f32x4 __attribute__((ext_vector_type(4)));
typedef float f32x16 __attribute__((ext_vector_type(16)));
typedef short bf16x8 __attribute__((ext_vector_type(8)));
typedef short s16x4 __attribute__((ext_vector_type(4)));
#define LDS_WAIT() asm volatile("s_waitcnt lgkmcnt(0)" ::: "memory")
#define VM_WAIT() asm volatile("s_waitcnt vmcnt(0)" ::: "memory")
typedef float f32x2_t __attribute__((ext_vector_type(2)));
typedef __bf16 bf16x2_t __attribute__((ext_vector_type(2)));
__device__ __forceinline__ unsigned cvtpk(float lo, float hi) { const f32x2_t v = {lo, hi}; return __builtin_bit_cast(unsigned, __builtin_convertvector(v, bf16x2_t)); }
__device__ __forceinline__ float bflo(unsigned w) { return __uint_as_float(w << 16); }
__device__ __forceinline__ float bfhi(unsigned w) { return __uint_as_float(w & 0xffff0000u); }
__device__ __forceinline__ float bf2f(bf16 b) { return __uint_as_float(((unsigned)b) << 16); }
__device__ __forceinline__ bf16 f2bf(float f) { return (bf16)(cvtpk(f, 0.f) & 0xffffu); }
__device__ __forceinline__ float fexp(float x) { return __builtin_amdgcn_exp2f(x * LOG2E); }
__device__ __forceinline__ float sigmoidf_(float x) { return __builtin_amdgcn_rcpf(1.f + fexp(-x)); }
__device__ __forceinline__ int opaque_tid() { int t = threadIdx.x; asm volatile("" : "+v"(t)); return t; }
__device__ __forceinline__ float shx(float v, int o, int lane) { return __int_as_float(__builtin_amdgcn_ds_bpermute((lane ^ o) << 2, __float_as_int(v))); }
namespace pg8 {
#define PG8_LAS __attribute__((address_space(3)))
typedef unsigned short bf16_t;
typedef short bf16x8 __attribute__((ext_vector_type(8)));
typedef float f32x4 __attribute__((ext_vector_type(4)));
typedef unsigned u32x4 __attribute__((ext_vector_type(4)));
constexpr int BM = 256, BK = 64, HALF = 128, HTB = HALF * BK * 2  , STAGE_BYTES = 8 * HTB, NXCD = 8, WGM = 8;

__host__ __device__ __forceinline__ int lds_byte(int r, int c) { const int st = (r >> 4) * 2 + (c >> 5), rr = r & 15, cc = c & 31, ob = rr * 64 + cc * 2; return st * 1024 + (ob ^ (((ob >> 9) & 1) << 5)); }
__host__ __device__ __forceinline__ void stage_rc(int b, int& R, int& C) { const int st = b / 1024, sb = b % 1024, swz = sb ^ (((sb >> 9) & 1) << 5); R = (st >> 1) * 16 + swz / 64; C = (st & 1) * 32 + (swz % 64) / 2; }
__host__ __device__ __forceinline__ int perm32(int rho) { const int n = rho >> 4, i = rho & 15; return 8 * (i >> 2) + 4 * n + (i & 3); }

struct Unit { int pm, pn; };
struct Gemm { const bf16_t* A; const bf16_t* Bt; int M, N, K; };

struct StaticOrder {
    int nM, nN, nwg, G, c;
    __host__ __device__ void init(int M, int N, int G_, int c_) { nM = M / BM; nN = N / BM; nwg = nM * nN; G = G_; c = c_; }
    __host__ __device__ bool next(int i, Unit& u) const {
        const long L = (long)i * G + c; if (L >= nwg) return false;
        int wgid = (int)L; { const int q = nwg / NXCD, r = nwg % NXCD, xcd = wgid % NXCD, off = wgid / NXCD; wgid = (xcd < r ? xcd * (q + 1) : r * (q + 1) + (xcd - r) * q) + off; }
        const int nig = WGM * nN, gid = wgid / nig, fm = gid * WGM, gsz = (nM - fm) < WGM ? (nM - fm) : WGM;
        u.pm = fm + ((wgid % nig) % gsz); u.pn = (wgid % nig) / gsz; return true;
    }
    __device__ __forceinline__ void a_ready(const Unit&) const {}
    __device__ __forceinline__ void done(const Unit&) const {}
};
__device__ __forceinline__ unsigned cvt_pk_bf16(float lo, float hi) { return ::cvtpk(lo, hi); }
__device__ __forceinline__ float sigm(float x) { return __builtin_amdgcn_rcpf(1.f + __builtin_amdgcn_exp2f(-1.4426950408889634f * x)); }

struct EpiRes {
    static constexpr bool PERM = false, AFTER_DRAIN = false;
    const float* base; float* out; int ldc;
    __device__ __forceinline__ void operator()(const f32x4 (&acc)[2][2][4][2], const Unit& u, int wr, int wc, int fr, int fq) const {
        const int row0 = u.pm * BM + wr * 64 + fr, col0 = u.pn * BM + wc * 32 + 4 * fq;
#pragma unroll
        for (int ai = 0; ai < 2; ++ai)
#pragma unroll
            for (int m = 0; m < 4; ++m) { const size_t off = (size_t)(row0 + ai * HALF + m * 16) * ldc + col0;
                f32x4 b[2][2];
#pragma unroll
                for (int bj = 0; bj < 2; ++bj)
#pragma unroll
                    for (int n = 0; n < 2; ++n) b[bj][n] = *(const f32x4*)(base + off + bj * HALF + n * 16);
#pragma unroll
                for (int bj = 0; bj < 2; ++bj)
#pragma unroll
                    for (int n = 0; n < 2; ++n) *(f32x4*)(out + off + bj * HALF + n * 16) = b[bj][n] + acc[ai][bj][m][n];
                asm volatile("" ::: "memory"); }
    }
};
struct EpiSqRelu {
    static constexpr bool PERM = true, AFTER_DRAIN = false;
    bf16_t* O; int ldc;
    __device__ __forceinline__ void operator()(const f32x4 (&acc)[2][2][4][2], const Unit& u, int wr, int wc, int fr, int fq) const {
        const int row0 = u.pm * BM + wr * 64 + fr, col0 = u.pn * BM + wc * 32 + 8 * fq;
#pragma unroll
        for (int ai = 0; ai < 2; ++ai)
#pragma unroll
            for (int m = 0; m < 4; ++m) { bf16_t* rowp = O + (size_t)(row0 + ai * HALF + m * 16) * ldc + col0;
#pragma unroll
                for (int bj = 0; bj < 2; ++bj) { f32x4 v0 = acc[ai][bj][m][0], v1 = acc[ai][bj][m][1];
#pragma unroll
                    for (int j = 0; j < 4; ++j) { const float a = fmaxf(v0[j], 0.f), b = fmaxf(v1[j], 0.f); v0[j] = a * a; v1[j] = b * b; }
                    u32x4 w; w.x = cvt_pk_bf16(v0[0], v0[1]); w.y = cvt_pk_bf16(v0[2], v0[3]); w.z = cvt_pk_bf16(v1[0], v1[1]); w.w = cvt_pk_bf16(v1[2], v1[3]);
                    *(u32x4*)(rowp + bj * HALF) = w; } }
    }
};
struct EpiFox {
    static constexpr bool PERM = true, AFTER_DRAIN = false;
    bf16_t* P; int ldc; float* logf; const float* fbias; float* cs;
    __device__ __forceinline__ void operator()(const f32x4 (&acc)[2][2][4][2], const Unit& u, int wr, int wc, int fr, int fq) const {
        const int row0 = u.pm * BM + wr * 64 + fr;
        if (u.pn < 64) {
            const int col0 = u.pn * BM + wc * 32 + 8 * fq; const bool gate = u.pn >= 48;
#pragma unroll
            for (int ai = 0; ai < 2; ++ai)
#pragma unroll
                for (int m = 0; m < 4; ++m) { bf16_t* rowp = P + (size_t)(row0 + ai * HALF + m * 16) * ldc + col0;
#pragma unroll
                    for (int bj = 0; bj < 2; ++bj) { f32x4 v0 = acc[ai][bj][m][0], v1 = acc[ai][bj][m][1];
                        if (gate) {
#pragma unroll
                            for (int j = 0; j < 4; ++j) { v0[j] = sigm(v0[j]); v1[j] = sigm(v1[j]); } }
                        u32x4 w; w.x = cvt_pk_bf16(v0[0], v0[1]); w.y = cvt_pk_bf16(v0[2], v0[3]); w.z = cvt_pk_bf16(v1[0], v1[1]); w.w = cvt_pk_bf16(v1[2], v1[3]);
                        *(u32x4*)(rowp + bj * HALF) = w; } }
        } else if (wc == 0) {
            const f32x4 b0 = *(const f32x4*)(fbias + 8 * fq), b1 = *(const f32x4*)(fbias + 8 * fq + 4);
            f32x4 s0[2] = {{0.f, 0.f, 0.f, 0.f}, {0.f, 0.f, 0.f, 0.f}}, s1[2] = {{0.f, 0.f, 0.f, 0.f}, {0.f, 0.f, 0.f, 0.f}};
#pragma unroll
            for (int ai = 0; ai < 2; ++ai)
#pragma unroll
                for (int m = 0; m < 4; ++m) { float* rowp = logf + (size_t)(row0 + ai * HALF + m * 16) * 32 + 8 * fq;
                    f32x4 v0 = acc[ai][0][m][0] + b0, v1 = acc[ai][0][m][1] + b1;
#pragma unroll
                    for (int j = 0; j < 4; ++j) { v0[j] = fminf(v0[j], 0.f) - log1pf(expf(-fabsf(v0[j]))); v1[j] = fminf(v1[j], 0.f) - log1pf(expf(-fabsf(v1[j]))); }
                    *(f32x4*)rowp = v0; *(f32x4*)(rowp + 4) = v1; s0[ai] += v0; s1[ai] += v1; }
            const int lane = fq * 16 + fr;
#pragma unroll
            for (int ai = 0; ai < 2; ++ai) {
#pragma unroll
                for (int j = 0; j < 4; ++j) {
#pragma unroll
                    for (int o = 1; o < 16; o <<= 1) { s0[ai][j] += ::shx(s0[ai][j], o, lane); s1[ai][j] += ::shx(s1[ai][j], o, lane); } }
                if (fr == 0) { float* cp = cs + (size_t)(u.pm * 4 + ai * 2 + wr) * 32 + 8 * fq; *(f32x4*)cp = s0[ai]; *(f32x4*)(cp + 4) = s1[ai]; } }
        }
    }
};
struct EpiHgrn {
    static constexpr bool PERM = true, AFTER_DRAIN = false;
    bf16_t* P; int ldc; float* G; const float* lb;
    __device__ __forceinline__ void operator()(const f32x4 (&acc)[2][2][4][2], const Unit& u, int wr, int wc, int fr, int fq) const {
        const int row0 = u.pm * BM + wr * 64 + fr, col0 = u.pn * BM + wc * 32 + 8 * fq; const int kind = u.pn >> 4;
        if (kind == 1) {
            const int gc0 = col0 - 4096;
            f32x4 l0[2], l1[2];
#pragma unroll
            for (int bj = 0; bj < 2; ++bj) { l0[bj] = *(const f32x4*)(lb + gc0 + bj * HALF); l1[bj] = *(const f32x4*)(lb + gc0 + bj * HALF + 4); }
#pragma unroll
            for (int ai = 0; ai < 2; ++ai)
#pragma unroll
                for (int m = 0; m < 4; ++m) { const size_t r = (size_t)(row0 + ai * HALF + m * 16); bf16_t* rowp = P + r * ldc + col0; float* gp = G + r * 4096 + gc0;
#pragma unroll
                    for (int bj = 0; bj < 2; ++bj) { f32x4 v0 = acc[ai][bj][m][0], v1 = acc[ai][bj][m][1], g0, g1;
#pragma unroll
                        for (int j = 0; j < 4; ++j) { const float f0 = l0[bj][j] + (1.f - l0[bj][j]) * sigm(v0[j]), f1 = l1[bj][j] + (1.f - l1[bj][j]) * sigm(v1[j]);
                            g0[j] = logf(f0); g1[j] = logf(f1); v0[j] = 1.f - f0; v1[j] = 1.f - f1; }
                        u32x4 w; w.x = cvt_pk_bf16(v0[0], v0[1]); w.y = cvt_pk_bf16(v0[2], v0[3]); w.z = cvt_pk_bf16(v1[0], v1[1]); w.w = cvt_pk_bf16(v1[2], v1[3]);
                        *(u32x4*)(rowp + bj * HALF) = w; *(f32x4*)(gp + bj * HALF) = g0; *(f32x4*)(gp + bj * HALF + 4) = g1; } }
        } else {
            const bool act = kind != 2;
#pragma unroll
            for (int ai = 0; ai < 2; ++ai)
#pragma unroll
                for (int m = 0; m < 4; ++m) { bf16_t* rowp = P + (size_t)(row0 + ai * HALF + m * 16) * ldc + col0;
#pragma unroll
                    for (int bj = 0; bj < 2; ++bj) { f32x4 v0 = acc[ai][bj][m][0], v1 = acc[ai][bj][m][1];
                        if (act) {
#pragma unroll
                            for (int j = 0; j < 4; ++j) { v0[j] = v0[j] * sigm(v0[j]); v1[j] = v1[j] * sigm(v1[j]); } }
                        u32x4 w; w.x = cvt_pk_bf16(v0[0], v0[1]); w.y = cvt_pk_bf16(v0[2], v0[3]); w.z = cvt_pk_bf16(v1[0], v1[1]); w.w = cvt_pk_bf16(v1[2], v1[3]);
                        *(u32x4*)(rowp + bj * HALF) = w; } }
        }
    }
};
template <class Epi, class Sched, bool ALIGN_EPI = false, bool SP2 = false>
__device__ __forceinline__ void gemm_phase(PG8_LAS unsigned char* lds, const Gemm g, const Sched& S, const Epi& E) {
    const int tid = opaque_tid(), wid = __builtin_amdgcn_readfirstlane(tid >> 6), lane = tid & 63, wr = wid >> 2, wc = wid & 3, fr = lane & 15, fq = lane >> 4;
    const int K = g.K, nt = K / BK;
    unsigned voffA[2], voffB[2];
#pragma unroll
    for (int i = 0; i < 2; ++i) { int R, C; stage_rc(tid * 16 + i * 8192, R, C); const int Rb = Epi::PERM ? ((R & ~31) + perm32(R & 31)) : R;
        voffA[i] = (unsigned)(R * K + C) * 2u; voffB[i] = (unsigned)(Rb * K + C) * 2u; }
    const size_t kstep = (size_t)(BK * 2);
    const size_t hstep = (size_t)HALF * K * 2;
    const size_t tstep = 2 * hstep;
    const unsigned ldsw = (unsigned)wid * 1024u;
    const int aoff = lds_byte(wr * 64 + fr, fq * 8), boff = lds_byte(wc * 32 + fr, fq * 8);
#define PG8_SA(b, h) (((b) * 2 + (h)) * HTB)
#define PG8_SB(b, h) ((4 + (b) * 2 + (h)) * HTB)
#define PG8_STAGE(bufoff, gbase, voff) do { _Pragma("unroll") for (int _i = 0; _i < 2; ++_i) \
        __builtin_amdgcn_global_load_lds((const unsigned*)((const char*)(gbase) + (voff)[_i]), (PG8_LAS unsigned*)(lds + (bufoff) + ldsw + _i * 8192), 16, 0, 0); } while (0)
#define PG8_LDA(dst, b, h) do { _Pragma("unroll") for (int m = 0; m < 4; ++m) _Pragma("unroll") for (int k = 0; k < 2; ++k) dst[m][k] = *(const PG8_LAS bf16x8*)(lds + PG8_SA(b, h) + aoff + m * 2048 + k * 1024); } while (0)
#define PG8_LDB(dst, b, h) do { _Pragma("unroll") for (int n = 0; n < 2; ++n) _Pragma("unroll") for (int k = 0; k < 2; ++k) dst[n][k] = *(const PG8_LAS bf16x8*)(lds + PG8_SB(b, h) + boff + n * 2048 + k * 1024); } while (0)
#define PG8_MMA(ai, bj, At, Bt) do { __builtin_amdgcn_s_setprio(1); _Pragma("unroll") for (int m = 0; m < 4; ++m) _Pragma("unroll") for (int n = 0; n < 2; ++n) _Pragma("unroll") for (int k = 0; k < 2; ++k) \
        acc[ai][bj][m][n] = __builtin_amdgcn_mfma_f32_16x16x32_bf16(Bt[n][k], At[m][k], acc[ai][bj][m][n], 0, 0, 0); __builtin_amdgcn_s_setprio(0); } while (0)
#define PG8_WAIT_V(n) asm volatile("s_waitcnt vmcnt(" #n ")" ::: "memory")
#define PG8_WAIT_L(n) asm volatile("s_waitcnt lgkmcnt(" #n ")" ::: "memory")
#define PG8_BAR __builtin_amdgcn_s_barrier()
#define PG8_SCHED __builtin_amdgcn_sched_barrier(0)
    Unit cur, nxt; int ui = 0;
    if (!S.next(0, cur)) return;
    f32x4 acc[2][2][4][2];
#pragma unroll
    for (int a = 0; a < 2; ++a)
#pragma unroll
        for (int b = 0; b < 2; ++b)
#pragma unroll
            for (int m = 0; m < 4; ++m)
#pragma unroll
                for (int n = 0; n < 2; ++n) acc[a][b][m][n] = (f32x4){0.f, 0.f, 0.f, 0.f};
    bf16x8 At[4][2], B0[2][2], B1[2][2];
    const char* cA = (const char*)g.A + (size_t)cur.pm * tstep; const char* cB = (const char*)g.Bt + (size_t)cur.pn * tstep;
    S.a_ready(cur);
    if constexpr (SP2) {
        PG8_STAGE(PG8_SB(0, 0), cB, voffB); PG8_STAGE(PG8_SB(0, 1), cB + hstep, voffB); PG8_STAGE(PG8_SA(0, 0), cA, voffA); PG8_STAGE(PG8_SA(0, 1), cA + hstep, voffA);
        if (wr == 1) PG8_BAR;
        PG8_WAIT_V(2); PG8_BAR;
        PG8_STAGE(PG8_SB(1, 0), cB + kstep, voffB); PG8_STAGE(PG8_SA(1, 0), cA + kstep, voffA); PG8_STAGE(PG8_SB(1, 1), cB + hstep + kstep, voffB);
        PG8_WAIT_V(6); PG8_BAR;
    } else {
        PG8_STAGE(PG8_SB(0, 0), cB, voffB); PG8_STAGE(PG8_SA(0, 0), cA, voffA); PG8_STAGE(PG8_SB(0, 1), cB + hstep, voffB); PG8_STAGE(PG8_SA(0, 1), cA + hstep, voffA);
        if (wr == 1) PG8_BAR;
        PG8_WAIT_V(4); PG8_BAR;
        PG8_STAGE(PG8_SB(1, 0), cB + kstep, voffB); PG8_STAGE(PG8_SA(1, 0), cA + kstep, voffA); PG8_STAGE(PG8_SB(1, 1), cB + hstep + kstep, voffB);
        PG8_WAIT_V(6); PG8_BAR;
    }
    for (;;) {
        const bool has_next = S.next(ui + 1, nxt);
        const char* nA = has_next ? (const char*)g.A + (size_t)nxt.pm * tstep : cA; const char* nB = has_next ? (const char*)g.Bt + (size_t)nxt.pn * tstep : cB;
        for (int t = 0; t < nt; t += 2) {
            const bool last = (t == nt - 2);
            const char* a1 = cA + (size_t)(t + 1) * kstep;
            const char* a2 = last ? nA : cA + (size_t)(t + 2) * kstep; const char* b2 = last ? nB : cB + (size_t)(t + 2) * kstep;
            const char* a3 = a2 + kstep; const char* b3 = b2 + kstep;
            if (last && has_next) S.a_ready(nxt);
            if constexpr (SP2) {
            PG8_LDB(B0, 0, 0); PG8_LDB(B1, 0, 1); PG8_SCHED; PG8_LDA(At, 0, 0); PG8_STAGE(PG8_SA(1, 1), a1 + hstep, voffA);
            PG8_WAIT_V(8); PG8_WAIT_L(0); PG8_BAR; PG8_MMA(0, 0, At, B0); PG8_MMA(0, 1, At, B1); PG8_BAR; PG8_SCHED;
            PG8_LDA(At, 0, 1); PG8_STAGE(PG8_SB(0, 0), b2, voffB); PG8_STAGE(PG8_SB(0, 1), b2 + hstep, voffB); PG8_STAGE(PG8_SA(0, 0), a2, voffA);
            PG8_WAIT_V(8); PG8_WAIT_L(0); PG8_BAR; PG8_MMA(1, 0, At, B0); PG8_MMA(1, 1, At, B1); PG8_BAR; PG8_SCHED;
            PG8_LDB(B0, 1, 0); PG8_LDB(B1, 1, 1); PG8_SCHED; PG8_LDA(At, 1, 0); PG8_STAGE(PG8_SA(0, 1), a2 + hstep, voffA);
            PG8_WAIT_V(8); PG8_WAIT_L(0); PG8_BAR; PG8_MMA(0, 0, At, B0); PG8_MMA(0, 1, At, B1); PG8_BAR; PG8_SCHED;
            PG8_LDA(At, 1, 1); PG8_STAGE(PG8_SB(1, 0), b3, voffB); PG8_STAGE(PG8_SB(1, 1), b3 + hstep, voffB); PG8_STAGE(PG8_SA(1, 0), a3, voffA);
            PG8_WAIT_V(8); PG8_WAIT_L(0); PG8_BAR; PG8_MMA(1, 0, At, B0); PG8_MMA(1, 1, At, B1); PG8_BAR; PG8_SCHED;
            } else {
            PG8_LDB(B0, 0, 0); PG8_SCHED; PG8_LDA(At, 0, 0); PG8_STAGE(PG8_SA(1, 1), a1 + hstep, voffA);
            PG8_WAIT_L(8); PG8_BAR; PG8_WAIT_L(0); PG8_MMA(0, 0, At, B0); PG8_BAR; PG8_SCHED;
            PG8_LDB(B1, 0, 1); PG8_STAGE(PG8_SB(0, 0), b2, voffB);
            PG8_BAR; PG8_WAIT_L(0); PG8_MMA(0, 1, At, B1); PG8_BAR;
            PG8_LDA(At, 0, 1); PG8_STAGE(PG8_SA(0, 0), a2, voffA);
            PG8_BAR; PG8_WAIT_L(0); PG8_MMA(1, 0, At, B0); PG8_BAR; PG8_SCHED;
            PG8_STAGE(PG8_SB(0, 1), b2 + hstep, voffB);
            PG8_WAIT_V(6); PG8_BAR; PG8_MMA(1, 1, At, B1); PG8_BAR;
            PG8_LDB(B0, 1, 0); PG8_SCHED; PG8_LDA(At, 1, 0); PG8_STAGE(PG8_SA(0, 1), a2 + hstep, voffA);
            PG8_WAIT_L(8); PG8_BAR; PG8_WAIT_L(0); PG8_MMA(0, 0, At, B0); PG8_BAR; PG8_SCHED;
            PG8_LDB(B1, 1, 1); PG8_STAGE(PG8_SB(1, 0), b3, voffB);
            PG8_BAR; PG8_WAIT_L(0); PG8_MMA(0, 1, At, B1); PG8_BAR;
            PG8_LDA(At, 1, 1); PG8_STAGE(PG8_SA(1, 0), a3, voffA);
            PG8_BAR; PG8_WAIT_L(0); PG8_MMA(1, 0, At, B0); PG8_BAR; PG8_SCHED;
            PG8_STAGE(PG8_SB(1, 1), b3 + hstep, voffB);
            PG8_WAIT_V(6); PG8_BAR; PG8_MMA(1, 1, At, B1); PG8_BAR;
            }
        }
        if constexpr (ALIGN_EPI) { if (wr == 0) PG8_BAR; }
        if constexpr (!Epi::AFTER_DRAIN) { E(acc, cur, wr, wc, fr, fq); S.done(cur); }
        if (!has_next) break;
#pragma unroll
        for (int a = 0; a < 2; ++a)
#pragma unroll
            for (int b = 0; b < 2; ++b)
#pragma unroll
                for (int m = 0; m < 4; ++m)
#pragma unroll
                    for (int n = 0; n < 2; ++n) acc[a][b][m][n] = (f32x4){0.f, 0.f, 0.f, 0.f};
        cur = nxt; cA = nA; cB = nB; ++ui;
        if constexpr (ALIGN_EPI) { if (wr == 1) PG8_BAR; }
    }
    PG8_WAIT_V(0);
    if constexpr (!ALIGN_EPI) { if (wr == 0) PG8_BAR; }
    PG8_BAR;
    if constexpr (Epi::AFTER_DRAIN) { E.fused(acc, cur, wr, wc, fr, fq, lds, wid, lane); S.done(cur); }
#undef PG8_SA
#undef PG8_SB
#undef PG8_STAGE
#undef PG8_LDA
#undef PG8_LDB
#undef PG8_MMA
#undef PG8_WAIT_V
#undef PG8_WAIT_L
#undef PG8_BAR
#undef PG8_SCHED
}
}
#define XB_TMO      128
#define XB_XCNT(j)  (256  + 64 * (j))
#define XB_XSUB(j)  (1280 + 64 * (j))
#define XB_XGEN(j)  (2304 + 64 * (j))
#define XB_TOP      3328
#define XB_TOPGEN   3392
#define XCD_BAR_WORDS 3456
#define XB_SPIN_CAP (1u << 18)
#define LAS __attribute__((address_space(3)))

__device__ __forceinline__ unsigned xb_ld(unsigned* p)              { return __hip_atomic_load(p, __ATOMIC_RELAXED, __HIP_MEMORY_SCOPE_AGENT); }
__device__ __forceinline__ unsigned xb_add(unsigned* p, unsigned v) { return __hip_atomic_fetch_add(p, v, __ATOMIC_RELAXED, __HIP_MEMORY_SCOPE_AGENT); }
__device__ __forceinline__ unsigned xb_xcc_id() { return (unsigned)__builtin_amdgcn_s_getreg((3 << 11) | 20) & 0xFu; }
#define XB_SPIN(cond, bar) do { unsigned _sp = 0; while (cond) { __builtin_amdgcn_s_sleep(1); \
    if ((++_sp & 255u) == 0u) { if (xb_ld(&(bar)[XB_TMO])) break; if (_sp > XB_SPIN_CAP) { atomicAdd(&(bar)[XB_TMO], 1u); break; } } } } while (0)

struct XcdBarrier {
    unsigned* bar; unsigned x;
    volatile LAS unsigned* st;
};

__device__ __forceinline__ XcdBarrier xcd_barrier_post(unsigned* bar, volatile LAS unsigned* st) {
    XcdBarrier b; b.bar = bar; b.x = xb_xcc_id(); b.st = st;
    if (threadIdx.x == 0) (void)xb_add(&bar[XB_XCNT(b.x)], 1u);
    return b;
}
__device__ __forceinline__ void xcd_barrier_complete(unsigned* bar, unsigned x, unsigned& nloc, unsigned& nx) {
    const unsigned G = gridDim.x * gridDim.y * gridDim.z;
    unsigned sum, cnt, mine, sp = 0u;
    for (;;) {
        sum = 0u; cnt = 0u; mine = 0u;
#pragma unroll
        for (unsigned j = 0; j < 16; ++j) { const unsigned c = xb_ld(&bar[XB_XCNT(j)]); sum += c; cnt += (c > 0u) ? 1u : 0u; mine = (j == x) ? c : mine; }
        if (sum == G) break;
        __builtin_amdgcn_s_sleep(1);
        if ((++sp & 255u) == 0u) { if (xb_ld(&bar[XB_TMO])) break; if (sp > XB_SPIN_CAP) { atomicAdd(&bar[XB_TMO], 1u); break; } }
    }
    nloc = mine > 0u ? mine : 1u; nx = cnt > 0u ? cnt : 1u;
}

__device__ __forceinline__ void xcd_barrier(const XcdBarrier& b) {
    asm volatile("s_waitcnt vmcnt(0)" ::: "memory");
    __syncthreads();
    if (threadIdx.x == 0) {
        unsigned* bar = b.bar;
        __builtin_amdgcn_s_waitcnt(0);
        unsigned nloc = b.st[0], nx = b.st[1];
        if (nloc == 0u) { xcd_barrier_complete(bar, b.x, nloc, nx); b.st[0] = nloc; b.st[1] = nx; }
        const unsigned old = xb_add(&bar[XB_XSUB(b.x)], 1u);
        const unsigned gen = old / nloc;
        if (old + 1u == (gen + 1u) * nloc) {
            __builtin_amdgcn_fence(__ATOMIC_RELEASE, "agent");
            asm volatile("s_waitcnt vmcnt(0)" ::: "memory");
            const unsigned og = xb_add(&bar[XB_TOP], 1u);
            const unsigned tg = og / nx;
            if (og + 1u == (tg + 1u) * nx) xb_add(&bar[XB_TOPGEN], 1u);
            else XB_SPIN(xb_ld(&bar[XB_TOPGEN]) == tg, bar);
            __builtin_amdgcn_fence(__ATOMIC_ACQUIRE, "agent");
            xb_add(&bar[XB_XGEN(b.x)], 1u);
            asm volatile("s_waitcnt vmcnt(0)" ::: "memory");
        } else {
            XB_SPIN(xb_ld(&bar[XB_XGEN(b.x)]) == gen, bar);
            __builtin_amdgcn_fence(__ATOMIC_ACQUIRE, "agent");
            asm volatile("s_waitcnt vmcnt(0)" ::: "memory");
        }
    }
    __syncthreads();
}
constexpr int NWAVES = 8;
__device__ __forceinline__ float wave_sum(float v, int lane) {
#pragma unroll
    for (int o = 1; o < 64; o <<= 1) v += shx(v, o, lane);
    return v;
}
__device__ __forceinline__ void transpose_tile(const float* W, int K, int N, bf16* WT, LAS unsigned* T, int k0, int n0, int lane) {
    const int half = lane >> 5, nn = lane & 31, n = 4 * nn;
    const bool ok = n0 + n < N;
    const int f = ((nn & 7) << 2) | (((nn >> 3) & 1) << 1);
    const float* src = W + (size_t)k0 * N + n0 + n;
#pragma unroll
    for (int b = 0; b < 4; ++b) {
        f32x4 va[4], vb[4];
#pragma unroll
        for (int i = 0; i < 4; ++i) { const int kp = 2 * (4 * b + i) + half;
            va[i] = ok ? *(const f32x4*)(src + (size_t)(2 * kp) * N) : (f32x4){0.f, 0.f, 0.f, 0.f};
            vb[i] = ok ? *(const f32x4*)(src + (size_t)(2 * kp + 1) * N) : (f32x4){0.f, 0.f, 0.f, 0.f}; }
#pragma unroll
        for (int i = 0; i < 4; ++i) { const int kp = 2 * (4 * b + i) + half;
#pragma unroll
            for (int e = 0; e < 4; ++e) T[(n + e) * 32 + (kp ^ f)] = cvtpk(va[i][e], vb[i][e]); }
    }
    LDS_WAIT(); asm volatile("" ::: "memory");
#pragma unroll 4
    for (int j = 0; j < 16; ++j) { const int idx = lane + 64 * j, c = idx & 7, nr = idx >> 3, nq = nr >> 2; const int fr = ((nq & 7) << 2) | (((nq >> 3) & 1) << 1);
        const v2u lo = *(const LAS v2u*)(T + nr * 32 + ((4 * c) ^ fr)), hi = *(const LAS v2u*)(T + nr * 32 + ((4 * c + 2) ^ fr));
        if (n0 + nr < N) *(v4u*)(WT + (size_t)(n0 + nr) * K + k0 + 8 * c) = (v4u){lo.x, lo.y, hi.x, hi.y}; }
    LDS_WAIT(); asm volatile("" ::: "memory");
}
__device__ __forceinline__ void transpose_matrix(const float* W, int K, int N, bf16* WT, LAS float* scr, int gw, int ngw, int lane) {
    const int nnt = (N + 127) / 128, nitems = (K / 64) * nnt;
    for (int it = gw; it < nitems; it += ngw) { const int kb = it / nnt, nb = it - kb * nnt; transpose_tile(W, K, N, WT, (LAS unsigned*)scr, 64 * kb, 128 * nb, lane); }
}
struct ProArgs { const float* fox_w_in; const float* fox_w_out; const float* hgrn_w_in; const float* hgrn_w_out; const float* up; const float* down; const float* lb_logits; };
__device__ __forceinline__ void prologue_phase(LAS unsigned char* lds, unsigned char* ws, const ProArgs& a, int vcu, int G) {
    const int tid = opaque_tid(), lane = tid & 63, wave = tid >> 6;
    LAS float* scr = (LAS float*)(lds + wave * 16384);
    const int gw = vcu * NWAVES + wave, ngw = G * NWAVES;
    for (int j = 0; j < 2; ++j) {
        transpose_matrix(a.fox_w_in + (size_t)j * DM * FOX_IN, DM, FOX_IN, (bf16*)(ws + WS_WFIN) + (size_t)j * FOX_INP * DM, scr, gw, ngw, lane);
        transpose_matrix(a.fox_w_out + (size_t)j * DM * DM, DM, DM, (bf16*)(ws + WS_WFOUT) + (size_t)j * DM * DM, scr, gw, ngw, lane);
        transpose_matrix(a.hgrn_w_in + (size_t)j * DM * HG_IN, DM, HG_IN, (bf16*)(ws + WS_WHIN) + (size_t)j * HG_IN * DM, scr, gw, ngw, lane);
        transpose_matrix(a.hgrn_w_out + (size_t)j * DM * DM, DM, DM, (bf16*)(ws + WS_WHOUT) + (size_t)j * DM * DM, scr, gw, ngw, lane);
        { v4u* z = (v4u*)((bf16*)(ws + WS_WFIN) + (size_t)j * FOX_INP * DM + (size_t)FOX_IN * DM); const size_t n16 = (size_t)(FOX_INP - FOX_IN) * DM * 2 / 16;
          for (size_t i = (size_t)(vcu * 512 + tid); i < n16; i += (size_t)G * 512) z[i] = (v4u){0u, 0u, 0u, 0u}; }
    }
    for (int j = 0; j < 4; ++j) {
        transpose_matrix(a.up + (size_t)j * DM * DFF, DM, DFF, (bf16*)(ws + WS_WUP) + (size_t)j * DFF * DM, scr, gw, ngw, lane);
        transpose_matrix(a.down + (size_t)j * DFF * DM, DFF, DM, (bf16*)(ws + WS_WDN) + (size_t)j * DM * DFF, scr, gw, ngw, lane);
    }
    for (int c = vcu * 512 + tid; c < DM; c += G * 512) {
        float l[4], mx = -1e30f; for (int i = 0; i < 4; ++i) { l[i] = a.lb_logits[i * DM + c]; mx = fmaxf(mx, l[i]); }
        float s = 0.f; for (int i = 0; i < 4; ++i) { l[i] = expf(l[i] - mx); s += l[i]; }
        float* LB = (float*)(ws + WS_LB); float cum = 0.f; const float p0 = l[0] / s;
        for (int i = 0; i < 4; ++i) { cum += l[i] / s; LB[i * DM + c] = cum - p0; }
    }
}
template <bool TO_F32>
__device__ __forceinline__ void rms_phase(const float* src, const float* gain, void* dst, int vcu, int G) {
    const int tid = opaque_tid(), lane = tid & 63, wave = tid >> 6;
    const int gw = vcu * NWAVES + wave, ngw = G * NWAVES;
    for (int row = gw; row < SEQ; row += ngw) {
        const f32x4* xr = (const f32x4*)(src + (size_t)row * DM) + lane;
        f32x4 v[16]; float ss = 0.f;
#pragma unroll
        for (int j = 0; j < 16; ++j) { v[j] = xr[64 * j]; ss += (v[j].x * v[j].x + v[j].y * v[j].y) + (v[j].z * v[j].z + v[j].w * v[j].w); }
        const float rstd = rsqrtf(wave_sum(ss, lane) * (1.f / DM) + NORM_EPS);
        const f32x4* gr = (const f32x4*)gain + lane;
#pragma unroll
        for (int j = 0; j < 16; ++j) { const f32x4 g = gr[64 * j]; const f32x4 o = v[j] * rstd * g;
            if constexpr (TO_F32) ((f32x4*)((float*)dst + (size_t)row * DM) + lane)[64 * j] = o;
            else { v2u w; w.x = cvtpk(o.x, o.y); w.y = cvtpk(o.z, o.w); ((v2u*)((bf16*)dst + (size_t)row * DM) + lane)[64 * j] = w; } }
    }
}
__device__ __forceinline__ void fox_thin_phase(LAS unsigned char* lds, bf16* PROJ, const float* LOGF, const float* CS, float* KB, const float* qg, const float* kg, int vcu, int G) {
    const int tid = opaque_tid(), lane = tid & 63, wave = tid >> 6;
    LAS float* red = (LAS float*)lds;
    LAS float* pre = red + 16 * 32;
    LAS float* tile = pre + 32;
    for (int blk = vcu; blk < SEQ / 64; blk += G) {
        const int r0 = blk * 64;
        { const int h = tid & 31, part = tid >> 5; float a = 0.f;
#pragma unroll 4
          for (int c = part; c < blk; c += 16) a += CS[c * 32 + h];
          red[part * 32 + h] = a; }
        { const int row = tid >> 3, c4 = tid & 7; const f32x4 v = *(const f32x4*)(LOGF + (size_t)(r0 + row) * 32 + 4 * c4);
          tile[row * 33 + 4 * c4 + 0] = v.x; tile[row * 33 + 4 * c4 + 1] = v.y; tile[row * 33 + 4 * c4 + 2] = v.z; tile[row * 33 + 4 * c4 + 3] = v.w; }
        __syncthreads();
        if (tid < 32) { float s = 0.f;
#pragma unroll
            for (int p = 0; p < 16; ++p) s += red[p * 32 + tid];
            float c = s;
            for (int r = 0; r < 64; ++r) { c += tile[r * 33 + tid]; tile[r * 33 + tid] = -c * LOG2E; } }
        __syncthreads();
        { const int h = tid >> 4, r4 = (tid & 15) * 4;
          const f32x4 o = {tile[(r4 + 0) * 33 + h], tile[(r4 + 1) * 33 + h], tile[(r4 + 2) * 33 + h], tile[(r4 + 3) * 33 + h]};
          *(f32x4*)(KB + (size_t)h * SEQ + r0 + r4) = o; }
        const int sub = lane >> 4, l16 = lane & 15;
        const f32x4 gq0 = *(const f32x4*)(qg + 8 * l16) * QSCALE, gq1 = *(const f32x4*)(qg + 8 * l16 + 4) * QSCALE, gk0 = *(const f32x4*)(kg + 8 * l16), gk1 = *(const f32x4*)(kg + 8 * l16 + 4);
        for (int it0 = wave; it0 < 64 * 16; it0 += NWAVES * 8) {
            v4u w[8];
#pragma unroll
            for (int b = 0; b < 8; ++b) { const int it = it0 + NWAVES * b, row = it >> 4, vec = (it & 15) * 4 + sub;
                w[b] = *(const v4u*)(PROJ + (size_t)(r0 + row) * 16384 + vec * 128 + 8 * l16); }
#pragma unroll
            for (int b = 0; b < 8; ++b) { const int it = it0 + NWAVES * b, row = it >> 4, vec = (it & 15) * 4 + sub;
                float x[8] = {bflo(w[b].x), bfhi(w[b].x), bflo(w[b].y), bfhi(w[b].y), bflo(w[b].z), bfhi(w[b].z), bflo(w[b].w), bfhi(w[b].w)};
                float ss = 0.f;
#pragma unroll
                for (int j = 0; j < 8; ++j) ss += x[j] * x[j];
                ss += shx(ss, 1, lane); ss += shx(ss, 2, lane); ss += shx(ss, 4, lane); ss += shx(ss, 8, lane);
                const float rstd = rsqrtf(ss * (1.f / 128.f) + NORM_EPS);
                const bool isq = vec < 32; const f32x4 g0 = isq ? gq0 : gk0, g1 = isq ? gq1 : gk1;
                v4u o; o.x = cvtpk(x[0] * rstd * g0.x, x[1] * rstd * g0.y); o.y = cvtpk(x[2] * rstd * g0.z, x[3] * rstd * g0.w);
                o.z = cvtpk(x[4] * rstd * g1.x, x[5] * rstd * g1.y); o.w = cvtpk(x[6] * rstd * g1.z, x[7] * rstd * g1.w);
                *(v4u*)(PROJ + (size_t)(r0 + row) * 16384 + vec * 128 + 8 * l16) = o; }
        }
        __syncthreads();
    }
}
__device__ __forceinline__ void jl_phase(LAS unsigned char* lds, const float* KB, const float* qg, const float* kg, int* JL, int vcu, int G) {
    const int tid = opaque_tid(), lane = tid & 63, wave = tid >> 6;
    LAS int* cnt = (LAS int*)lds;
    float gq = fmaxf(fabsf(qg[lane]), fabsf(qg[lane + 64])), gk = fmaxf(fabsf(kg[lane]), fabsf(kg[lane + 64]));
#pragma unroll
    for (int o = 1; o < 64; o <<= 1) { gq = fmaxf(gq, shx(gq, o, lane)); gk = fmaxf(gk, shx(gk, o, lane)); }
    const float TH = 64.f + 2.f * (128.f * gq * gk * QSCALE * 1.02f);
    for (int id = vcu; id < 2048; id += G) {
        const int h = id & 31, qb = 63 - (id >> 5);
        const float* kb = KB + (size_t)h * SEQ;
        const float lim = kb[qb * 256] - TH;
        const bool pred = (tid < 4 * qb) && (kb[64 * tid + 63] < lim);
        const unsigned long long bal = __ballot(pred);
        if (lane == 0) cnt[wave] = __popcll(bal);
        __syncthreads();
        if (tid == 0) { int s = 0; for (int w = 0; w < 8; ++w) s += cnt[w]; JL[id] = s; }
        __syncthreads();
    }
}
namespace fa {
constexpr int D = 128, NW = 8, QBLK = 32, KVBLK = 64, QB = NW * QBLK;
constexpr int LDQ = 16384, LDO = 4096;
constexpr int SHM_V = KVBLK * D * 2, SHM_K = KVBLK * D * 2;
constexpr int OFF_WS = 2 * SHM_V + 2 * SHM_K, OFF_KB = OFF_WS + NW * 64 * 4;
constexpr int LDS_BYTES = OFF_KB + 2 * 64 * 4;
constexpr float THR2 = 11.5f;
#define KSWZ(row, colB) ((row) * 256 + ((colB) ^ (((row) & 7) << 4)))
#define SBAR() __builtin_amdgcn_sched_barrier(0)
__device__ __forceinline__ int v_st(int k, int c) { const int kk = (k & ~0xC) | ((k & 4) << 1) | ((k & 8) >> 1); return ((kk >> 3) * 4 + (c >> 5)) * 512 + ((kk & 7) * 32 + (c & 31)) * 2; }
__device__ __forceinline__ int v_rd_base(int lane) { return ((lane & 3) << 3) | (((lane >> 2) & 3) << 6) | (((lane >> 4) & 1) << 5) | (((lane >> 5) & 1) << 8); }
constexpr int v_rd_off(int d0, int ks, int half) { return d0 * 512 + ks * 4096 + half * 2048; }
__device__ __forceinline__ int crow(int r, int hi) { return (r & 3) + 8 * (r >> 2) + 4 * hi; }
__device__ __forceinline__ bf16x8 ld8(const bf16* p) { return *reinterpret_cast<const bf16x8*>(p); }
__device__ __forceinline__ void mask_tile(f32x16& p0, f32x16& p1, int dq) {
    const float NEG = -__builtin_inff();
#pragma unroll
    for (int r = 0; r < 16; ++r) {
        const int c = (r & 3) + 8 * (r >> 2);
        if (dq - c < 0) p0[r] = NEG;
        if (dq - c - 32 < 0) p1[r] = NEG;
    }
}
__device__ __forceinline__ void partialSM(f32x16& p0, f32x16& p1, float& m_reg, float& mn, float& alpha) {
    float pmax = p0[0];
#pragma unroll
    for (int r = 1; r < 16; ++r) pmax = fmaxf(pmax, p0[r]);
#pragma unroll
    for (int r = 0; r < 16; ++r) pmax = fmaxf(pmax, p1[r]);
    { auto rr = __builtin_amdgcn_permlane32_swap(__float_as_uint(pmax), __float_as_uint(pmax), false, false);
      pmax = fmaxf(__uint_as_float(rr[0]), __uint_as_float(rr[1])); }
    if (__builtin_expect(__all(pmax - m_reg <= THR2), 1)) { mn = m_reg; alpha = 1.f; }
    else { mn = fmaxf(m_reg, pmax); alpha = __builtin_amdgcn_exp2f(m_reg - mn); m_reg = mn; }
#pragma unroll
    for (int r = 0; r < 16; ++r) p0[r] = p0[r] - mn;
#pragma unroll
    for (int r = 0; r < 16; ++r) p1[r] = p1[r] - mn;
#pragma unroll
    for (int r = 0; r < 16; ++r) p0[r] = __builtin_amdgcn_exp2f(p0[r]);
}
__device__ __forceinline__ void finishSM(f32x16& p0, f32x16& p1, float alpha, float& l_reg, bf16x8& pa0, bf16x8& pa1, bf16x8& pa2, bf16x8& pa3) {
#pragma unroll
    for (int r = 0; r < 16; ++r) p1[r] = __builtin_amdgcn_exp2f(p1[r]);
    float ps = 0;
#pragma unroll
    for (int r = 0; r < 16; ++r) ps += p0[r];
#pragma unroll
    for (int r = 0; r < 16; ++r) ps += p1[r];
    { auto rr = __builtin_amdgcn_permlane32_swap(__float_as_uint(ps), __float_as_uint(ps), false, false);
      ps = __uint_as_float(rr[0]) + __uint_as_float(rr[1]); }
    l_reg = l_reg * alpha + ps;
#define PK4(P, B_, OUT) do { unsigned a0 = cvtpk(P[B_+0], P[B_+1]), a1 = cvtpk(P[B_+2], P[B_+3]);                          \
        unsigned b0 = cvtpk(P[B_+4], P[B_+5]), b1 = cvtpk(P[B_+6], P[B_+7]);                                             \
        auto r0 = __builtin_amdgcn_permlane32_swap(a0, b0, false, false); auto r1 = __builtin_amdgcn_permlane32_swap(a1, b1, false, false); \
        v4u w = {r0[0], r1[0], r0[1], r1[1]}; OUT = *reinterpret_cast<bf16x8*>(&w); } while (0)
    PK4(p0, 0, pa0); PK4(p0, 8, pa1); PK4(p1, 0, pa2); PK4(p1, 8, pa3);
#undef PK4
}
template <int KB>
__device__ __forceinline__ void qkt(f32x16& p0, f32x16& p1, const char* K_lds, const float* kbl, int r32, int hi, const bf16x8* qr) {
#ifdef X_NOBIAS
    p0 = f32x16{}; p1 = f32x16{};
#else
    { const float* kb = kbl + KB * 64 + 4 * hi;
      const f32x4 a0 = *(const f32x4*)(kb), a1 = *(const f32x4*)(kb + 8), a2 = *(const f32x4*)(kb + 16), a3 = *(const f32x4*)(kb + 24);
      const f32x4 b0 = *(const f32x4*)(kb + 32), b1 = *(const f32x4*)(kb + 40), b2 = *(const f32x4*)(kb + 48), b3 = *(const f32x4*)(kb + 56);
      p0 = f32x16{a0[0], a0[1], a0[2], a0[3], a1[0], a1[1], a1[2], a1[3], a2[0], a2[1], a2[2], a2[3], a3[0], a3[1], a3[2], a3[3]};
      p1 = f32x16{b0[0], b0[1], b0[2], b0[3], b1[0], b1[1], b1[2], b1[3], b2[0], b2[1], b2[2], b2[3], b3[0], b3[1], b3[2], b3[3]}; }
#endif
    const char* kb4[4];
#pragma unroll
    for (int dd = 0; dd < 4; ++dd) kb4[dd] = K_lds + KB * SHM_K + KSWZ(r32, (dd * 16 + hi * 8) * 2);
#pragma unroll
    for (int d0 = 0; d0 < 8; ++d0) { const char* a = kb4[d0 & 3] + (d0 >> 2) * 128;
        bf16x8 b0 = *reinterpret_cast<const bf16x8*>(a);
        bf16x8 b1 = *reinterpret_cast<const bf16x8*>(a + 32 * 256);
        p0 = __builtin_amdgcn_mfma_f32_32x32x16_bf16(b0, qr[d0], p0, 0, 0, 0);
        p1 = __builtin_amdgcn_mfma_f32_32x32x16_bf16(b1, qr[d0], p1, 0, 0, 0); }
}
template <int VB>
__device__ __forceinline__ void pv_tile(f32x16* o, int vb0, bf16x8 pa0, bf16x8 pa1, bf16x8 pa2, bf16x8 pa3) {
#define TRRD(dst, off) asm volatile("ds_read_b64_tr_b16 %0, %1 offset:%2" : "=&v"(dst) : "v"(vb0), "i"(off) : "memory")
#define PV_D0(d0) do { s16x4 l0, l1, l2, l3, h0, h1, h2, h3; constexpr int b_ = VB * SHM_V + v_rd_off(d0, 0, 0); \
        TRRD(l0, b_); TRRD(h0, b_ + 2048); TRRD(l1, b_ + 4096); TRRD(h1, b_ + 6144); TRRD(l2, b_ + 8192); TRRD(h2, b_ + 10240); TRRD(l3, b_ + 12288); TRRD(h3, b_ + 14336); \
        asm volatile("s_waitcnt lgkmcnt(0)" ::: "memory"); SBAR();   \
        o[d0] = __builtin_amdgcn_mfma_f32_32x32x16_bf16(pa0, (bf16x8){l0[0], l0[1], l0[2], l0[3], h0[0], h0[1], h0[2], h0[3]}, o[d0], 0, 0, 0);   \
        o[d0] = __builtin_amdgcn_mfma_f32_32x32x16_bf16(pa1, (bf16x8){l1[0], l1[1], l1[2], l1[3], h1[0], h1[1], h1[2], h1[3]}, o[d0], 0, 0, 0);   \
        o[d0] = __builtin_amdgcn_mfma_f32_32x32x16_bf16(pa2, (bf16x8){l2[0], l2[1], l2[2], l2[3], h2[0], h2[1], h2[2], h2[3]}, o[d0], 0, 0, 0);   \
        o[d0] = __builtin_amdgcn_mfma_f32_32x32x16_bf16(pa3, (bf16x8){l3[0], l3[1], l3[2], l3[3], h3[0], h3[1], h3[2], h3[3]}, o[d0], 0, 0, 0); } while (0)
    PV_D0(0); PV_D0(1); PV_D0(2); PV_D0(3);
#undef PV_D0
#undef TRRD
}
struct BlockRef { const bf16* Q; const bf16* K; const bf16* V; const float* KBp; const bf16* G; bf16* O; int P0; int j0; };
struct Seam { bf16x8 qr[8]; bf16x8 st_v0, st_v1, st_k0, st_k1; float st_b; };
#define ROWP(p, k0, rr) ((const char*)(p) + (size_t)((k0) + (rr)) * (LDQ * 2))
#define LD8V(base, off) (*reinterpret_cast<const bf16x8*>((base) + (off)))
#define VMW() asm volatile("s_waitcnt vmcnt(0)" ::: "memory")
#define VMWN(n) asm volatile("s_waitcnt vmcnt(%0)" :: "i"(n) : "memory")
#define SLOAD_H(Kp, Vp, Bp, k0) do { S.st_v0 = LD8V(ROWP(Vp, k0, 0), voff); S.st_v1 = LD8V(ROWP(Vp, k0, 32), voff);              \
                         S.st_k0 = LD8V(ROWP(Kp, k0, 0), voff); S.st_k1 = LD8V(ROWP(Kp, k0, 32), voff); \
                         if (tid < 64) S.st_b = *(const float*)((const char*)((Bp) + (k0)) + (unsigned)(tid * 4)); } while (0)
#define SWRITE_HK(bf) do { *(bf16x8*)(K_lds + (bf) * SHM_K + kws) = S.st_k0; *(bf16x8*)(K_lds + (bf) * SHM_K + kws + 32 * 256) = S.st_k1; if (tid < 64) kbl[(bf) * 64 + tid] = S.st_b; } while (0)
#define SWRITE_HV(bf) do { *(bf16x8*)(V_lds + (bf) * SHM_V + vst0) = S.st_v0; *(bf16x8*)(V_lds + (bf) * SHM_V + vst1) = S.st_v1; } while (0)
#define SWRITE_H(bf) do { SWRITE_HV(bf); SWRITE_HK(bf); } while (0)
__device__ __forceinline__ void fox_prime(const BlockRef& cur, char* lds, Seam& S) {
    const int tid = opaque_tid(), wid = __builtin_amdgcn_readfirstlane(tid >> 6), lane = tid & 63, r32 = lane & 31, hi = lane >> 5;
    const int sr = tid >> 4, sc = (tid & 15) * 8, kws = KSWZ(sr, sc * 2); char* K_lds = lds + 2 * SHM_V; float* kbl = (float*)(lds + OFF_KB);
    const unsigned voff = (unsigned)(sr * LDQ + sc) * 2u, qoff = (unsigned)(r32 * LDQ + hi * 8) * 2u;
    { const char* qb_ = (const char*)(cur.Q + (size_t)(wid * QBLK) * LDQ);
#pragma unroll
      for (int d0 = 0; d0 < 8; ++d0) S.qr[d0] = LD8V(qb_ + d0 * 32, qoff); }
    SLOAD_H(cur.K, cur.V, cur.KBp, cur.j0 * KVBLK); VMW(); SWRITE_HK(0);
    __syncthreads();
}
__device__ __forceinline__ void fox_block(const BlockRef& cur, const BlockRef& nxt, char* lds, Seam& S) {
    const int tid = opaque_tid(), wid = __builtin_amdgcn_readfirstlane(tid >> 6), lane = tid & 63, r32 = lane & 31, hi = lane >> 5;
    const int j_lo = cur.j0, NT = (cur.P0 + QB - 1) / KVBLK + 1 - j_lo;
    const int qlo = cur.P0 + wid * QBLK, qm = qlo + r32 - 4 * hi;
    char* V_lds = lds; char* K_lds = lds + 2 * SHM_V; float* kbl = (float*)(lds + OFF_KB);
    float* ws = (float*)(lds + OFF_WS) + wid * 64; float* li_l = ws, * al_l = ws + 32;
    float m_reg = -1e30f, l_reg = 0; f32x16 o[4] = {};
    const int sr = tid >> 4, sc = (tid & 15) * 8, vst0 = v_st(sr, sc), vst1 = v_st(32 + sr, sc), kws = KSWZ(sr, sc * 2);
    const unsigned voff = (unsigned)(sr * LDQ + sc) * 2u, qoff = (unsigned)(r32 * LDQ + hi * 8) * 2u;
    const int vb0 = (int)(uintptr_t)V_lds + v_rd_base(lane);
    const bf16* Kh = cur.K; const bf16* Vh = cur.V; const float* Bh = cur.KBp;
#define RESC(a) do { if (__any((a) < 1.f)) { if (hi == 0) al_l[r32] = (a); asm volatile("s_waitcnt lgkmcnt(0)" ::: "memory");              \
                     for (int d_ = 0; d_ < 4; ++d_) for (int r = 0; r < 16; ++r) o[d_][r] *= al_l[crow(r, hi)]; } } while (0)
#define KBASE(t) ((j_lo + (t)) * KVBLK)
#define MASKT(P0_, P1_, t) do { const int kb_ = KBASE(t); if (kb_ + KVBLK - 1 > qlo) mask_tile(P0_, P1_, qm - kb_); } while (0)
    constexpr int NQL = 8;
#define SEAM_K0() do { VMWN(NQL); SWRITE_HK(0); SBAR(); } while (0)
    f32x16 pA0, pA1, pB0, pB1; float mnA, mnB, alA, alB; bf16x8 pa0, pa1, pa2, pa3;
    SWRITE_HV(0); SBAR();
    if (NT > 1) { SLOAD_H(Kh, Vh, Bh, KBASE(1)); }
    SBAR(); qkt<0>(pA0, pA1, K_lds, kbl, r32, hi, S.qr);
    MASKT(pA0, pA1, 0); partialSM(pA0, pA1, m_reg, mnA, alA);
    if (NT > 1) { VMW(); SWRITE_H(1); }
    __syncthreads();
#define HALF_STEP(PX0, PX1, mnX, alX, PY0, PY1, alY, t, KB, VB, SB) do {                                                      \
        SBAR(); qkt<KB>(PX0, PX1, K_lds, kbl, r32, hi, S.qr);                                             \
        finishSM(PY0, PY1, alY, l_reg, pa0, pa1, pa2, pa3); SBAR();                                                           \
        if ((t) + 1 < NT) { SLOAD_H(Kh, Vh, Bh, KBASE((t) + 1)); SBAR(); }                                               \
        pv_tile<VB>(o, vb0, pa0, pa1, pa2, pa3); MASKT(PX0, PX1, (t)); partialSM(PX0, PX1, m_reg, mnX, alX);                                        \
        __syncthreads();                                                                                                      \
        if ((t) + 1 < NT) { VMW(); SWRITE_H(SB); }                                                                          \
        RESC(alX); __syncthreads(); } while (0)
    for (int t = 1; t + 1 < NT; t += 2) {
        HALF_STEP(pB0, pB1, mnB, alB, pA0, pA1, alA, t, 1, 0, 0);
        HALF_STEP(pA0, pA1, mnA, alA, pB0, pB1, alB, t + 1, 0, 1, 1);
    }
    const bool even = (NT & 1) == 0;
    if (even) { SBAR(); qkt<1>(pB0, pB1, K_lds, kbl, r32, hi, S.qr); SBAR(); }
    SLOAD_H(nxt.K, nxt.V, nxt.KBp, nxt.j0 * KVBLK); SBAR();
    { const char* qb_ = (const char*)(nxt.Q + (size_t)(wid * QBLK) * LDQ);
#pragma unroll
      for (int d0 = 0; d0 < 8; ++d0) S.qr[d0] = LD8V(qb_ + d0 * 32, qoff); }
    SBAR();
    finishSM(pA0, pA1, alA, l_reg, pa0, pa1, pa2, pa3); SBAR();
    pv_tile<0>(o, vb0, pa0, pa1, pa2, pa3);
    if (even) { MASKT(pB0, pB1, NT - 1); partialSM(pB0, pB1, m_reg, mnB, alB); __syncthreads(); RESC(alB);
        finishSM(pB0, pB1, alB, l_reg, pa0, pa1, pa2, pa3); SBAR(); pv_tile<1>(o, vb0, pa0, pa1, pa2, pa3); }
    SBAR(); SEAM_K0();
    if (hi == 0) li_l[r32] = l_reg; asm volatile("s_waitcnt lgkmcnt(0)" ::: "memory");
    float rli[16];
#pragma unroll
    for (int r = 0; r < 16; ++r) rli[r] = __builtin_amdgcn_rcpf(li_l[crow(r, hi)]);
    const char* Ob = (const char*)(cur.O + (size_t)(wid * QBLK) * LDO); const char* Gb = (const char*)(cur.G + (size_t)(wid * QBLK) * LDQ);
    const unsigned voffO = (unsigned)((4 * hi) * LDO + r32) * 2u, voffG = (unsigned)((4 * hi) * LDQ + r32) * 2u;
#pragma unroll
    for (int r = 0; r < 16; ++r) { const int rc = (r & 3) + 8 * (r >> 2);
        const char* Or = Ob + (size_t)rc * LDO * 2; const char* Gr = Gb + (size_t)rc * LDQ * 2;
#pragma unroll
        for (int d0 = 0; d0 < 4; ++d0) { const float v = o[d0][r] * rli[r]; const float vn = shx(v, 1, lane);
#ifdef X_NOGATE
            if ((r32 & 1) == 0) { *(unsigned*)(Or + d0 * 64 + voffO) = cvtpk(v, vn); } }
#else
            if ((r32 & 1) == 0) { const unsigned g2 = *(const unsigned*)(Gr + d0 * 64 + voffG);
                *(unsigned*)(Or + d0 * 64 + voffO) = cvtpk(v * bflo(g2), vn * bfhi(g2)); } }
#endif
        if ((r & 3) == 3) asm volatile("" ::: "memory"); }
    __syncthreads();
#undef RESC
#undef KBASE
#undef MASKT
#undef SEAM_K0
#undef HALF_STEP
}
#undef ROWP
#undef LD8V
#undef VMWN
#undef SLOAD_H
#undef SWRITE_HK
#undef SWRITE_HV
#undef SWRITE_H
__device__ __forceinline__ BlockRef mk_ref(const bf16* PROJ, const float* KBg, bf16* MO, const int* JL, int id) {
    const int bh = id & 31, qb = 63 - (id >> 5);
    BlockRef r; r.Q = PROJ + (size_t)(qb * QB) * LDQ + bh * D; r.K = PROJ + 4096 + bh * D; r.V = PROJ + 8192 + bh * D; r.KBp = KBg + (size_t)bh * SEQ;
    r.G = PROJ + (size_t)(qb * QB) * LDQ + 12288 + bh * D; r.O = MO + (size_t)(qb * QB) * LDO + bh * D; r.P0 = qb * QB; r.j0 = JL[id]; return r;
}
__device__ __forceinline__ void attn_phase(char* lds, const bf16* PROJ, const float* KBg, bf16* MO, const int* JL, unsigned* qctr) {
    constexpr int total = 32 * 64;
    const int tid = opaque_tid();
    volatile int* slot = (volatile int*)(lds + LDS_BYTES);
    if (tid == 0) slot[0] = (int)__hip_atomic_fetch_add(qctr, 1u, __ATOMIC_RELAXED, __HIP_MEMORY_SCOPE_AGENT);
    __syncthreads();
    int id = __builtin_amdgcn_readfirstlane(slot[0]);
    if (id >= total) return;
    BlockRef cur = mk_ref(PROJ, KBg, MO, JL, id);
    Seam S;
    fox_prime(cur, lds, S);
    for (;;) {
        if (tid == 0) slot[1] = (int)__hip_atomic_fetch_add(qctr, 1u, __ATOMIC_RELAXED, __HIP_MEMORY_SCOPE_AGENT);
        __syncthreads();
        const int idn = __builtin_amdgcn_readfirstlane(slot[1]);
        const bool last = idn >= total;
        const BlockRef nxt = last ? cur : mk_ref(PROJ, KBg, MO, JL, idn);
        fox_block(cur, nxt, lds, S);
        if (last) break;
        cur = nxt;
    }
}
#undef VMW
}
namespace hg {
constexpr int CH = 64, NCH = SEQ / CH;
constexpr int PK = 144;
constexpr int PQ = 272;
__device__ __forceinline__ f32x4 mma(bf16x8 bfrag, bf16x8 afrag, f32x4 acc) { return __builtin_amdgcn_mfma_f32_16x16x32_bf16(bfrag, afrag, acc, 0, 0, 0); }
__device__ __forceinline__ bf16x8 ldsfrag(const LAS unsigned char* base, int row, int pitch, int kbyte) { return *(const LAS bf16x8*)(base + row * pitch + kbyte); }

__device__ __forceinline__ void b1_phase(LAS unsigned char* lds, const bf16* PROJ, const float* Gg, bf16* UT, float* DEC, int vcu, int G) {
    const int tid = opaque_tid(), lane = tid & 63, wave = __builtin_amdgcn_readfirstlane(tid >> 6), col = tid & 127, sg = tid >> 7, r = lane & 15, q = lane >> 4;
    LAS unsigned char* KT = lds;
    LAS unsigned char* VT = lds + 128 * PK;
    LAS float* segtot = (LAS float*)(lds + 2 * 128 * PK);
    float nb[16]; unsigned short nk[16], nv[16];
#define B1_LOAD(u_) do { const int c_ = (u_) >> 5, h_ = (u_) & 31; const int rw_ = c_ * CH + 16 * sg; \
        _Pragma("unroll") for (int j = 0; j < 16; ++j) { nb[j] = Gg[(size_t)(rw_ + j) * DM + h_ * DH + col]; const bf16* p_ = PROJ + (size_t)(rw_ + j) * 16384 + 4096 + h_ * DH + col; nk[j] = p_[0]; nv[j] = p_[4096]; } } while (0)
    if (vcu < NCH * NH) B1_LOAD(vcu);
    for (int u = vcu; u < NCH * NH; u += G) {
        float b[16]; unsigned short kk[16], vv[16];
#pragma unroll
        for (int j = 0; j < 16; ++j) { b[j] = nb[j]; kk[j] = nk[j]; vv[j] = nv[j]; }
#pragma unroll
        for (int j = 1; j < 16; ++j) b[j] += b[j - 1];
        segtot[sg * 128 + col] = b[15];
        __syncthreads();
        float off = 0.f, total = 0.f;
#pragma unroll
        for (int s2 = 0; s2 < 4; ++s2) { const float t = segtot[s2 * 128 + col]; total += t; if (s2 < sg) off += t; }
        const float rem = total - off;
        unsigned kw[8], vw[8];
#pragma unroll
        for (int j = 0; j < 8; ++j) { kw[j] = cvtpk(bf2f(kk[2 * j]) * fexp(rem - b[2 * j]), bf2f(kk[2 * j + 1]) * fexp(rem - b[2 * j + 1])); vw[j] = (unsigned)vv[2 * j] | ((unsigned)vv[2 * j + 1] << 16); }
        *(LAS v4u*)(KT + col * PK + 32 * sg) = (v4u){kw[0], kw[1], kw[2], kw[3]}; *(LAS v4u*)(KT + col * PK + 32 * sg + 16) = (v4u){kw[4], kw[5], kw[6], kw[7]};
        *(LAS v4u*)(VT + col * PK + 32 * sg) = (v4u){vw[0], vw[1], vw[2], vw[3]}; *(LAS v4u*)(VT + col * PK + 32 * sg + 16) = (v4u){vw[4], vw[5], vw[6], vw[7]};
        if (sg == 0) DEC[(size_t)u * 128 + col] = fexp(total);
        if (u + G < NCH * NH) B1_LOAD(u + G);
        __syncthreads();
        const bf16x8 a0 = ldsfrag(VT, 16 * wave + r, PK, 16 * q), a1 = ldsfrag(VT, 16 * wave + r, PK, 64 + 16 * q);
        bf16* up = UT + ((size_t)u * 128 + 16 * wave + r) * 128 + 4 * q;
#pragma unroll
        for (int nt = 0; nt < 8; ++nt) { f32x4 acc = {0.f, 0.f, 0.f, 0.f};
            acc = mma(ldsfrag(KT, 16 * nt + r, PK, 16 * q), a0, acc); acc = mma(ldsfrag(KT, 16 * nt + r, PK, 64 + 16 * q), a1, acc);
            v2u w; w.x = cvtpk(acc[0], acc[1]); w.y = cvtpk(acc[2], acc[3]); *(v2u*)(up + 16 * nt) = w; }
        __syncthreads();
    }
#undef B1_LOAD
}
__device__ __forceinline__ void b2_phase(const bf16* UT, const float* DEC, bf16* ST, int vcu, int G) {
    for (int gid = vcu * 512 + opaque_tid(); gid < NH * 128 * 32; gid += G * 512) {
        const int h = gid >> 12, dv = (gid >> 5) & 127, dk4 = (gid & 31) * 4;
        f32x4 st = {0.f, 0.f, 0.f, 0.f};
        const size_t eo = ((size_t)h * 128 + dv) * 128 + dk4, estep = (size_t)NH * 128 * 128;
        const size_t dofs = (size_t)h * 128 + dk4, dstep = (size_t)NH * 128;
#pragma unroll 8
        for (int c = 0; c < NCH; ++c) {
            const v2u uw = *(const v2u*)(UT + eo + c * estep); const f32x4 uu = {bflo(uw.x), bfhi(uw.x), bflo(uw.y), bfhi(uw.y)}; const f32x4 dd = *(const f32x4*)(DEC + dofs + c * dstep);
            v2u w; w.x = cvtpk(st.x, st.y); w.y = cvtpk(st.z, st.w); *(v2u*)(ST + eo + c * estep) = w;
            st = dd * st + uu;
        }
    }
}
constexpr int B3_QT = 0, B3_QH = B3_QT + 64 * PQ, B3_KH = B3_QH + 64 * PQ  , B3_VT = B3_KH + 160 * PQ, B3_P = B3_VT + 128 * PK, B3_SEG = B3_P + 64 * PK, B3_RS = B3_SEG + 2048, B3_END = B3_RS + 512;
__device__ __forceinline__ int kh_base(int I) { return 16 * (I * (I + 1) / 2); }
__device__ __forceinline__ void b3_phase(LAS unsigned char* lds, const bf16* PROJ, const float* Gg, const bf16* ST, const float* ogain, bf16* MO, int vcu, int G) {
    const int tid = opaque_tid(), lane = tid & 63, wave = __builtin_amdgcn_readfirstlane(tid >> 6), col = tid & 127, sg = tid >> 7, r = lane & 15, q = lane >> 4;
    LAS unsigned char* QT = lds + B3_QT; LAS unsigned char* QH = lds + B3_QH; LAS unsigned char* KH = lds + B3_KH; LAS unsigned char* VT = lds + B3_VT; LAS unsigned char* PP = lds + B3_P;
    LAS float* segtot = (LAS float*)(lds + B3_SEG); LAS float* rs = (LAS float*)(lds + B3_RS);
    float nb[16]; unsigned short nq[16], nk[16], nv[16];
#define B3_LOAD(u_) do { const int c_ = (u_) >> 5, h_ = (u_) & 31; const int rw_ = c_ * CH + 16 * sg; \
        _Pragma("unroll") for (int j = 0; j < 16; ++j) { nb[j] = Gg[(size_t)(rw_ + j) * DM + h_ * DH + col]; const bf16* p_ = PROJ + (size_t)(rw_ + j) * 16384 + h_ * DH + col; nq[j] = p_[0]; nk[j] = p_[4096]; nv[j] = p_[8192]; } } while (0)
    if (vcu < NCH * NH) B3_LOAD(vcu);
    for (int u = vcu; u < NCH * NH; u += G) {
        const int c = u >> 5, h = u & 31;
        float b[16]; unsigned short qq[16], kk[16], vv[16];
#pragma unroll
        for (int j = 0; j < 16; ++j) { b[j] = nb[j]; qq[j] = nq[j]; kk[j] = nk[j]; vv[j] = nv[j]; }
#pragma unroll
        for (int j = 1; j < 16; ++j) b[j] += b[j - 1];
        segtot[sg * 128 + col] = b[15];
        __syncthreads();
        float st[4];
#pragma unroll
        for (int s2 = 0; s2 < 4; ++s2) st[s2] = segtot[s2 * 128 + col];
        float off = 0.f;
#pragma unroll
        for (int s2 = 0; s2 < 4; ++s2) if (s2 < sg) off += st[s2];
#pragma unroll
        for (int j = 0; j < 16; ++j) { const float qf = bf2f(qq[j]);
            *(LAS bf16*)(QT + (16 * sg + j) * PQ + 2 * col) = f2bf(qf * fexp(off + b[j]));
            *(LAS bf16*)(QH + (16 * sg + j) * PQ + 2 * col) = f2bf(qf * fexp(b[j])); }
        { float d = 0.f;
#pragma unroll
          for (int I = 0; I < 4; ++I) { if (I >= sg) {
#pragma unroll
                for (int j = 0; j < 16; ++j) *(LAS bf16*)(KH + (kh_base(I) + 16 * sg + j) * PQ + 2 * col) = f2bf(bf2f(kk[j]) * fexp(d - b[j]));
                d += st[I]; } } }
        { unsigned vw[8];
#pragma unroll
          for (int j = 0; j < 8; ++j) vw[j] = (unsigned)vv[2 * j] | ((unsigned)vv[2 * j + 1] << 16);
          *(LAS v4u*)(VT + col * PK + 32 * sg) = (v4u){vw[0], vw[1], vw[2], vw[3]}; *(LAS v4u*)(VT + col * PK + 32 * sg + 16) = (v4u){vw[4], vw[5], vw[6], vw[7]}; }
        if (u + G < NCH * NH) B3_LOAD(u + G);
        __syncthreads();
#pragma unroll
        for (int tt = 0; tt < 2; ++tt) { const int tile = wave * 2 + tt, I = tile >> 2, J = tile & 3;
            f32x4 acc = {0.f, 0.f, 0.f, 0.f};
            if (J <= I) {
#pragma unroll
                for (int ks = 0; ks < 4; ++ks) acc = mma(ldsfrag(KH, kh_base(I) + 16 * J + r, PQ, 64 * ks + 16 * q), ldsfrag(QH, 16 * I + r, PQ, 64 * ks + 16 * q), acc);
                if (J == I) {
#pragma unroll
                    for (int i = 0; i < 4; ++i) if (4 * q + i > r) acc[i] = 0.f; }
            }
            v2u w; w.x = cvtpk(acc[0], acc[1]); w.y = cvtpk(acc[2], acc[3]);
            *(LAS v2u*)(PP + (16 * I + r) * PK + (16 * J + 4 * q) * 2) = w; }
        __syncthreads();
        const int mt = wave & 3, nh = wave >> 2;
        f32x4 acc[4];
        const bf16x8 pa0 = ldsfrag(PP, 16 * mt + r, PK, 16 * q), pa1 = ldsfrag(PP, 16 * mt + r, PK, 64 + 16 * q);
        bf16x8 qa[4];
#pragma unroll
        for (int ks = 0; ks < 4; ++ks) qa[ks] = ldsfrag(QT, 16 * mt + r, PQ, 64 * ks + 16 * q);
        const bf16* stp = ST + ((size_t)u * 128 + 64 * nh + r) * 128 + 8 * q;
#pragma unroll
        for (int nt = 0; nt < 4; ++nt) { f32x4 a = {0.f, 0.f, 0.f, 0.f};
            a = mma(ldsfrag(VT, 64 * nh + 16 * nt + r, PK, 16 * q), pa0, a); a = mma(ldsfrag(VT, 64 * nh + 16 * nt + r, PK, 64 + 16 * q), pa1, a);
#pragma unroll
            for (int ks = 0; ks < 4; ++ks) a = mma(*(const bf16x8*)(stp + (size_t)(16 * nt) * 128 + 32 * ks), qa[ks], a);
            acc[nt] = a; }
        float ss = 0.f;
#pragma unroll
        for (int nt = 0; nt < 4; ++nt) ss += (acc[nt][0] * acc[nt][0] + acc[nt][1] * acc[nt][1]) + (acc[nt][2] * acc[nt][2] + acc[nt][3] * acc[nt][3]);
        ss += shx(ss, 16, lane); ss += shx(ss, 32, lane);
        if (q == 0) rs[nh * 64 + 16 * mt + r] = ss;
        __syncthreads();
        const float rstd = rsqrtf((rs[16 * mt + r] + rs[64 + 16 * mt + r]) * (1.f / 128.f) + NORM_EPS);
        const size_t orow = (size_t)(c * CH + 16 * mt + r);
#pragma unroll
        for (int nt = 0; nt < 4; ++nt) { const int dv = 64 * nh + 16 * nt + 4 * q;
            const f32x4 g = *(const f32x4*)(ogain + dv); const v2u gt = *(const v2u*)(PROJ + orow * 16384 + 12288 + h * DH + dv);
            v2u w; w.x = cvtpk(acc[nt][0] * rstd * g.x * bflo(gt.x), acc[nt][1] * rstd * g.y * bfhi(gt.x)); w.y = cvtpk(acc[nt][2] * rstd * g.z * bflo(gt.y), acc[nt][3] * rstd * g.w * bfhi(gt.y));
            *(v2u*)(MO + orow * DM + h * DH + dv) = w; }
        __syncthreads();
    }
#undef B3_LOAD
}
}
constexpr int RING_BYTES = 131072;
constexpr int MISC_OFF = RING_BYTES + 320;
constexpr int LDS_BYTES = 147456;
constexpr int CW_BAR = 4096;
constexpr int CW_Q = 8192;
static_assert(fa::LDS_BYTES + 16 <= RING_BYTES && hg::B3_END <= RING_BYTES, "phase scratch fits the ring region");
static_assert(WS_END <= (size_t)4096 * MiB, "workspace map");

constexpr int PH_FINAL = 49, PH_END = 50;
struct Args { const float* in[15]; float* out; unsigned char* ws; int ph_lo, ph_hi; };
static_assert(sizeof(Args) == 15 * 8 + 8 + 8 + 4 + 4, "Args has no padding bytes");

__global__ void __launch_bounds__(NWAVES * 64, 2) trunk_fwd(Args args) {
    extern __shared__ __attribute__((aligned(16))) unsigned char lds_raw[];
    LAS unsigned char* lds = (LAS unsigned char*)lds_raw;
    volatile LAS unsigned* MISC = (volatile LAS unsigned*)(lds + MISC_OFF);
    const int tid = threadIdx.x;
    const int G = gridDim.x, bx = blockIdx.x;
    const int vcu = (G % 8 == 0) ? (bx % 8) * (G / 8) + bx / 8 : bx;
    unsigned char* ws = args.ws;
    for (int u = tid; u < (LDS_BYTES - RING_BYTES) / 4; u += NWAVES * 64) ((LAS unsigned*)(lds + RING_BYTES))[u] = 0u;
    __syncthreads();
    const int lo = args.ph_lo, hi = args.ph_hi;
#if MK_PER_PHASE
#define GRID_BAR(p) do { } while (0)
#else
    XcdBarrier bar = xcd_barrier_post((unsigned*)(ws + WS_CTL) + CW_BAR, MISC + 8);
#define GRID_BAR(p) do { if ((p) + 1 < hi) xcd_barrier(bar); } while (0)
#endif
#ifndef ONLY_SITE
#define ONLY_SITE -1
#endif
#define EN(s) (ONLY_SITE == -1 || ONLY_SITE == (s))
#ifndef DUP_SITE
#define DUP_SITE -1
#endif
#define DUP(s) (DUP_SITE == (s))
#define IN(k) (lo <= (k) && (k) < hi)
    const float* x = args.in[0];
    float* Hb = (float*)(ws + WS_H); bf16* XN = (bf16*)(ws + WS_XN); bf16* MO = (bf16*)(ws + WS_MO); bf16* PROJ = (bf16*)(ws + WS_PROJ);
    float* Gg = (float*)(ws + WS_G); bf16* UT = (bf16*)(ws + WS_UT); bf16* ST = (bf16*)(ws + WS_ST);
    float* LOGF = (float*)(ws + WS_LOGF); float* KB = (float*)(ws + WS_KB); float* DEC = (float*)(ws + WS_DEC); const float* LB = (const float*)(ws + WS_LB); int* JL = (int*)(ws + WS_LB + 512 * 1024); float* CSb = (float*)(ws + WS_LB + 768 * 1024);

    if (EN(0) && IN(0)) {
        ProArgs pa{args.in[1], args.in[2], args.in[6], args.in[7], args.in[12], args.in[13], args.in[9]};
        prologue_phase(lds, ws, pa, vcu, G);
        GRID_BAR(0);
        if (DUP(0)) { prologue_phase(lds, ws, pa, vcu, G); GRID_BAR(0); }
    }
    for (int L = 0; L < DEPTH; ++L) {
        const int pb = 1 + 12 * L, j = L >> 1; const bool fox = (L & 1) == 0;
        const float* hsrc = (L == 0) ? x : Hb;
        if (EN(1) && IN(pb + 0)) { rms_phase<false>(hsrc, args.in[10] + (size_t)L * DM, XN, vcu, G); GRID_BAR(pb + 0); if (DUP(1)) { rms_phase<false>(hsrc, args.in[10] + (size_t)L * DM, XN, vcu, G); GRID_BAR(pb + 0); } }
        if (fox) {
            if (EN(2) && IN(pb + 1)) {
                pg8::Gemm g{XN, (const bf16*)(ws + WS_WFIN) + (size_t)j * FOX_INP * DM, SEQ, FOX_INP, DM}; pg8::StaticOrder S; S.init(SEQ, FOX_INP, G, bx);
                pg8::EpiFox E{PROJ, 16384, LOGF, args.in[5] + j * NH, CSb};
                pg8::gemm_phase<pg8::EpiFox, pg8::StaticOrder, true, true>(lds, g, S, E);
                GRID_BAR(pb + 1);
                if (DUP(2)) { pg8::gemm_phase<pg8::EpiFox, pg8::StaticOrder, true, true>(lds, g, S, E); GRID_BAR(pb + 1); }
            }
            if (EN(3) && IN(pb + 2)) { fox_thin_phase(lds, PROJ, LOGF, CSb, KB, args.in[3] + j * DH, args.in[4] + j * DH, vcu, G); GRID_BAR(pb + 2); }
            if (EN(14) && IN(pb + 3)) { jl_phase(lds, KB, args.in[3] + j * DH, args.in[4] + j * DH, JL, vcu, G); GRID_BAR(pb + 3); }
            if (EN(4) && IN(pb + 4)) { fa::attn_phase((char*)lds_raw, PROJ, KB, MO, JL, (unsigned*)(ws + WS_CTL) + CW_Q + 64 * j); GRID_BAR(pb + 4); }
        } else {
            if (EN(5) && IN(pb + 1)) {
                pg8::Gemm g{XN, (const bf16*)(ws + WS_WHIN) + (size_t)j * HG_IN * DM, SEQ, HG_IN, DM}; pg8::StaticOrder S; S.init(SEQ, HG_IN, G, bx);
                pg8::EpiHgrn E{PROJ, 16384, Gg, LB + (size_t)L * DM};
                pg8::gemm_phase<pg8::EpiHgrn, pg8::StaticOrder, true, true>(lds, g, S, E);
                GRID_BAR(pb + 1);
                if (DUP(2)) { pg8::gemm_phase<pg8::EpiHgrn, pg8::StaticOrder, true, true>(lds, g, S, E); GRID_BAR(pb + 1); }
            }
            if (EN(6) && IN(pb + 2)) { hg::b1_phase(lds, PROJ, Gg, UT, DEC, vcu, G); GRID_BAR(pb + 2); }
            if (EN(7) && IN(pb + 3)) { hg::b2_phase(UT, DEC, ST, vcu, G); GRID_BAR(pb + 3); }
            if (EN(8) && IN(pb + 4)) { hg::b3_phase(lds, PROJ, Gg, ST, args.in[8] + j * DH, MO, vcu, G); GRID_BAR(pb + 4); }
            if (DUP(6)) { hg::b1_phase(lds, PROJ, Gg, UT, DEC, vcu, G); GRID_BAR(pb + 2); hg::b2_phase(UT, DEC, ST, vcu, G); GRID_BAR(pb + 3); hg::b3_phase(lds, PROJ, Gg, ST, args.in[8] + j * DH, MO, vcu, G); GRID_BAR(pb + 4); }
        }
        if (EN(9) && IN(pb + 5)) {
            const bf16* W = fox ? (const bf16*)(ws + WS_WFOUT) + (size_t)j * DM * DM : (const bf16*)(ws + WS_WHOUT) + (size_t)j * DM * DM;
            pg8::Gemm g{MO, W, SEQ, DM, DM}; pg8::StaticOrder S; S.init(SEQ, DM, G, bx);
            if (DUP(9)) { pg8::EpiRes E2{hsrc, (float*)UT, DM}; pg8::gemm_phase<pg8::EpiRes, pg8::StaticOrder, true, true>(lds, g, S, E2); GRID_BAR(pb + 4); }
            pg8::EpiRes E{hsrc, Hb, DM};
            pg8::gemm_phase<pg8::EpiRes, pg8::StaticOrder, true, true>(lds, g, S, E);
            GRID_BAR(pb + 5);
        }
        if (EN(10) && IN(pb + 6)) { rms_phase<false>(Hb, args.in[11] + (size_t)L * DM, XN, vcu, G); GRID_BAR(pb + 6); if (DUP(1)) { rms_phase<false>(Hb, args.in[11] + (size_t)L * DM, XN, vcu, G); GRID_BAR(pb + 6); } }
        if (EN(11) && IN(pb + 7)) {
            pg8::Gemm g{XN, (const bf16*)(ws + WS_WUP) + (size_t)L * DFF * DM, SEQ, DFF, DM}; pg8::StaticOrder S; S.init(SEQ, DFF, G, bx);
            pg8::EpiSqRelu E{PROJ, DFF};
            pg8::gemm_phase<pg8::EpiSqRelu, pg8::StaticOrder, true, true>(lds, g, S, E);
            GRID_BAR(pb + 7);
            if (DUP(11)) { pg8::gemm_phase<pg8::EpiSqRelu, pg8::StaticOrder, true, true>(lds, g, S, E); GRID_BAR(pb + 7); }
        }
        if (EN(12) && IN(pb + 8)) {
            pg8::Gemm g{PROJ, (const bf16*)(ws + WS_WDN) + (size_t)L * DM * DFF, SEQ, DM, DFF}; pg8::StaticOrder S; S.init(SEQ, DM, G, bx);
            if (DUP(12)) { pg8::EpiRes E2{Hb, (float*)UT, DM}; pg8::gemm_phase<pg8::EpiRes, pg8::StaticOrder, true, true>(lds, g, S, E2); GRID_BAR(pb + 7); }
            pg8::EpiRes E{Hb, Hb, DM};
            pg8::gemm_phase<pg8::EpiRes, pg8::StaticOrder, true, true>(lds, g, S, E);
            GRID_BAR(pb + 8);
        }
    }
    if (EN(13) && IN(PH_FINAL)) rms_phase<true>(Hb, args.in[14], args.out, vcu, G);
#undef IN
#undef GRID_BAR
}

extern "C" void kernel_launch(void* const* d_in, const int* in_sizes, int n_in, void* d_out, int out_size, void* d_ws, size_t ws_size, hipStream_t stream) {
    static int grid = 0;
    if (grid == 0) {
        if (n_in != 15 || in_sizes[0] != SEQ * DM || out_size != SEQ * DM || ws_size < WS_END) { fprintf(stderr, "kernel_launch: unexpected shapes (n_in %d, in0 %d, out %d, ws %zu < %zu)\n", n_in, n_in > 0 ? in_sizes[0] : -1, out_size, ws_size, (size_t)WS_END); grid = -1; return; }
        int dev = 0, cus = 0, per_cu = 0;
        if (hipGetDevice(&dev) != hipSuccess || hipDeviceGetAttribute(&cus, hipDeviceAttributeMultiprocessorCount, dev) != hipSuccess) { grid = -1; return; }
        if (hipFuncSetAttribute((const void*)trunk_fwd, hipFuncAttributeMaxDynamicSharedMemorySize, LDS_BYTES) != hipSuccess) { fprintf(stderr, "kernel_launch: hipFuncSetAttribute failed\n"); grid = -1; return; }
        if (hipOccupancyMaxActiveBlocksPerMultiprocessor(&per_cu, (const void*)trunk_fwd, NWAVES * 64, LDS_BYTES) != hipSuccess || per_cu < 1) fprintf(stderr, "kernel_launch: occupancy query says %d\n", per_cu);
        (void)hipGetLastError();
        grid = cus;
    }
    if (grid < 0) return;
    if (hipMemsetAsync((char*)d_ws + WS_CTL, 0, CTL_ZERO_BYTES, stream) != hipSuccess) return;
    Args a{};
    for (int i = 0; i < 15; ++i) a.in[i] = (const float*)d_in[i];
    a.out = (float*)d_out; a.ws = (unsigned char*)d_ws;
#if MK_PER_PHASE
    for (int p = 0; p < PH_END; ++p) {
        bool valid = (p == 0) || (p == PH_FINAL);
        if (p >= 1 && p < PH_FINAL) { const int L = (p - 1) / 12, k = (p - 1) % 12; const bool fox = (L & 1) == 0; valid = (k <= 8); }
        if (!valid) continue;
        a.ph_lo = p; a.ph_hi = p + 1;
        hipLaunchKernelGGL(trunk_fwd, dim3(grid), dim3(NWAVES * 64), LDS_BYTES, stream, a);
    }
#else
    a.ph_lo = 0; a.ph_hi = PH_END;
    hipLaunchKernelGGL(trunk_fwd, dim3(grid), dim3(NWAVES * 64), LDS_BYTES, stream, a);
#endif
}
```

```cpp
#define MK_PER_PHASE 0
#define DUP_SITE -1
#include <hip/hip_runtime.h>
#include <hip/hip_bf16.h>
#include <cstdio>
#include <cstdint>

#ifndef MK_PER_PHASE
#define MK_PER_PHASE 0
#endif

constexpr int SEQ = 16384, DM = 4096, DFF = 16384, NH = 32, DH = 128, DEPTH = 4;
constexpr int FOX_IN = 4 * DM + NH;
constexpr int FOX_INP = 65 * 256;
constexpr int HG_IN = 4 * DM;
constexpr float NORM_EPS = 1e-6f;
constexpr float LOG2E = 1.4426950408889634f;
constexpr float QSCALE = 0.08838834764831845f * LOG2E;

constexpr size_t MiB = 1u << 20;
constexpr size_t WS_CTL = 0, CTL_ZERO_BYTES = 1 * MiB;
constexpr size_t WS_WFIN = 1 * MiB;
constexpr size_t WS_WFOUT = WS_WFIN + 260 * MiB;
constexpr size_t WS_WHIN = WS_WFOUT + 64 * MiB;
constexpr size_t WS_WHOUT = WS_WHIN + 256 * MiB;
constexpr size_t WS_WUP = WS_WHOUT + 64 * MiB;
constexpr size_t WS_WDN = WS_WUP + 512 * MiB;
constexpr size_t WS_H = WS_WDN + 512 * MiB;
constexpr size_t WS_XN = WS_H + 256 * MiB;
constexpr size_t WS_MO = WS_XN + 128 * MiB;
constexpr size_t WS_PROJ = WS_MO + 128 * MiB;
constexpr size_t WS_G = WS_PROJ + 512 * MiB;
constexpr size_t WS_UT = WS_G + 256 * MiB;
constexpr size_t WS_ST = WS_UT + 512 * MiB;
constexpr size_t WS_LOGF = WS_ST + 256 * MiB;
constexpr size_t WS_KB = WS_LOGF + 2 * MiB;
constexpr size_t WS_DEC = WS_KB + 2 * MiB;
constexpr size_t WS_LB = WS_DEC + 4 * MiB;
constexpr size_t WS_PART = WS_LB + 1 * MiB;
constexpr size_t WS_END = WS_PART + 4 * MiB;

#define GAS __attribute__((address_space(1)))
#define LAS __attribute__((address_space(3)))
typedef unsigned short bf16;
typedef unsigned v4u __attribute__((ext_vector_type(4)));
typedef unsigned v2u __attribute__((ext_vector_type(2)));
typedef float f32x4 __attribute__((ext_vector_type(4)));
typedef float f32x16 __attribute__((ext_vector_type(16)));
typedef short bf16x8 __attribute__((ext_vector_type(8)));
typedef short s16x4 __attribute__((ext_vector_type(4)));
#define LDS_WAIT() asm volatile("s_waitcnt lgkmcnt(0)" ::: "memory")
#define VM_WAIT() asm volatile("s_waitcnt vmcnt(0)" ::: "memory")
typedef float f32x2_t __attribute__((ext_vector_type(2)));
typedef __bf16 bf16x2_t __attribute__((ext_vector_type(2)));
__device__ __forceinline__ unsigned cvtpk(float lo, float hi) { const f32x2_t v = {lo, hi}; return __builtin_bit_cast(unsigned, __builtin_convertvector(v, bf16x2_t)); }
__device__ __forceinline__ float bflo(unsigned w) { return __uint_as_float(w << 16); }
__device__ __forceinline__ float bfhi(unsigned w) { return __uint_as_float(w & 0xffff0000u); }
__device__ __forceinline__ float bf2f(bf16 b) { return __uint_as_float(((unsigned)b) << 16); }
__device__ __forceinline__ bf16 f2bf(float f) { return (bf16)(cvtpk(f, 0.f) & 0xffffu); }
__device__ __forceinline__ float fexp(float x) { return __builtin_amdgcn_exp2f(x * LOG2E); }
__device__ __forceinline__ float sigmoidf_(float x) { return __builtin_amdgcn_rcpf(1.f + fexp(-x)); }
constexpr int WAVE_TAB_OFF = 131072 + 2048;
__device__ __forceinline__ unsigned hw_wave_slot() { return (unsigned)__builtin_amdgcn_s_getreg((5 << 11) | 4) & 63u; }
__device__ __forceinline__ int opaque_tid() {
    extern __shared__ __attribute__((aligned(16))) unsigned char dyn_lds_[];
    int l; asm volatile("v_mbcnt_lo_u32_b32 %0, -1, 0\n\tv_mbcnt_hi_u32_b32 %0, -1, %0" : "=v"(l));
    const int w = __builtin_amdgcn_readfirstlane(((const volatile LAS int*)((LAS unsigned char*)dyn_lds_ + WAVE_TAB_OFF))[hw_wave_slot()]);
    return (w << 6) | l;
}
__device__ __forceinline__ float shx(float v, int o, int lane) { return __int_as_float(__builtin_amdgcn_ds_bpermute((lane ^ o) << 2, __float_as_int(v))); }
namespace pg8 {
#define PG8_LAS __attribute__((address_space(3)))
typedef unsigned short bf16_t;
typedef short bf16x8 __attribute__((ext_vector_type(8)));
typedef float f32x4 __attribute__((ext_vector_type(4)));
typedef unsigned u32x4 __attribute__((ext_vector_type(4)));
constexpr int BM = 256, BK = 64, HALF = 128, HTB = HALF * BK * 2  , STAGE_BYTES = 8 * HTB, NXCD = 8, WGM = 8;

__host__ __device__ __forceinline__ int lds_byte(int r, int c) { const int st = (r >> 4) * 2 + (c >> 5), rr = r & 15, cc = c & 31, ob = rr * 64 + cc * 2; return st * 1024 + (ob ^ (((ob >> 9) & 1) << 5)); }
__host__ __device__ __forceinline__ void stage_rc(int b, int& R, int& C) { const int st = b / 1024, sb = b % 1024, swz = sb ^ (((sb >> 9) & 1) << 5); R = (st >> 1) * 16 + swz / 64; C = (st & 1) * 32 + (swz % 64) / 2; }
__host__ __device__ __forceinline__ int perm32(int rho) { const int n = rho >> 4, i = rho & 15; return 8 * (i >> 2) + 4 * n + (i & 3); }

struct Unit { int pm, pn; };
struct Gemm { const bf16_t* A; const bf16_t* Bt; int M, N, K; };

struct StaticOrder {
    int nM, nN, nwg, G, c;
    __host__ __device__ __forceinline__ void init(int M, int N, int G_, int c_) { nM = M / BM; nN = N / BM; nwg = nM * nN; G = G_; c = c_; }
    __host__ __device__ __forceinline__ bool next(int i, Unit& u) const {
        const long L = (long)i * G + c; if (L >= nwg) return false;
        int wgid = (int)L; { const int q = nwg / NXCD, r = nwg % NXCD, xcd = wgid % NXCD, off = wgid / NXCD; wgid = (xcd < r ? xcd * (q + 1) : r * (q + 1) + (xcd - r) * q) + off; }
        const int nig = WGM * nN, gid = wgid / nig, fm = gid * WGM, gsz = (nM - fm) < WGM ? (nM - fm) : WGM;
        u.pm = fm + ((wgid % nig) % gsz); u.pn = (wgid % nig) / gsz; return true;
    }
    __device__ __forceinline__ void a_ready(const Unit&) const {}
    __device__ __forceinline__ void done(const Unit&) const {}
};
#ifndef EPI_NT
#define EPI_NT 0
#endif
#if EPI_NT
#define STORE_NT(p, v) __builtin_nontemporal_store((v), (p))
#else
#define STORE_NT(p, v) (*(p) = (v))
#endif
__device__ __forceinline__ unsigned cvt_pk_bf16(float lo, float hi) { return ::cvtpk(lo, hi); }
__device__ __forceinline__ float lsig(float z) { return fminf(z, 0.f) - 0.6931471805599453f * __builtin_amdgcn_logf(1.f + __builtin_amdgcn_exp2f(-1.4426950408889634f * fabsf(z))); }
__device__ __forceinline__ float sigm(float x) { return __builtin_amdgcn_rcpf(1.f + __builtin_amdgcn_exp2f(-1.4426950408889634f * x)); }

struct RowScale {
    const PG8_LAS float* tab; int pm0; const float* part;
    __device__ __forceinline__ float get(const Unit& u, int rowin) const {
        if (u.pm == pm0) return tab[rowin];
        int ri = rowin; asm volatile("" : "+v"(ri));
        const f32x4* p = (const f32x4*)(part + (size_t)(u.pm * BM + ri) * 64); f32x4 a = {0.f, 0.f, 0.f, 0.f};
#pragma unroll 1
        for (int i = 0; i < 16; ++i) a += p[i];
        return rsqrtf(((a.x + a.y) + (a.z + a.w)) * (1.f / 4096.f) + 1e-6f);
    }
};
struct EpiRes {
    static constexpr bool PERM = true, AFTER_DRAIN = false;
    const float* base; float* out; int ldc; bf16_t* xn; const float* gain; float* part;
    __device__ __forceinline__ void operator()(const f32x4 (&acc)[2][2][4][2], const Unit& u, int wr, int wc, int fr, int fq) const {
        const int row0 = u.pm * BM + wr * 64 + fr, col0 = u.pn * BM + wc * 32 + 8 * fq, lane = fq * 16 + fr;
        f32x4 g0[2], g1[2];
        if (xn) {
#pragma unroll
            for (int bj = 0; bj < 2; ++bj) { g0[bj] = *(const f32x4*)(gain + col0 + bj * HALF); g1[bj] = *(const f32x4*)(gain + col0 + bj * HALF + 4); } }
#pragma unroll
        for (int ai = 0; ai < 2; ++ai) {
            f32x4 b0[4][2], b1[4][2];
#pragma unroll
            for (int m = 0; m < 4; ++m) { const size_t off = (size_t)(row0 + ai * HALF + m * 16) * ldc + col0;
#pragma unroll
                for (int bj = 0; bj < 2; ++bj) { b0[m][bj] = *(const f32x4*)(base + off + bj * HALF); b1[m][bj] = *(const f32x4*)(base + off + bj * HALF + 4); } }
#pragma unroll
            for (int m = 0; m < 4; ++m) { const size_t row = (size_t)(row0 + ai * HALF + m * 16); const size_t off = row * ldc + col0;
                float ss = 0.f;
#pragma unroll
                for (int bj = 0; bj < 2; ++bj) { const f32x4 h0 = b0[m][bj] + acc[ai][bj][m][0], h1 = b1[m][bj] + acc[ai][bj][m][1];
                    STORE_NT((f32x4*)(out + off + bj * HALF), h0); STORE_NT((f32x4*)(out + off + bj * HALF + 4), h1);
                    if (xn) { ss += ((h0[0] * h0[0] + h0[1] * h0[1]) + (h0[2] * h0[2] + h0[3] * h0[3])) + ((h1[0] * h1[0] + h1[1] * h1[1]) + (h1[2] * h1[2] + h1[3] * h1[3]));
                        const f32x4 x0 = h0 * g0[bj], x1 = h1 * g1[bj];
                        u32x4 w; w.x = cvt_pk_bf16(x0[0], x0[1]); w.y = cvt_pk_bf16(x0[2], x0[3]); w.z = cvt_pk_bf16(x1[0], x1[1]); w.w = cvt_pk_bf16(x1[2], x1[3]);
                        STORE_NT((u32x4*)(xn + off + bj * HALF), w); } }
                if (xn) { ss += ::shx(ss, 16, lane); ss += ::shx(ss, 32, lane); if (fq == 0) part[row * 64 + u.pn * 4 + wc] = ss; } }
            asm volatile("" ::: "memory"); }
    }
};
struct EpiSqRelu {
    static constexpr bool PERM = true, AFTER_DRAIN = false;
    bf16_t* O; int ldc; RowScale rsc;
    __device__ __forceinline__ void operator()(const f32x4 (&acc)[2][2][4][2], const Unit& u, int wr, int wc, int fr, int fq) const {
        const int row0 = u.pm * BM + wr * 64 + fr, col0 = u.pn * BM + wc * 32 + 8 * fq;
#pragma unroll
        for (int ai = 0; ai < 2; ++ai)
#pragma unroll
            for (int m = 0; m < 4; ++m) { bf16_t* rowp = O + (size_t)(row0 + ai * HALF + m * 16) * ldc + col0; const float rs = rsc.get(u, wr * 64 + fr + ai * HALF + m * 16);
#pragma unroll
                for (int bj = 0; bj < 2; ++bj) { f32x4 v0 = acc[ai][bj][m][0] * rs, v1 = acc[ai][bj][m][1] * rs;
#pragma unroll
                    for (int j = 0; j < 4; ++j) { const float a = fmaxf(v0[j], 0.f), b = fmaxf(v1[j], 0.f); v0[j] = a * a; v1[j] = b * b; }
                    u32x4 w; w.x = cvt_pk_bf16(v0[0], v0[1]); w.y = cvt_pk_bf16(v0[2], v0[3]); w.z = cvt_pk_bf16(v1[0], v1[1]); w.w = cvt_pk_bf16(v1[2], v1[3]);
                    STORE_NT((u32x4*)(rowp + bj * HALF), w); } }
    }
};
struct EpiFox {
    static constexpr bool PERM = true, AFTER_DRAIN = false;
    bf16_t* P; int ldc; float* logf; const float* fbias; float* cs; RowScale rsc; const float* qg; const float* kg; PG8_LAS float* qkt; float QS;
    __device__ __forceinline__ void operator()(const f32x4 (&acc)[2][2][4][2], const Unit& u, int wr, int wc, int fr, int fq) const {
        const int row0 = u.pm * BM + wr * 64 + fr;
        if (u.pn < 32) {
            const int col0 = u.pn * BM + wc * 32 + 8 * fq, lane = fq * 16 + fr; const bool isq = u.pn < 16;
            const float* gs = (isq ? qg : kg) + wc * 32 + 8 * fq; const float sc = isq ? QS : 1.f;
            const f32x4 g0 = *(const f32x4*)gs * sc, g1 = *(const f32x4*)(gs + 4) * sc;
#pragma unroll
            for (int ai = 0; ai < 2; ++ai)
#pragma unroll
                for (int m = 0; m < 4; ++m) { const int rowin = ai * 64 + m * 16 + fr; const float rs = rsc.get(u, wr * 64 + fr + ai * HALF + m * 16);
#pragma unroll
                    for (int bj = 0; bj < 2; ++bj) { const f32x4 v0 = acc[ai][bj][m][0] * rs, v1 = acc[ai][bj][m][1] * rs;
                        float ss = ((v0[0] * v0[0] + v0[1] * v0[1]) + (v0[2] * v0[2] + v0[3] * v0[3])) + ((v1[0] * v1[0] + v1[1] * v1[1]) + (v1[2] * v1[2] + v1[3] * v1[3]));
                        ss += ::shx(ss, 16, lane); ss += ::shx(ss, 32, lane);
                        if (fq == 0) qkt[(((wr * 128 + rowin) * 2 + bj) << 2) + wc] = ss; } }
            asm volatile("s_waitcnt lgkmcnt(0)" ::: "memory"); __builtin_amdgcn_s_barrier(); asm volatile("" ::: "memory");
#pragma unroll
            for (int ai = 0; ai < 2; ++ai)
#pragma unroll
                for (int m = 0; m < 4; ++m) { const int rowin = ai * 64 + m * 16 + fr; const float rs = rsc.get(u, wr * 64 + fr + ai * HALF + m * 16);
                    bf16_t* rowp = P + (size_t)(row0 + ai * HALF + m * 16) * ldc + col0;
#pragma unroll
                    for (int bj = 0; bj < 2; ++bj) { const f32x4 t = *(const PG8_LAS f32x4*)(qkt + (((wr * 128 + rowin) * 2 + bj) << 2));
                        const float r2 = rs * rsqrtf(((t[0] + t[1]) + (t[2] + t[3])) * (1.f / 128.f) + 1e-6f);
                        const f32x4 v0 = acc[ai][bj][m][0] * r2 * g0, v1 = acc[ai][bj][m][1] * r2 * g1;
                        u32x4 w; w.x = cvt_pk_bf16(v0[0], v0[1]); w.y = cvt_pk_bf16(v0[2], v0[3]); w.z = cvt_pk_bf16(v1[0], v1[1]); w.w = cvt_pk_bf16(v1[2], v1[3]);
                        STORE_NT((u32x4*)(rowp + bj * HALF), w); } }
        } else if (u.pn < 64) {
            const int col0 = u.pn * BM + wc * 32 + 8 * fq; const bool gate = u.pn >= 48;
#pragma unroll
            for (int ai = 0; ai < 2; ++ai)
#pragma unroll
                for (int m = 0; m < 4; ++m) { bf16_t* rowp = P + (size_t)(row0 + ai * HALF + m * 16) * ldc + col0; const float rs = rsc.get(u, wr * 64 + fr + ai * HALF + m * 16);
#pragma unroll
                    for (int bj = 0; bj < 2; ++bj) { f32x4 v0 = acc[ai][bj][m][0] * rs, v1 = acc[ai][bj][m][1] * rs;
                        if (gate) {
#pragma unroll
                            for (int j = 0; j < 4; ++j) { v0[j] = sigm(v0[j]); v1[j] = sigm(v1[j]); } }
                        u32x4 w; w.x = cvt_pk_bf16(v0[0], v0[1]); w.y = cvt_pk_bf16(v0[2], v0[3]); w.z = cvt_pk_bf16(v1[0], v1[1]); w.w = cvt_pk_bf16(v1[2], v1[3]);
                        STORE_NT((u32x4*)(rowp + bj * HALF), w); } }
        } else if (wc == 0) {
            const f32x4 b0 = *(const f32x4*)(fbias + 8 * fq), b1 = *(const f32x4*)(fbias + 8 * fq + 4);
            const int lane = fq * 16 + fr;
#pragma unroll
            for (int ai = 0; ai < 2; ++ai) {
                f32x4 s0 = {0.f, 0.f, 0.f, 0.f}, s1 = {0.f, 0.f, 0.f, 0.f};
#pragma unroll
                for (int m = 0; m < 4; ++m) { float* rowp = logf + (size_t)(row0 + ai * HALF + m * 16) * 32 + 8 * fq; const float rs = rsc.get(u, wr * 64 + fr + ai * HALF + m * 16);
                    f32x4 v0 = acc[ai][0][m][0] * rs + b0, v1 = acc[ai][0][m][1] * rs + b1;
#pragma unroll
                    for (int j = 0; j < 4; ++j) { v0[j] = lsig(v0[j]); v1[j] = lsig(v1[j]); }
                    *(f32x4*)rowp = v0; *(f32x4*)(rowp + 4) = v1; s0 += v0; s1 += v1; }
#pragma unroll
                for (int j = 0; j < 4; ++j) {
#pragma unroll
                    for (int o = 1; o < 16; o <<= 1) { s0[j] += ::shx(s0[j], o, lane); s1[j] += ::shx(s1[j], o, lane); } }
                if (fr == 0) { float* cp = cs + (size_t)(u.pm * 4 + ai * 2 + wr) * 32 + 8 * fq; *(f32x4*)cp = s0; *(f32x4*)(cp + 4) = s1; }
                asm volatile("" ::: "memory"); }
        }
    }
};
struct EpiHgrn {
    static constexpr bool PERM = true, AFTER_DRAIN = false;
    bf16_t* P; int ldc; float* G; const float* lb; RowScale rsc;
    __device__ __forceinline__ void operator()(const f32x4 (&acc)[2][2][4][2], const Unit& u, int wr, int wc, int fr, int fq) const {
        const int row0 = u.pm * BM + wr * 64 + fr, col0 = u.pn * BM + wc * 32 + 8 * fq; const int kind = u.pn >> 4;
        if (kind == 1) {
            const int gc0 = col0 - 4096;
            f32x4 l0[2], l1[2];
#pragma unroll
            for (int bj = 0; bj < 2; ++bj) { l0[bj] = *(const f32x4*)(lb + gc0 + bj * HALF); l1[bj] = *(const f32x4*)(lb + gc0 + bj * HALF + 4); }
#pragma unroll
            for (int ai = 0; ai < 2; ++ai)
#pragma unroll
                for (int m = 0; m < 4; ++m) { const size_t r = (size_t)(row0 + ai * HALF + m * 16); bf16_t* rowp = P + r * ldc + col0; float* gp = G + r * 4096 + gc0; const float rs = rsc.get(u, wr * 64 + fr + ai * HALF + m * 16);
#pragma unroll
                    for (int bj = 0; bj < 2; ++bj) { f32x4 v0 = acc[ai][bj][m][0] * rs, v1 = acc[ai][bj][m][1] * rs, g0, g1;
#pragma unroll
                        for (int j = 0; j < 4; ++j) { const float f0 = l0[bj][j] + (1.f - l0[bj][j]) * sigm(v0[j]), f1 = l1[bj][j] + (1.f - l1[bj][j]) * sigm(v1[j]);
                            g0[j] = logf(f0); g1[j] = logf(f1); v0[j] = 1.f - f0; v1[j] = 1.f - f1; }
                        u32x4 w; w.x = cvt_pk_bf16(v0[0], v0[1]); w.y = cvt_pk_bf16(v0[2], v0[3]); w.z = cvt_pk_bf16(v1[0], v1[1]); w.w = cvt_pk_bf16(v1[2], v1[3]);
                        STORE_NT((u32x4*)(rowp + bj * HALF), w); STORE_NT((f32x4*)(gp + bj * HALF), g0); STORE_NT((f32x4*)(gp + bj * HALF + 4), g1); } }
        } else {
            const bool act = kind != 2;
#pragma unroll
            for (int ai = 0; ai < 2; ++ai)
#pragma unroll
                for (int m = 0; m < 4; ++m) { bf16_t* rowp = P + (size_t)(row0 + ai * HALF + m * 16) * ldc + col0; const float rs = rsc.get(u, wr * 64 + fr + ai * HALF + m * 16);
#pragma unroll
                    for (int bj = 0; bj < 2; ++bj) { f32x4 v0 = acc[ai][bj][m][0] * rs, v1 = acc[ai][bj][m][1] * rs;
                        if (act) {
#pragma unroll
                            for (int j = 0; j < 4; ++j) { v0[j] = v0[j] * sigm(v0[j]); v1[j] = v1[j] * sigm(v1[j]); } }
                        u32x4 w; w.x = cvt_pk_bf16(v0[0], v0[1]); w.y = cvt_pk_bf16(v0[2], v0[3]); w.z = cvt_pk_bf16(v1[0], v1[1]); w.w = cvt_pk_bf16(v1[2], v1[3]);
                        STORE_NT((u32x4*)(rowp + bj * HALF), w); } }
        }
    }
};
template <class Epi, class Sched, bool ALIGN_EPI = false, bool SP2 = false>
__device__ __forceinline__ void gemm_phase(PG8_LAS unsigned char* lds, const Gemm g, const Sched& S, const Epi& E) {
    const int tid = opaque_tid(), wid = __builtin_amdgcn_readfirstlane(tid >> 6), lane = tid & 63, wr = wid >> 2, wc = wid & 3, fr = lane & 15, fq = lane >> 4;
    const int K = g.K, nt = K / BK;
    unsigned voffA[2], voffB[2];
#pragma unroll
    for (int i = 0; i < 2; ++i) { int R, C; stage_rc(tid * 16 + i * 8192, R, C); const int Rb = Epi::PERM ? ((R & ~31) + perm32(R & 31)) : R;
        voffA[i] = (unsigned)(R * K + C) * 2u; voffB[i] = (unsigned)(Rb * K + C) * 2u; }
    const size_t kstep = (size_t)(BK * 2);
    const size_t hstep = (size_t)HALF * K * 2;
    const size_t tstep = 2 * hstep;
    const unsigned ldsw = (unsigned)wid * 1024u;
    const int aoff = lds_byte(wr * 64 + fr, fq * 8), boff = lds_byte(wc * 32 + fr, fq * 8);
#define PG8_SA(b, h) (((b) * 2 + (h)) * HTB)
#define PG8_SB(b, h) ((4 + (b) * 2 + (h)) * HTB)
#define PG8_STAGE(bufoff, gbase, voff) do { _Pragma("unroll") for (int _i = 0; _i < 2; ++_i) \
        __builtin_amdgcn_global_load_lds((const unsigned*)((const char*)(gbase) + (voff)[_i]), (PG8_LAS unsigned*)(lds + (bufoff) + ldsw + _i * 8192), 16, 0, 0); } while (0)
#define PG8_LDA(dst, b, h) do { _Pragma("unroll") for (int m = 0; m < 4; ++m) _Pragma("unroll") for (int k = 0; k < 2; ++k) dst[m][k] = *(const PG8_LAS bf16x8*)(lds + PG8_SA(b, h) + aoff + m * 2048 + k * 1024); } while (0)
#define PG8_LDB(dst, b, h) do { _Pragma("unroll") for (int n = 0; n < 2; ++n) _Pragma("unroll") for (int k = 0; k < 2; ++k) dst[n][k] = *(const PG8_LAS bf16x8*)(lds + PG8_SB(b, h) + boff + n * 2048 + k * 1024); } while (0)
#define PG8_MMA(ai, bj, At, Bt) do { __builtin_amdgcn_s_setprio(1); _Pragma("unroll") for (int m = 0; m < 4; ++m) _Pragma("unroll") for (int n = 0; n < 2; ++n) _Pragma("unroll") for (int k = 0; k < 2; ++k) \
        acc[ai][bj][m][n] = __builtin_amdgcn_mfma_f32_16x16x32_bf16(Bt[n][k], At[m][k], acc[ai][bj][m][n], 0, 0, 0); __builtin_amdgcn_s_setprio(0); } while (0)
#define PG8_WAIT_V(n) asm volatile("s_waitcnt vmcnt(" #n ")" ::: "memory")
#define PG8_WAIT_L(n) asm volatile("s_waitcnt lgkmcnt(" #n ")" ::: "memory")
#define PG8_BAR __builtin_amdgcn_s_barrier()
#define PG8_SCHED __builtin_amdgcn_sched_barrier(0)
    Unit cur, nxt; int ui = 0;
    if (!S.next(0, cur)) return;
    f32x4 acc[2][2][4][2];
#pragma unroll
    for (int a = 0; a < 2; ++a)
#pragma unroll
        for (int b = 0; b < 2; ++b)
#pragma unroll
            for (int m = 0; m < 4; ++m)
#pragma unroll
                for (int n = 0; n < 2; ++n) acc[a][b][m][n] = (f32x4){0.f, 0.f, 0.f, 0.f};
    bf16x8 At[4][2], B0[2][2], B1[2][2];
    const char* cA = (const char*)g.A + (size_t)cur.pm * tstep; const char* cB = (const char*)g.Bt + (size_t)cur.pn * tstep;
    S.a_ready(cur);
    if constexpr (SP2) {
        PG8_STAGE(PG8_SB(0, 0), cB, voffB); PG8_STAGE(PG8_SB(0, 1), cB + hstep, voffB); PG8_STAGE(PG8_SA(0, 0), cA, voffA); PG8_STAGE(PG8_SA(0, 1), cA + hstep, voffA);
        if (wr == 1) PG8_BAR;
        PG8_WAIT_V(2); PG8_BAR;
        PG8_STAGE(PG8_SB(1, 0), cB + kstep, voffB); PG8_STAGE(PG8_SA(1, 0), cA + kstep, voffA); PG8_STAGE(PG8_SB(1, 1), cB + hstep + kstep, voffB);
        PG8_WAIT_V(6); PG8_BAR;
    } else {
        PG8_STAGE(PG8_SB(0, 0), cB, voffB); PG8_STAGE(PG8_SA(0, 0), cA, voffA); PG8_STAGE(PG8_SB(0, 1), cB + hstep, voffB); PG8_STAGE(PG8_SA(0, 1), cA + hstep, voffA);
        if (wr == 1) PG8_BAR;
        PG8_WAIT_V(4); PG8_BAR;
        PG8_STAGE(PG8_SB(1, 0), cB + kstep, voffB); PG8_STAGE(PG8_SA(1, 0), cA + kstep, voffA); PG8_STAGE(PG8_SB(1, 1), cB + hstep + kstep, voffB);
        PG8_WAIT_V(6); PG8_BAR;
    }
    for (;;) {
        const bool has_next = S.next(ui + 1, nxt);
        const char* nA = has_next ? (const char*)g.A + (size_t)nxt.pm * tstep : cA; const char* nB = has_next ? (const char*)g.Bt + (size_t)nxt.pn * tstep : cB;
        for (int t = 0; t < nt; t += 2) {
            const bool last = (t == nt - 2);
            const char* a1 = cA + (size_t)(t + 1) * kstep;
            const char* a2 = last ? nA : cA + (size_t)(t + 2) * kstep; const char* b2 = last ? nB : cB + (size_t)(t + 2) * kstep;
            const char* a3 = a2 + kstep; const char* b3 = b2 + kstep;
            if (last && has_next) S.a_ready(nxt);
            if constexpr (SP2) {
            PG8_LDB(B0, 0, 0); PG8_LDB(B1, 0, 1); PG8_SCHED; PG8_LDA(At, 0, 0); PG8_STAGE(PG8_SA(1, 1), a1 + hstep, voffA);
            PG8_WAIT_V(8); PG8_WAIT_L(0); PG8_BAR; PG8_MMA(0, 0, At, B0); PG8_MMA(0, 1, At, B1); PG8_BAR; PG8_SCHED;
            PG8_LDA(At, 0, 1); PG8_STAGE(PG8_SB(0, 0), b2, voffB); PG8_STAGE(PG8_SB(0, 1), b2 + hstep, voffB); PG8_STAGE(PG8_SA(0, 0), a2, voffA);
            PG8_WAIT_V(8); PG8_WAIT_L(0); PG8_BAR; PG8_MMA(1, 0, At, B0); PG8_MMA(1, 1, At, B1); PG8_BAR; PG8_SCHED;
            PG8_LDB(B0, 1, 0); PG8_LDB(B1, 1, 1); PG8_SCHED; PG8_LDA(At, 1, 0); PG8_STAGE(PG8_SA(0, 1), a2 + hstep, voffA);
            PG8_WAIT_V(8); PG8_WAIT_L(0); PG8_BAR; PG8_MMA(0, 0, At, B0); PG8_MMA(0, 1, At, B1); PG8_BAR; PG8_SCHED;
            PG8_LDA(At, 1, 1); PG8_STAGE(PG8_SB(1, 0), b3, voffB); PG8_STAGE(PG8_SB(1, 1), b3 + hstep, voffB); PG8_STAGE(PG8_SA(1, 0), a3, voffA);
            PG8_WAIT_V(8); PG8_WAIT_L(0); PG8_BAR; PG8_MMA(1, 0, At, B0); PG8_MMA(1, 1, At, B1); PG8_BAR; PG8_SCHED;
            } else {
            PG8_LDB(B0, 0, 0); PG8_SCHED; PG8_LDA(At, 0, 0); PG8_STAGE(PG8_SA(1, 1), a1 + hstep, voffA);
            PG8_WAIT_L(8); PG8_BAR; PG8_WAIT_L(0); PG8_MMA(0, 0, At, B0); PG8_BAR; PG8_SCHED;
            PG8_LDB(B1, 0, 1); PG8_STAGE(PG8_SB(0, 0), b2, voffB);
            PG8_BAR; PG8_WAIT_L(0); PG8_MMA(0, 1, At, B1); PG8_BAR;
            PG8_LDA(At, 0, 1); PG8_STAGE(PG8_SA(0, 0), a2, voffA);
            PG8_BAR; PG8_WAIT_L(0); PG8_MMA(1, 0, At, B0); PG8_BAR; PG8_SCHED;
            PG8_STAGE(PG8_SB(0, 1), b2 + hstep, voffB);
            PG8_WAIT_V(6); PG8_BAR; PG8_MMA(1, 1, At, B1); PG8_BAR;
            PG8_LDB(B0, 1, 0); PG8_SCHED; PG8_LDA(At, 1, 0); PG8_STAGE(PG8_SA(0, 1), a2 + hstep, voffA);
            PG8_WAIT_L(8); PG8_BAR; PG8_WAIT_L(0); PG8_MMA(0, 0, At, B0); PG8_BAR; PG8_SCHED;
            PG8_LDB(B1, 1, 1); PG8_STAGE(PG8_SB(1, 0), b3, voffB);
            PG8_BAR; PG8_WAIT_L(0); PG8_MMA(0, 1, At, B1); PG8_BAR;
            PG8_LDA(At, 1, 1); PG8_STAGE(PG8_SA(1, 0), a3, voffA);
            PG8_BAR; PG8_WAIT_L(0); PG8_MMA(1, 0, At, B0); PG8_BAR; PG8_SCHED;
            PG8_STAGE(PG8_SB(1, 1), b3 + hstep, voffB);
            PG8_WAIT_V(6); PG8_BAR; PG8_MMA(1, 1, At, B1); PG8_BAR;
            }
        }
        if constexpr (ALIGN_EPI) { if (wr == 0) PG8_BAR; }
        if constexpr (!Epi::AFTER_DRAIN) { E(acc, cur, wr, wc, fr, fq); S.done(cur); }
        if (!has_next) break;
#pragma unroll
        for (int a = 0; a < 2; ++a)
#pragma unroll
            for (int b = 0; b < 2; ++b)
#pragma unroll
                for (int m = 0; m < 4; ++m)
#pragma unroll
                    for (int n = 0; n < 2; ++n) acc[a][b][m][n] = (f32x4){0.f, 0.f, 0.f, 0.f};
        cur = nxt; cA = nA; cB = nB; ++ui;
        if constexpr (ALIGN_EPI) { if (wr == 1) PG8_BAR; }
    }
    PG8_WAIT_V(0);
    if constexpr (!ALIGN_EPI) { if (wr == 0) PG8_BAR; }
    PG8_BAR;
    if constexpr (Epi::AFTER_DRAIN) { E.fused(acc, cur, wr, wc, fr, fq, lds, wid, lane); S.done(cur); }
#undef PG8_SA
#undef PG8_SB
#undef PG8_STAGE
#undef PG8_LDA
#undef PG8_LDB
#undef PG8_MMA
#undef PG8_WAIT_V
#undef PG8_WAIT_L
#undef PG8_BAR
#undef PG8_SCHED
}
}
#define XB_TMO      128
#define XB_XCNT(j)  (256  + 64 * (j))
#define XB_XSUB(j)  (1280 + 64 * (j))
#define XB_XGEN(j)  (2304 + 64 * (j))
#define XB_TOP      3328
#define XB_TOPGEN   3392
#define XCD_BAR_WORDS 3456
#define XB_SPIN_CAP (1u << 18)
#define LAS __attribute__((address_space(3)))

__device__ __forceinline__ unsigned xb_ld(unsigned* p)              { return __hip_atomic_load(p, __ATOMIC_RELAXED, __HIP_MEMORY_SCOPE_AGENT); }
__device__ __forceinline__ unsigned xb_add(unsigned* p, unsigned v) { return __hip_atomic_fetch_add(p, v, __ATOMIC_RELAXED, __HIP_MEMORY_SCOPE_AGENT); }
__device__ __forceinline__ unsigned xb_xcc_id() { return (unsigned)__builtin_amdgcn_s_getreg((3 << 11) | 20) & 0xFu; }
#define XB_SPIN(cond, bar) do { unsigned _sp = 0; while (cond) { __builtin_amdgcn_s_sleep(1); \
    if ((++_sp & 255u) == 0u) { if (xb_ld(&(bar)[XB_TMO])) break; if (_sp > XB_SPIN_CAP) { atomicAdd(&(bar)[XB_TMO], 1u); break; } } } } while (0)

struct XcdBarrier {
    unsigned* bar; unsigned x;
    volatile LAS unsigned* st;
};

__device__ __forceinline__ XcdBarrier xcd_barrier_post(unsigned* bar, volatile LAS unsigned* st) {
    XcdBarrier b; b.bar = bar; b.x = xb_xcc_id(); b.st = st;
    if (threadIdx.x == 0) (void)xb_add(&bar[XB_XCNT(b.x)], 1u);
    return b;
}
__device__ __forceinline__ void xcd_barrier_complete(unsigned* bar, unsigned x, unsigned& nloc, unsigned& nx) {
    const unsigned G = gridDim.x * gridDim.y * gridDim.z;
    unsigned sum, cnt, mine, sp = 0u;
    for (;;) {
        sum = 0u; cnt = 0u; mine = 0u;
#pragma unroll
        for (unsigned j = 0; j < 16; ++j) { const unsigned c = xb_ld(&bar[XB_XCNT(j)]); sum += c; cnt += (c > 0u) ? 1u : 0u; mine = (j == x) ? c : mine; }
        if (sum == G) break;
        __builtin_amdgcn_s_sleep(1);
        if ((++sp & 255u) == 0u) { if (xb_ld(&bar[XB_TMO])) break; if (sp > XB_SPIN_CAP) { atomicAdd(&bar[XB_TMO], 1u); break; } }
    }
    nloc = mine > 0u ? mine : 1u; nx = cnt > 0u ? cnt : 1u;
}

__device__ __forceinline__ void xcd_barrier(const XcdBarrier& b) {
    asm volatile("s_waitcnt vmcnt(0)" ::: "memory");
    __syncthreads();
    if (threadIdx.x == 0) {
        unsigned* bar = b.bar;
        __builtin_amdgcn_s_waitcnt(0);
        unsigned nloc = b.st[0], nx = b.st[1];
        if (nloc == 0u) { xcd_barrier_complete(bar, b.x, nloc, nx); b.st[0] = nloc; b.st[1] = nx; }
        const unsigned old = xb_add(&bar[XB_XSUB(b.x)], 1u);
        const unsigned gen = old / nloc;
        if (old + 1u == (gen + 1u) * nloc) {
            __builtin_amdgcn_fence(__ATOMIC_RELEASE, "agent");
            asm volatile("s_waitcnt vmcnt(0)" ::: "memory");
            const unsigned og = xb_add(&bar[XB_TOP], 1u);
            const unsigned tg = og / nx;
            if (og + 1u == (tg + 1u) * nx) xb_add(&bar[XB_TOPGEN], 1u);
            else XB_SPIN(xb_ld(&bar[XB_TOPGEN]) == tg, bar);
            __builtin_amdgcn_fence(__ATOMIC_ACQUIRE, "agent");
            xb_add(&bar[XB_XGEN(b.x)], 1u);
            asm volatile("s_waitcnt vmcnt(0)" ::: "memory");
        } else {
            XB_SPIN(xb_ld(&bar[XB_XGEN(b.x)]) == gen, bar);
            __builtin_amdgcn_fence(__ATOMIC_ACQUIRE, "agent");
            asm volatile("s_waitcnt vmcnt(0)" ::: "memory");
        }
    }
    __syncthreads();
}
constexpr int NWAVES = 8;
__device__ __forceinline__ float wave_sum(float v, int lane) {
#pragma unroll
    for (int o = 1; o < 64; o <<= 1) v += shx(v, o, lane);
    return v;
}
__device__ __forceinline__ void transpose_tile(const float* W, int K, int N, bf16* WT, LAS unsigned* T, int k0, int n0, int lane) {
    const int half = lane >> 5, nn = lane & 31, n = 4 * nn;
    const bool ok = n0 + n < N;
    const int f = ((nn & 7) << 2) | (((nn >> 3) & 1) << 1);
    const float* src = W + (size_t)k0 * N + n0 + n;
#pragma unroll
    for (int b = 0; b < 4; ++b) {
        f32x4 va[4], vb[4];
#pragma unroll
        for (int i = 0; i < 4; ++i) { const int kp = 2 * (4 * b + i) + half;
            va[i] = ok ? *(const f32x4*)(src + (size_t)(2 * kp) * N) : (f32x4){0.f, 0.f, 0.f, 0.f};
            vb[i] = ok ? *(const f32x4*)(src + (size_t)(2 * kp + 1) * N) : (f32x4){0.f, 0.f, 0.f, 0.f}; }
#pragma unroll
        for (int i = 0; i < 4; ++i) { const int kp = 2 * (4 * b + i) + half;
#pragma unroll
            for (int e = 0; e < 4; ++e) T[(n + e) * 32 + (kp ^ f)] = cvtpk(va[i][e], vb[i][e]); }
    }
    LDS_WAIT(); asm volatile("" ::: "memory");
#pragma unroll 4
    for (int j = 0; j < 16; ++j) { const int idx = lane + 64 * j, c = idx & 7, nr = idx >> 3, nq = nr >> 2; const int fr = ((nq & 7) << 2) | (((nq >> 3) & 1) << 1);
        const v2u lo = *(const LAS v2u*)(T + nr * 32 + ((4 * c) ^ fr)), hi = *(const LAS v2u*)(T + nr * 32 + ((4 * c + 2) ^ fr));
        if (n0 + nr < N) *(v4u*)(WT + (size_t)(n0 + nr) * K + k0 + 8 * c) = (v4u){lo.x, lo.y, hi.x, hi.y}; }
    LDS_WAIT(); asm volatile("" ::: "memory");
}
__device__ __forceinline__ void transpose_matrix(const float* W, int K, int N, bf16* WT, LAS float* scr, int gw, int ngw, int lane) {
    const int nnt = (N + 127) / 128, nitems = (K / 64) * nnt;
    for (int it = gw; it < nitems; it += ngw) { const int kb = it / nnt, nb = it - kb * nnt; transpose_tile(W, K, N, WT, (LAS unsigned*)scr, 64 * kb, 128 * nb, lane); }
}
struct ProArgs { const float* fox_w_in; const float* fox_w_out; const float* hgrn_w_in; const float* hgrn_w_out; const float* up; const float* down; const float* lb_logits; };
__device__ __forceinline__ void prologue_phase(LAS unsigned char* lds, unsigned char* ws, const ProArgs& a, int vcu, int G) {
    const int tid = opaque_tid(), lane = tid & 63, wave = tid >> 6;
    LAS float* scr = (LAS float*)(lds + wave * 16384);
    const int gw = vcu * NWAVES + wave, ngw = G * NWAVES;
    for (int j = 0; j < 2; ++j) {
        transpose_matrix(a.fox_w_in + (size_t)j * DM * FOX_IN, DM, FOX_IN, (bf16*)(ws + WS_WFIN) + (size_t)j * FOX_INP * DM, scr, gw, ngw, lane);
        transpose_matrix(a.fox_w_out + (size_t)j * DM * DM, DM, DM, (bf16*)(ws + WS_WFOUT) + (size_t)j * DM * DM, scr, gw, ngw, lane);
        transpose_matrix(a.hgrn_w_in + (size_t)j * DM * HG_IN, DM, HG_IN, (bf16*)(ws + WS_WHIN) + (size_t)j * HG_IN * DM, scr, gw, ngw, lane);
        transpose_matrix(a.hgrn_w_out + (size_t)j * DM * DM, DM, DM, (bf16*)(ws + WS_WHOUT) + (size_t)j * DM * DM, scr, gw, ngw, lane);
        { v4u* z = (v4u*)((bf16*)(ws + WS_WFIN) + (size_t)j * FOX_INP * DM + (size_t)FOX_IN * DM); const size_t n16 = (size_t)(FOX_INP - FOX_IN) * DM * 2 / 16;
          for (size_t i = (size_t)(vcu * 512 + tid); i < n16; i += (size_t)G * 512) z[i] = (v4u){0u, 0u, 0u, 0u}; }
    }
    for (int j = 0; j < 4; ++j) {
        transpose_matrix(a.up + (size_t)j * DM * DFF, DM, DFF, (bf16*)(ws + WS_WUP) + (size_t)j * DFF * DM, scr, gw, ngw, lane);
        transpose_matrix(a.down + (size_t)j * DFF * DM, DFF, DM, (bf16*)(ws + WS_WDN) + (size_t)j * DM * DFF, scr, gw, ngw, lane);
    }
    for (int c = vcu * 512 + tid; c < DM; c += G * 512) {
        float l[4], mx = -1e30f; for (int i = 0; i < 4; ++i) { l[i] = a.lb_logits[i * DM + c]; mx = fmaxf(mx, l[i]); }
        float s = 0.f; for (int i = 0; i < 4; ++i) { l[i] = expf(l[i] - mx); s += l[i]; }
        float* LB = (float*)(ws + WS_LB); float cum = 0.f; const float p0 = l[0] / s;
        for (int i = 0; i < 4; ++i) { cum += l[i] / s; LB[i * DM + c] = cum - p0; }
    }
}
template <bool TO_F32>
__device__ __forceinline__ void rms_phase(const float* src, const float* gain, void* dst, int vcu, int G) {
    const int tid = opaque_tid(), lane = tid & 63, wave = tid >> 6;
    const int gw = vcu * NWAVES + wave, ngw = G * NWAVES;
    for (int row = gw; row < SEQ; row += ngw) {
        const f32x4* xr = (const f32x4*)(src + (size_t)row * DM) + lane;
        f32x4 v[16]; float ss = 0.f;
#pragma unroll
        for (int j = 0; j < 16; ++j) { v[j] = xr[64 * j]; ss += (v[j].x * v[j].x + v[j].y * v[j].y) + (v[j].z * v[j].z + v[j].w * v[j].w); }
        const float rstd = rsqrtf(wave_sum(ss, lane) * (1.f / DM) + NORM_EPS);
        const f32x4* gr = (const f32x4*)gain + lane;
#pragma unroll
        for (int j = 0; j < 16; ++j) { const f32x4 g = gr[64 * j]; const f32x4 o = v[j] * rstd * g;
            if constexpr (TO_F32) ((f32x4*)((float*)dst + (size_t)row * DM) + lane)[64 * j] = o;
            else { v2u w; w.x = cvtpk(o.x, o.y); w.y = cvtpk(o.z, o.w); ((v2u*)((bf16*)dst + (size_t)row * DM) + lane)[64 * j] = w; } }
    }
}
__device__ __forceinline__ void rms0_phase(const float* src, const float* gain, bf16* dst, float* part, int vcu, int G) {
    const int tid = opaque_tid(), lane = tid & 63, wave = tid >> 6;
    const int gw = vcu * NWAVES + wave, ngw = G * NWAVES;
    for (int row = gw; row < SEQ; row += ngw) {
        const f32x4* xr = (const f32x4*)(src + (size_t)row * DM) + lane; const f32x4* gr = (const f32x4*)gain + lane;
        float ss = 0.f;
#pragma unroll
        for (int j = 0; j < 16; ++j) { const f32x4 v = xr[64 * j], g = gr[64 * j]; ss += (v.x * v.x + v.y * v.y) + (v.z * v.z + v.w * v.w); const f32x4 o = v * g;
            v2u w; w.x = cvtpk(o.x, o.y); w.y = cvtpk(o.z, o.w); ((v2u*)(dst + (size_t)row * DM) + lane)[64 * j] = w; }
        ss = wave_sum(ss, lane);
        part[(size_t)row * 64 + lane] = lane == 0 ? ss : 0.f;
    }
}
__device__ __forceinline__ void rstd_table(LAS float* tab, const float* part, int pm0) {
    const int tid = opaque_tid(), lane = tid & 63, row = tid >> 1, half = tid & 1;
    const f32x4* p = (const f32x4*)(part + (size_t)(pm0 * 256 + row) * 64 + half * 32); f32x4 a = {0.f, 0.f, 0.f, 0.f};
#pragma unroll
    for (int i = 0; i < 8; ++i) a += p[i];
    float s = (a.x + a.y) + (a.z + a.w); s += shx(s, 1, lane);
    if (half == 0) tab[row] = rsqrtf(s * (1.f / DM) + NORM_EPS);
    __syncthreads();
}
__device__ __forceinline__ void fox_thin_phase(LAS unsigned char* lds, const float* LOGF, const float* CS, float* KB, int vcu, int G) {
    const int tid = opaque_tid(), lane = tid & 63, wave = tid >> 6;
    LAS float* red = (LAS float*)lds;
    LAS float* pre = red + 16 * 32;
    LAS float* tile = pre + 32;
    for (int blk = vcu; blk < SEQ / 64; blk += G) {
        const int r0 = blk * 64;
        { const int h = tid & 31, part = tid >> 5; float a = 0.f;
#pragma unroll 4
          for (int c = part; c < blk; c += 16) a += CS[c * 32 + h];
          red[part * 32 + h] = a; }
        { const int row = tid >> 3, c4 = tid & 7; const f32x4 v = *(const f32x4*)(LOGF + (size_t)(r0 + row) * 32 + 4 * c4);
          tile[row * 33 + 4 * c4 + 0] = v.x; tile[row * 33 + 4 * c4 + 1] = v.y; tile[row * 33 + 4 * c4 + 2] = v.z; tile[row * 33 + 4 * c4 + 3] = v.w; }
        __syncthreads();
        if (tid < 32) { float s = 0.f;
#pragma unroll
            for (int p = 0; p < 16; ++p) s += red[p * 32 + tid];
            float c = s;
            for (int r = 0; r < 64; ++r) { c += tile[r * 33 + tid]; tile[r * 33 + tid] = -c * LOG2E; } }
        __syncthreads();
        { const int h = tid >> 4, r4 = (tid & 15) * 4;
          const f32x4 o = {tile[(r4 + 0) * 33 + h], tile[(r4 + 1) * 33 + h], tile[(r4 + 2) * 33 + h], tile[(r4 + 3) * 33 + h]};
          *(f32x4*)(KB + (size_t)h * SEQ + r0 + r4) = o; }
        __syncthreads();
    }
}
__device__ __forceinline__ void jl_phase(LAS unsigned char* lds, const float* KB, const float* qg, const float* kg, int* JL, int vcu, int G) {
    const int tid = opaque_tid(), lane = tid & 63, wave = tid >> 6;
    LAS int* cnt = (LAS int*)lds;
    float gq = fmaxf(fabsf(qg[lane]), fabsf(qg[lane + 64])), gk = fmaxf(fabsf(kg[lane]), fabsf(kg[lane + 64]));
#pragma unroll
    for (int o = 1; o < 64; o <<= 1) { gq = fmaxf(gq, shx(gq, o, lane)); gk = fmaxf(gk, shx(gk, o, lane)); }
    const float TH = 64.f + 2.f * (128.f * gq * gk * QSCALE * 1.02f);
    for (int id = vcu; id < 2048; id += G) {
        const int h = id & 31, qb = 63 - (id >> 5);
        const float* kb = KB + (size_t)h * SEQ;
        const float lim = kb[qb * 256] - TH;
        const bool pred = (tid < 4 * qb) && (kb[64 * tid + 63] < lim);
        const unsigned long long bal = __ballot(pred);
        if (lane == 0) cnt[wave] = __popcll(bal);
        __syncthreads();
        if (tid == 0) { int s = 0; for (int w = 0; w < 8; ++w) s += cnt[w]; JL[id] = s; }
        __syncthreads();
    }
}
namespace fa {
constexpr int D = 128, NW = 8, QBLK = 32, KVBLK = 64, QB = NW * QBLK;
constexpr int LDQ = 16384, LDO = 4096;
constexpr int SHM_V = KVBLK * D * 2, SHM_K = KVBLK * D * 2;
constexpr int OFF_WS = 2 * SHM_V + 2 * SHM_K, OFF_KB = OFF_WS + NW * 64 * 4;
constexpr int LDS_BYTES = OFF_KB + 2 * 64 * 4;
constexpr float THR2 = 11.5f;
#define KSWZ(row, colB) ((row) * 256 + ((colB) ^ (((row) & 7) << 4)))
#define SBAR() __builtin_amdgcn_sched_barrier(0)
__device__ __forceinline__ int v_st(int k, int c) { const int kk = (k & ~0xC) | ((k & 4) << 1) | ((k & 8) >> 1); return ((kk >> 3) * 4 + (c >> 5)) * 512 + ((kk & 7) * 32 + (c & 31)) * 2; }
__device__ __forceinline__ int v_rd_base(int lane) { return ((lane & 3) << 3) | (((lane >> 2) & 3) << 6) | (((lane >> 4) & 1) << 5) | (((lane >> 5) & 1) << 8); }
constexpr int v_rd_off(int d0, int ks, int half) { return d0 * 512 + ks * 4096 + half * 2048; }
__device__ __forceinline__ int crow(int r, int hi) { return (r & 3) + 8 * (r >> 2) + 4 * hi; }
__device__ __forceinline__ bf16x8 ld8(const bf16* p) { return *reinterpret_cast<const bf16x8*>(p); }
__device__ __forceinline__ void mask_tile(f32x16& p0, f32x16& p1, int dq) {
    const float NEG = -__builtin_inff();
#pragma unroll
    for (int r = 0; r < 16; ++r) {
        const int c = (r & 3) + 8 * (r >> 2);
        if (dq - c < 0) p0[r] = NEG;
        if (dq - c - 32 < 0) p1[r] = NEG;
    }
}
__device__ __forceinline__ void partialSM(f32x16& p0, f32x16& p1, float& m_reg, float& mn, float& alpha) {
    float pmax = p0[0];
#pragma unroll
    for (int r = 1; r < 16; ++r) pmax = fmaxf(pmax, p0[r]);
#pragma unroll
    for (int r = 0; r < 16; ++r) pmax = fmaxf(pmax, p1[r]);
    { auto rr = __builtin_amdgcn_permlane32_swap(__float_as_uint(pmax), __float_as_uint(pmax), false, false);
      pmax = fmaxf(__uint_as_float(rr[0]), __uint_as_float(rr[1])); }
    if (__builtin_expect(__all(pmax - m_reg <= THR2), 1)) { mn = m_reg; alpha = 1.f; }
    else { mn = fmaxf(m_reg, pmax); alpha = __builtin_amdgcn_exp2f(m_reg - mn); m_reg = mn; }
#pragma unroll
    for (int r = 0; r < 16; ++r) p0[r] = p0[r] - mn;
#pragma unroll
    for (int r = 0; r < 16; ++r) p1[r] = p1[r] - mn;
#pragma unroll
    for (int r = 0; r < 16; ++r) p0[r] = __builtin_amdgcn_exp2f(p0[r]);
}
__device__ __forceinline__ void finishSM(f32x16& p0, f32x16& p1, float alpha, float& l_reg, bf16x8& pa0, bf16x8& pa1, bf16x8& pa2, bf16x8& pa3) {
#pragma unroll
    for (int r = 0; r < 16; ++r) p1[r] = __builtin_amdgcn_exp2f(p1[r]);
    float ps = 0;
#pragma unroll
    for (int r = 0; r < 16; ++r) ps += p0[r];
#pragma unroll
    for (int r = 0; r < 16; ++r) ps += p1[r];
    { auto rr = __builtin_amdgcn_permlane32_swap(__float_as_uint(ps), __float_as_uint(ps), false, false);
      ps = __uint_as_float(rr[0]) + __uint_as_float(rr[1]); }
    l_reg = l_reg * alpha + ps;
#define PK4(P, B_, OUT) do { unsigned a0 = cvtpk(P[B_+0], P[B_+1]), a1 = cvtpk(P[B_+2], P[B_+3]);                          \
        unsigned b0 = cvtpk(P[B_+4], P[B_+5]), b1 = cvtpk(P[B_+6], P[B_+7]);                                             \
        auto r0 = __builtin_amdgcn_permlane32_swap(a0, b0, false, false); auto r1 = __builtin_amdgcn_permlane32_swap(a1, b1, false, false); \
        v4u w = {r0[0], r1[0], r0[1], r1[1]}; OUT = *reinterpret_cast<bf16x8*>(&w); } while (0)
    PK4(p0, 0, pa0); PK4(p0, 8, pa1); PK4(p1, 0, pa2); PK4(p1, 8, pa3);
#undef PK4
}
template <int KB>
__device__ __forceinline__ void qkt(f32x16& p0, f32x16& p1, const char* K_lds, const float* kbl, int r32, int hi, const bf16x8* qr) {
#ifdef X_NOBIAS
    p0 = f32x16{}; p1 = f32x16{};
#else
    { const float* kb = kbl + KB * 64 + 4 * hi;
      const f32x4 a0 = *(const f32x4*)(kb), a1 = *(const f32x4*)(kb + 8), a2 = *(const f32x4*)(kb + 16), a3 = *(const f32x4*)(kb + 24);
      const f32x4 b0 = *(const f32x4*)(kb + 32), b1 = *(const f32x4*)(kb + 40), b2 = *(const f32x4*)(kb + 48), b3 = *(const f32x4*)(kb + 56);
      p0 = f32x16{a0[0], a0[1], a0[2], a0[3], a1[0], a1[1], a1[2], a1[3], a2[0], a2[1], a2[2], a2[3], a3[0], a3[1], a3[2], a3[3]};
      p1 = f32x16{b0[0], b0[1], b0[2], b0[3], b1[0], b1[1], b1[2], b1[3], b2[0], b2[1], b2[2], b2[3], b3[0], b3[1], b3[2], b3[3]}; }
#endif
    const char* kb4[4];
#pragma unroll
    for (int dd = 0; dd < 4; ++dd) kb4[dd] = K_lds + KB * SHM_K + KSWZ(r32, (dd * 16 + hi * 8) * 2);
#pragma unroll
    for (int d0 = 0; d0 < 8; ++d0) { const char* a = kb4[d0 & 3] + (d0 >> 2) * 128;
        bf16x8 b0 = *reinterpret_cast<const bf16x8*>(a);
        bf16x8 b1 = *reinterpret_cast<const bf16x8*>(a + 32 * 256);
        p0 = __builtin_amdgcn_mfma_f32_32x32x16_bf16(b0, qr[d0], p0, 0, 0, 0);
        p1 = __builtin_amdgcn_mfma_f32_32x32x16_bf16(b1, qr[d0], p1, 0, 0, 0); }
}
template <int VB>
__device__ __forceinline__ void pv_tile(f32x16* o, int vb0, bf16x8 pa0, bf16x8 pa1, bf16x8 pa2, bf16x8 pa3) {
#define TRRD(dst, off) asm volatile("ds_read_b64_tr_b16 %0, %1 offset:%2" : "=&v"(dst) : "v"(vb0), "i"(off) : "memory")
#define PV_D0(d0) do { s16x4 l0, l1, l2, l3, h0, h1, h2, h3; constexpr int b_ = VB * SHM_V + v_rd_off(d0, 0, 0); \
        TRRD(l0, b_); TRRD(h0, b_ + 2048); TRRD(l1, b_ + 4096); TRRD(h1, b_ + 6144); TRRD(l2, b_ + 8192); TRRD(h2, b_ + 10240); TRRD(l3, b_ + 12288); TRRD(h3, b_ + 14336); \
        asm volatile("s_waitcnt lgkmcnt(0)" ::: "memory"); SBAR();   \
        o[d0] = __builtin_amdgcn_mfma_f32_32x32x16_bf16(pa0, (bf16x8){l0[0], l0[1], l0[2], l0[3], h0[0], h0[1], h0[2], h0[3]}, o[d0], 0, 0, 0);   \
        o[d0] = __builtin_amdgcn_mfma_f32_32x32x16_bf16(pa1, (bf16x8){l1[0], l1[1], l1[2], l1[3], h1[0], h1[1], h1[2], h1[3]}, o[d0], 0, 0, 0);   \
        o[d0] = __builtin_amdgcn_mfma_f32_32x32x16_bf16(pa2, (bf16x8){l2[0], l2[1], l2[2], l2[3], h2[0], h2[1], h2[2], h2[3]}, o[d0], 0, 0, 0);   \
        o[d0] = __builtin_amdgcn_mfma_f32_32x32x16_bf16(pa3, (bf16x8){l3[0], l3[1], l3[2], l3[3], h3[0], h3[1], h3[2], h3[3]}, o[d0], 0, 0, 0); } while (0)
    PV_D0(0); PV_D0(1); PV_D0(2); PV_D0(3);
#undef PV_D0
#undef TRRD
}
struct BlockRef { const bf16* Q; const bf16* K; const bf16* V; const float* KBp; const bf16* G; bf16* O; int P0; int j0; };
struct Seam { bf16x8 qr[8]; bf16x8 st_v0, st_v1, st_k0, st_k1; float st_b; };
#define ROWP(p, k0, rr) ((const char*)(p) + (size_t)((k0) + (rr)) * (LDQ * 2))
#define LD8V(base, off) (*reinterpret_cast<const bf16x8*>((base) + (off)))
#define VMW() asm volatile("s_waitcnt vmcnt(0)" ::: "memory")
#define VMWN(n) asm volatile("s_waitcnt vmcnt(%0)" :: "i"(n) : "memory")
#define SLOAD_H(Kp, Vp, Bp, k0) do { S.st_v0 = LD8V(ROWP(Vp, k0, 0), voff); S.st_v1 = LD8V(ROWP(Vp, k0, 32), voff);              \
                         S.st_k0 = LD8V(ROWP(Kp, k0, 0), voff); S.st_k1 = LD8V(ROWP(Kp, k0, 32), voff); \
                         if (tid < 64) S.st_b = *(const float*)((const char*)((Bp) + (k0)) + (unsigned)(tid * 4)); } while (0)
#define SWRITE_HK(bf) do { *(bf16x8*)(K_lds + (bf) * SHM_K + kws) = S.st_k0; *(bf16x8*)(K_lds + (bf) * SHM_K + kws + 32 * 256) = S.st_k1; if (tid < 64) kbl[(bf) * 64 + tid] = S.st_b; } while (0)
#define SWRITE_HV(bf) do { *(bf16x8*)(V_lds + (bf) * SHM_V + vst0) = S.st_v0; *(bf16x8*)(V_lds + (bf) * SHM_V + vst1) = S.st_v1; } while (0)
#define SWRITE_H(bf) do { SWRITE_HV(bf); SWRITE_HK(bf); } while (0)
__device__ __forceinline__ void fox_prime(const BlockRef& cur, char* lds, Seam& S) {
    const int tid = opaque_tid(), wid = __builtin_amdgcn_readfirstlane(tid >> 6), lane = tid & 63, r32 = lane & 31, hi = lane >> 5;
    const int sr = tid >> 4, sc = (tid & 15) * 8, kws = KSWZ(sr, sc * 2); char* K_lds = lds + 2 * SHM_V; float* kbl = (float*)(lds + OFF_KB);
    const unsigned voff = (unsigned)(sr * LDQ + sc) * 2u, qoff = (unsigned)(r32 * LDQ + hi * 8) * 2u;
    { const char* qb_ = (const char*)(cur.Q + (size_t)(wid * QBLK) * LDQ);
#pragma unroll
      for (int d0 = 0; d0 < 8; ++d0) S.qr[d0] = LD8V(qb_ + d0 * 32, qoff); }
    SLOAD_H(cur.K, cur.V, cur.KBp, cur.j0 * KVBLK); VMW(); SWRITE_HK(0);
    __syncthreads();
}
__device__ __forceinline__ void fox_block(const BlockRef& cur, const BlockRef& nxt, char* lds, Seam& S) {
    const int tid = opaque_tid(), wid = __builtin_amdgcn_readfirstlane(tid >> 6), lane = tid & 63, r32 = lane & 31, hi = lane >> 5;
    const int j_lo = cur.j0, NT = (cur.P0 + QB - 1) / KVBLK + 1 - j_lo;
    const int qlo = cur.P0 + wid * QBLK, qm = qlo + r32 - 4 * hi;
    char* V_lds = lds; char* K_lds = lds + 2 * SHM_V; float* kbl = (float*)(lds + OFF_KB);
    float* ws = (float*)(lds + OFF_WS) + wid * 64; float* li_l = ws, * al_l = ws + 32;
    float m_reg = -1e30f, l_reg = 0; f32x16 o[4] = {};
    const int sr = tid >> 4, sc = (tid & 15) * 8, vst0 = v_st(sr, sc), vst1 = v_st(32 + sr, sc), kws = KSWZ(sr, sc * 2);
    const unsigned voff = (unsigned)(sr * LDQ + sc) * 2u;
    const int vb0 = (int)(uintptr_t)V_lds + v_rd_base(lane);
    const bf16* Kh = cur.K; const bf16* Vh = cur.V; const float* Bh = cur.KBp;
#define RESC(a) do { if (__any((a) < 1.f)) { if (hi == 0) al_l[r32] = (a); asm volatile("s_waitcnt lgkmcnt(0)" ::: "memory");              \
                     for (int d_ = 0; d_ < 4; ++d_) for (int r = 0; r < 16; ++r) o[d_][r] *= al_l[crow(r, hi)]; } } while (0)
#define KBASE(t) ((j_lo + (t)) * KVBLK)
#define MASKT(P0_, P1_, t) do { const int kb_ = KBASE(t); if (kb_ + KVBLK - 1 > qlo) mask_tile(P0_, P1_, qm - kb_); } while (0)
    constexpr int NQL = 8;
#define SEAM_K0() do { VMWN(NQL); SWRITE_HK(0); SBAR(); } while (0)
    f32x16 pA0, pA1, pB0, pB1; float mnA, mnB, alA, alB; bf16x8 pa0, pa1, pa2, pa3;
    SWRITE_HV(0); SBAR();
    if (NT > 1) { SLOAD_H(Kh, Vh, Bh, KBASE(1)); }
    SBAR(); qkt<0>(pA0, pA1, K_lds, kbl, r32, hi, S.qr);
    MASKT(pA0, pA1, 0); partialSM(pA0, pA1, m_reg, mnA, alA);
    if (NT > 1) { VMW(); SWRITE_H(1); }
    __syncthreads();
#define HALF_STEP(PX0, PX1, mnX, alX, PY0, PY1, alY, t, KB, VB, SB) do {                                                      \
        SBAR(); qkt<KB>(PX0, PX1, K_lds, kbl, r32, hi, S.qr);                                             \
        finishSM(PY0, PY1, alY, l_reg, pa0, pa1, pa2, pa3); SBAR();                                                           \
        if ((t) + 1 < NT) { SLOAD_H(Kh, Vh, Bh, KBASE((t) + 1)); SBAR(); }                                               \
        pv_tile<VB>(o, vb0, pa0, pa1, pa2, pa3); MASKT(PX0, PX1, (t)); partialSM(PX0, PX1, m_reg, mnX, alX);                                        \
        __syncthreads();                                                                                                      \
        if ((t) + 1 < NT) { VMW(); SWRITE_H(SB); }                                                                          \
        RESC(alX); __syncthreads(); } while (0)
    for (int t = 1; t + 1 < NT; t += 2) {
        HALF_STEP(pB0, pB1, mnB, alB, pA0, pA1, alA, t, 1, 0, 0);
        HALF_STEP(pA0, pA1, mnA, alA, pB0, pB1, alB, t + 1, 0, 1, 1);
    }
    const bool even = (NT & 1) == 0;
    if (even) { SBAR(); qkt<1>(pB0, pB1, K_lds, kbl, r32, hi, S.qr); SBAR(); }
    SLOAD_H(nxt.K, nxt.V, nxt.KBp, nxt.j0 * KVBLK); SBAR();
    { const int l2 = opaque_tid() & 63; const unsigned qoff = (unsigned)((l2 & 31) * LDQ + (l2 >> 5) * 8) * 2u;
      const char* qb_ = (const char*)(nxt.Q + (size_t)(wid * QBLK) * LDQ);
#pragma unroll
      for (int d0 = 0; d0 < 8; ++d0) S.qr[d0] = LD8V(qb_ + d0 * 32, qoff); }
    SBAR();
    finishSM(pA0, pA1, alA, l_reg, pa0, pa1, pa2, pa3); SBAR();
    pv_tile<0>(o, vb0, pa0, pa1, pa2, pa3);
    if (even) { MASKT(pB0, pB1, NT - 1); partialSM(pB0, pB1, m_reg, mnB, alB); __syncthreads(); RESC(alB);
        finishSM(pB0, pB1, alB, l_reg, pa0, pa1, pa2, pa3); SBAR(); pv_tile<1>(o, vb0, pa0, pa1, pa2, pa3); }
    SBAR(); SEAM_K0();
    if (hi == 0) li_l[r32] = l_reg; asm volatile("s_waitcnt lgkmcnt(0)" ::: "memory");
    float rli[16];
#pragma unroll
    for (int r = 0; r < 16; ++r) rli[r] = __builtin_amdgcn_rcpf(li_l[crow(r, hi)]);
    const char* Ob = (const char*)(cur.O + (size_t)(wid * QBLK) * LDO); const char* Gb = (const char*)(cur.G + (size_t)(wid * QBLK) * LDQ);
    const int l3 = opaque_tid() & 63; const unsigned voffO = (unsigned)((4 * (l3 >> 5)) * LDO + (l3 & 31)) * 2u, voffG = (unsigned)((4 * (l3 >> 5)) * LDQ + (l3 & 31)) * 2u;
#pragma unroll
    for (int r = 0; r < 16; ++r) { const int rc = (r & 3) + 8 * (r >> 2);
        const char* Or = Ob + (size_t)rc * LDO * 2; const char* Gr = Gb + (size_t)rc * LDQ * 2;
#pragma unroll
        for (int d0 = 0; d0 < 4; ++d0) { const float v = o[d0][r] * rli[r]; const float vn = shx(v, 1, lane);
#ifdef X_NOGATE
            if ((r32 & 1) == 0) { *(unsigned*)(Or + d0 * 64 + voffO) = cvtpk(v, vn); } }
#else
            if ((r32 & 1) == 0) { const unsigned g2 = *(const unsigned*)(Gr + d0 * 64 + voffG);
                *(unsigned*)(Or + d0 * 64 + voffO) = cvtpk(v * bflo(g2), vn * bfhi(g2)); } }
#endif
        if ((r & 3) == 3) asm volatile("" ::: "memory"); }
    __syncthreads();
#undef RESC
#undef KBASE
#undef MASKT
#undef SEAM_K0
#undef HALF_STEP
}
#undef ROWP
#undef LD8V
#undef VMWN
#undef SLOAD_H
#undef SWRITE_HK
#undef SWRITE_HV
#undef SWRITE_H
__device__ __forceinline__ BlockRef mk_ref(const bf16* PROJ, const float* KBg, bf16* MO, const int* JL, int id) {
    const int bh = id & 31, qb = 63 - (id >> 5);
    BlockRef r; r.Q = PROJ + (size_t)(qb * QB) * LDQ + bh * D; r.K = PROJ + 4096 + bh * D; r.V = PROJ + 8192 + bh * D; r.KBp = KBg + (size_t)bh * SEQ;
    r.G = PROJ + (size_t)(qb * QB) * LDQ + 12288 + bh * D; r.O = MO + (size_t)(qb * QB) * LDO + bh * D; r.P0 = qb * QB; r.j0 = JL[id]; return r;
}
__device__ __forceinline__ void attn_phase(char* lds, const bf16* PROJ, const float* KBg, bf16* MO, const int* JL, unsigned* qctr) {
    constexpr int total = 32 * 64;
    const int tid = opaque_tid();
    volatile int* slot = (volatile int*)(lds + LDS_BYTES);
    if (tid == 0) slot[0] = (int)__hip_atomic_fetch_add(qctr, 1u, __ATOMIC_RELAXED, __HIP_MEMORY_SCOPE_AGENT);
    __syncthreads();
    int id = __builtin_amdgcn_readfirstlane(slot[0]);
    if (id >= total) return;
    BlockRef cur = mk_ref(PROJ, KBg, MO, JL, id);
    Seam S;
    fox_prime(cur, lds, S);
    for (;;) {
        if (tid == 0) slot[1] = (int)__hip_atomic_fetch_add(qctr, 1u, __ATOMIC_RELAXED, __HIP_MEMORY_SCOPE_AGENT);
        __syncthreads();
        const int idn = __builtin_amdgcn_readfirstlane(slot[1]);
        const bool last = idn >= total;
        const BlockRef nxt = last ? cur : mk_ref(PROJ, KBg, MO, JL, idn);
        fox_block(cur, nxt, lds, S);
        if (last) break;
        cur = nxt;
    }
}
#undef VMW
}
namespace hg {
constexpr int CH = 64, NCH = SEQ / CH;
constexpr int PK = 144;
constexpr int PQ = 272;
__device__ __forceinline__ f32x4 mma(bf16x8 bfrag, bf16x8 afrag, f32x4 acc) { return __builtin_amdgcn_mfma_f32_16x16x32_bf16(bfrag, afrag, acc, 0, 0, 0); }
__device__ __forceinline__ bf16x8 ldsfrag(const LAS unsigned char* base, int row, int pitch, int kbyte) { return *(const LAS bf16x8*)(base + row * pitch + kbyte); }

__device__ __forceinline__ void b1_phase(LAS unsigned char* lds, const bf16* PROJ, const float* Gg, bf16* UT, float* DEC, int vcu, int G) {
    const int tid = opaque_tid(), lane = tid & 63, wave = __builtin_amdgcn_readfirstlane(tid >> 6), col = tid & 127, sg = tid >> 7, r = lane & 15, q = lane >> 4;
    LAS unsigned char* KT = lds;
    LAS unsigned char* VT = lds + 128 * PK;
    LAS float* segtot = (LAS float*)(lds + 2 * 128 * PK);
    float nb[16]; unsigned short nk[16], nv[16];
#define B1_LOAD(u_) do { const int c_ = (u_) >> 5, h_ = (u_) & 31; const int rw_ = c_ * CH + 16 * sg; \
        _Pragma("unroll") for (int j = 0; j < 16; ++j) { nb[j] = Gg[(size_t)(rw_ + j) * DM + h_ * DH + col]; const bf16* p_ = PROJ + (size_t)(rw_ + j) * 16384 + 4096 + h_ * DH + col; nk[j] = p_[0]; nv[j] = p_[4096]; } } while (0)
    if (vcu < NCH * NH) B1_LOAD(vcu);
    for (int u = vcu; u < NCH * NH; u += G) {
        float b[16]; unsigned short kk[16], vv[16];
#pragma unroll
        for (int j = 0; j < 16; ++j) { b[j] = nb[j]; kk[j] = nk[j]; vv[j] = nv[j]; }
#pragma unroll
        for (int j = 1; j < 16; ++j) b[j] += b[j - 1];
        segtot[sg * 128 + col] = b[15];
        __syncthreads();
        float off = 0.f, total = 0.f;
#pragma unroll
        for (int s2 = 0; s2 < 4; ++s2) { const float t = segtot[s2 * 128 + col]; total += t; if (s2 < sg) off += t; }
        const float rem = total - off;
        unsigned kw[8], vw[8];
#pragma unroll
        for (int j = 0; j < 8; ++j) { kw[j] = cvtpk(bf2f(kk[2 * j]) * fexp(rem - b[2 * j]), bf2f(kk[2 * j + 1]) * fexp(rem - b[2 * j + 1])); vw[j] = (unsigned)vv[2 * j] | ((unsigned)vv[2 * j + 1] << 16); }
        *(LAS v4u*)(KT + col * PK + 32 * sg) = (v4u){kw[0], kw[1], kw[2], kw[3]}; *(LAS v4u*)(KT + col * PK + 32 * sg + 16) = (v4u){kw[4], kw[5], kw[6], kw[7]};
        *(LAS v4u*)(VT + col * PK + 32 * sg) = (v4u){vw[0], vw[1], vw[2], vw[3]}; *(LAS v4u*)(VT + col * PK + 32 * sg + 16) = (v4u){vw[4], vw[5], vw[6], vw[7]};
        if (sg == 0) DEC[(size_t)u * 128 + col] = fexp(total);
        if (u + G < NCH * NH) B1_LOAD(u + G);
        __syncthreads();
        const bf16x8 a0 = ldsfrag(VT, 16 * wave + r, PK, 16 * q), a1 = ldsfrag(VT, 16 * wave + r, PK, 64 + 16 * q);
        bf16* up = UT + ((size_t)u * 128 + 16 * wave + r) * 128 + 4 * q;
#pragma unroll
        for (int nt = 0; nt < 8; ++nt) { f32x4 acc = {0.f, 0.f, 0.f, 0.f};
            acc = mma(ldsfrag(KT, 16 * nt + r, PK, 16 * q), a0, acc); acc = mma(ldsfrag(KT, 16 * nt + r, PK, 64 + 16 * q), a1, acc);
            v2u w; w.x = cvtpk(acc[0], acc[1]); w.y = cvtpk(acc[2], acc[3]); *(v2u*)(up + 16 * nt) = w; }
        __syncthreads();
    }
#undef B1_LOAD
}
__device__ __forceinline__ void b2_phase(const bf16* UT, const float* DEC, bf16* ST, int vcu, int G) {
    for (int gid = vcu * 512 + opaque_tid(); gid < NH * 128 * 32; gid += G * 512) {
        const int h = gid >> 12, dv = (gid >> 5) & 127, dk4 = (gid & 31) * 4;
        f32x4 st = {0.f, 0.f, 0.f, 0.f};
        const size_t eo = ((size_t)h * 128 + dv) * 128 + dk4, estep = (size_t)NH * 128 * 128;
        const size_t dofs = (size_t)h * 128 + dk4, dstep = (size_t)NH * 128;
#pragma unroll 8
        for (int c = 0; c < NCH; ++c) {
            const v2u uw = *(const v2u*)(UT + eo + c * estep); const f32x4 uu = {bflo(uw.x), bfhi(uw.x), bflo(uw.y), bfhi(uw.y)}; const f32x4 dd = *(const f32x4*)(DEC + dofs + c * dstep);
            v2u w; w.x = cvtpk(st.x, st.y); w.y = cvtpk(st.z, st.w); *(v2u*)(ST + eo + c * estep) = w;
            st = dd * st + uu;
        }
    }
}
constexpr int B3_QT = 0, B3_QH = B3_QT + 64 * PQ, B3_KH = B3_QH + 64 * PQ  , B3_VT = B3_KH + 160 * PQ, B3_P = B3_VT + 128 * PK, B3_SEG = B3_P + 64 * PK, B3_RS = B3_SEG + 2048, B3_END = B3_RS + 512;
__device__ __forceinline__ int kh_base(int I) { return 16 * (I * (I + 1) / 2); }
__device__ __forceinline__ void b3_phase(LAS unsigned char* lds, const bf16* PROJ, const float* Gg, const bf16* ST, const float* ogain, bf16* MO, int vcu, int G) {
    const int tid = opaque_tid(), lane = tid & 63, wave = __builtin_amdgcn_readfirstlane(tid >> 6), col = tid & 127, sg = tid >> 7, r = lane & 15, q = lane >> 4;
    LAS unsigned char* QT = lds + B3_QT; LAS unsigned char* QH = lds + B3_QH; LAS unsigned char* KH = lds + B3_KH; LAS unsigned char* VT = lds + B3_VT; LAS unsigned char* PP = lds + B3_P;
    LAS float* segtot = (LAS float*)(lds + B3_SEG); LAS float* rs = (LAS float*)(lds + B3_RS);
    float nb[16]; unsigned short nq[16], nk[16], nv[16];
#define B3_LOAD(u_) do { const int c_ = (u_) >> 5, h_ = (u_) & 31; const int rw_ = c_ * CH + 16 * sg; \
        _Pragma("unroll") for (int j = 0; j < 16; ++j) { nb[j] = Gg[(size_t)(rw_ + j) * DM + h_ * DH + col]; const bf16* p_ = PROJ + (size_t)(rw_ + j) * 16384 + h_ * DH + col; nq[j] = p_[0]; nk[j] = p_[4096]; nv[j] = p_[8192]; } } while (0)
    if (vcu < NCH * NH) B3_LOAD(vcu);
    for (int u = vcu; u < NCH * NH; u += G) {
        const int c = u >> 5, h = u & 31;
        float b[16]; unsigned short qq[16], kk[16], vv[16];
#pragma unroll
        for (int j = 0; j < 16; ++j) { b[j] = nb[j]; qq[j] = nq[j]; kk[j] = nk[j]; vv[j] = nv[j]; }
#pragma unroll
        for (int j = 1; j < 16; ++j) b[j] += b[j - 1];
        segtot[sg * 128 + col] = b[15];
        __syncthreads();
        float st[4];
#pragma unroll
        for (int s2 = 0; s2 < 4; ++s2) st[s2] = segtot[s2 * 128 + col];
        float off = 0.f;
#pragma unroll
        for (int s2 = 0; s2 < 4; ++s2) if (s2 < sg) off += st[s2];
#pragma unroll
        for (int j = 0; j < 16; ++j) { const float qf = bf2f(qq[j]);
            *(LAS bf16*)(QT + (16 * sg + j) * PQ + 2 * col) = f2bf(qf * fexp(off + b[j]));
            *(LAS bf16*)(QH + (16 * sg + j) * PQ + 2 * col) = f2bf(qf * fexp(b[j])); }
        { float d = 0.f;
#pragma unroll
          for (int I = 0; I < 4; ++I) { if (I >= sg) {
#pragma unroll
                for (int j = 0; j < 16; ++j) *(LAS bf16*)(KH + (kh_base(I) + 16 * sg + j) * PQ + 2 * col) = f2bf(bf2f(kk[j]) * fexp(d - b[j]));
                d += st[I]; } } }
        { unsigned vw[8];
#pragma unroll
          for (int j = 0; j < 8; ++j) vw[j] = (unsigned)vv[2 * j] | ((unsigned)vv[2 * j + 1] << 16);
          *(LAS v4u*)(VT + col * PK + 32 * sg) = (v4u){vw[0], vw[1], vw[2], vw[3]}; *(LAS v4u*)(VT + col * PK + 32 * sg + 16) = (v4u){vw[4], vw[5], vw[6], vw[7]}; }
        if (u + G < NCH * NH) B3_LOAD(u + G);
        __syncthreads();
#pragma unroll
        for (int tt = 0; tt < 2; ++tt) { const int tile = wave * 2 + tt, I = tile >> 2, J = tile & 3;
            f32x4 acc = {0.f, 0.f, 0.f, 0.f};
            if (J <= I) {
#pragma unroll
                for (int ks = 0; ks < 4; ++ks) acc = mma(ldsfrag(KH, kh_base(I) + 16 * J + r, PQ, 64 * ks + 16 * q), ldsfrag(QH, 16 * I + r, PQ, 64 * ks + 16 * q), acc);
                if (J == I) {
#pragma unroll
                    for (int i = 0; i < 4; ++i) if (4 * q + i > r) acc[i] = 0.f; }
            }
            v2u w; w.x = cvtpk(acc[0], acc[1]); w.y = cvtpk(acc[2], acc[3]);
            *(LAS v2u*)(PP + (16 * I + r) * PK + (16 * J + 4 * q) * 2) = w; }
        __syncthreads();
        const int mt = wave & 3, nh = wave >> 2;
        f32x4 acc[4];
        const bf16x8 pa0 = ldsfrag(PP, 16 * mt + r, PK, 16 * q), pa1 = ldsfrag(PP, 16 * mt + r, PK, 64 + 16 * q);
        bf16x8 qa[4];
#pragma unroll
        for (int ks = 0; ks < 4; ++ks) qa[ks] = ldsfrag(QT, 16 * mt + r, PQ, 64 * ks + 16 * q);
        const bf16* stp = ST + ((size_t)u * 128 + 64 * nh + r) * 128 + 8 * q;
#pragma unroll
        for (int nt = 0; nt < 4; ++nt) { f32x4 a = {0.f, 0.f, 0.f, 0.f};
            a = mma(ldsfrag(VT, 64 * nh + 16 * nt + r, PK, 16 * q), pa0, a); a = mma(ldsfrag(VT, 64 * nh + 16 * nt + r, PK, 64 + 16 * q), pa1, a);
#pragma unroll
            for (int ks = 0; ks < 4; ++ks) a = mma(*(const bf16x8*)(stp + (size_t)(16 * nt) * 128 + 32 * ks), qa[ks], a);
            acc[nt] = a; }
        float ss = 0.f;
#pragma unroll
        for (int nt = 0; nt < 4; ++nt) ss += (acc[nt][0] * acc[nt][0] + acc[nt][1] * acc[nt][1]) + (acc[nt][2] * acc[nt][2] + acc[nt][3] * acc[nt][3]);
        ss += shx(ss, 16, lane); ss += shx(ss, 32, lane);
        if (q == 0) rs[nh * 64 + 16 * mt + r] = ss;
        __syncthreads();
        const float rstd = rsqrtf((rs[16 * mt + r] + rs[64 + 16 * mt + r]) * (1.f / 128.f) + NORM_EPS);
        const size_t orow = (size_t)(c * CH + 16 * mt + r);
#pragma unroll
        for (int nt = 0; nt < 4; ++nt) { const int dv = 64 * nh + 16 * nt + 4 * q;
            const f32x4 g = *(const f32x4*)(ogain + dv); const v2u gt = *(const v2u*)(PROJ + orow * 16384 + 12288 + h * DH + dv);
            v2u w; w.x = cvtpk(acc[nt][0] * rstd * g.x * bflo(gt.x), acc[nt][1] * rstd * g.y * bfhi(gt.x)); w.y = cvtpk(acc[nt][2] * rstd * g.z * bflo(gt.y), acc[nt][3] * rstd * g.w * bfhi(gt.y));
            *(v2u*)(MO + orow * DM + h * DH + dv) = w; }
        __syncthreads();
    }
#undef B3_LOAD
}
}
constexpr int RING_BYTES = 131072;
constexpr int MISC_OFF = RING_BYTES + 320;
constexpr int LDS_BYTES = 147456;
constexpr int CW_BAR = 4096;
constexpr int CW_Q = 8192;
static_assert(fa::LDS_BYTES + 16 <= RING_BYTES && hg::B3_END <= RING_BYTES, "phase scratch fits the ring region");
static_assert(WS_END <= (size_t)4096 * MiB, "workspace map");

constexpr int PH_FINAL = 49, PH_END = 50;
struct Args { const float* in[15]; float* out; unsigned char* ws; int ph_lo, ph_hi; };
static_assert(sizeof(Args) == 15 * 8 + 8 + 8 + 4 + 4, "Args has no padding bytes");

__global__ void __launch_bounds__(NWAVES * 64, 2) trunk_fwd(Args args) {
    extern __shared__ __attribute__((aligned(16))) unsigned char lds_raw[];
    LAS unsigned char* lds = (LAS unsigned char*)lds_raw;
    volatile LAS unsigned* MISC = (volatile LAS unsigned*)(lds + MISC_OFF);
    const int tid = threadIdx.x;
    const int G = gridDim.x, bx = blockIdx.x;
    const int vcu = (G % 8 == 0) ? (bx % 8) * (G / 8) + bx / 8 : bx;
    for (int u = tid; u < (LDS_BYTES - RING_BYTES) / 4; u += NWAVES * 64) ((LAS unsigned*)(lds + RING_BYTES))[u] = 0u;
    __syncthreads();
    if ((tid & 63) == 0) ((volatile LAS int*)(lds + WAVE_TAB_OFF))[hw_wave_slot()] = tid >> 6;
    __syncthreads();
    const int lo = args.ph_lo, hi = args.ph_hi;
#if MK_PER_PHASE
#define GRID_BAR(p) do { } while (0)
#else
    XcdBarrier bar = xcd_barrier_post((unsigned*)(args.ws + WS_CTL) + CW_BAR, MISC + 8);
#define GRID_BAR(p) do { if ((p) + 1 < hi) { XcdBarrier b_ = bar; asm volatile("" : "+s"(b_.bar), "+s"(b_.x)); xcd_barrier(b_); } } while (0)
#endif
#ifndef ONLY_SITE
#define ONLY_SITE -1
#endif
#define EN(s) (ONLY_SITE == -1 || ONLY_SITE == (s))
#ifndef DUP_SITE
#define DUP_SITE -1
#endif
#define DUP(s) (DUP_SITE == (s))
#define IN(k) (lo <= (k) && (k) < hi)
#define OPQ(v) ({ int o_ = (v); asm volatile("" : "+s"(o_)); o_; })
#define WSP() ({ unsigned char* w_ = args.ws; asm volatile("" : "+s"(w_)); w_; })
#define INP(i) ({ const float* p_ = args.in[i]; asm volatile("" : "+s"(p_)); p_; })
    LAS float* RTAB = (LAS float*)(lds + RING_BYTES + 1024);
#define P_H ((float*)(WSP() + WS_H))
#define P_XN ((bf16*)(WSP() + WS_XN))
#define P_MO ((bf16*)(WSP() + WS_MO))
#define P_PROJ ((bf16*)(WSP() + WS_PROJ))
#define P_G ((float*)(WSP() + WS_G))
#define P_UT ((bf16*)(WSP() + WS_UT))
#define P_ST ((bf16*)(WSP() + WS_ST))
#define P_LOGF ((float*)(WSP() + WS_LOGF))
#define P_KB ((float*)(WSP() + WS_KB))
#define P_DEC ((float*)(WSP() + WS_DEC))
#define P_LB ((const float*)(WSP() + WS_LB))
#define P_JL ((int*)(WSP() + WS_LB + 512 * 1024))
#define P_CS ((float*)(WSP() + WS_LB + 768 * 1024))
#define P_PART ((float*)(WSP() + WS_PART))

    if (EN(0) && IN(0)) {
        ProArgs pa{INP(1), INP(2), INP(6), INP(7), INP(12), INP(13), INP(9)};
        prologue_phase(lds, WSP(), pa, OPQ(vcu), OPQ(G));
        GRID_BAR(0);
        if (DUP(0)) { prologue_phase(lds, WSP(), pa, OPQ(vcu), OPQ(G)); GRID_BAR(0); }
    }
    for (int L = 0; L < DEPTH; ++L) {
        const int pb = 1 + 12 * L, j = L >> 1; const bool fox = (L & 1) == 0;
        if (EN(1) && L == 0 && IN(pb + 0)) { rms0_phase(INP(0), INP(10), P_XN, P_PART, OPQ(vcu), OPQ(G)); GRID_BAR(pb + 0); }
        if (fox) {
            if (EN(2) && IN(pb + 1)) {
                unsigned char* w = WSP();
                pg8::Gemm g{(const bf16*)(w + WS_XN), (const bf16*)(w + WS_WFIN) + (size_t)j * FOX_INP * DM, SEQ, FOX_INP, DM}; pg8::StaticOrder S; S.init(SEQ, FOX_INP, OPQ(G), OPQ(bx));
                pg8::Unit u0; S.next(0, u0); rstd_table(RTAB, (const float*)(w + WS_PART), u0.pm);
                pg8::EpiFox E{(bf16*)(w + WS_PROJ), 16384, (float*)(w + WS_LOGF), INP(5) + j * NH, (float*)(w + WS_LB + 768 * 1024), pg8::RowScale{RTAB, u0.pm, (const float*)(w + WS_PART)}, INP(3) + j * DH, INP(4) + j * DH, (LAS float*)(lds + RING_BYTES + 4096), QSCALE};
                pg8::gemm_phase<pg8::EpiFox, pg8::StaticOrder, true, true>(lds, g, S, E);
                GRID_BAR(pb + 1);
                if (DUP(2)) { pg8::gemm_phase<pg8::EpiFox, pg8::StaticOrder, true, true>(lds, g, S, E); GRID_BAR(pb + 1); }
            }
            if (EN(3) && IN(pb + 2)) { fox_thin_phase(lds, P_LOGF, P_CS, P_KB, OPQ(vcu), OPQ(G)); GRID_BAR(pb + 2); }
            if (EN(14) && IN(pb + 3)) { jl_phase(lds, P_KB, INP(3) + j * DH, INP(4) + j * DH, P_JL, OPQ(vcu), OPQ(G)); GRID_BAR(pb + 3); }
            if (EN(4) && IN(pb + 4)) { unsigned char* w = WSP(); fa::attn_phase((char*)lds_raw, (const bf16*)(w + WS_PROJ), (const float*)(w + WS_KB), (bf16*)(w + WS_MO), (const int*)(w + WS_LB + 512 * 1024), (unsigned*)(w + WS_CTL) + CW_Q + 64 * j); GRID_BAR(pb + 4);
                if (DUP(4)) { fa::attn_phase((char*)lds_raw, (const bf16*)(w + WS_PROJ), (const float*)(w + WS_KB), (bf16*)(w + WS_MO), (const int*)(w + WS_LB + 512 * 1024), (unsigned*)(w + WS_CTL) + CW_Q + 64 * (j + 2)); GRID_BAR(pb + 4); } }
        } else {
            if (EN(5) && IN(pb + 1)) {
                unsigned char* w = WSP();
                pg8::Gemm g{(const bf16*)(w + WS_XN), (const bf16*)(w + WS_WHIN) + (size_t)j * HG_IN * DM, SEQ, HG_IN, DM}; pg8::StaticOrder S; S.init(SEQ, HG_IN, OPQ(G), OPQ(bx));
                pg8::Unit u0; S.next(0, u0); rstd_table(RTAB, (const float*)(w + WS_PART), u0.pm);
                pg8::EpiHgrn E{(bf16*)(w + WS_PROJ), 16384, (float*)(w + WS_G), (const float*)(w + WS_LB) + (size_t)L * DM, pg8::RowScale{RTAB, u0.pm, (const float*)(w + WS_PART)}};
                pg8::gemm_phase<pg8::EpiHgrn, pg8::StaticOrder, true, true>(lds, g, S, E);
                GRID_BAR(pb + 1);
                if (DUP(2)) { pg8::gemm_phase<pg8::EpiHgrn, pg8::StaticOrder, true, true>(lds, g, S, E); GRID_BAR(pb + 1); }
            }
            if (EN(6) && IN(pb + 2)) { hg::b1_phase(lds, P_PROJ, P_G, P_UT, P_DEC, OPQ(vcu), OPQ(G)); GRID_BAR(pb + 2); }
            if (EN(7) && IN(pb + 3)) { hg::b2_phase(P_UT, P_DEC, P_ST, OPQ(vcu), OPQ(G)); GRID_BAR(pb + 3); }
            if (EN(8) && IN(pb + 4)) { hg::b3_phase(lds, P_PROJ, P_G, P_ST, INP(8) + j * DH, P_MO, OPQ(vcu), OPQ(G)); GRID_BAR(pb + 4); }
            if (DUP(6)) { hg::b1_phase(lds, P_PROJ, P_G, P_UT, P_DEC, OPQ(vcu), OPQ(G)); GRID_BAR(pb + 2); hg::b2_phase(P_UT, P_DEC, P_ST, OPQ(vcu), OPQ(G)); GRID_BAR(pb + 3); hg::b3_phase(lds, P_PROJ, P_G, P_ST, INP(8) + j * DH, P_MO, OPQ(vcu), OPQ(G)); GRID_BAR(pb + 4); }
        }
        if (EN(9) && IN(pb + 5)) {
            unsigned char* w = WSP();
            const bf16* W = fox ? (const bf16*)(w + WS_WFOUT) + (size_t)j * DM * DM : (const bf16*)(w + WS_WHOUT) + (size_t)j * DM * DM;
            pg8::Gemm g{(const bf16*)(w + WS_MO), W, SEQ, DM, DM}; pg8::StaticOrder S; S.init(SEQ, DM, OPQ(G), OPQ(bx));
            pg8::EpiRes E{L == 0 ? INP(0) : (const float*)(w + WS_H), (float*)(w + WS_H), DM, (bf16*)(w + WS_XN), INP(11) + (size_t)L * DM, (float*)(w + WS_PART)};
            pg8::gemm_phase<pg8::EpiRes, pg8::StaticOrder, true, true>(lds, g, S, E);
            GRID_BAR(pb + 5);
        }
        if (EN(11) && IN(pb + 7)) {
            unsigned char* w = WSP();
            pg8::Gemm g{(const bf16*)(w + WS_XN), (const bf16*)(w + WS_WUP) + (size_t)L * DFF * DM, SEQ, DFF, DM}; pg8::StaticOrder S; S.init(SEQ, DFF, OPQ(G), OPQ(bx));
            pg8::Unit u0; S.next(0, u0); rstd_table(RTAB, (const float*)(w + WS_PART), u0.pm);
            pg8::EpiSqRelu E{(bf16*)(w + WS_PROJ), DFF, pg8::RowScale{RTAB, u0.pm, (const float*)(w + WS_PART)}};
            pg8::gemm_phase<pg8::EpiSqRelu, pg8::StaticOrder, true, true>(lds, g, S, E);
            GRID_BAR(pb + 7);
            if (DUP(11)) { pg8::gemm_phase<pg8::EpiSqRelu, pg8::StaticOrder, true, true>(lds, g, S, E); GRID_BAR(pb + 7); }
        }
        if (EN(12) && IN(pb + 8)) {
            unsigned char* w = WSP();
            pg8::Gemm g{(const bf16*)(w + WS_PROJ), (const bf16*)(w + WS_WDN) + (size_t)L * DM * DFF, SEQ, DM, DFF}; pg8::StaticOrder S; S.init(SEQ, DM, OPQ(G), OPQ(bx));
            pg8::EpiRes E{(const float*)(w + WS_H), (float*)(w + WS_H), DM, L + 1 < DEPTH ? (bf16*)(w + WS_XN) : nullptr, INP(10) + (size_t)(L + 1 < DEPTH ? L + 1 : 0) * DM, (float*)(w + WS_PART)};
            pg8::gemm_phase<pg8::EpiRes, pg8::StaticOrder, true, true>(lds, g, S, E);
            GRID_BAR(pb + 8);
        }
    }
    if (EN(13) && IN(PH_FINAL)) rms_phase<true>(P_H, INP(14), args.out, OPQ(vcu), OPQ(G));
#undef IN
#undef GRID_BAR
}

extern "C" void kernel_launch(void* const* d_in, const int* in_sizes, int n_in, void* d_out, int out_size, void* d_ws, size_t ws_size, hipStream_t stream) {
    static int grid = 0;
    if (grid == 0) {
        if (n_in != 15 || in_sizes[0] != SEQ * DM || out_size != SEQ * DM || ws_size < WS_END) { fprintf(stderr, "kernel_launch: unexpected shapes (n_in %d, in0 %d, out %d, ws %zu < %zu)\n", n_in, n_in > 0 ? in_sizes[0] : -1, out_size, ws_size, (size_t)WS_END); grid = -1; return; }
        int dev = 0, cus = 0, per_cu = 0;
        if (hipGetDevice(&dev) != hipSuccess || hipDeviceGetAttribute(&cus, hipDeviceAttributeMultiprocessorCount, dev) != hipSuccess) { grid = -1; return; }
        if (hipFuncSetAttribute((const void*)trunk_fwd, hipFuncAttributeMaxDynamicSharedMemorySize, LDS_BYTES) != hipSuccess) { fprintf(stderr, "kernel_launch: hipFuncSetAttribute failed\n"); grid = -1; return; }
        if (hipOccupancyMaxActiveBlocksPerMultiprocessor(&per_cu, (const void*)trunk_fwd, NWAVES * 64, LDS_BYTES) != hipSuccess || per_cu < 1) fprintf(stderr, "kernel_launch: occupancy query says %d\n", per_cu);
        (void)hipGetLastError();
        grid = cus;
    }
    if (grid < 0) return;
    if (hipMemsetAsync((char*)d_ws + WS_CTL, 0, CTL_ZERO_BYTES, stream) != hipSuccess) return;
    Args a{};
    for (int i = 0; i < 15; ++i) a.in[i] = (const float*)d_in[i];
    a.out = (float*)d_out; a.ws = (unsigned char*)d_ws;
#if MK_PER_PHASE
    for (int p = 0; p < PH_END; ++p) {
        bool valid = (p == 0) || (p == PH_FINAL);
        if (p >= 1 && p < PH_FINAL) { const int L = (p - 1) / 12, k = (p - 1) % 12; const bool fox = (L & 1) == 0; valid = (k <= 8) && (k != 6) && (k != 0 || L == 0); }
        if (!valid) continue;
        a.ph_lo = p; a.ph_hi = p + 1;
        hipLaunchKernelGGL(trunk_fwd, dim3(grid), dim3(NWAVES * 64), LDS_BYTES, stream, a);
    }
#else
    a.ph_lo = 0; a.ph_hi = PH_END;
    hipLaunchKernelGGL(trunk_fwd, dim3(grid), dim3(NWAVES * 64), LDS_BYTES, stream, a);
#endif
}
```

```cpp
#define MK_PER_PHASE 0
#define DUP_SITE -1
#include <hip/hip_runtime.h>
#include <hip/hip_bf16.h>
#include <cstdio>
#include <cstdint>

#ifndef MK_PER_PHASE
#define MK_PER_PHASE 0
#endif

constexpr int SEQ = 16384, DM = 4096, DFF = 16384, NH = 32, DH = 128, DEPTH = 4;
constexpr int FOX_IN = 4 * DM + NH;
constexpr int FOX_INP = 65 * 256;
constexpr int HG_IN = 4 * DM;
constexpr float NORM_EPS = 1e-6f;
constexpr float LOG2E = 1.4426950408889634f;
constexpr float QSCALE = 0.08838834764831845f * LOG2E;

constexpr size_t MiB = 1u << 20;
constexpr size_t WS_CTL = 0, CTL_ZERO_BYTES = 1 * MiB;
constexpr size_t WS_WFIN = 1 * MiB;
constexpr size_t WS_WFOUT = WS_WFIN + 260 * MiB;
constexpr size_t WS_WHIN = WS_WFOUT + 64 * MiB;
constexpr size_t WS_WHOUT = WS_WHIN + 256 * MiB;
constexpr size_t WS_WUP = WS_WHOUT + 64 * MiB;
constexpr size_t WS_WDN = WS_WUP + 512 * MiB;
constexpr size_t WS_H = WS_WDN + 512 * MiB;
constexpr size_t WS_XN = WS_H + 256 * MiB;
constexpr size_t WS_MO = WS_XN + 128 * MiB;
constexpr size_t WS_PROJ = WS_MO + 128 * MiB;
constexpr size_t WS_G = WS_PROJ + 512 * MiB;
constexpr size_t WS_UT = WS_G + 256 * MiB;
constexpr size_t WS_ST = WS_UT + 512 * MiB;
constexpr size_t WS_LOGF = WS_ST + 256 * MiB;
constexpr size_t WS_KB = WS_LOGF + 2 * MiB;
constexpr size_t WS_DEC = WS_KB + 2 * MiB;
constexpr size_t WS_LB = WS_DEC + 4 * MiB;
constexpr size_t WS_PART = WS_LB + 1 * MiB;
constexpr size_t WS_END = WS_PART + 4 * MiB;

#define GAS __attribute__((address_space(1)))
#define LAS __attribute__((address_space(3)))
typedef unsigned short bf16;
typedef unsigned v4u __attribute__((ext_vector_type(4)));
typedef unsigned v2u __attribute__((ext_vector_type(2)));
typedef float f32x4 __attribute__((ext_vector_type(4)));
typedef float f32x16 __attribute__((ext_vector_type(16)));
typedef short bf16x8 __attribute__((ext_vector_type(8)));
typedef short s16x4 __attribute__((ext_vector_type(4)));
#define LDS_WAIT() asm volatile("s_waitcnt lgkmcnt(0)" ::: "memory")
#define VM_WAIT() asm volatile("s_waitcnt vmcnt(0)" ::: "memory")
typedef float f32x2_t __attribute__((ext_vector_type(2)));
typedef __bf16 bf16x2_t __attribute__((ext_vector_type(2)));
__device__ __forceinline__ unsigned cvtpk(float lo, float hi) { const f32x2_t v = {lo, hi}; return __builtin_bit_cast(unsigned, __builtin_convertvector(v, bf16x2_t)); }
__device__ __forceinline__ float bflo(unsigned w) { return __uint_as_float(w << 16); }
__device__ __forceinline__ float bfhi(unsigned w) { return __uint_as_float(w & 0xffff0000u); }
__device__ __forceinline__ float bf2f(bf16 b) { return __uint_as_float(((unsigned)b) << 16); }
__device__ __forceinline__ bf16 f2bf(float f) { return (bf16)(cvtpk(f, 0.f) & 0xffffu); }
__device__ __forceinline__ float fexp(float x) { return __builtin_amdgcn_exp2f(x * LOG2E); }
__device__ __forceinline__ float sigmoidf_(float x) { return __builtin_amdgcn_rcpf(1.f + fexp(-x)); }
constexpr int WAVE_TAB_OFF = 131072 + 2048;
__device__ __forceinline__ unsigned hw_wave_slot() { return (unsigned)__builtin_amdgcn_s_getreg((5 << 11) | 4) & 63u; }
__device__ __forceinline__ int opaque_tid() {
    extern __shared__ __attribute__((aligned(16))) unsigned char dyn_lds_[];
    int l; asm volatile("v_mbcnt_lo_u32_b32 %0, -1, 0\n\tv_mbcnt_hi_u32_b32 %0, -1, %0" : "=v"(l));
    const int w = __builtin_amdgcn_readfirstlane(((const volatile LAS int*)((LAS unsigned char*)dyn_lds_ + WAVE_TAB_OFF))[hw_wave_slot()]);
    return (w << 6) | l;
}
__device__ __forceinline__ float shx(float v, int o, int lane) { return __int_as_float(__builtin_amdgcn_ds_bpermute((lane ^ o) << 2, __float_as_int(v))); }
__host__ __device__ __forceinline__ int img_byte(int r, int c) { const int st = (r >> 4) * 2 + (c >> 5), rr = r & 15, cc = c & 31, ob = rr * 64 + cc * 2; return st * 1024 + (ob ^ (((ob >> 9) & 1) << 5)); }
__host__ __device__ __forceinline__ size_t tiled_off(size_t row, int col, int nkt) { const int rl = (int)(row & 255);
    return (((row >> 8) * (size_t)nkt + (size_t)(col >> 6)) << 14) + (size_t)((rl >> 7) * 8192 + (img_byte(rl & 127, col & 63) >> 1)); }
__host__ __device__ __forceinline__ size_t tiled_off_w(size_t n, int k, int nkt) { const int w = (int)(n & 31), rho = 16 * ((w >> 2) & 1) + 4 * (w >> 3) + (w & 3);
    return tiled_off((n & ~(size_t)31) + (size_t)rho, k, nkt); }
namespace pg8 {
#define PG8_LAS __attribute__((address_space(3)))
typedef unsigned short bf16_t;
typedef short bf16x8 __attribute__((ext_vector_type(8)));
typedef float f32x4 __attribute__((ext_vector_type(4)));
typedef unsigned u32x4 __attribute__((ext_vector_type(4)));
constexpr int BM = 256, BK = 64, HALF = 128, HTB = HALF * BK * 2  , STAGE_BYTES = 8 * HTB, NXCD = 8, WGM = 8;

__host__ __device__ __forceinline__ int lds_byte(int r, int c) { const int st = (r >> 4) * 2 + (c >> 5), rr = r & 15, cc = c & 31, ob = rr * 64 + cc * 2; return st * 1024 + (ob ^ (((ob >> 9) & 1) << 5)); }
__host__ __device__ __forceinline__ void stage_rc(int b, int& R, int& C) { const int st = b / 1024, sb = b % 1024, swz = sb ^ (((sb >> 9) & 1) << 5); R = (st >> 1) * 16 + swz / 64; C = (st & 1) * 32 + (swz % 64) / 2; }
__host__ __device__ __forceinline__ int perm32(int rho) { const int n = rho >> 4, i = rho & 15; return 8 * (i >> 2) + 4 * n + (i & 3); }

struct Unit { int pm, pn; };
struct Gemm { const bf16_t* A; const bf16_t* Bt; int M, N, K; };

struct StaticOrder {
    int nM, nN, nwg, G, c, wgm;
    __host__ __device__ __forceinline__ void init(int M, int N, int G_, int c_, int wgm_ = WGM) { nM = M / BM; nN = N / BM; nwg = nM * nN; G = G_; c = c_; wgm = wgm_; }
    __host__ __device__ __forceinline__ bool next(int i, Unit& u) const {
        const long L = (long)i * G + c; if (L >= nwg) return false;
        int wgid = (int)L; { const int q = nwg / NXCD, r = nwg % NXCD, xcd = wgid % NXCD, off = wgid / NXCD; wgid = (xcd < r ? xcd * (q + 1) : r * (q + 1) + (xcd - r) * q) + off; }
        const int nig = wgm * nN, gid = wgid / nig, fm = gid * wgm, gsz = (nM - fm) < wgm ? (nM - fm) : wgm;
        u.pm = fm + ((wgid % nig) % gsz); u.pn = (wgid % nig) / gsz; return true;
    }
    __device__ __forceinline__ void a_ready(const Unit&) const {}
    __device__ __forceinline__ void done(const Unit&) const {}
};
#ifndef EPI_NT
#define EPI_NT 0
#endif
#if EPI_NT
#define STORE_NT(p, v) __builtin_nontemporal_store((v), (p))
#else
#define STORE_NT(p, v) (*(p) = (v))
#endif
__device__ __forceinline__ unsigned cvt_pk_bf16(float lo, float hi) { return ::cvtpk(lo, hi); }
__device__ __forceinline__ float lsig(float z) { return fminf(z, 0.f) - 0.6931471805599453f * __builtin_amdgcn_logf(1.f + __builtin_amdgcn_exp2f(-1.4426950408889634f * fabsf(z))); }
__device__ __forceinline__ float sigm(float x) { return __builtin_amdgcn_rcpf(1.f + __builtin_amdgcn_exp2f(-1.4426950408889634f * x)); }

struct RowScale {
    const PG8_LAS float* tab; int pm0; const float* part;
    __device__ __forceinline__ float get(const Unit& u, int rowin) const {
        if (u.pm == pm0) return tab[rowin];
        int ri = rowin; asm volatile("" : "+v"(ri));
        const f32x4* p = (const f32x4*)(part + (size_t)(u.pm * BM + ri) * 64); f32x4 a = {0.f, 0.f, 0.f, 0.f};
#pragma unroll 1
        for (int i = 0; i < 16; ++i) a += p[i];
        return rsqrtf(((a.x + a.y) + (a.z + a.w)) * (1.f / 4096.f) + 1e-6f);
    }
};
struct EpiRes {
    static constexpr bool PERM = true, AFTER_DRAIN = false;
    const float* base; float* out; int ldc; bf16_t* xn; const float* gain; float* part;
    __device__ __forceinline__ void operator()(const f32x4 (&acc)[2][2][4][2], const Unit& u, int wr, int wc, int fr_, int fq_) const {
        int fr = fr_, fq = fq_; asm volatile("" : "+v"(fr), "+v"(fq));
        const int row0 = u.pm * BM + wr * 64 + fr, col0 = u.pn * BM + wc * 32 + 8 * fq, lane = fq * 16 + fr;
        f32x4 g0[2], g1[2];
        if (xn) {
#pragma unroll
            for (int bj = 0; bj < 2; ++bj) { g0[bj] = *(const f32x4*)(gain + col0 + bj * HALF); g1[bj] = *(const f32x4*)(gain + col0 + bj * HALF + 4); } }
#pragma unroll
        for (int ai = 0; ai < 2; ++ai) {
            f32x4 b0[4][2], b1[4][2];
#pragma unroll
            for (int m = 0; m < 4; ++m) { const size_t off = (size_t)(row0 + ai * HALF + m * 16) * ldc + col0;
#pragma unroll
                for (int bj = 0; bj < 2; ++bj) { b0[m][bj] = *(const f32x4*)(base + off + bj * HALF); b1[m][bj] = *(const f32x4*)(base + off + bj * HALF + 4); } }
#pragma unroll
            for (int m = 0; m < 4; ++m) { const size_t row = (size_t)(row0 + ai * HALF + m * 16); const size_t off = row * ldc + col0;
                float ss = 0.f;
#pragma unroll
                for (int bj = 0; bj < 2; ++bj) { const f32x4 h0 = b0[m][bj] + acc[ai][bj][m][0], h1 = b1[m][bj] + acc[ai][bj][m][1];
                    STORE_NT((f32x4*)(out + off + bj * HALF), h0); STORE_NT((f32x4*)(out + off + bj * HALF + 4), h1);
                    if (xn) { ss += ((h0[0] * h0[0] + h0[1] * h0[1]) + (h0[2] * h0[2] + h0[3] * h0[3])) + ((h1[0] * h1[0] + h1[1] * h1[1]) + (h1[2] * h1[2] + h1[3] * h1[3]));
                        const f32x4 x0 = h0 * g0[bj], x1 = h1 * g1[bj];
                        u32x4 w; w.x = cvt_pk_bf16(x0[0], x0[1]); w.y = cvt_pk_bf16(x0[2], x0[3]); w.z = cvt_pk_bf16(x1[0], x1[1]); w.w = cvt_pk_bf16(x1[2], x1[3]);
                        STORE_NT((u32x4*)(xn + ::tiled_off(row, col0 + bj * HALF, ldc >> 6)), w); } }
                if (xn) { ss += ::shx(ss, 16, lane); ss += ::shx(ss, 32, lane); if (fq == 0) part[row * 64 + u.pn * 4 + wc] = ss; } }
            asm volatile("" ::: "memory"); }
    }
};
struct EpiSqRelu {
    static constexpr bool PERM = true, AFTER_DRAIN = false;
    bf16_t* O; int ldc; RowScale rsc;
    __device__ __forceinline__ void operator()(const f32x4 (&acc)[2][2][4][2], const Unit& u, int wr, int wc, int fr_, int fq_) const {
        int fr = fr_, fq = fq_; asm volatile("" : "+v"(fr), "+v"(fq));
        const int row0 = u.pm * BM + wr * 64 + fr, col0 = u.pn * BM + wc * 32 + 8 * fq;
#pragma unroll
        for (int ai = 0; ai < 2; ++ai)
#pragma unroll
            for (int m = 0; m < 4; ++m) { bf16_t* rowp = O + ::tiled_off((size_t)(row0 + ai * HALF + m * 16), col0, ldc >> 6); const float rs = rsc.get(u, wr * 64 + fr + ai * HALF + m * 16);
#pragma unroll
                for (int bj = 0; bj < 2; ++bj) { f32x4 v0 = acc[ai][bj][m][0] * rs, v1 = acc[ai][bj][m][1] * rs;
#pragma unroll
                    for (int j = 0; j < 4; ++j) { const float a = fmaxf(v0[j], 0.f), b = fmaxf(v1[j], 0.f); v0[j] = a * a; v1[j] = b * b; }
                    u32x4 w; w.x = cvt_pk_bf16(v0[0], v0[1]); w.y = cvt_pk_bf16(v0[2], v0[3]); w.z = cvt_pk_bf16(v1[0], v1[1]); w.w = cvt_pk_bf16(v1[2], v1[3]);
                    STORE_NT((u32x4*)(rowp + (size_t)bj * (2 * 16384)), w); } }
    }
};
struct EpiFox {
    static constexpr bool PERM = true, AFTER_DRAIN = false;
    bf16_t* P; int ldc; float* logf; const float* fbias; float* cs; RowScale rsc; const float* qg; const float* kg; PG8_LAS float* qkt; float QS;
    __device__ __forceinline__ void operator()(const f32x4 (&acc)[2][2][4][2], const Unit& u, int wr, int wc, int fr_, int fq_) const {
        int fr = fr_, fq = fq_; asm volatile("" : "+v"(fr), "+v"(fq));
        const int row0 = u.pm * BM + wr * 64 + fr;
        if (u.pn < 32) {
            const int col0 = u.pn * BM + wc * 32 + 8 * fq, lane = fq * 16 + fr; const bool isq = u.pn < 16;
            const float* gs = (isq ? qg : kg) + wc * 32 + 8 * fq; const float sc = isq ? QS : 1.f;
            const f32x4 g0 = *(const f32x4*)gs * sc, g1 = *(const f32x4*)(gs + 4) * sc;
#pragma unroll
            for (int ai = 0; ai < 2; ++ai)
#pragma unroll
                for (int m = 0; m < 4; ++m) { const int rowin = ai * 64 + m * 16 + fr; const float rs = rsc.get(u, wr * 64 + fr + ai * HALF + m * 16);
#pragma unroll
                    for (int bj = 0; bj < 2; ++bj) { const f32x4 v0 = acc[ai][bj][m][0] * rs, v1 = acc[ai][bj][m][1] * rs;
                        float ss = ((v0[0] * v0[0] + v0[1] * v0[1]) + (v0[2] * v0[2] + v0[3] * v0[3])) + ((v1[0] * v1[0] + v1[1] * v1[1]) + (v1[2] * v1[2] + v1[3] * v1[3]));
                        ss += ::shx(ss, 16, lane); ss += ::shx(ss, 32, lane);
                        if (fq == 0) qkt[(((wr * 128 + rowin) * 2 + bj) << 2) + wc] = ss; } }
            asm volatile("s_waitcnt lgkmcnt(0)" ::: "memory"); __builtin_amdgcn_s_barrier(); asm volatile("" ::: "memory");
#pragma unroll
            for (int ai = 0; ai < 2; ++ai)
#pragma unroll
                for (int m = 0; m < 4; ++m) { const int rowin = ai * 64 + m * 16 + fr; const float rs = rsc.get(u, wr * 64 + fr + ai * HALF + m * 16);
                    bf16_t* rowp = P + (((size_t)(u.pn >> 4) * 32 + (u.pn & 15) * 2) * 16384 + (size_t)(row0 + ai * HALF + m * 16)) * 128 + wc * 32 + 8 * fq;
#pragma unroll
                    for (int bj = 0; bj < 2; ++bj) { const f32x4 t = *(const PG8_LAS f32x4*)(qkt + (((wr * 128 + rowin) * 2 + bj) << 2));
                        const float r2 = rs * rsqrtf(((t[0] + t[1]) + (t[2] + t[3])) * (1.f / 128.f) + 1e-6f);
                        const f32x4 v0 = acc[ai][bj][m][0] * r2 * g0, v1 = acc[ai][bj][m][1] * r2 * g1;
                        u32x4 w; w.x = cvt_pk_bf16(v0[0], v0[1]); w.y = cvt_pk_bf16(v0[2], v0[3]); w.z = cvt_pk_bf16(v1[0], v1[1]); w.w = cvt_pk_bf16(v1[2], v1[3]);
                        STORE_NT((u32x4*)(rowp + (size_t)bj * ((size_t)16384 * 128)), w); } }
        } else if (u.pn < 64) {
            const int col0 = u.pn * BM + wc * 32 + 8 * fq; const bool gate = u.pn >= 48;
#pragma unroll
            for (int ai = 0; ai < 2; ++ai)
#pragma unroll
                for (int m = 0; m < 4; ++m) { bf16_t* rowp = P + (((size_t)(u.pn >> 4) * 32 + (u.pn & 15) * 2) * 16384 + (size_t)(row0 + ai * HALF + m * 16)) * 128 + wc * 32 + 8 * fq; const float rs = rsc.get(u, wr * 64 + fr + ai * HALF + m * 16);
#pragma unroll
                    for (int bj = 0; bj < 2; ++bj) { f32x4 v0 = acc[ai][bj][m][0] * rs, v1 = acc[ai][bj][m][1] * rs;
                        if (gate) {
#pragma unroll
                            for (int j = 0; j < 4; ++j) { v0[j] = sigm(v0[j]); v1[j] = sigm(v1[j]); } }
                        u32x4 w; w.x = cvt_pk_bf16(v0[0], v0[1]); w.y = cvt_pk_bf16(v0[2], v0[3]); w.z = cvt_pk_bf16(v1[0], v1[1]); w.w = cvt_pk_bf16(v1[2], v1[3]);
                        STORE_NT((u32x4*)(rowp + (size_t)bj * ((size_t)16384 * 128)), w); } }
        } else if (wc == 0) {
            const f32x4 b0 = *(const f32x4*)(fbias + 8 * fq), b1 = *(const f32x4*)(fbias + 8 * fq + 4);
            const int lane = fq * 16 + fr;
#pragma unroll
            for (int ai = 0; ai < 2; ++ai) {
                f32x4 s0 = {0.f, 0.f, 0.f, 0.f}, s1 = {0.f, 0.f, 0.f, 0.f};
#pragma unroll
                for (int m = 0; m < 4; ++m) { float* rowp = logf + (size_t)(row0 + ai * HALF + m * 16) * 32 + 8 * fq; const float rs = rsc.get(u, wr * 64 + fr + ai * HALF + m * 16);
                    f32x4 v0 = acc[ai][0][m][0] * rs + b0, v1 = acc[ai][0][m][1] * rs + b1;
#pragma unroll
                    for (int j = 0; j < 4; ++j) { v0[j] = lsig(v0[j]); v1[j] = lsig(v1[j]); }
                    *(f32x4*)rowp = v0; *(f32x4*)(rowp + 4) = v1; s0 += v0; s1 += v1; }
#pragma unroll
                for (int j = 0; j < 4; ++j) {
#pragma unroll
                    for (int o = 1; o < 16; o <<= 1) { s0[j] += ::shx(s0[j], o, lane); s1[j] += ::shx(s1[j], o, lane); } }
                if (fr == 0) { float* cp = cs + (size_t)(u.pm * 4 + ai * 2 + wr) * 32 + 8 * fq; *(f32x4*)cp = s0; *(f32x4*)(cp + 4) = s1; }
                asm volatile("" ::: "memory"); }
        }
    }
};
struct EpiHgrn {
    static constexpr bool PERM = true, AFTER_DRAIN = false;
    bf16_t* P; int ldc; _Float16* G; const float* lb; RowScale rsc;
    __device__ __forceinline__ void operator()(const f32x4 (&acc)[2][2][4][2], const Unit& u, int wr, int wc, int fr_, int fq_) const {
        int fr = fr_, fq = fq_; asm volatile("" : "+v"(fr), "+v"(fq));
        constexpr size_t HSTR = (size_t)16384 * 128;
        const int row0 = u.pm * BM + wr * 64 + fr, col0 = u.pn * BM + wc * 32 + 8 * fq; const int kind = u.pn >> 4, hd0 = (u.pn & 15) * 2, dcol = wc * 32 + 8 * fq;
        if (kind == 1) {
            const int gc0 = col0 - 4096;
            f32x4 l0[2], l1[2];
#pragma unroll
            for (int bj = 0; bj < 2; ++bj) { l0[bj] = *(const f32x4*)(lb + gc0 + bj * HALF); l1[bj] = *(const f32x4*)(lb + gc0 + bj * HALF + 4); }
#pragma unroll
            for (int ai = 0; ai < 2; ++ai)
#pragma unroll
                for (int m = 0; m < 4; ++m) { const size_t r = (size_t)(row0 + ai * HALF + m * 16); bf16_t* rowp = P + (((size_t)1 * 32 + hd0) * 16384 + r) * 128 + dcol; _Float16* gp = G + ((size_t)hd0 * 16384 + r) * 128 + dcol; const float rs = rsc.get(u, wr * 64 + fr + ai * HALF + m * 16);
#pragma unroll
                    for (int bj = 0; bj < 2; ++bj) { f32x4 v0 = acc[ai][bj][m][0] * rs, v1 = acc[ai][bj][m][1] * rs, g0, g1;
#pragma unroll
                        for (int j = 0; j < 4; ++j) { const float f0 = l0[bj][j] + (1.f - l0[bj][j]) * sigm(v0[j]), f1 = l1[bj][j] + (1.f - l1[bj][j]) * sigm(v1[j]);
                            g0[j] = log2f(f0); g1[j] = log2f(f1); v0[j] = 1.f - f0; v1[j] = 1.f - f1; }
                        u32x4 w; w.x = cvt_pk_bf16(v0[0], v0[1]); w.y = cvt_pk_bf16(v0[2], v0[3]); w.z = cvt_pk_bf16(v1[0], v1[1]); w.w = cvt_pk_bf16(v1[2], v1[3]);
                        STORE_NT((u32x4*)(rowp + (size_t)bj * HSTR), w); { typedef _Float16 h2 __attribute__((ext_vector_type(2))); typedef float f2 __attribute__((ext_vector_type(2)));
                          u32x4 gw; gw.x = __builtin_bit_cast(unsigned, __builtin_convertvector((f2){g0[0], g0[1]}, h2)); gw.y = __builtin_bit_cast(unsigned, __builtin_convertvector((f2){g0[2], g0[3]}, h2));
                          gw.z = __builtin_bit_cast(unsigned, __builtin_convertvector((f2){g1[0], g1[1]}, h2)); gw.w = __builtin_bit_cast(unsigned, __builtin_convertvector((f2){g1[2], g1[3]}, h2));
                          STORE_NT((u32x4*)(gp + (size_t)bj * HSTR), gw); } } }
        } else {
            const bool act = kind != 2;
#pragma unroll
            for (int ai = 0; ai < 2; ++ai)
#pragma unroll
                for (int m = 0; m < 4; ++m) { bf16_t* rowp = P + (((size_t)kind * 32 + hd0) * 16384 + (size_t)(row0 + ai * HALF + m * 16)) * 128 + dcol; const float rs = rsc.get(u, wr * 64 + fr + ai * HALF + m * 16);
#pragma unroll
                    for (int bj = 0; bj < 2; ++bj) { f32x4 v0 = acc[ai][bj][m][0] * rs, v1 = acc[ai][bj][m][1] * rs;
                        if (act) {
#pragma unroll
                            for (int j = 0; j < 4; ++j) { v0[j] = v0[j] * sigm(v0[j]); v1[j] = v1[j] * sigm(v1[j]); } }
                        u32x4 w; w.x = cvt_pk_bf16(v0[0], v0[1]); w.y = cvt_pk_bf16(v0[2], v0[3]); w.z = cvt_pk_bf16(v1[0], v1[1]); w.w = cvt_pk_bf16(v1[2], v1[3]);
                        STORE_NT((u32x4*)(rowp + (size_t)bj * HSTR), w); } }
        }
    }
};
template <class Epi, class Sched, bool ALIGN_EPI = false, bool SP2 = false>
__device__ __forceinline__ void gemm_phase(PG8_LAS unsigned char* lds, const Gemm g, const Sched& S, const Epi& E) {
    const int tid = opaque_tid(), wid = __builtin_amdgcn_readfirstlane(tid >> 6), lane = tid & 63, wr = wid >> 2, wc = wid & 3, fr = lane & 15, fq = lane >> 4;
    const int K = g.K, nt = K / BK;
    unsigned voffA[2], voffB[2];
    static_assert(Epi::PERM, "the weights are stored with the PERM row order baked in");
#pragma unroll
    for (int i = 0; i < 2; ++i) { voffA[i] = (unsigned)(tid * 16 + i * 8192); voffB[i] = voffA[i]; }
    const size_t kstep = (size_t)BM * BK * 2, hstep = (size_t)HALF * BK * 2;
    const size_t tstep = (size_t)BM * K * 2;
    const size_t kstepB = kstep, hstepB = hstep;
    const unsigned ldsw = (unsigned)wid * 1024u;
    const int aoff = lds_byte(wr * 64 + fr, fq * 8), boff = lds_byte(wc * 32 + fr, fq * 8);
#define PG8_SA(b, h) (((b) * 2 + (h)) * HTB)
#define PG8_SB(b, h) ((4 + (b) * 2 + (h)) * HTB)
#define PG8_STAGE(bufoff, gbase, voff) do { _Pragma("unroll") for (int _i = 0; _i < 2; ++_i) \
        __builtin_amdgcn_global_load_lds((const unsigned*)((const char*)(gbase) + (voff)[_i]), (PG8_LAS unsigned*)(lds + (bufoff) + ldsw + _i * 8192), 16, 0, 0); } while (0)
#define PG8_LDA(dst, b, h) do { _Pragma("unroll") for (int m = 0; m < 4; ++m) _Pragma("unroll") for (int k = 0; k < 2; ++k) dst[m][k] = *(const PG8_LAS bf16x8*)(lds + PG8_SA(b, h) + aoff + m * 2048 + k * 1024); } while (0)
#define PG8_LDB(dst, b, h) do { _Pragma("unroll") for (int n = 0; n < 2; ++n) _Pragma("unroll") for (int k = 0; k < 2; ++k) dst[n][k] = *(const PG8_LAS bf16x8*)(lds + PG8_SB(b, h) + boff + n * 2048 + k * 1024); } while (0)
#ifndef PG8_PRIO
#define PG8_PRIO 1
#endif
#define PG8_MMA(ai, bj, At, Bt) do { if (PG8_PRIO) __builtin_amdgcn_s_setprio(1); _Pragma("unroll") for (int m = 0; m < 4; ++m) _Pragma("unroll") for (int n = 0; n < 2; ++n) _Pragma("unroll") for (int k = 0; k < 2; ++k) \
        acc[ai][bj][m][n] = __builtin_amdgcn_mfma_f32_16x16x32_bf16(Bt[n][k], At[m][k], acc[ai][bj][m][n], 0, 0, 0); if (PG8_PRIO) __builtin_amdgcn_s_setprio(0); } while (0)
#define PG8_WAIT_V(n) asm volatile("s_waitcnt vmcnt(" #n ")" ::: "memory")
#define PG8_WAIT_L(n) asm volatile("s_waitcnt lgkmcnt(" #n ")" ::: "memory")
#define PG8_BAR __builtin_amdgcn_s_barrier()
#define PG8_SCHED __builtin_amdgcn_sched_barrier(0)
    Unit cur, nxt; int ui = 0;
    if (!S.next(0, cur)) return;
    f32x4 acc[2][2][4][2];
#pragma unroll
    for (int a = 0; a < 2; ++a)
#pragma unroll
        for (int b = 0; b < 2; ++b)
#pragma unroll
            for (int m = 0; m < 4; ++m)
#pragma unroll
                for (int n = 0; n < 2; ++n) acc[a][b][m][n] = (f32x4){0.f, 0.f, 0.f, 0.f};
    bf16x8 At[4][2], B0[2][2], B1[2][2];
    const char* cA = (const char*)g.A + (size_t)cur.pm * tstep; const char* cB = (const char*)g.Bt + (size_t)cur.pn * tstep;
    S.a_ready(cur);
    if constexpr (SP2) {
        PG8_STAGE(PG8_SB(0, 0), cB, voffB); PG8_STAGE(PG8_SB(0, 1), cB + hstepB, voffB); PG8_STAGE(PG8_SA(0, 0), cA, voffA); PG8_STAGE(PG8_SA(0, 1), cA + hstep, voffA);
        if (wr == 1) PG8_BAR;
        PG8_WAIT_V(2); PG8_BAR;
        PG8_STAGE(PG8_SB(1, 0), cB + kstepB, voffB); PG8_STAGE(PG8_SA(1, 0), cA + kstep, voffA); PG8_STAGE(PG8_SB(1, 1), cB + hstepB + kstepB, voffB);
        PG8_WAIT_V(6); PG8_BAR;
    } else {
        PG8_STAGE(PG8_SB(0, 0), cB, voffB); PG8_STAGE(PG8_SA(0, 0), cA, voffA); PG8_STAGE(PG8_SB(0, 1), cB + hstepB, voffB); PG8_STAGE(PG8_SA(0, 1), cA + hstep, voffA);
        if (wr == 1) PG8_BAR;
        PG8_WAIT_V(4); PG8_BAR;
        PG8_STAGE(PG8_SB(1, 0), cB + kstepB, voffB); PG8_STAGE(PG8_SA(1, 0), cA + kstep, voffA); PG8_STAGE(PG8_SB(1, 1), cB + hstepB + kstepB, voffB);
        PG8_WAIT_V(6); PG8_BAR;
    }
    for (;;) {
        const bool has_next = S.next(ui + 1, nxt);
        const char* nA = has_next ? (const char*)g.A + (size_t)nxt.pm * tstep : cA; const char* nB = has_next ? (const char*)g.Bt + (size_t)nxt.pn * tstep : cB;
        for (int t = 0; t < nt; t += 2) {
            const bool last = (t == nt - 2);
            const char* a1 = cA + (size_t)(t + 1) * kstep;
            const char* a2 = last ? nA : cA + (size_t)(t + 2) * kstep; const char* b2 = last ? nB : cB + (size_t)(t + 2) * kstepB;
            const char* a3 = a2 + kstep; const char* b3 = b2 + kstepB;
            if (last && has_next) S.a_ready(nxt);
            if constexpr (SP2) {
            PG8_LDB(B0, 0, 0); PG8_LDB(B1, 0, 1); PG8_SCHED; PG8_LDA(At, 0, 0); PG8_STAGE(PG8_SA(1, 1), a1 + hstep, voffA);
            PG8_WAIT_V(8); PG8_WAIT_L(0); PG8_BAR; PG8_MMA(0, 0, At, B0); PG8_MMA(0, 1, At, B1); PG8_BAR; PG8_SCHED;
            PG8_LDA(At, 0, 1); PG8_STAGE(PG8_SB(0, 0), b2, voffB); PG8_STAGE(PG8_SB(0, 1), b2 + hstepB, voffB); PG8_STAGE(PG8_SA(0, 0), a2, voffA);
            PG8_WAIT_V(8); PG8_WAIT_L(0); PG8_BAR; PG8_MMA(1, 0, At, B0); PG8_MMA(1, 1, At, B1); PG8_BAR; PG8_SCHED;
            PG8_LDB(B0, 1, 0); PG8_LDB(B1, 1, 1); PG8_SCHED; PG8_LDA(At, 1, 0); PG8_STAGE(PG8_SA(0, 1), a2 + hstep, voffA);
            PG8_WAIT_V(8); PG8_WAIT_L(0); PG8_BAR; PG8_MMA(0, 0, At, B0); PG8_MMA(0, 1, At, B1); PG8_BAR; PG8_SCHED;
            PG8_LDA(At, 1, 1); PG8_STAGE(PG8_SB(1, 0), b3, voffB); PG8_STAGE(PG8_SB(1, 1), b3 + hstepB, voffB); PG8_STAGE(PG8_SA(1, 0), a3, voffA);
            PG8_WAIT_V(8); PG8_WAIT_L(0); PG8_BAR; PG8_MMA(1, 0, At, B0); PG8_MMA(1, 1, At, B1); PG8_BAR; PG8_SCHED;
            } else {
            PG8_LDB(B0, 0, 0); PG8_SCHED; PG8_LDA(At, 0, 0); PG8_STAGE(PG8_SA(1, 1), a1 + hstep, voffA);
            PG8_WAIT_L(8); PG8_BAR; PG8_WAIT_L(0); PG8_MMA(0, 0, At, B0); PG8_BAR; PG8_SCHED;
            PG8_LDB(B1, 0, 1); PG8_STAGE(PG8_SB(0, 0), b2, voffB);
            PG8_BAR; PG8_WAIT_L(0); PG8_MMA(0, 1, At, B1); PG8_BAR;
            PG8_LDA(At, 0, 1); PG8_STAGE(PG8_SA(0, 0), a2, voffA);
            PG8_BAR; PG8_WAIT_L(0); PG8_MMA(1, 0, At, B0); PG8_BAR; PG8_SCHED;
            PG8_STAGE(PG8_SB(0, 1), b2 + hstepB, voffB);
            PG8_WAIT_V(6); PG8_BAR; PG8_MMA(1, 1, At, B1); PG8_BAR;
            PG8_LDB(B0, 1, 0); PG8_SCHED; PG8_LDA(At, 1, 0); PG8_STAGE(PG8_SA(0, 1), a2 + hstep, voffA);
            PG8_WAIT_L(8); PG8_BAR; PG8_WAIT_L(0); PG8_MMA(0, 0, At, B0); PG8_BAR; PG8_SCHED;
            PG8_LDB(B1, 1, 1); PG8_STAGE(PG8_SB(1, 0), b3, voffB);
            PG8_BAR; PG8_WAIT_L(0); PG8_MMA(0, 1, At, B1); PG8_BAR;
            PG8_LDA(At, 1, 1); PG8_STAGE(PG8_SA(1, 0), a3, voffA);
            PG8_BAR; PG8_WAIT_L(0); PG8_MMA(1, 0, At, B0); PG8_BAR; PG8_SCHED;
            PG8_STAGE(PG8_SB(1, 1), b3 + hstepB, voffB);
            PG8_WAIT_V(6); PG8_BAR; PG8_MMA(1, 1, At, B1); PG8_BAR;
            }
        }
        if constexpr (ALIGN_EPI) { if (wr == 0) PG8_BAR; }
        if constexpr (!Epi::AFTER_DRAIN) { E(acc, cur, wr, wc, fr, fq); S.done(cur); }
        if (!has_next) break;
#pragma unroll
        for (int a = 0; a < 2; ++a)
#pragma unroll
            for (int b = 0; b < 2; ++b)
#pragma unroll
                for (int m = 0; m < 4; ++m)
#pragma unroll
                    for (int n = 0; n < 2; ++n) acc[a][b][m][n] = (f32x4){0.f, 0.f, 0.f, 0.f};
        cur = nxt; cA = nA; cB = nB; ++ui;
        if constexpr (ALIGN_EPI) { if (wr == 1) PG8_BAR; }
    }
    PG8_WAIT_V(0);
    if constexpr (!ALIGN_EPI) { if (wr == 0) PG8_BAR; }
    PG8_BAR;
    if constexpr (Epi::AFTER_DRAIN) { E.fused(acc, cur, wr, wc, fr, fq, lds, wid, lane); S.done(cur); }
#undef PG8_SA
#undef PG8_SB
#undef PG8_STAGE
#undef PG8_LDA
#undef PG8_LDB
#undef PG8_MMA
#undef PG8_WAIT_V
#undef PG8_WAIT_L
#undef PG8_BAR
#undef PG8_SCHED
}
}
#define XB_TMO      128
#define XB_XCNT(j)  (256  + 64 * (j))
#define XB_XSUB(j)  (1280 + 64 * (j))
#define XB_XGEN(j)  (2304 + 64 * (j))
#define XB_TOP      3328
#define XB_TOPGEN   3392
#define XCD_BAR_WORDS 3456
#define XB_SPIN_CAP (1u << 18)
#define LAS __attribute__((address_space(3)))

__device__ __forceinline__ unsigned xb_ld(unsigned* p)              { return __hip_atomic_load((__attribute__((address_space(1))) unsigned*)p, __ATOMIC_RELAXED, __HIP_MEMORY_SCOPE_AGENT); }
__device__ __forceinline__ unsigned xb_add(unsigned* p, unsigned v) { return __hip_atomic_fetch_add((__attribute__((address_space(1))) unsigned*)p, v, __ATOMIC_RELAXED, __HIP_MEMORY_SCOPE_AGENT); }
__device__ __forceinline__ unsigned xb_xcc_id() { return (unsigned)__builtin_amdgcn_s_getreg((3 << 11) | 20) & 0xFu; }
#define XB_SPIN(cond, bar) do { unsigned _sp = 0; while (cond) { __builtin_amdgcn_s_sleep(1); \
    if ((++_sp & 255u) == 0u) { if (xb_ld(&(bar)[XB_TMO])) break; if (_sp > XB_SPIN_CAP) { atomicAdd(&(bar)[XB_TMO], 1u); break; } } } } while (0)

struct XcdBarrier {
    unsigned* bar; unsigned x;
    volatile LAS unsigned* st;
};

__device__ __forceinline__ XcdBarrier xcd_barrier_post(unsigned* bar, volatile LAS unsigned* st) {
    XcdBarrier b; b.bar = bar; b.x = xb_xcc_id(); b.st = st;
    if (threadIdx.x == 0) (void)xb_add(&bar[XB_XCNT(b.x)], 1u);
    return b;
}
__device__ __forceinline__ void xcd_barrier_complete(unsigned* bar, unsigned x, unsigned& nloc, unsigned& nx) {
    const unsigned G = gridDim.x * gridDim.y * gridDim.z;
    unsigned sum, cnt, mine, sp = 0u;
    for (;;) {
        sum = 0u; cnt = 0u; mine = 0u;
#pragma unroll
        for (unsigned j = 0; j < 16; ++j) { const unsigned c = xb_ld(&bar[XB_XCNT(j)]); sum += c; cnt += (c > 0u) ? 1u : 0u; mine = (j == x) ? c : mine; }
        if (sum == G) break;
        __builtin_amdgcn_s_sleep(1);
        if ((++sp & 255u) == 0u) { if (xb_ld(&bar[XB_TMO])) break; if (sp > XB_SPIN_CAP) { atomicAdd(&bar[XB_TMO], 1u); break; } }
    }
    nloc = mine > 0u ? mine : 1u; nx = cnt > 0u ? cnt : 1u;
}

__device__ __forceinline__ void xcd_barrier(const XcdBarrier& b) {
    asm volatile("s_waitcnt vmcnt(0)" ::: "memory");
    __syncthreads();
    if (threadIdx.x == 0) {
        unsigned* bar = b.bar;
        __builtin_amdgcn_s_waitcnt(0);
        unsigned nloc = b.st[0], nx = b.st[1];
        if (nloc == 0u) { xcd_barrier_complete(bar, b.x, nloc, nx); b.st[0] = nloc; b.st[1] = nx; }
        const unsigned old = xb_add(&bar[XB_XSUB(b.x)], 1u);
        const unsigned gen = old / nloc;
        if (old + 1u == (gen + 1u) * nloc) {
            __builtin_amdgcn_fence(__ATOMIC_RELEASE, "agent");
            asm volatile("s_waitcnt vmcnt(0)" ::: "memory");
            const unsigned og = xb_add(&bar[XB_TOP], 1u);
            const unsigned tg = og / nx;
            if (og + 1u == (tg + 1u) * nx) xb_add(&bar[XB_TOPGEN], 1u);
            else XB_SPIN(xb_ld(&bar[XB_TOPGEN]) == tg, bar);
            __builtin_amdgcn_fence(__ATOMIC_ACQUIRE, "agent");
            xb_add(&bar[XB_XGEN(b.x)], 1u);
            asm volatile("s_waitcnt vmcnt(0)" ::: "memory");
        } else {
            XB_SPIN(xb_ld(&bar[XB_XGEN(b.x)]) == gen, bar);
            __builtin_amdgcn_fence(__ATOMIC_ACQUIRE, "agent");
            asm volatile("s_waitcnt vmcnt(0)" ::: "memory");
        }
    }
    __syncthreads();
}
constexpr int NWAVES = 8;
__device__ __forceinline__ float wave_sum(float v, int lane) {
#pragma unroll
    for (int o = 1; o < 64; o <<= 1) v += shx(v, o, lane);
    return v;
}
struct TileRegs { f32x4 v[4][8]; };
__device__ __forceinline__ void tile_load(const float* W, int N, int k0, int n0, int lane, TileRegs& t) {
    const int half = lane >> 5, nn = lane & 31, n = 4 * nn;
    const bool ok = n0 + n < N;
    const float* src = W + (size_t)k0 * N + n0 + n;
#pragma unroll
    for (int j = 0; j < 4; ++j)
#pragma unroll
        for (int r = 0; r < 8; ++r)
            t.v[j][r] = ok ? __builtin_nontemporal_load((const f32x4*)(src + (size_t)(8 * (2 * j + half) + r) * N)) : (f32x4){0.f, 0.f, 0.f, 0.f};
}
__device__ __forceinline__ void tile_to_lds(LAS unsigned* T, int lane, const TileRegs& t) {
    const int half = lane >> 5, nn = lane & 31, n = 4 * nn, sw = nn & 7;
#pragma unroll
    for (int j = 0; j < 4; ++j) { const int ch = (2 * j + half) ^ sw;
#pragma unroll
        for (int e = 0; e < 4; ++e)
            *(LAS v4u*)(T + (n + e) * 32 + 4 * ch) = (v4u){cvtpk(t.v[j][0][e], t.v[j][1][e]), cvtpk(t.v[j][2][e], t.v[j][3][e]), cvtpk(t.v[j][4][e], t.v[j][5][e]), cvtpk(t.v[j][6][e], t.v[j][7][e])}; }
    LDS_WAIT(); asm volatile("" ::: "memory");
}
__device__ __forceinline__ void tile_store(int K, int N, bf16* WT, const LAS unsigned* T, int k0, int n0, int lane) {
#pragma unroll 4
    for (int j = 0; j < 16; ++j) { const int idx = lane + 64 * j, c = idx & 7, nr = idx >> 3;
        const v4u w = *(const LAS v4u*)(T + nr * 32 + 4 * (c ^ ((nr >> 2) & 7)));
        if (n0 + nr < N) *(v4u*)(WT + tiled_off_w((size_t)(n0 + nr), k0 + 8 * c, K >> 6)) = w; }
    LDS_WAIT(); asm volatile("" ::: "memory");
}
__device__ __forceinline__ void transpose_matrix(const float* W, int K, int N, bf16* WT, LAS float* scr, int gw, int ngw, int lane, int i_lo, int i_hi) {
    const int nnt = (N + 127) / 128, nitems = (K / 64) * nnt;
    TileRegs t;
    if (i_lo < i_hi && gw + i_lo * ngw < nitems) { const int it = gw + i_lo * ngw, kb = it / nnt, nb = it - kb * nnt; tile_load(W, N, 64 * kb, 128 * nb, lane, t); }
    for (int i = i_lo; i < i_hi; ++i) { const int it = gw + i * ngw; if (it >= nitems) break; const int kb = it / nnt, nb = it - kb * nnt;
        tile_to_lds((LAS unsigned*)scr, lane, t);
        const int itn = it + ngw; if (i + 1 < i_hi && itn < nitems) { const int kbn = itn / nnt, nbn = itn - kbn * nnt; tile_load(W, N, 64 * kbn, 128 * nbn, lane, t); }
        tile_store(K, N, WT, (const LAS unsigned*)scr, 64 * kb, 128 * nb, lane); }
}
struct ConvArgs { const float* fox_w_in; const float* fox_w_out; const float* hgrn_w_in; const float* hgrn_w_out; const float* up; const float* down; };
__device__ __forceinline__ void conv_pick(unsigned char* ws, const ConvArgs& a, int q, const float*& src, bf16*& dst, int& K, int& N) {
    const int L = q >> 2, k = q & 3, j = L >> 1; const bool fox = (L & 1) == 0;
    if (k == 0) { K = DM; if (fox) { src = a.fox_w_in + (size_t)j * DM * FOX_IN; N = FOX_IN; dst = (bf16*)(ws + WS_WFIN) + (size_t)j * FOX_INP * DM; } else { src = a.hgrn_w_in + (size_t)j * DM * HG_IN; N = HG_IN; dst = (bf16*)(ws + WS_WHIN) + (size_t)j * HG_IN * DM; } }
    else if (k == 1) { K = DM; N = DM; if (fox) { src = a.fox_w_out + (size_t)j * DM * DM; dst = (bf16*)(ws + WS_WFOUT) + (size_t)j * DM * DM; } else { src = a.hgrn_w_out + (size_t)j * DM * DM; dst = (bf16*)(ws + WS_WHOUT) + (size_t)j * DM * DM; } }
    else if (k == 2) { K = DM; N = DFF; src = a.up + (size_t)L * DM * DFF; dst = (bf16*)(ws + WS_WUP) + (size_t)L * DFF * DM; }
    else { K = DFF; N = DM; src = a.down + (size_t)L * DFF * DM; dst = (bf16*)(ws + WS_WDN) + (size_t)L * DM * DFF; }
}
__device__ __forceinline__ void conv_weights(LAS unsigned char* lds, unsigned char* ws, const ConvArgs& a, int q, int vcu, int G, int part, int g) {
    const int tid = opaque_tid(), lane = tid & 63, wave = tid >> 6;
    LAS float* scr = (LAS float*)(lds + wave * 16384);
    const int gw = vcu * NWAVES + wave, ngw = G * NWAVES;
    const int L = q >> 2, k = q & 3; const bool fox = (L & 1) == 0;
    const float* src; bf16* dst; int K, N;
    conv_pick(ws, a, q, src, dst, K, N);
    const int cnt = ((K / 64) * ((N + 127) / 128) + ngw - 1) / ngw, cut = (g * cnt + 1) / 3;
    transpose_matrix(src, K, N, dst, scr, gw, ngw, lane, part == 2 ? cut : 0, part == 1 ? cut : cnt);
    if (k == 0 && fox && (part == 0 || (part == 1) == (g >= 2))) {
        const size_t n16 = (size_t)(FOX_INP - FOX_IN) * DM * 2 / 16; v4u zz = {0u, 0u, 0u, 0u}; asm volatile("" : "+v"(zz));
        for (size_t i = (size_t)(vcu * 512 + tid); i < n16; i += (size_t)G * 512) { const int kt = (int)(i / (224 * 8)), rem = (int)(i % (224 * 8)), nl = 32 + (rem >> 3), c = rem & 7;
            *(v4u*)(dst + tiled_off_w((size_t)(16384 + nl), 64 * kt + 8 * c, DM >> 6)) = zz; } }
    __syncthreads();
}
__device__ __forceinline__ void conv_tiles(LAS unsigned char* lds, unsigned char* ws, const ConvArgs& a, int q, int vcu, int G, int i_lo, int i_hi) {
    const int tid = opaque_tid(), lane = tid & 63, wave = tid >> 6;
    LAS float* scr = (LAS float*)(lds + wave * 16384);
    const float* src; bf16* dst; int K, N;
    conv_pick(ws, a, q, src, dst, K, N);
    transpose_matrix(src, K, N, dst, scr, vcu * NWAVES + wave, G * NWAVES, lane, i_lo, i_hi);
    __syncthreads();
}
constexpr int ATT_CHUNKS = 7;
__device__ __forceinline__ void conv_chunk(LAS unsigned char* lds, unsigned char* ws, const ConvArgs& a, int qbase, int c, int vcu, int G) {
    if (c == 0) conv_tiles(lds, ws, a, qbase, vcu, G, 0, 1);
    else { const int il = 2 * ((c - 1) & 1); conv_tiles(lds, ws, a, qbase + 1 + ((c - 1) >> 1), vcu, G, il, il + 2); }
}
__device__ __forceinline__ void prologue_phase(LAS unsigned char* lds, unsigned char* ws, const ConvArgs& a, const float* lb_logits, int vcu, int G) {
    conv_weights(lds, ws, a, 0, vcu, G, 0, 0);
    const int tid = opaque_tid();
    for (int c = vcu * 512 + tid; c < DM; c += G * 512) {
        float l[4], mx = -1e30f; for (int i = 0; i < 4; ++i) { l[i] = lb_logits[i * DM + c]; mx = fmaxf(mx, l[i]); }
        float s = 0.f; for (int i = 0; i < 4; ++i) { l[i] = expf(l[i] - mx); s += l[i]; }
        float* LB = (float*)(ws + WS_LB); float cum = 0.f; const float p0 = l[0] / s;
        for (int i = 0; i < 4; ++i) { cum += l[i] / s; LB[i * DM + c] = cum - p0; }
    }
}
struct RowRegs { f32x4 v[16]; };
__device__ __forceinline__ void row_load(const float* src, int row, int lane, RowRegs& r) {
    const f32x4* xr = (const f32x4*)(src + (size_t)row * DM) + lane;
#pragma unroll
    for (int j = 0; j < 16; ++j) r.v[j] = xr[64 * j];
}
template <bool TO_F32>
__device__ __forceinline__ void rms_row(const RowRegs& r, const f32x4 (&g)[16], void* dst, int row, int lane) {
    float ss = 0.f;
#pragma unroll
    for (int j = 0; j < 16; ++j) ss += (r.v[j].x * r.v[j].x + r.v[j].y * r.v[j].y) + (r.v[j].z * r.v[j].z + r.v[j].w * r.v[j].w);
    const float rstd = rsqrtf(wave_sum(ss, lane) * (1.f / DM) + NORM_EPS);
#pragma unroll
    for (int j = 0; j < 16; ++j) { const f32x4 o = r.v[j] * rstd * g[j];
        if constexpr (TO_F32) ((f32x4*)((float*)dst + (size_t)row * DM) + lane)[64 * j] = o;
        else { v2u w; w.x = cvtpk(o.x, o.y); w.y = cvtpk(o.z, o.w); ((v2u*)((bf16*)dst + (size_t)row * DM) + lane)[64 * j] = w; } }
}
template <bool TO_F32>
__device__ __forceinline__ void rms_phase(const float* src, const float* gain, void* dst, int vcu, int G) {
    const int tid = opaque_tid(), lane = tid & 63, wave = tid >> 6;
    const int gw = vcu * NWAVES + wave, ngw = G * NWAVES;
    f32x4 g[16];
#pragma unroll
    for (int j = 0; j < 16; ++j) g[j] = ((const f32x4*)gain + lane)[64 * j];
    RowRegs ra, rb;
    if (gw < SEQ) row_load(src, gw, lane, ra);
    for (int row = gw; row < SEQ; row += 2 * ngw) {
        if (row + ngw < SEQ) row_load(src, row + ngw, lane, rb);
        rms_row<TO_F32>(ra, g, dst, row, lane);
        if (row + 2 * ngw < SEQ) row_load(src, row + 2 * ngw, lane, ra);
        if (row + ngw < SEQ) rms_row<TO_F32>(rb, g, dst, row + ngw, lane);
    }
}
__device__ __forceinline__ void rms0_row(const RowRegs& r, const f32x4 (&g)[16], bf16* dst, float* part, int row, int lane) {
    float ss = 0.f;
#pragma unroll
    for (int j = 0; j < 16; ++j) { const f32x4 v = r.v[j]; ss += (v.x * v.x + v.y * v.y) + (v.z * v.z + v.w * v.w); const f32x4 o = v * g[j];
        v2u w; w.x = cvtpk(o.x, o.y); w.y = cvtpk(o.z, o.w); *(v2u*)(dst + tiled_off((size_t)row, 4 * (lane + 64 * j), DM >> 6)) = w; }
    ss = wave_sum(ss, lane);
    part[(size_t)row * 64 + lane] = lane == 0 ? ss : 0.f;
}
__device__ __forceinline__ void rms0_phase(const float* src, const float* gain, bf16* dst, float* part, int vcu, int G) {
    const int tid = opaque_tid(), lane = tid & 63, wave = tid >> 6;
    const int gw = vcu * NWAVES + wave, ngw = G * NWAVES;
    f32x4 g[16];
#pragma unroll
    for (int j = 0; j < 16; ++j) g[j] = ((const f32x4*)gain + lane)[64 * j];
    RowRegs ra, rb;
    if (gw < SEQ) row_load(src, gw, lane, ra);
    for (int row = gw; row < SEQ; row += 2 * ngw) {
        if (row + ngw < SEQ) row_load(src, row + ngw, lane, rb);
        rms0_row(ra, g, dst, part, row, lane);
        if (row + 2 * ngw < SEQ) row_load(src, row + 2 * ngw, lane, ra);
        if (row + ngw < SEQ) rms0_row(rb, g, dst, part, row + ngw, lane);
    }
}
__device__ __forceinline__ void fz_phase(LAS unsigned char* lds, const bf16* XN, const bf16* WF, const float* part, const float* fbias, float* LOGF, float* CS, int vcu, int G) {
    const int tid = opaque_tid(), lane = tid & 63, wave = __builtin_amdgcn_readfirstlane(tid >> 6), r = lane & 15, q = lane >> 4, rt = wave & 3, kh = wave >> 2;
    LAS float* red = (LAS float*)lds;
    LAS float* csw = red + 4 * 8 * 64;
    for (int blk = vcu; blk < SEQ / 64; blk += G) {
        const int row0 = blk * 64 + 16 * rt;
        const size_t khoff = (size_t)kh * 32 * 32768;
        const char* pa = (const char*)(XN + tiled_off((size_t)(row0 + r), 8 * q, DM >> 6)) + khoff;
        const char* px = (const char*)(WF + tiled_off((size_t)(16384 + r), 8 * q, DM >> 6)) + khoff;
        const char* py = (const char*)(WF + tiled_off((size_t)(16384 + 16 + r), 8 * q, DM >> 6)) + khoff;
        f32x4 acc1 = {0.f, 0.f, 0.f, 0.f}, acc2 = {0.f, 0.f, 0.f, 0.f};
        bf16x8 A0[4], X0[4], Y0[4], A1[4], X1[4], Y1[4], A2[4], X2[4], Y2[4];
#define FZ_LOAD(A_, X_, Y_, b_) do { _Pragma("unroll") for (int s_ = 0; s_ < 4; ++s_) { const size_t o_ = (size_t)(2 * (b_) + (s_ >> 1)) * 32768 + (size_t)(s_ & 1) * 1024; \
            A_[s_] = *(const bf16x8*)(pa + o_); X_[s_] = *(const bf16x8*)(px + o_); Y_[s_] = *(const bf16x8*)(py + o_); } } while (0)
#define FZ_MMA(A_, X_, Y_) do { _Pragma("unroll") for (int s_ = 0; s_ < 4; ++s_) { acc1 = __builtin_amdgcn_mfma_f32_16x16x32_bf16(X_[s_], A_[s_], acc1, 0, 0, 0); acc2 = __builtin_amdgcn_mfma_f32_16x16x32_bf16(Y_[s_], A_[s_], acc2, 0, 0, 0); } } while (0)
        FZ_LOAD(A0, X0, Y0, 0); FZ_LOAD(A1, X1, Y1, 1);
#pragma unroll 1
        for (int b = 0; b < 15; b += 3) {
            FZ_LOAD(A2, X2, Y2, b + 2); FZ_MMA(A0, X0, Y0);
            FZ_LOAD(A0, X0, Y0, b + 3); FZ_MMA(A1, X1, Y1);
            if (b + 4 < 16) FZ_LOAD(A1, X1, Y1, b + 4);
            FZ_MMA(A2, X2, Y2);
        }
        FZ_MMA(A0, X0, Y0);
#undef FZ_LOAD
#undef FZ_MMA
        if (kh == 1) {
#pragma unroll
            for (int i = 0; i < 4; ++i) { red[(rt * 8 + i) * 64 + lane] = acc1[i]; red[(rt * 8 + 4 + i) * 64 + lane] = acc2[i]; } }
        __syncthreads();
        if (kh == 0) {
#pragma unroll
            for (int i = 0; i < 4; ++i) { acc1[i] += red[(rt * 8 + i) * 64 + lane]; acc2[i] += red[(rt * 8 + 4 + i) * 64 + lane]; }
            const f32x4* pp = (const f32x4*)(part + (size_t)(row0 + r) * 64 + 16 * q);
            const f32x4 a = (pp[0] + pp[1]) + (pp[2] + pp[3]); float ssq = (a.x + a.y) + (a.z + a.w); ssq += shx(ssq, 16, lane); ssq += shx(ssq, 32, lane);
            const float rs = rsqrtf(ssq * (1.f / DM) + NORM_EPS);
            const f32x4 b0 = *(const f32x4*)(fbias + 8 * q), b1 = *(const f32x4*)(fbias + 8 * q + 4);
            f32x4 v0 = acc1 * rs + b0, v1 = acc2 * rs + b1;
#pragma unroll
            for (int jj = 0; jj < 4; ++jj) { v0[jj] = pg8::lsig(v0[jj]); v1[jj] = pg8::lsig(v1[jj]); }
            float* rowp = LOGF + (size_t)(row0 + r) * 32 + 8 * q; *(f32x4*)rowp = v0; *(f32x4*)(rowp + 4) = v1;
#pragma unroll
            for (int jj = 0; jj < 4; ++jj) {
#pragma unroll
                for (int o = 1; o < 16; o <<= 1) { v0[jj] += shx(v0[jj], o, lane); v1[jj] += shx(v1[jj], o, lane); } }
            if (r == 0) { *(LAS f32x4*)(csw + rt * 32 + 8 * q) = v0; *(LAS f32x4*)(csw + rt * 32 + 8 * q + 4) = v1; }
        }
        __syncthreads();
        if (tid < 32) CS[(size_t)blk * 32 + tid] = (csw[tid] + csw[32 + tid]) + (csw[64 + tid] + csw[96 + tid]);
        __syncthreads();
    }
}
__device__ __forceinline__ void rstd_table(LAS float* tab, const float* part, int pm0) {
    const int tid = opaque_tid(), lane = tid & 63, row = tid >> 1, half = tid & 1;
    const f32x4* p = (const f32x4*)(part + (size_t)(pm0 * 256 + row) * 64 + half * 32); f32x4 a = {0.f, 0.f, 0.f, 0.f};
#pragma unroll
    for (int i = 0; i < 8; ++i) a += p[i];
    float s = (a.x + a.y) + (a.z + a.w); s += shx(s, 1, lane);
    if (half == 0) tab[row] = rsqrtf(s * (1.f / DM) + NORM_EPS);
    __syncthreads();
}
__device__ __forceinline__ void fox_thin_phase(LAS unsigned char* lds, const float* LOGF, const float* CS, float* KB, int vcu, int G) {
    const int tid = opaque_tid(), lane = tid & 63, wave = tid >> 6;
    LAS float* red = (LAS float*)lds;
    LAS float* pre = red + 16 * 32;
    LAS float* tile = pre + 32;
    for (int blk = vcu; blk < SEQ / 64; blk += G) {
        const int r0 = blk * 64;
        { const int h = tid & 31, part = tid >> 5; float a = 0.f;
#pragma unroll 4
          for (int c = part; c < blk; c += 16) a += CS[c * 32 + h];
          red[part * 32 + h] = a; }
        { const int row = tid >> 3, c4 = tid & 7; const f32x4 v = *(const f32x4*)(LOGF + (size_t)(r0 + row) * 32 + 4 * c4);
          tile[row * 33 + 4 * c4 + 0] = v.x; tile[row * 33 + 4 * c4 + 1] = v.y; tile[row * 33 + 4 * c4 + 2] = v.z; tile[row * 33 + 4 * c4 + 3] = v.w; }
        __syncthreads();
        if (tid < 32) { float s = 0.f;
#pragma unroll
            for (int p = 0; p < 16; ++p) s += red[p * 32 + tid];
            float c = s;
            for (int r = 0; r < 64; ++r) { c += tile[r * 33 + tid]; tile[r * 33 + tid] = -c * LOG2E; } }
        __syncthreads();
        { const int h = tid >> 4, r4 = (tid & 15) * 4;
          const f32x4 o = {tile[(r4 + 0) * 33 + h], tile[(r4 + 1) * 33 + h], tile[(r4 + 2) * 33 + h], tile[(r4 + 3) * 33 + h]};
          *(f32x4*)(KB + (size_t)h * SEQ + r0 + r4) = o; }
        __syncthreads();
    }
}
__device__ __forceinline__ void jl_phase(LAS unsigned char* lds, const float* KB, const float* qg, const float* kg, int* JL, int vcu, int G) {
    const int tid = opaque_tid(), lane = tid & 63, wave = tid >> 6;
    LAS int* cnt = (LAS int*)lds;
    float gq = fmaxf(fabsf(qg[lane]), fabsf(qg[lane + 64])), gk = fmaxf(fabsf(kg[lane]), fabsf(kg[lane + 64]));
#pragma unroll
    for (int o = 1; o < 64; o <<= 1) { gq = fmaxf(gq, shx(gq, o, lane)); gk = fmaxf(gk, shx(gk, o, lane)); }
    const float TH = 48.f + 2.f * (128.f * gq * gk * QSCALE * 1.02f);
    for (int id = vcu; id < 2048; id += G) {
        const int h = id & 31, qb = 63 - (id >> 5);
        const float* kb = KB + (size_t)h * SEQ;
        const float lim = kb[qb * 256] - TH;
        const bool pred = (tid < 4 * qb) && (kb[64 * tid + 63] < lim);
        const unsigned long long bal = __ballot(pred);
        if (lane == 0) cnt[wave] = __popcll(bal);
        __syncthreads();
        if (tid == 0) { int s = 0; for (int w = 0; w < 8; ++w) s += cnt[w]; JL[id] = s; }
        __syncthreads();
    }
}
namespace fa {
constexpr int D = 128, NW = 8, QBLK = 32, KVBLK = 64, QB = NW * QBLK;
constexpr int LDQ = 128, LDO = 4096;
constexpr int SHM_V = KVBLK * D * 2, SHM_K = KVBLK * D * 2;
constexpr int OFF_WS = 2 * SHM_V + 2 * SHM_K, OFF_KB = OFF_WS + NW * 64 * 4;
constexpr int LDS_BYTES = OFF_KB + 2 * 64 * 4;
constexpr int OFF_OST = LDS_BYTES + 16 + 112;
constexpr int LDS_END = OFF_OST + NW * 8 * 132 * 4;
#define KSWZ(row, colB) ((row) * 256 + ((colB) ^ (((row) & 7) << 4)))
#define SBAR() __builtin_amdgcn_sched_barrier(0)
__device__ __forceinline__ int v_st(int k, int c) { const int kk = (k & ~0xC) | ((k & 4) << 1) | ((k & 8) >> 1); return ((kk >> 3) * 4 + (c >> 5)) * 512 + ((kk & 7) * 32 + (c & 31)) * 2; }
__device__ __forceinline__ int v_rd_base(int lane) { return ((lane & 3) << 3) | (((lane >> 2) & 3) << 6) | (((lane >> 4) & 1) << 5) | (((lane >> 5) & 1) << 8); }
constexpr int v_rd_off(int d0, int ks, int half) { return d0 * 512 + ks * 4096 + half * 2048; }
__device__ __forceinline__ int crow(int r, int hi) { return (r & 3) + 8 * (r >> 2) + 4 * hi; }
__device__ __forceinline__ bf16x8 ld8(const bf16* p) { return *reinterpret_cast<const bf16x8*>(p); }
__device__ __forceinline__ void mask_tile(f32x16& p0, f32x16& p1, int dq) {
    const float NEG = -__builtin_inff();
#pragma unroll
    for (int r = 0; r < 16; ++r) {
        const int c = (r & 3) + 8 * (r >> 2);
        if (dq - c < 0) p0[r] = NEG;
        if (dq - c - 32 < 0) p1[r] = NEG;
    }
}
__device__ __forceinline__ void partialSM(f32x16& p0, f32x16& p1, float mt) {
#pragma unroll
    for (int r = 0; r < 16; ++r) p0[r] = __builtin_amdgcn_exp2f(p0[r] - mt);
#pragma unroll
    for (int r = 0; r < 16; ++r) p1[r] = p1[r] - mt;
}
__device__ __forceinline__ void finishSM(f32x16& p0, f32x16& p1, float& l_reg, bf16x8& pa0, bf16x8& pa1, bf16x8& pa2, bf16x8& pa3) {
#pragma unroll
    for (int r = 0; r < 16; ++r) p1[r] = __builtin_amdgcn_exp2f(p1[r]);
    float ps = 0;
#pragma unroll
    for (int r = 0; r < 16; ++r) ps += p0[r];
#pragma unroll
    for (int r = 0; r < 16; ++r) ps += p1[r];
    { auto rr = __builtin_amdgcn_permlane32_swap(__float_as_uint(ps), __float_as_uint(ps), false, false);
      ps = __uint_as_float(rr[0]) + __uint_as_float(rr[1]); }
    l_reg += ps;
#define PK4(P, B_, OUT) do { unsigned a0 = cvtpk(P[B_+0], P[B_+1]), a1 = cvtpk(P[B_+2], P[B_+3]);                          \
        unsigned b0 = cvtpk(P[B_+4], P[B_+5]), b1 = cvtpk(P[B_+6], P[B_+7]);                                             \
        auto r0 = __builtin_amdgcn_permlane32_swap(a0, b0, false, false); auto r1 = __builtin_amdgcn_permlane32_swap(a1, b1, false, false); \
        v4u w = {r0[0], r1[0], r0[1], r1[1]}; OUT = *reinterpret_cast<bf16x8*>(&w); } while (0)
    PK4(p0, 0, pa0); PK4(p0, 8, pa1); PK4(p1, 0, pa2); PK4(p1, 8, pa3);
#undef PK4
}
template <int KB>
__device__ __forceinline__ void qkt(f32x16& p0, f32x16& p1, const char* K_lds, const float* kbl, int r32, int hi, const bf16x8* qr) {
#ifdef X_NOBIAS
    p0 = f32x16{}; p1 = f32x16{};
#else
    { const float* kb = kbl + KB * 64 + 4 * hi;
      const f32x4 a0 = *(const f32x4*)(kb), a1 = *(const f32x4*)(kb + 8), a2 = *(const f32x4*)(kb + 16), a3 = *(const f32x4*)(kb + 24);
      const f32x4 b0 = *(const f32x4*)(kb + 32), b1 = *(const f32x4*)(kb + 40), b2 = *(const f32x4*)(kb + 48), b3 = *(const f32x4*)(kb + 56);
      p0 = f32x16{a0[0], a0[1], a0[2], a0[3], a1[0], a1[1], a1[2], a1[3], a2[0], a2[1], a2[2], a2[3], a3[0], a3[1], a3[2], a3[3]};
      p1 = f32x16{b0[0], b0[1], b0[2], b0[3], b1[0], b1[1], b1[2], b1[3], b2[0], b2[1], b2[2], b2[3], b3[0], b3[1], b3[2], b3[3]}; }
#endif
    const char* kb4[4];
#pragma unroll
    for (int dd = 0; dd < 4; ++dd) kb4[dd] = K_lds + KB * SHM_K + KSWZ(r32, (dd * 16 + hi * 8) * 2);
#pragma unroll
    for (int d0 = 0; d0 < 8; ++d0) { const char* a = kb4[d0 & 3] + (d0 >> 2) * 128;
        bf16x8 b0 = *reinterpret_cast<const bf16x8*>(a);
        bf16x8 b1 = *reinterpret_cast<const bf16x8*>(a + 32 * 256);
        p0 = __builtin_amdgcn_mfma_f32_32x32x16_bf16(b0, qr[d0], p0, 0, 0, 0);
        p1 = __builtin_amdgcn_mfma_f32_32x32x16_bf16(b1, qr[d0], p1, 0, 0, 0); }
}
template <int VB>
__device__ __forceinline__ void pv_tile(f32x16* o, int vb0, bf16x8 pa0, bf16x8 pa1, bf16x8 pa2, bf16x8 pa3) {
#define TRRD(dst, off) asm volatile("ds_read_b64_tr_b16 %0, %1 offset:%2" : "=&v"(dst) : "v"(vb0), "i"(off) : "memory")
#define PV_D0(d0) do { s16x4 l0, l1, l2, l3, h0, h1, h2, h3; constexpr int b_ = VB * SHM_V + v_rd_off(d0, 0, 0); \
        TRRD(l0, b_); TRRD(h0, b_ + 2048); TRRD(l1, b_ + 4096); TRRD(h1, b_ + 6144); TRRD(l2, b_ + 8192); TRRD(h2, b_ + 10240); TRRD(l3, b_ + 12288); TRRD(h3, b_ + 14336); \
        asm volatile("s_waitcnt lgkmcnt(0)" ::: "memory"); SBAR();   \
        o[d0] = __builtin_amdgcn_mfma_f32_32x32x16_bf16(pa0, (bf16x8){l0[0], l0[1], l0[2], l0[3], h0[0], h0[1], h0[2], h0[3]}, o[d0], 0, 0, 0);   \
        o[d0] = __builtin_amdgcn_mfma_f32_32x32x16_bf16(pa1, (bf16x8){l1[0], l1[1], l1[2], l1[3], h1[0], h1[1], h1[2], h1[3]}, o[d0], 0, 0, 0);   \
        o[d0] = __builtin_amdgcn_mfma_f32_32x32x16_bf16(pa2, (bf16x8){l2[0], l2[1], l2[2], l2[3], h2[0], h2[1], h2[2], h2[3]}, o[d0], 0, 0, 0);   \
        o[d0] = __builtin_amdgcn_mfma_f32_32x32x16_bf16(pa3, (bf16x8){l3[0], l3[1], l3[2], l3[3], h3[0], h3[1], h3[2], h3[3]}, o[d0], 0, 0, 0); } while (0)
    PV_D0(0); PV_D0(1); PV_D0(2); PV_D0(3);
#undef PV_D0
#undef TRRD
}
struct BlockRef { const bf16* Q; const bf16* K; const bf16* V; const float* KBp; const bf16* G; bf16* O; int P0; int j0; int hcol; };
struct Seam { bf16x8 qr[8]; bf16x8 st_v0, st_v1, st_k0, st_k1; float st_b; };
#define ROWP(p, k0, rr) ((const char*)(p) + (size_t)((k0) + (rr)) * (LDQ * 2))
#define LD8V(base, off) (*reinterpret_cast<const bf16x8*>((base) + (off)))
#define VMW() asm volatile("s_waitcnt vmcnt(0)" ::: "memory")
#define VMWN(n) asm volatile("s_waitcnt vmcnt(%0)" :: "i"(n) : "memory")
#define SLOAD_H(Kp, Vp, Bp, k0) do { S.st_v0 = LD8V(ROWP(Vp, k0, 0), voff); S.st_v1 = LD8V(ROWP(Vp, k0, 32), voff);              \
                         S.st_k0 = LD8V(ROWP(Kp, k0, 0), voff); S.st_k1 = LD8V(ROWP(Kp, k0, 32), voff); \
                         if (tid < 64) S.st_b = *(const float*)((const char*)((Bp) + (k0)) + (unsigned)(tid * 4)); } while (0)
#define SWRITE_HK(bf) do { *(bf16x8*)(K_lds + (bf) * SHM_K + kws) = S.st_k0; *(bf16x8*)(K_lds + (bf) * SHM_K + kws + 32 * 256) = S.st_k1; if (tid < 64) kbl[(bf) * 64 + tid] = S.st_b; } while (0)
#define SWRITE_HV(bf) do { *(bf16x8*)(V_lds + (bf) * SHM_V + vst0) = S.st_v0; *(bf16x8*)(V_lds + (bf) * SHM_V + vst1) = S.st_v1; } while (0)
#define SWRITE_H(bf) do { SWRITE_HV(bf); SWRITE_HK(bf); } while (0)
__device__ __forceinline__ void fox_prime(const BlockRef& cur, char* lds, Seam& S) {
    const int tid = opaque_tid(), wid = __builtin_amdgcn_readfirstlane(tid >> 6), lane = tid & 63, r32 = lane & 31, hi = lane >> 5;
    const int sr = tid >> 4, sc = (tid & 15) * 8, kws = KSWZ(sr, sc * 2); char* K_lds = lds + 2 * SHM_V; float* kbl = (float*)(lds + OFF_KB);
    const unsigned voff = (unsigned)(sr * LDQ + sc) * 2u, qoff = (unsigned)(r32 * LDQ + hi * 8) * 2u;
    { const char* qb_ = (const char*)(cur.Q + (size_t)(wid * QBLK) * LDQ);
#pragma unroll
      for (int d0 = 0; d0 < 8; ++d0) S.qr[d0] = LD8V(qb_ + d0 * 32, qoff); }
    SLOAD_H(cur.K, cur.V, cur.KBp, cur.j0 * KVBLK); VMW(); SWRITE_HK(0);
    __syncthreads();
}
__device__ __forceinline__ void fox_block(const BlockRef& cur, const BlockRef& nxt, char* lds, Seam& S, float Bq) {
    const int tid = opaque_tid(), wid = __builtin_amdgcn_readfirstlane(tid >> 6), lane = tid & 63, r32 = lane & 31, hi = lane >> 5;
    const int j_lo = cur.j0, NT = (cur.P0 + QB - 1) / KVBLK + 1 - j_lo;
    const int qlo = cur.P0 + wid * QBLK, qm = qlo + r32 - 4 * hi;
    char* V_lds = lds; char* K_lds = lds + 2 * SHM_V; float* kbl = (float*)(lds + OFF_KB);
    float* ws = (float*)(lds + OFF_WS) + wid * 64; float* li_l = ws;
    float l_reg = 0; f32x16 o[4] = {};
    const float mt = cur.KBp[qlo + r32] + Bq;
    const int sr = tid >> 4, sc = (tid & 15) * 8, vst0 = v_st(sr, sc), vst1 = v_st(32 + sr, sc), kws = KSWZ(sr, sc * 2);
    const unsigned voff = (unsigned)(sr * LDQ + sc) * 2u;
    const int vb0 = (int)(uintptr_t)V_lds + v_rd_base(lane);
    const bf16* Kh = cur.K; const bf16* Vh = cur.V; const float* Bh = cur.KBp;
#define KBASE(t) ((j_lo + (t)) * KVBLK)
#define MASKT(P0_, P1_, t) do { const int kb_ = KBASE(t); if (kb_ + KVBLK - 1 > qlo) mask_tile(P0_, P1_, qm - kb_); } while (0)
    constexpr int NQL = 8;
#define SEAM_K0() do { VMWN(NQL); SWRITE_HK(0); SBAR(); } while (0)
    f32x16 pA0, pA1, pB0, pB1; bf16x8 pa0, pa1, pa2, pa3;
    SWRITE_HV(0); SBAR();
    if (NT > 1) { SLOAD_H(Kh, Vh, Bh, KBASE(1)); }
    SBAR(); qkt<0>(pA0, pA1, K_lds, kbl, r32, hi, S.qr);
    MASKT(pA0, pA1, 0); partialSM(pA0, pA1, mt);
    if (NT > 1) { VMW(); SWRITE_H(1); }
    __syncthreads();
#define HALF_STEP(PX0, PX1, PY0, PY1, t, KB, VB, SB) do {                                                      \
        if ((t) + 1 < NT) { SLOAD_H(Kh, Vh, Bh, KBASE((t) + 1)); }        \
        SBAR(); qkt<KB>(PX0, PX1, K_lds, kbl, r32, hi, S.qr);                                             \
        finishSM(PY0, PY1, l_reg, pa0, pa1, pa2, pa3); SBAR();                                                           \
        pv_tile<VB>(o, vb0, pa0, pa1, pa2, pa3); MASKT(PX0, PX1, (t)); partialSM(PX0, PX1, mt);                                        \
        __syncthreads();                                                                                                      \
        if ((t) + 1 < NT) { VMW(); SWRITE_H(SB); }                                                                          \
        __syncthreads(); } while (0)
    for (int t = 1; t + 1 < NT; t += 2) {
        HALF_STEP(pB0, pB1, pA0, pA1, t, 1, 0, 0);
        HALF_STEP(pA0, pA1, pB0, pB1, t + 1, 0, 1, 1);
    }
    const bool even = (NT & 1) == 0;
    if (even) { SBAR(); qkt<1>(pB0, pB1, K_lds, kbl, r32, hi, S.qr); SBAR(); }
    SLOAD_H(nxt.K, nxt.V, nxt.KBp, nxt.j0 * KVBLK); SBAR();
    { const int l2 = opaque_tid() & 63; const unsigned qoff = (unsigned)((l2 & 31) * LDQ + (l2 >> 5) * 8) * 2u;
      const char* qb_ = (const char*)(nxt.Q + (size_t)(wid * QBLK) * LDQ);
#pragma unroll
      for (int d0 = 0; d0 < 8; ++d0) S.qr[d0] = LD8V(qb_ + d0 * 32, qoff); }
    SBAR();
    finishSM(pA0, pA1, l_reg, pa0, pa1, pa2, pa3); SBAR();
    pv_tile<0>(o, vb0, pa0, pa1, pa2, pa3);
    if (even) { MASKT(pB0, pB1, NT - 1); partialSM(pB0, pB1, mt); __syncthreads();
        finishSM(pB0, pB1, l_reg, pa0, pa1, pa2, pa3); SBAR(); pv_tile<1>(o, vb0, pa0, pa1, pa2, pa3); }
    SBAR(); SEAM_K0();
    if (hi == 0) li_l[r32] = l_reg; asm volatile("s_waitcnt lgkmcnt(0)" ::: "memory");
    { const int l3 = opaque_tid() & 63, er = l3 >> 4, ec = l3 & 15;
      const bf16* Gp = cur.G + (size_t)(wid * QBLK + er) * LDQ + 8 * ec;
      bf16* Op = cur.O; const size_t orow0 = (size_t)(cur.P0 + wid * QBLK + er); const int ocol = cur.hcol + 8 * ec;
      v4u gt[4][2];
#pragma unroll
      for (int ps = 0; ps < 4; ++ps)
#pragma unroll
          for (int k = 0; k < 2; ++k) gt[ps][k] = *(const v4u*)(Gp + (size_t)(8 * ps + 4 * k) * LDQ);
      float* ost = (float*)(lds + OFF_OST) + wid * (8 * 132);
      const int wofs = (4 * (l3 >> 5)) * 132 + (l3 & 31);
#pragma unroll
      for (int ps = 0; ps < 4; ++ps) {
#pragma unroll
          for (int rr = 0; rr < 4; ++rr) { const int r = 4 * ps + rr; const float rl = __builtin_amdgcn_rcpf(li_l[crow(r, hi)]);
#pragma unroll
              for (int d0 = 0; d0 < 4; ++d0) ost[wofs + rr * 132 + d0 * 32] = o[d0][r] * rl; }
          asm volatile("s_waitcnt lgkmcnt(0)" ::: "memory");
#pragma unroll
          for (int k = 0; k < 2; ++k) { const float* sp = ost + (er + 4 * k) * 132 + 8 * ec; const f32x4 x0 = *(const f32x4*)sp, x1 = *(const f32x4*)(sp + 4); const v4u g = gt[ps][k];
              v4u w; w.x = cvtpk(x0[0] * bflo(g.x), x0[1] * bfhi(g.x)); w.y = cvtpk(x0[2] * bflo(g.y), x0[3] * bfhi(g.y)); w.z = cvtpk(x1[0] * bflo(g.z), x1[1] * bfhi(g.z)); w.w = cvtpk(x1[2] * bflo(g.w), x1[3] * bfhi(g.w));
              *(v4u*)(Op + tiled_off(orow0 + 8 * ps + 4 * k, ocol, LDO >> 6)) = w; }
          asm volatile("s_waitcnt lgkmcnt(0)" ::: "memory"); } }
    __syncthreads();
#undef KBASE
#undef MASKT
#undef SEAM_K0
#undef HALF_STEP
}
__device__ __forceinline__ void fox_rewrite_k0(char* lds, const Seam& S) {
    const int tid = opaque_tid(); const int sr = tid >> 4, sc = (tid & 15) * 8, kws = KSWZ(sr, sc * 2); char* K_lds = lds + 2 * SHM_V; float* kbl = (float*)(lds + OFF_KB);
    SWRITE_HK(0); __syncthreads();
}
#undef ROWP
#undef LD8V
#undef VMWN
#undef SLOAD_H
#undef SWRITE_HK
#undef SWRITE_HV
#undef SWRITE_H
__device__ __forceinline__ BlockRef mk_ref(const bf16* PROJ, const float* KBg, bf16* MO, const int* JL, int id) {
    const int bh = id & 31, qb = 63 - (id >> 5);
    BlockRef r; r.Q = PROJ + ((size_t)bh * SEQ + qb * QB) * D; r.K = PROJ + ((size_t)(32 + bh) * SEQ) * D; r.V = PROJ + ((size_t)(64 + bh) * SEQ) * D; r.KBp = KBg + (size_t)bh * SEQ;
    r.G = PROJ + ((size_t)(96 + bh) * SEQ + qb * QB) * D; r.O = MO; r.hcol = bh * D; r.P0 = qb * QB; r.j0 = JL[id]; return r;
}
__device__ __forceinline__ void attn_phase(char* lds, const bf16* PROJ, const float* KBg, bf16* MO, const int* JL, unsigned* qctr, const float* qg, const float* kg, unsigned char* ws, const ConvArgs& ca, int qbase, int nchunks, int vcu, int G) {
    constexpr int total = 32 * 64;
    const int tid = opaque_tid();
    float Bq;
    { const int l_ = tid & 63; float gq = fmaxf(fabsf(qg[l_]), fabsf(qg[l_ + 64])), gk = fmaxf(fabsf(kg[l_]), fabsf(kg[l_ + 64]));
#pragma unroll
      for (int o_ = 1; o_ < 64; o_ <<= 1) { gq = fmaxf(gq, shx(gq, o_, l_)); gk = fmaxf(gk, shx(gk, o_, l_)); }
      Bq = 128.f * gq * gk * QSCALE * 1.02f; }
    volatile int* slot = (volatile int*)(lds + LDS_BYTES);
    if (tid == 0) slot[0] = (int)__hip_atomic_fetch_add((GAS unsigned*)qctr, 1u, __ATOMIC_RELAXED, __HIP_MEMORY_SCOPE_AGENT);
    __syncthreads();
    if (__builtin_amdgcn_readfirstlane(tid) >= 256) __builtin_amdgcn_s_setprio(1);
    int id = __builtin_amdgcn_readfirstlane(slot[0]);
    int cc = 0;
    if (id < total) {
        BlockRef cur = mk_ref(PROJ, KBg, MO, JL, id);
        Seam S;
        fox_prime(cur, lds, S);
        for (;;) {
            if (tid == 0) slot[1] = (int)__hip_atomic_fetch_add((GAS unsigned*)qctr, 1u, __ATOMIC_RELAXED, __HIP_MEMORY_SCOPE_AGENT);
            __syncthreads();
            const int idn = __builtin_amdgcn_readfirstlane(slot[1]);
            const bool last = idn >= total;
            const BlockRef nxt = last ? cur : mk_ref(PROJ, KBg, MO, JL, idn);
            fox_block(cur, nxt, lds, S, Bq);
            if (last) break;
            cur = nxt;
            if (cc < nchunks) { __syncthreads(); conv_chunk((LAS unsigned char*)lds, ws, ca, qbase, cc, vcu, G); ++cc; fox_rewrite_k0(lds, S); }
        }
    }
    __builtin_amdgcn_s_setprio(0);
    __syncthreads();
    for (; cc < nchunks; ++cc) conv_chunk((LAS unsigned char*)lds, ws, ca, qbase, cc, vcu, G);
}
#undef VMW
}
namespace hg {
constexpr int CH = 64, NCH = SEQ / CH;
constexpr size_t AOFF = (size_t)32 * SEQ * DH / 2;
constexpr int PK = 144;
constexpr int PQ = 272;
constexpr int B1_STG = 2 * 128 * PK + 4096;
__device__ __forceinline__ f32x4 mma(bf16x8 bfrag, bf16x8 afrag, f32x4 acc) { return __builtin_amdgcn_mfma_f32_16x16x32_bf16(bfrag, afrag, acc, 0, 0, 0); }
__device__ __forceinline__ bf16x8 ldsfrag(const LAS unsigned char* base, int row, int pitch, int kbyte) { return *(const LAS bf16x8*)(base + row * pitch + kbyte); }

typedef float f32x2 __attribute__((ext_vector_type(2)));
typedef _Float16 f16x2 __attribute__((ext_vector_type(2)));
__device__ __forceinline__ float ex2(float x) { return __builtin_amdgcn_exp2f(x); }
__device__ __forceinline__ unsigned ldg2(const _Float16* p) { return *(const unsigned*)p; }
__device__ __forceinline__ f32x2 h2f(unsigned w) { const f16x2 h = __builtin_bit_cast(f16x2, w); return (f32x2){(float)h[0], (float)h[1]}; }
__device__ __forceinline__ void b1_phase(LAS unsigned char* lds, const bf16* PROJ, const _Float16* Gg, bf16* UT, float* DEC, int vcu, int G) {
    const int tid = opaque_tid(), lane = tid & 63, wave = __builtin_amdgcn_readfirstlane(tid >> 6), cp = tid & 63, seg = wave, r = lane & 15, q = lane >> 4;
    LAS unsigned char* KT = lds;
    LAS unsigned char* VT = lds + 128 * PK;
    LAS float* segtot = (LAS float*)(lds + 2 * 128 * PK);
    unsigned nb[8], nk[8], nv[8];
#define B1_LOAD(u_) do { const int c_ = (u_) >> 5, h_ = (u_) & 31; const int rw_ = c_ * CH + 8 * seg; \
        _Pragma("unroll") for (int j = 0; j < 8; ++j) { nb[j] = ldg2(Gg + ((size_t)h_ * SEQ + rw_ + j) * DH + 2 * cp); const unsigned* p_ = (const unsigned*)(PROJ + (((size_t)32 + h_) * SEQ + rw_ + j) * DH + 2 * cp); nk[j] = p_[0]; nv[j] = p_[AOFF]; } } while (0)
    if (vcu < NCH * NH) B1_LOAD(vcu);
    for (int u = vcu; u < NCH * NH; u += G) {
        f32x2 b[8]; unsigned kk[8], vv[8];
#pragma unroll
        for (int j = 0; j < 8; ++j) { b[j] = h2f(nb[j]); kk[j] = nk[j]; vv[j] = nv[j]; }
#pragma unroll
        for (int j = 1; j < 8; ++j) b[j] += b[j - 1];
        *(LAS f32x2*)(segtot + seg * 128 + 2 * cp) = b[7];
        __syncthreads();
        f32x2 off = {0.f, 0.f}, total = {0.f, 0.f};
#pragma unroll
        for (int s2 = 0; s2 < 8; ++s2) { const f32x2 t = *(const LAS f32x2*)(segtot + s2 * 128 + 2 * cp); total += t; if (s2 < seg) off += t; }
        const f32x2 rem = total - off;
        unsigned k0w[4], k1w[4], v0w[4], v1w[4];
#pragma unroll
        for (int i = 0; i < 4; ++i) { const int ja = 2 * i, jb = 2 * i + 1;
            k0w[i] = cvtpk(bflo(kk[ja]) * ex2(rem.x - b[ja].x), bflo(kk[jb]) * ex2(rem.x - b[jb].x)); k1w[i] = cvtpk(bfhi(kk[ja]) * ex2(rem.y - b[ja].y), bfhi(kk[jb]) * ex2(rem.y - b[jb].y));
            v0w[i] = (vv[ja] & 0xffffu) | (vv[jb] << 16); v1w[i] = (vv[ja] >> 16) | (vv[jb] & 0xffff0000u); }
        *(LAS v4u*)(KT + (2 * cp) * PK + 16 * seg) = (v4u){k0w[0], k0w[1], k0w[2], k0w[3]}; *(LAS v4u*)(KT + (2 * cp + 1) * PK + 16 * seg) = (v4u){k1w[0], k1w[1], k1w[2], k1w[3]};
        *(LAS v4u*)(VT + (2 * cp) * PK + 16 * seg) = (v4u){v0w[0], v0w[1], v0w[2], v0w[3]}; *(LAS v4u*)(VT + (2 * cp + 1) * PK + 16 * seg) = (v4u){v1w[0], v1w[1], v1w[2], v1w[3]};
        if (seg == 0) *(f32x2*)(DEC + (size_t)u * 128 + 2 * cp) = (f32x2){ex2(total.x), ex2(total.y)};
        if (u + G < NCH * NH) B1_LOAD(u + G);
        __syncthreads();
        const bf16x8 a0 = ldsfrag(VT, 16 * wave + r, PK, 16 * q), a1 = ldsfrag(VT, 16 * wave + r, PK, 64 + 16 * q);
        LAS unsigned char* stg = lds + B1_STG + wave * (16 * PQ);
#pragma unroll
        for (int nt = 0; nt < 8; ++nt) { f32x4 acc = {0.f, 0.f, 0.f, 0.f};
            acc = mma(ldsfrag(KT, 16 * nt + r, PK, 16 * q), a0, acc); acc = mma(ldsfrag(KT, 16 * nt + r, PK, 64 + 16 * q), a1, acc);
            v2u w; w.x = cvtpk(acc[0], acc[1]); w.y = cvtpk(acc[2], acc[3]); *(LAS v2u*)(stg + r * PQ + (16 * nt + 4 * q) * 2) = w; }
        LDS_WAIT();
        { bf16* up = UT + ((size_t)u * 128 + 16 * wave + (lane >> 4)) * 128 + 8 * (lane & 15);
#pragma unroll
          for (int jj = 0; jj < 4; ++jj) { const v4u w = *(const LAS v4u*)(stg + (4 * jj + (lane >> 4)) * PQ + 16 * (lane & 15)); *(v4u*)(up + (size_t)(4 * jj) * 128) = w; }
          LDS_WAIT(); }
    }
#undef B1_LOAD
}
__device__ __forceinline__ void b2_phase(const bf16* UT, const float* DEC, bf16* ST, int vcu, int G) {
    constexpr int BT = 8;
    for (int gid = vcu * 512 + opaque_tid(); gid < NH * 128 * 32; gid += G * 512) {
        const int h = gid >> 12, dv = (gid >> 5) & 127, dk4 = (gid & 31) * 4;
        f32x4 st = {0.f, 0.f, 0.f, 0.f};
        const size_t eo = ((size_t)h * 128 + dv) * 128 + dk4, estep = (size_t)NH * 128 * 128;
        const size_t dofs = (size_t)h * 128 + dk4, dstep = (size_t)NH * 128;
        v2u uwa[BT], uwb[BT]; f32x4 dda[BT], ddb[BT];
#define B2_LOAD(uw_, dd_, c0_) do { _Pragma("unroll") for (int i = 0; i < BT; ++i) { uw_[i] = *(const v2u*)(UT + eo + (size_t)((c0_) + i) * estep); dd_[i] = *(const f32x4*)(DEC + dofs + (size_t)((c0_) + i) * dstep); } } while (0)
#define B2_RUN(uw_, dd_, c0_) do { _Pragma("unroll") for (int i = 0; i < BT; ++i) { const f32x4 uu = {bflo(uw_[i].x), bfhi(uw_[i].x), bflo(uw_[i].y), bfhi(uw_[i].y)}; \
            v2u w; w.x = cvtpk(st.x, st.y); w.y = cvtpk(st.z, st.w); *(v2u*)(ST + eo + (size_t)((c0_) + i) * estep) = w; st = dd_[i] * st + uu; } } while (0)
        B2_LOAD(uwa, dda, 0);
        for (int c = 0; c < NCH; c += 2 * BT) {
            B2_LOAD(uwb, ddb, c + BT);
            B2_RUN(uwa, dda, c);
            if (c + 2 * BT < NCH) B2_LOAD(uwa, dda, c + 2 * BT);
            B2_RUN(uwb, ddb, c + BT);
        }
#undef B2_LOAD
#undef B2_RUN
    }
}
constexpr int B3_QT = 0, B3_QH = B3_QT + 64 * PQ, B3_KH = B3_QH + 64 * PQ  , B3_VT = B3_KH + 160 * PQ, B3_P = B3_VT + 128 * PK, B3_SEG = B3_P + 64 * PK, B3_RS = B3_SEG + 4096, B3_END = B3_RS + 512;
__device__ __forceinline__ int kh_base(int I) { return 16 * (I * (I + 1) / 2); }
__device__ __forceinline__ void b3_phase(LAS unsigned char* lds, const bf16* PROJ, const _Float16* Gg, const bf16* ST, const float* ogain, bf16* MO, int vcu, int G) {
    const int tid = opaque_tid(), lane = tid & 63, wave = __builtin_amdgcn_readfirstlane(tid >> 6), cp = tid & 63, seg = wave, r = lane & 15, q = lane >> 4;
    LAS unsigned char* QT = lds + B3_QT; LAS unsigned char* QH = lds + B3_QH; LAS unsigned char* KH = lds + B3_KH; LAS unsigned char* VT = lds + B3_VT; LAS unsigned char* PP = lds + B3_P;
    LAS float* segtot = (LAS float*)(lds + B3_SEG); LAS float* rs = (LAS float*)(lds + B3_RS);
    unsigned nb[8], nq[8], nk[8], nv[8];
#define B3_LOAD(u_) do { const int c_ = (u_) >> 5, h_ = (u_) & 31; const int rw_ = c_ * CH + 8 * seg; \
        _Pragma("unroll") for (int j = 0; j < 8; ++j) { nb[j] = ldg2(Gg + ((size_t)h_ * SEQ + rw_ + j) * DH + 2 * cp); const unsigned* p_ = (const unsigned*)(PROJ + ((size_t)h_ * SEQ + rw_ + j) * DH + 2 * cp); nq[j] = p_[0]; nk[j] = p_[AOFF]; nv[j] = p_[2 * AOFF]; } } while (0)
    f32x4 og[4];
#pragma unroll
    for (int nt = 0; nt < 4; ++nt) og[nt] = *(const f32x4*)(ogain + 64 * (wave >> 2) + 16 * nt + 4 * q);
    if (vcu < NCH * NH) B3_LOAD(vcu);
    for (int u = vcu; u < NCH * NH; u += G) {
        const int c = u >> 5, h = u & 31;
        const int mt = wave & 3, nh = wave >> 2;
        const size_t orow = (size_t)(c * CH + 16 * mt + r);
        v2u gtv[4];
#pragma unroll
        for (int nt = 0; nt < 4; ++nt) gtv[nt] = *(const v2u*)(PROJ + (((size_t)96 + h) * SEQ + orow) * DH + 64 * nh + 16 * nt + 4 * q);
        f32x2 b[8]; unsigned qq[8], kk[8], vv[8];
#pragma unroll
        for (int j = 0; j < 8; ++j) { b[j] = h2f(nb[j]); qq[j] = nq[j]; kk[j] = nk[j]; vv[j] = nv[j]; }
#pragma unroll
        for (int j = 1; j < 8; ++j) b[j] += b[j - 1];
        *(LAS f32x2*)(segtot + seg * 128 + 2 * cp) = b[7];
        __syncthreads();
        f32x2 st[8];
#pragma unroll
        for (int s2 = 0; s2 < 8; ++s2) st[s2] = *(const LAS f32x2*)(segtot + s2 * 128 + 2 * cp);
        const int I0 = seg >> 1;
        f32x2 off = {0.f, 0.f};
#pragma unroll
        for (int s2 = 0; s2 < 8; ++s2) if (s2 < seg) off += st[s2];
        f32x2 lsb[8];
        { f32x2 hb = {0.f, 0.f};
#pragma unroll
          for (int s2 = 0; s2 < 8; s2 += 2) if (s2 + 1 == seg) hb = st[s2];
#pragma unroll
          for (int j = 0; j < 8; ++j) lsb[j] = hb + b[j]; }
        f32x2 hbq = off;
#pragma unroll
        for (int s2 = 0; s2 < 8; s2 += 2) if (s2 + 1 == seg) hbq -= st[s2];
        const float eq0 = ex2(hbq.x), eq1 = ex2(hbq.y);
        f32x2 em[8];
#pragma unroll
        for (int j = 0; j < 8; ++j) { const float q0 = bflo(qq[j]), q1 = bfhi(qq[j]); const int row = 8 * seg + j;
            const float h0 = q0 * ex2(lsb[j].x), h1 = q1 * ex2(lsb[j].y); em[j] = (f32x2){ex2(-lsb[j].x), ex2(-lsb[j].y)};
            *(LAS unsigned*)(QT + row * PQ + 4 * cp) = cvtpk(h0 * eq0, h1 * eq1);
            *(LAS unsigned*)(QH + row * PQ + 4 * cp) = cvtpk(h0, h1); }
        { f32x2 d = {0.f, 0.f};
#pragma unroll
          for (int I = 0; I < 4; ++I) { if (I >= I0) {
                const float ed0 = ex2(d.x), ed1 = ex2(d.y);
#pragma unroll
                for (int j = 0; j < 8; ++j) *(LAS unsigned*)(KH + (kh_base(I) + 8 * seg + j) * PQ + 4 * cp) = cvtpk(bflo(kk[j]) * em[j].x * ed0, bfhi(kk[j]) * em[j].y * ed1);
                d += st[2 * I] + st[2 * I + 1]; } } }
        { unsigned v0w[4], v1w[4];
#pragma unroll
          for (int i = 0; i < 4; ++i) { const int ja = 2 * i, jb = 2 * i + 1; v0w[i] = (vv[ja] & 0xffffu) | (vv[jb] << 16); v1w[i] = (vv[ja] >> 16) | (vv[jb] & 0xffff0000u); }
          *(LAS v4u*)(VT + (2 * cp) * PK + 16 * seg) = (v4u){v0w[0], v0w[1], v0w[2], v0w[3]}; *(LAS v4u*)(VT + (2 * cp + 1) * PK + 16 * seg) = (v4u){v1w[0], v1w[1], v1w[2], v1w[3]}; }
        bf16x8 sf[4][4];
        { const bf16* stp = ST + ((size_t)u * 128 + 64 * nh + r) * 128 + 8 * q;
#pragma unroll
          for (int nt = 0; nt < 4; ++nt)
#pragma unroll
              for (int ks = 0; ks < 4; ++ks) sf[nt][ks] = *(const bf16x8*)(stp + (size_t)(16 * nt) * 128 + 32 * ks); }
        if (u + G < NCH * NH) B3_LOAD(u + G);
        __syncthreads();
#pragma unroll
        for (int tt = 0; tt < 2; ++tt) { const int tile = wave * 2 + tt, I = tile >> 2, J = tile & 3;
            f32x4 acc = {0.f, 0.f, 0.f, 0.f};
            if (J <= I) {
#pragma unroll
                for (int ks = 0; ks < 4; ++ks) acc = mma(ldsfrag(KH, kh_base(I) + 16 * J + r, PQ, 64 * ks + 16 * q), ldsfrag(QH, 16 * I + r, PQ, 64 * ks + 16 * q), acc);
                if (J == I) {
#pragma unroll
                    for (int i = 0; i < 4; ++i) if (4 * q + i > r) acc[i] = 0.f; }
            }
            v2u w; w.x = cvtpk(acc[0], acc[1]); w.y = cvtpk(acc[2], acc[3]);
            *(LAS v2u*)(PP + (16 * I + r) * PK + (16 * J + 4 * q) * 2) = w; }
        __syncthreads();
        f32x4 acc[4];
        const bf16x8 pa0 = ldsfrag(PP, 16 * mt + r, PK, 16 * q), pa1 = ldsfrag(PP, 16 * mt + r, PK, 64 + 16 * q);
        bf16x8 qa[4];
#pragma unroll
        for (int ks = 0; ks < 4; ++ks) qa[ks] = ldsfrag(QT, 16 * mt + r, PQ, 64 * ks + 16 * q);
#pragma unroll
        for (int nt = 0; nt < 4; ++nt) { f32x4 a = {0.f, 0.f, 0.f, 0.f};
            a = mma(ldsfrag(VT, 64 * nh + 16 * nt + r, PK, 16 * q), pa0, a); a = mma(ldsfrag(VT, 64 * nh + 16 * nt + r, PK, 64 + 16 * q), pa1, a);
#pragma unroll
            for (int ks = 0; ks < 4; ++ks) a = mma(sf[nt][ks], qa[ks], a);
            acc[nt] = a; }
        float ss = 0.f;
#pragma unroll
        for (int nt = 0; nt < 4; ++nt) ss += (acc[nt][0] * acc[nt][0] + acc[nt][1] * acc[nt][1]) + (acc[nt][2] * acc[nt][2] + acc[nt][3] * acc[nt][3]);
        ss += shx(ss, 16, lane); ss += shx(ss, 32, lane);
        if (q == 0) rs[nh * 64 + 16 * mt + r] = ss;
        __syncthreads();
        const float rstd = rsqrtf((rs[16 * mt + r] + rs[64 + 16 * mt + r]) * (1.f / 128.f) + NORM_EPS);
#pragma unroll
        for (int nt = 0; nt < 4; ++nt) { const int dv = 64 * nh + 16 * nt + 4 * q;
            const f32x4 g = og[nt]; const v2u gt = gtv[nt];
            v2u w; w.x = cvtpk(acc[nt][0] * rstd * g.x * bflo(gt.x), acc[nt][1] * rstd * g.y * bfhi(gt.x)); w.y = cvtpk(acc[nt][2] * rstd * g.z * bflo(gt.y), acc[nt][3] * rstd * g.w * bfhi(gt.y));
            *(v2u*)(MO + tiled_off(orow, h * DH + dv, DM >> 6)) = w; }
    }
#undef B3_LOAD
}
}
constexpr int RING_BYTES = 131072;
constexpr int MISC_OFF = RING_BYTES + 320;
constexpr int LDS_BYTES = 147456;
#ifndef DOWN_WGM
#define DOWN_WGM 2
#endif
constexpr int CW_BAR = 4096;
constexpr int CW_Q = 8192;
static_assert(fa::LDS_END <= RING_BYTES && fa::OFF_OST % 16 == 0 && hg::B3_END <= RING_BYTES, "phase scratch fits the ring region");
static_assert(WS_END <= (size_t)4096 * MiB, "workspace map");

constexpr int PH_FINAL = 49, PH_END = 50;
struct Args { const float* in[15]; float* out; unsigned char* ws; int ph_lo, ph_hi; };
static_assert(sizeof(Args) == 15 * 8 + 8 + 8 + 4 + 4, "Args has no padding bytes");

__global__ void __launch_bounds__(NWAVES * 64, 2) trunk_fwd(Args args) {
    extern __shared__ __attribute__((aligned(16))) unsigned char lds_raw[];
    LAS unsigned char* lds = (LAS unsigned char*)lds_raw;
    volatile LAS unsigned* MISC = (volatile LAS unsigned*)(lds + MISC_OFF);
    const int tid = threadIdx.x;
    const int G = gridDim.x, bx = blockIdx.x;
    const int vcu = (G % 8 == 0) ? (bx % 8) * (G / 8) + bx / 8 : bx;
    for (int u = tid; u < (LDS_BYTES - RING_BYTES) / 4; u += NWAVES * 64) ((LAS unsigned*)(lds + RING_BYTES))[u] = 0u;
    __syncthreads();
    if ((tid & 63) == 0) ((volatile LAS int*)(lds + WAVE_TAB_OFF))[hw_wave_slot()] = tid >> 6;
    __syncthreads();
    const int lo = args.ph_lo, hi = args.ph_hi;
#if MK_PER_PHASE
#define GRID_BAR(p) do { } while (0)
#else
    XcdBarrier bar = xcd_barrier_post((unsigned*)(args.ws + WS_CTL) + CW_BAR, MISC + 8);
#define GRID_BAR(p) do { if ((p) + 1 < hi) { XcdBarrier b_ = bar; asm volatile("" : "+s"(b_.bar), "+s"(b_.x)); xcd_barrier(b_); } } while (0)
#endif
#ifndef ONLY_SITE
#define ONLY_SITE -1
#endif
#define EN(s) (ONLY_SITE == -1 || ONLY_SITE == (s))
#ifndef DUP_SITE
#define DUP_SITE -1
#endif
#define DUP(s) (DUP_SITE == (s))
#define IN(k) (lo <= (k) && (k) < hi)
#ifndef STAGGER_US
#define STAGGER_US 0
#endif
#define STAGGER() do { if (STAGGER_US > 0) { const unsigned long long t0_ = __builtin_amdgcn_s_memrealtime(), dl_ = (unsigned long long)(bx & 7) * (STAGGER_US * 100ull); while (__builtin_amdgcn_s_memrealtime() - t0_ < dl_) __builtin_amdgcn_s_sleep(4); } } while (0)
#define OPQ(v) ({ int o_ = (v); asm volatile("" : "+s"(o_)); o_; })
#define WSP() ({ GAS unsigned char* w_ = (GAS unsigned char*)args.ws; asm volatile("" : "+s"(w_)); (unsigned char*)w_; })
#define INP(i) ({ const GAS float* p_ = (const GAS float*)args.in[i]; asm volatile("" : "+s"(p_)); (const float*)p_; })
    LAS float* RTAB = (LAS float*)(lds + RING_BYTES + 1024);
#define P_H ((float*)(WSP() + WS_H))
#define P_XN ((bf16*)(WSP() + WS_XN))
#define P_MO ((bf16*)(WSP() + WS_MO))
#define P_PROJ ((bf16*)(WSP() + WS_PROJ))
#define P_G ((_Float16*)(WSP() + WS_G))
#define P_UT ((bf16*)(WSP() + WS_UT))
#define P_ST ((bf16*)(WSP() + WS_ST))
#define P_LOGF ((float*)(WSP() + WS_LOGF))
#define P_KB ((float*)(WSP() + WS_KB))
#define P_DEC ((float*)(WSP() + WS_DEC))
#define P_LB ((const float*)(WSP() + WS_LB))
#define P_JL ((int*)(WSP() + WS_LB + 512 * 1024))
#define P_CS ((float*)(WSP() + WS_LB + 768 * 1024))
#define P_PART ((float*)(WSP() + WS_PART))

    if (EN(0) && IN(0)) {
        ConvArgs ca{INP(1), INP(2), INP(6), INP(7), INP(12), INP(13)};
        prologue_phase(lds, WSP(), ca, INP(9), OPQ(vcu), OPQ(G));
        GRID_BAR(0);
    }
#ifndef FZ_PHASE
#define FZ_PHASE 1
#endif
#ifndef ATT_HOST
#define ATT_HOST 1
#endif
#define HOSTED(m) (ATT_HOST && (((m) - 1) & 7) < 4)
#define CONV_PRE(q) do { if ((q) + 1 < 4 * DEPTH && !HOSTED((q) + 1) && (bx & 3)) { ConvArgs ca_{INP(1), INP(2), INP(6), INP(7), INP(12), INP(13)}; conv_weights(lds, WSP(), ca_, OPQ((q) + 1), OPQ(vcu), OPQ(G), 1, OPQ(bx & 3)); } } while (0)
#define CONV_POST(q) do { if ((q) + 1 < 4 * DEPTH && !HOSTED((q) + 1) && (bx & 3) != 3) { ConvArgs ca_{INP(1), INP(2), INP(6), INP(7), INP(12), INP(13)}; conv_weights(lds, WSP(), ca_, OPQ((q) + 1), OPQ(vcu), OPQ(G), 2, OPQ(bx & 3)); } } while (0)
    for (int L = 0; L < DEPTH; ++L) {
        const int pb = 1 + 12 * L, j = L >> 1; const bool fox = (L & 1) == 0;
        if (EN(1) && L == 0 && IN(pb + 0)) { rms0_phase(INP(0), INP(10), P_XN, P_PART, OPQ(vcu), OPQ(G)); GRID_BAR(pb + 0); }
        if (fox) {
            if (EN(2) && IN(pb + 1)) {
                unsigned char* w = WSP();
                pg8::Gemm g{(const bf16*)(w + WS_XN), (const bf16*)(w + WS_WFIN) + (size_t)j * FOX_INP * DM, SEQ, FZ_PHASE ? 4 * DM : FOX_INP, DM}; pg8::StaticOrder S; S.init(SEQ, FZ_PHASE ? 4 * DM : FOX_INP, OPQ(G), OPQ(bx));
                pg8::Unit u0; S.next(0, u0); rstd_table(RTAB, (const float*)(w + WS_PART), u0.pm);
                pg8::EpiFox E{(bf16*)(w + WS_PROJ), 16384, (float*)(w + WS_LOGF), INP(5) + j * NH, (float*)(w + WS_LB + 768 * 1024), pg8::RowScale{RTAB, u0.pm, (const float*)(w + WS_PART)}, INP(3) + j * DH, INP(4) + j * DH, (LAS float*)(lds + RING_BYTES + 4096), QSCALE};
                CONV_PRE(4 * L); pg8::gemm_phase<pg8::EpiFox, pg8::StaticOrder, true, true>(lds, g, S, E); CONV_POST(4 * L);
                if (!FZ_PHASE) GRID_BAR(pb + 1);
            }
            if (FZ_PHASE && EN(15) && IN(pb + 1)) { unsigned char* w = WSP(); __syncthreads();
                int fzb = vcu; if (G == 256) { pg8::StaticOrder S; S.init(SEQ, 4 * DM, OPQ(G), OPQ(bx)); pg8::Unit u0; S.next(0, u0); fzb = u0.pm * 4 + ((bx >> 3) >> 3); }
                fz_phase(lds, (const bf16*)(w + WS_XN), (const bf16*)(w + WS_WFIN) + (size_t)OPQ(j) * FOX_INP * DM, (const float*)(w + WS_PART), INP(5) + OPQ(j) * NH, (float*)(w + WS_LOGF), (float*)(w + WS_LB + 768 * 1024), OPQ(fzb), OPQ(G));
                GRID_BAR(pb + 1); }
            if (EN(3) && IN(pb + 2)) { fox_thin_phase(lds, P_LOGF, P_CS, P_KB, OPQ(vcu), OPQ(G)); GRID_BAR(pb + 2); }
            if (EN(14) && IN(pb + 3)) { jl_phase(lds, P_KB, INP(3) + j * DH, INP(4) + j * DH, P_JL, OPQ(vcu), OPQ(G)); GRID_BAR(pb + 3); }
            if (EN(4) && IN(pb + 4)) { unsigned char* w = WSP(); ConvArgs ca_{INP(1), INP(2), INP(6), INP(7), INP(12), INP(13)}; fa::attn_phase((char*)lds_raw, (const bf16*)(w + WS_PROJ), (const float*)(w + WS_KB), (bf16*)(w + WS_MO), (const int*)(w + WS_LB + 512 * 1024), (unsigned*)(w + WS_CTL) + CW_Q + 64 * j, INP(3) + j * DH, INP(4) + j * DH, w, ca_, OPQ(4 * L + 1), ATT_HOST ? ATT_CHUNKS : 0, OPQ(vcu), OPQ(G)); GRID_BAR(pb + 4);
                if (DUP(4)) { fa::attn_phase((char*)lds_raw, (const bf16*)(w + WS_PROJ), (const float*)(w + WS_KB), (bf16*)(w + WS_MO), (const int*)(w + WS_LB + 512 * 1024), (unsigned*)(w + WS_CTL) + CW_Q + 64 * (j + 2), INP(3) + j * DH, INP(4) + j * DH, w, ca_, OPQ(4 * L + 1), 0, OPQ(vcu), OPQ(G)); GRID_BAR(pb + 4); } }
        } else {
            if (EN(5) && IN(pb + 1)) {
                unsigned char* w = WSP();
                pg8::Gemm g{(const bf16*)(w + WS_XN), (const bf16*)(w + WS_WHIN) + (size_t)j * HG_IN * DM, SEQ, HG_IN, DM}; pg8::StaticOrder S; S.init(SEQ, HG_IN, OPQ(G), OPQ(bx));
                pg8::Unit u0; S.next(0, u0); rstd_table(RTAB, (const float*)(w + WS_PART), u0.pm);
                pg8::EpiHgrn E{(bf16*)(w + WS_PROJ), 16384, (_Float16*)(w + WS_G), (const float*)(w + WS_LB) + (size_t)L * DM, pg8::RowScale{RTAB, u0.pm, (const float*)(w + WS_PART)}};
                CONV_PRE(4 * L); pg8::gemm_phase<pg8::EpiHgrn, pg8::StaticOrder, true, true>(lds, g, S, E); CONV_POST(4 * L);
                GRID_BAR(pb + 1);
            }
            if (EN(6) && IN(pb + 2)) { hg::b1_phase(lds, P_PROJ, P_G, P_UT, P_DEC, OPQ(vcu), OPQ(G)); GRID_BAR(pb + 2); }
            if (EN(7) && IN(pb + 3)) { hg::b2_phase(P_UT, P_DEC, P_ST, OPQ(vcu), OPQ(G)); GRID_BAR(pb + 3); }
            if (EN(8) && IN(pb + 4)) { hg::b3_phase(lds, P_PROJ, P_G, P_ST, INP(8) + j * DH, P_MO, OPQ(vcu), OPQ(G)); GRID_BAR(pb + 4); }
            if (DUP(6)) { hg::b1_phase(lds, P_PROJ, P_G, P_UT, P_DEC, OPQ(vcu), OPQ(G)); GRID_BAR(pb + 2); hg::b2_phase(P_UT, P_DEC, P_ST, OPQ(vcu), OPQ(G)); GRID_BAR(pb + 3); hg::b3_phase(lds, P_PROJ, P_G, P_ST, INP(8) + j * DH, P_MO, OPQ(vcu), OPQ(G)); GRID_BAR(pb + 4); }
        }
        if (EN(9) && IN(pb + 5)) {
            unsigned char* w = WSP();
            const bf16* W = fox ? (const bf16*)(w + WS_WFOUT) + (size_t)j * DM * DM : (const bf16*)(w + WS_WHOUT) + (size_t)j * DM * DM;
            pg8::Gemm g{(const bf16*)(w + WS_MO), W, SEQ, DM, DM}; pg8::StaticOrder S; S.init(SEQ, DM, OPQ(G), OPQ(bx));
            pg8::EpiRes E{L == 0 ? INP(0) : (const float*)(w + WS_H), (float*)(w + WS_H), DM, (bf16*)(w + WS_XN), INP(11) + (size_t)L * DM, (float*)(w + WS_PART)};
            CONV_PRE(4 * L + 1); pg8::gemm_phase<pg8::EpiRes, pg8::StaticOrder, true, true>(lds, g, S, E); CONV_POST(4 * L + 1);
            GRID_BAR(pb + 5);
        }
        if (EN(11) && IN(pb + 7)) {
            unsigned char* w = WSP();
            pg8::Gemm g{(const bf16*)(w + WS_XN), (const bf16*)(w + WS_WUP) + (size_t)L * DFF * DM, SEQ, DFF, DM}; pg8::StaticOrder S; S.init(SEQ, DFF, OPQ(G), OPQ(bx));
            pg8::Unit u0; S.next(0, u0); rstd_table(RTAB, (const float*)(w + WS_PART), u0.pm);
            pg8::EpiSqRelu E{(bf16*)(w + WS_PROJ), DFF, pg8::RowScale{RTAB, u0.pm, (const float*)(w + WS_PART)}};
            CONV_PRE(4 * L + 2); pg8::gemm_phase<pg8::EpiSqRelu, pg8::StaticOrder, true, true>(lds, g, S, E); CONV_POST(4 * L + 2);
            GRID_BAR(pb + 7);
        }
        if (EN(12) && IN(pb + 8)) {
            unsigned char* w = WSP();
            pg8::Gemm g{(const bf16*)(w + WS_PROJ), (const bf16*)(w + WS_WDN) + (size_t)L * DM * DFF, SEQ, DM, DFF}; pg8::StaticOrder S; S.init(SEQ, DM, OPQ(G), OPQ(bx), DOWN_WGM);
            pg8::EpiRes E{(const float*)(w + WS_H), (float*)(w + WS_H), DM, L + 1 < DEPTH ? (bf16*)(w + WS_XN) : nullptr, INP(10) + (size_t)(L + 1 < DEPTH ? L + 1 : 0) * DM, (float*)(w + WS_PART)};
            CONV_PRE(4 * L + 3); pg8::gemm_phase<pg8::EpiRes, pg8::StaticOrder, true, true>(lds, g, S, E); CONV_POST(4 * L + 3);
            GRID_BAR(pb + 8);
        }
    }
    if (EN(13) && IN(PH_FINAL)) rms_phase<true>(P_H, INP(14), args.out, OPQ(vcu), OPQ(G));
#undef IN
#undef GRID_BAR
}

extern "C" void kernel_launch(void* const* d_in, const int* in_sizes, int n_in, void* d_out, int out_size, void* d_ws, size_t ws_size, hipStream_t stream) {
    static int grid = 0;
    if (grid == 0) {
        if (n_in != 15 || in_sizes[0] != SEQ * DM || out_size != SEQ * DM || ws_size < WS_END) { fprintf(stderr, "kernel_launch: unexpected shapes (n_in %d, in0 %d, out %d, ws %zu < %zu)\n", n_in, n_in > 0 ? in_sizes[0] : -1, out_size, ws_size, (size_t)WS_END); grid = -1; return; }
        int dev = 0, cus = 0, per_cu = 0;
        if (hipGetDevice(&dev) != hipSuccess || hipDeviceGetAttribute(&cus, hipDeviceAttributeMultiprocessorCount, dev) != hipSuccess) { grid = -1; return; }
        if (hipFuncSetAttribute((const void*)trunk_fwd, hipFuncAttributeMaxDynamicSharedMemorySize, LDS_BYTES) != hipSuccess) { fprintf(stderr, "kernel_launch: hipFuncSetAttribute failed\n"); grid = -1; return; }
        if (hipOccupancyMaxActiveBlocksPerMultiprocessor(&per_cu, (const void*)trunk_fwd, NWAVES * 64, LDS_BYTES) != hipSuccess || per_cu < 1) fprintf(stderr, "kernel_launch: occupancy query says %d\n", per_cu);
        (void)hipGetLastError();
        grid = cus;
    }
    if (grid < 0) return;
    if (hipMemsetAsync((char*)d_ws + WS_CTL, 0, CTL_ZERO_BYTES, stream) != hipSuccess) return;
    Args a{};
    for (int i = 0; i < 15; ++i) a.in[i] = (const float*)d_in[i];
    a.out = (float*)d_out; a.ws = (unsigned char*)d_ws;
#if MK_PER_PHASE
    for (int p = 0; p < PH_END; ++p) {
        bool valid = (p == 0) || (p == PH_FINAL);
        if (p >= 1 && p < PH_FINAL) { const int L = (p - 1) / 12, k = (p - 1) % 12; const bool fox = (L & 1) == 0; valid = (k <= 8) && (k != 6) && (k != 0 || L == 0); }
        if (!valid) continue;
        a.ph_lo = p; a.ph_hi = p + 1;
        hipLaunchKernelGGL(trunk_fwd, dim3(grid), dim3(NWAVES * 64), LDS_BYTES, stream, a);
    }
#else
    a.ph_lo = 0; a.ph_hi = PH_END;
    hipLaunchKernelGGL(trunk_fwd, dim3(grid), dim3(NWAVES * 64), LDS_BYTES, stream, a);
#endif
}
```

```cpp
#define MK_PER_PHASE 0
#define DUP_SITE -1
#include <hip/hip_runtime.h>
#include <hip/hip_bf16.h>
#include <cstdio>
#include <cstdint>

#ifndef MK_PER_PHASE
#define MK_PER_PHASE 0
#endif

constexpr int SEQ = 16384, DM = 4096, DFF = 16384, NH = 32, DH = 128, DEPTH = 4;
constexpr int FOX_IN = 4 * DM + NH;
constexpr int FOX_INP = 65 * 256;
constexpr int HG_IN = 4 * DM;
constexpr float NORM_EPS = 1e-6f;
constexpr float LOG2E = 1.4426950408889634f;
constexpr float QSCALE = 0.08838834764831845f * LOG2E;

constexpr size_t MiB = 1u << 20;
constexpr size_t WS_CTL = 0, CTL_ZERO_BYTES = 1 * MiB;
constexpr size_t WS_WFIN = 1 * MiB;
constexpr size_t WS_WFOUT = WS_WFIN + 260 * MiB;
constexpr size_t WS_WHIN = WS_WFOUT + 64 * MiB;
constexpr size_t WS_WHOUT = WS_WHIN + 256 * MiB;
constexpr size_t WS_WUP = WS_WHOUT + 64 * MiB;
constexpr size_t WS_WDN = WS_WUP + 512 * MiB;
constexpr size_t WS_H = WS_WDN + 512 * MiB;
constexpr size_t WS_XN = WS_H + 256 * MiB;
constexpr size_t WS_MO = WS_XN + 128 * MiB;
constexpr size_t WS_PROJ = WS_MO + 128 * MiB;
constexpr size_t WS_G = WS_PROJ + 512 * MiB;
constexpr size_t WS_UT = WS_G + 256 * MiB;
constexpr size_t WS_ST = WS_UT + 512 * MiB;
constexpr size_t WS_LOGF = WS_ST + 256 * MiB;
constexpr size_t WS_KB = WS_LOGF + 2 * MiB;
constexpr size_t WS_DEC = WS_KB + 2 * MiB;
constexpr size_t WS_LB = WS_DEC + 4 * MiB;
constexpr size_t WS_PART = WS_LB + 1 * MiB;
constexpr size_t WS_END = WS_PART + 4 * MiB;

#define GAS __attribute__((address_space(1)))
#define LAS __attribute__((address_space(3)))
typedef unsigned short bf16;
typedef unsigned v4u __attribute__((ext_vector_type(4)));
typedef unsigned v2u __attribute__((ext_vector_type(2)));
typedef float f32x4 __attribute__((ext_vector_type(4)));
typedef float f32x16 __attribute__((ext_vector_type(16)));
typedef short bf16x8 __attribute__((ext_vector_type(8)));
typedef short s16x4 __attribute__((ext_vector_type(4)));
#define LDS_WAIT() asm volatile("s_waitcnt lgkmcnt(0)" ::: "memory")
#define VM_WAIT() asm volatile("s_waitcnt vmcnt(0)" ::: "memory")
typedef float f32x2_t __attribute__((ext_vector_type(2)));
typedef __bf16 bf16x2_t __attribute__((ext_vector_type(2)));
__device__ __forceinline__ unsigned cvtpk(float lo, float hi) { const f32x2_t v = {lo, hi}; return __builtin_bit_cast(unsigned, __builtin_convertvector(v, bf16x2_t)); }
__device__ __forceinline__ float bflo(unsigned w) { return __uint_as_float(w << 16); }
__device__ __forceinline__ float bfhi(unsigned w) { return __uint_as_float(w & 0xffff0000u); }
__device__ __forceinline__ float bf2f(bf16 b) { return __uint_as_float(((unsigned)b) << 16); }
__device__ __forceinline__ bf16 f2bf(float f) { return (bf16)(cvtpk(f, 0.f) & 0xffffu); }
__device__ __forceinline__ float fexp(float x) { return __builtin_amdgcn_exp2f(x * LOG2E); }
__device__ __forceinline__ float sigmoidf_(float x) { return __builtin_amdgcn_rcpf(1.f + fexp(-x)); }
constexpr int WAVE_TAB_OFF = 131072 + 2048;
__device__ __forceinline__ unsigned hw_wave_slot() { return (unsigned)__builtin_amdgcn_s_getreg((5 << 11) | 4) & 63u; }
__device__ __forceinline__ int opaque_tid() {
    extern __shared__ __attribute__((aligned(16))) unsigned char dyn_lds_[];
    int l; asm volatile("v_mbcnt_lo_u32_b32 %0, -1, 0\n\tv_mbcnt_hi_u32_b32 %0, -1, %0" : "=v"(l));
    const int w = __builtin_amdgcn_readfirstlane(((const volatile LAS int*)((LAS unsigned char*)dyn_lds_ + WAVE_TAB_OFF))[hw_wave_slot()]);
    return (w << 6) | l;
}
__device__ __forceinline__ float shx(float v, int o, int lane) { return __int_as_float(__builtin_amdgcn_ds_bpermute((lane ^ o) << 2, __float_as_int(v))); }
__host__ __device__ __forceinline__ int img_byte(int r, int c) { const int st = (r >> 4) * 2 + (c >> 5), rr = r & 15, cc = c & 31, ob = rr * 64 + cc * 2; return st * 1024 + (ob ^ (((ob >> 9) & 1) << 5)); }
__host__ __device__ __forceinline__ size_t tiled_off(size_t row, int col, int nkt) { const int rl = (int)(row & 255);
    return (((row >> 8) * (size_t)nkt + (size_t)(col >> 6)) << 14) + (size_t)((rl >> 7) * 8192 + (img_byte(rl & 127, col & 63) >> 1)); }
__host__ __device__ __forceinline__ size_t tiled_off_w(size_t n, int k, int nkt) { const int w = (int)(n & 31), rho = 16 * ((w >> 2) & 1) + 4 * (w >> 3) + (w & 3);
    return tiled_off((n & ~(size_t)31) + (size_t)rho, k, nkt); }
namespace pg8 {
#define PG8_LAS __attribute__((address_space(3)))
typedef unsigned short bf16_t;
typedef short bf16x8 __attribute__((ext_vector_type(8)));
typedef float f32x4 __attribute__((ext_vector_type(4)));
typedef unsigned u32x4 __attribute__((ext_vector_type(4)));
constexpr int BM = 256, BK = 64, HALF = 128, HTB = HALF * BK * 2  , STAGE_BYTES = 8 * HTB, NXCD = 8, WGM = 8;

__host__ __device__ __forceinline__ int lds_byte(int r, int c) { const int st = (r >> 4) * 2 + (c >> 5), rr = r & 15, cc = c & 31, ob = rr * 64 + cc * 2; return st * 1024 + (ob ^ (((ob >> 9) & 1) << 5)); }
__host__ __device__ __forceinline__ void stage_rc(int b, int& R, int& C) { const int st = b / 1024, sb = b % 1024, swz = sb ^ (((sb >> 9) & 1) << 5); R = (st >> 1) * 16 + swz / 64; C = (st & 1) * 32 + (swz % 64) / 2; }
__host__ __device__ __forceinline__ int perm32(int rho) { const int n = rho >> 4, i = rho & 15; return 8 * (i >> 2) + 4 * n + (i & 3); }

struct Unit { int pm, pn; };
struct Gemm { const bf16_t* A; const bf16_t* Bt; int M, N, K; };

struct StaticOrder {
    int nM, nN, nwg, G, c, wgm;
    __host__ __device__ __forceinline__ void init(int M, int N, int G_, int c_, int wgm_ = WGM) { nM = M / BM; nN = N / BM; nwg = nM * nN; G = G_; c = c_; wgm = wgm_; }
    __host__ __device__ __forceinline__ bool next(int i, Unit& u) const {
        const long L = (long)i * G + c; if (L >= nwg) return false;
        int wgid = (int)L; { const int q = nwg / NXCD, r = nwg % NXCD, xcd = wgid % NXCD, off = wgid / NXCD; wgid = (xcd < r ? xcd * (q + 1) : r * (q + 1) + (xcd - r) * q) + off; }
        const int nig = wgm * nN, gid = wgid / nig, fm = gid * wgm, gsz = (nM - fm) < wgm ? (nM - fm) : wgm;
        u.pm = fm + ((wgid % nig) % gsz); u.pn = (wgid % nig) / gsz; return true;
    }
    __device__ __forceinline__ void a_ready(const Unit&) const {}
    __device__ __forceinline__ void done(const Unit&) const {}
};
#ifndef EPI_NT
#define EPI_NT 0
#endif
#if EPI_NT
#define STORE_NT(p, v) __builtin_nontemporal_store((v), (p))
#else
#define STORE_NT(p, v) (*(p) = (v))
#endif
__device__ __forceinline__ unsigned cvt_pk_bf16(float lo, float hi) { return ::cvtpk(lo, hi); }
__device__ __forceinline__ float lsig(float z) { return fminf(z, 0.f) - 0.6931471805599453f * __builtin_amdgcn_logf(1.f + __builtin_amdgcn_exp2f(-1.4426950408889634f * fabsf(z))); }
__device__ __forceinline__ float sigm(float x) { return __builtin_amdgcn_rcpf(1.f + __builtin_amdgcn_exp2f(-1.4426950408889634f * x)); }

struct RowScale {
    const PG8_LAS float* tab; int pm0; const float* part;
    __device__ __forceinline__ float get(const Unit& u, int rowin) const {
        if (u.pm == pm0) return tab[rowin];
        int ri = rowin; asm volatile("" : "+v"(ri));
        const f32x4* p = (const f32x4*)(part + (size_t)(u.pm * BM + ri) * 64); f32x4 a = {0.f, 0.f, 0.f, 0.f};
#pragma unroll 1
        for (int i = 0; i < 16; ++i) a += p[i];
        return rsqrtf(((a.x + a.y) + (a.z + a.w)) * (1.f / 4096.f) + 1e-6f);
    }
};
struct EpiRes {
    static constexpr bool PERM = true, AFTER_DRAIN = false;
    const float* base; float* out; int ldc; bf16_t* xn; const float* gain; float* part;
    __device__ __forceinline__ void operator()(const f32x4 (&acc)[2][2][4][2], const Unit& u, int wr, int wc, int fr_, int fq_) const {
        int fr = fr_, fq = fq_; asm volatile("" : "+v"(fr), "+v"(fq));
        const int row0 = u.pm * BM + wr * 64 + fr, col0 = u.pn * BM + wc * 32 + 8 * fq, lane = fq * 16 + fr;
        f32x4 g0[2], g1[2];
        if (xn) {
#pragma unroll
            for (int bj = 0; bj < 2; ++bj) { g0[bj] = *(const f32x4*)(gain + col0 + bj * HALF); g1[bj] = *(const f32x4*)(gain + col0 + bj * HALF + 4); } }
#pragma unroll
        for (int ai = 0; ai < 2; ++ai) {
            f32x4 b0[4][2], b1[4][2];
#pragma unroll
            for (int m = 0; m < 4; ++m) { const size_t off = (size_t)(row0 + ai * HALF + m * 16) * ldc + col0;
#pragma unroll
                for (int bj = 0; bj < 2; ++bj) { b0[m][bj] = *(const f32x4*)(base + off + bj * HALF); b1[m][bj] = *(const f32x4*)(base + off + bj * HALF + 4); } }
#pragma unroll
            for (int m = 0; m < 4; ++m) { const size_t row = (size_t)(row0 + ai * HALF + m * 16); const size_t off = row * ldc + col0;
                float ss = 0.f;
#pragma unroll
                for (int bj = 0; bj < 2; ++bj) { const f32x4 h0 = b0[m][bj] + acc[ai][bj][m][0], h1 = b1[m][bj] + acc[ai][bj][m][1];
                    STORE_NT((f32x4*)(out + off + bj * HALF), h0); STORE_NT((f32x4*)(out + off + bj * HALF + 4), h1);
                    if (xn) { ss += ((h0[0] * h0[0] + h0[1] * h0[1]) + (h0[2] * h0[2] + h0[3] * h0[3])) + ((h1[0] * h1[0] + h1[1] * h1[1]) + (h1[2] * h1[2] + h1[3] * h1[3]));
                        const f32x4 x0 = h0 * g0[bj], x1 = h1 * g1[bj];
                        u32x4 w; w.x = cvt_pk_bf16(x0[0], x0[1]); w.y = cvt_pk_bf16(x0[2], x0[3]); w.z = cvt_pk_bf16(x1[0], x1[1]); w.w = cvt_pk_bf16(x1[2], x1[3]);
                        STORE_NT((u32x4*)(xn + ::tiled_off(row, col0 + bj * HALF, ldc >> 6)), w); } }
                if (xn) { ss += ::shx(ss, 16, lane); ss += ::shx(ss, 32, lane); if (fq == 0) part[row * 64 + u.pn * 4 + wc] = ss; } }
            asm volatile("" ::: "memory"); }
    }
};
struct EpiSqRelu {
    static constexpr bool PERM = true, AFTER_DRAIN = false;
    bf16_t* O; int ldc; RowScale rsc;
    __device__ __forceinline__ void operator()(const f32x4 (&acc)[2][2][4][2], const Unit& u, int wr, int wc, int fr_, int fq_) const {
        int fr = fr_, fq = fq_; asm volatile("" : "+v"(fr), "+v"(fq));
        const int row0 = u.pm * BM + wr * 64 + fr, col0 = u.pn * BM + wc * 32 + 8 * fq;
#pragma unroll
        for (int ai = 0; ai < 2; ++ai)
#pragma unroll
            for (int m = 0; m < 4; ++m) { bf16_t* rowp = O + ::tiled_off((size_t)(row0 + ai * HALF + m * 16), col0, ldc >> 6); const float rs = rsc.get(u, wr * 64 + fr + ai * HALF + m * 16);
#pragma unroll
                for (int bj = 0; bj < 2; ++bj) { f32x4 v0 = acc[ai][bj][m][0] * rs, v1 = acc[ai][bj][m][1] * rs;
#pragma unroll
                    for (int j = 0; j < 4; ++j) { const float a = fmaxf(v0[j], 0.f), b = fmaxf(v1[j], 0.f); v0[j] = a * a; v1[j] = b * b; }
                    u32x4 w; w.x = cvt_pk_bf16(v0[0], v0[1]); w.y = cvt_pk_bf16(v0[2], v0[3]); w.z = cvt_pk_bf16(v1[0], v1[1]); w.w = cvt_pk_bf16(v1[2], v1[3]);
                    STORE_NT((u32x4*)(rowp + (size_t)bj * (2 * 16384)), w); } }
    }
};
struct EpiFox {
    static constexpr bool PERM = true, AFTER_DRAIN = false;
    bf16_t* P; int ldc; float* logf; const float* fbias; float* cs; RowScale rsc; const float* qg; const float* kg; PG8_LAS float* qkt; float QS;
    __device__ __forceinline__ void operator()(const f32x4 (&acc)[2][2][4][2], const Unit& u, int wr, int wc, int fr_, int fq_) const {
        int fr = fr_, fq = fq_; asm volatile("" : "+v"(fr), "+v"(fq));
        const int row0 = u.pm * BM + wr * 64 + fr;
        if (u.pn < 32) {
            const int col0 = u.pn * BM + wc * 32 + 8 * fq, lane = fq * 16 + fr; const bool isq = u.pn < 16;
            const float* gs = (isq ? qg : kg) + wc * 32 + 8 * fq; const float sc = isq ? QS : 1.f;
            const f32x4 g0 = *(const f32x4*)gs * sc, g1 = *(const f32x4*)(gs + 4) * sc;
#pragma unroll
            for (int ai = 0; ai < 2; ++ai)
#pragma unroll
                for (int m = 0; m < 4; ++m) { const int rowin = ai * 64 + m * 16 + fr; const float rs = rsc.get(u, wr * 64 + fr + ai * HALF + m * 16);
#pragma unroll
                    for (int bj = 0; bj < 2; ++bj) { const f32x4 v0 = acc[ai][bj][m][0] * rs, v1 = acc[ai][bj][m][1] * rs;
                        float ss = ((v0[0] * v0[0] + v0[1] * v0[1]) + (v0[2] * v0[2] + v0[3] * v0[3])) + ((v1[0] * v1[0] + v1[1] * v1[1]) + (v1[2] * v1[2] + v1[3] * v1[3]));
                        ss += ::shx(ss, 16, lane); ss += ::shx(ss, 32, lane);
                        if (fq == 0) qkt[(((wr * 128 + rowin) * 2 + bj) << 2) + wc] = ss; } }
            asm volatile("s_waitcnt lgkmcnt(0)" ::: "memory"); __builtin_amdgcn_s_barrier(); asm volatile("" ::: "memory");
#pragma unroll
            for (int ai = 0; ai < 2; ++ai)
#pragma unroll
                for (int m = 0; m < 4; ++m) { const int rowin = ai * 64 + m * 16 + fr; const float rs = rsc.get(u, wr * 64 + fr + ai * HALF + m * 16);
                    bf16_t* rowp = P + (((size_t)(u.pn >> 4) * 32 + (u.pn & 15) * 2) * 16384 + (size_t)(row0 + ai * HALF + m * 16)) * 128 + wc * 32 + 8 * fq;
#pragma unroll
                    for (int bj = 0; bj < 2; ++bj) { const f32x4 t = *(const PG8_LAS f32x4*)(qkt + (((wr * 128 + rowin) * 2 + bj) << 2));
                        const float r2 = rs * rsqrtf(((t[0] + t[1]) + (t[2] + t[3])) * (1.f / 128.f) + 1e-6f);
                        const f32x4 v0 = acc[ai][bj][m][0] * r2 * g0, v1 = acc[ai][bj][m][1] * r2 * g1;
                        u32x4 w; w.x = cvt_pk_bf16(v0[0], v0[1]); w.y = cvt_pk_bf16(v0[2], v0[3]); w.z = cvt_pk_bf16(v1[0], v1[1]); w.w = cvt_pk_bf16(v1[2], v1[3]);
                        STORE_NT((u32x4*)(rowp + (size_t)bj * ((size_t)16384 * 128)), w); } }
        } else if (u.pn < 64) {
            const int col0 = u.pn * BM + wc * 32 + 8 * fq; const bool gate = u.pn >= 48;
#pragma unroll
            for (int ai = 0; ai < 2; ++ai)
#pragma unroll
                for (int m = 0; m < 4; ++m) { bf16_t* rowp = P + (((size_t)(u.pn >> 4) * 32 + (u.pn & 15) * 2) * 16384 + (size_t)(row0 + ai * HALF + m * 16)) * 128 + wc * 32 + 8 * fq; const float rs = rsc.get(u, wr * 64 + fr + ai * HALF + m * 16);
#pragma unroll
                    for (int bj = 0; bj < 2; ++bj) { f32x4 v0 = acc[ai][bj][m][0] * rs, v1 = acc[ai][bj][m][1] * rs;
                        if (gate) {
#pragma unroll
                            for (int j = 0; j < 4; ++j) { v0[j] = sigm(v0[j]); v1[j] = sigm(v1[j]); } }
                        u32x4 w; w.x = cvt_pk_bf16(v0[0], v0[1]); w.y = cvt_pk_bf16(v0[2], v0[3]); w.z = cvt_pk_bf16(v1[0], v1[1]); w.w = cvt_pk_bf16(v1[2], v1[3]);
                        STORE_NT((u32x4*)(rowp + (size_t)bj * ((size_t)16384 * 128)), w); } }
        } else if (wc == 0) {
            const f32x4 b0 = *(const f32x4*)(fbias + 8 * fq), b1 = *(const f32x4*)(fbias + 8 * fq + 4);
            const int lane = fq * 16 + fr;
#pragma unroll
            for (int ai = 0; ai < 2; ++ai) {
                f32x4 s0 = {0.f, 0.f, 0.f, 0.f}, s1 = {0.f, 0.f, 0.f, 0.f};
#pragma unroll
                for (int m = 0; m < 4; ++m) { float* rowp = logf + (size_t)(row0 + ai * HALF + m * 16) * 32 + 8 * fq; const float rs = rsc.get(u, wr * 64 + fr + ai * HALF + m * 16);
                    f32x4 v0 = acc[ai][0][m][0] * rs + b0, v1 = acc[ai][0][m][1] * rs + b1;
#pragma unroll
                    for (int j = 0; j < 4; ++j) { v0[j] = lsig(v0[j]); v1[j] = lsig(v1[j]); }
                    *(f32x4*)rowp = v0; *(f32x4*)(rowp + 4) = v1; s0 += v0; s1 += v1; }
#pragma unroll
                for (int j = 0; j < 4; ++j) {
#pragma unroll
                    for (int o = 1; o < 16; o <<= 1) { s0[j] += ::shx(s0[j], o, lane); s1[j] += ::shx(s1[j], o, lane); } }
                if (fr == 0) { float* cp = cs + (size_t)(u.pm * 4 + ai * 2 + wr) * 32 + 8 * fq; *(f32x4*)cp = s0; *(f32x4*)(cp + 4) = s1; }
                asm volatile("" ::: "memory"); }
        }
    }
};
struct EpiHgrn {
    static constexpr bool PERM = true, AFTER_DRAIN = false;
    bf16_t* P; int ldc; _Float16* G; const float* lb; RowScale rsc;
    __device__ __forceinline__ void operator()(const f32x4 (&acc)[2][2][4][2], const Unit& u, int wr, int wc, int fr_, int fq_) const {
        int fr = fr_, fq = fq_; asm volatile("" : "+v"(fr), "+v"(fq));
        constexpr size_t HSTR = (size_t)16384 * 128;
        const int row0 = u.pm * BM + wr * 64 + fr, col0 = u.pn * BM + wc * 32 + 8 * fq; const int kind = u.pn >> 4, hd0 = (u.pn & 15) * 2, dcol = wc * 32 + 8 * fq;
        if (kind == 1) {
            const int gc0 = col0 - 4096;
            f32x4 l0[2], l1[2];
#pragma unroll
            for (int bj = 0; bj < 2; ++bj) { l0[bj] = *(const f32x4*)(lb + gc0 + bj * HALF); l1[bj] = *(const f32x4*)(lb + gc0 + bj * HALF + 4); }
#pragma unroll
            for (int ai = 0; ai < 2; ++ai)
#pragma unroll
                for (int m = 0; m < 4; ++m) { const size_t r = (size_t)(row0 + ai * HALF + m * 16); bf16_t* rowp = P + (((size_t)1 * 32 + hd0) * 16384 + r) * 128 + dcol; _Float16* gp = G + ((size_t)hd0 * 16384 + r) * 128 + dcol; const float rs = rsc.get(u, wr * 64 + fr + ai * HALF + m * 16);
#pragma unroll
                    for (int bj = 0; bj < 2; ++bj) { f32x4 v0 = acc[ai][bj][m][0] * rs, v1 = acc[ai][bj][m][1] * rs, g0, g1;
#pragma unroll
                        for (int j = 0; j < 4; ++j) { const float f0 = l0[bj][j] + (1.f - l0[bj][j]) * sigm(v0[j]), f1 = l1[bj][j] + (1.f - l1[bj][j]) * sigm(v1[j]);
                            g0[j] = log2f(f0); g1[j] = log2f(f1); v0[j] = 1.f - f0; v1[j] = 1.f - f1; }
                        u32x4 w; w.x = cvt_pk_bf16(v0[0], v0[1]); w.y = cvt_pk_bf16(v0[2], v0[3]); w.z = cvt_pk_bf16(v1[0], v1[1]); w.w = cvt_pk_bf16(v1[2], v1[3]);
                        STORE_NT((u32x4*)(rowp + (size_t)bj * HSTR), w); { typedef _Float16 h2 __attribute__((ext_vector_type(2))); typedef float f2 __attribute__((ext_vector_type(2)));
                          u32x4 gw; gw.x = __builtin_bit_cast(unsigned, __builtin_convertvector((f2){g0[0], g0[1]}, h2)); gw.y = __builtin_bit_cast(unsigned, __builtin_convertvector((f2){g0[2], g0[3]}, h2));
                          gw.z = __builtin_bit_cast(unsigned, __builtin_convertvector((f2){g1[0], g1[1]}, h2)); gw.w = __builtin_bit_cast(unsigned, __builtin_convertvector((f2){g1[2], g1[3]}, h2));
                          STORE_NT((u32x4*)(gp + (size_t)bj * HSTR), gw); } } }
        } else {
            const bool act = kind != 2;
#pragma unroll
            for (int ai = 0; ai < 2; ++ai)
#pragma unroll
                for (int m = 0; m < 4; ++m) { bf16_t* rowp = P + (((size_t)kind * 32 + hd0) * 16384 + (size_t)(row0 + ai * HALF + m * 16)) * 128 + dcol; const float rs = rsc.get(u, wr * 64 + fr + ai * HALF + m * 16);
#pragma unroll
                    for (int bj = 0; bj < 2; ++bj) { f32x4 v0 = acc[ai][bj][m][0] * rs, v1 = acc[ai][bj][m][1] * rs;
                        if (act) {
#pragma unroll
                            for (int j = 0; j < 4; ++j) { v0[j] = v0[j] * sigm(v0[j]); v1[j] = v1[j] * sigm(v1[j]); } }
                        u32x4 w; w.x = cvt_pk_bf16(v0[0], v0[1]); w.y = cvt_pk_bf16(v0[2], v0[3]); w.z = cvt_pk_bf16(v1[0], v1[1]); w.w = cvt_pk_bf16(v1[2], v1[3]);
                        STORE_NT((u32x4*)(rowp + (size_t)bj * HSTR), w); } }
        }
    }
};
template <class Epi, class Sched, bool ALIGN_EPI = false, bool SP2 = false>
__device__ __forceinline__ void gemm_phase(PG8_LAS unsigned char* lds, const Gemm g, const Sched& S, const Epi& E) {
    const int tid = opaque_tid(), wid = __builtin_amdgcn_readfirstlane(tid >> 6), lane = tid & 63, wr = wid >> 2, wc = wid & 3, fr = lane & 15, fq = lane >> 4;
    const int K = g.K, nt = K / BK;
    unsigned voffA[2], voffB[2];
    static_assert(Epi::PERM, "the weights are stored with the PERM row order baked in");
#pragma unroll
    for (int i = 0; i < 2; ++i) { voffA[i] = (unsigned)(tid * 16 + i * 8192); voffB[i] = voffA[i]; }
    const size_t kstep = (size_t)BM * BK * 2, hstep = (size_t)HALF * BK * 2;
    const size_t tstep = (size_t)BM * K * 2;
    const size_t kstepB = kstep, hstepB = hstep;
    const unsigned ldsw = (unsigned)wid * 1024u;
    const int aoff = lds_byte(wr * 64 + fr, fq * 8), boff = lds_byte(wc * 32 + fr, fq * 8);
#define PG8_SA(b, h) (((b) * 2 + (h)) * HTB)
#define PG8_SB(b, h) ((4 + (b) * 2 + (h)) * HTB)
#define PG8_STAGE(bufoff, gbase, voff) do { _Pragma("unroll") for (int _i = 0; _i < 2; ++_i) \
        __builtin_amdgcn_global_load_lds((const unsigned*)((const char*)(gbase) + (voff)[_i]), (PG8_LAS unsigned*)(lds + (bufoff) + ldsw + _i * 8192), 16, 0, 0); } while (0)
#define PG8_LDA(dst, b, h) do { _Pragma("unroll") for (int m = 0; m < 4; ++m) _Pragma("unroll") for (int k = 0; k < 2; ++k) dst[m][k] = *(const PG8_LAS bf16x8*)(lds + PG8_SA(b, h) + aoff + m * 2048 + k * 1024); } while (0)
#define PG8_LDB(dst, b, h) do { _Pragma("unroll") for (int n = 0; n < 2; ++n) _Pragma("unroll") for (int k = 0; k < 2; ++k) dst[n][k] = *(const PG8_LAS bf16x8*)(lds + PG8_SB(b, h) + boff + n * 2048 + k * 1024); } while (0)
#ifndef PG8_PRIO
#define PG8_PRIO 1
#endif
#define PG8_MMA(ai, bj, At, Bt) do { if (PG8_PRIO) __builtin_amdgcn_s_setprio(1); _Pragma("unroll") for (int m = 0; m < 4; ++m) _Pragma("unroll") for (int n = 0; n < 2; ++n) _Pragma("unroll") for (int k = 0; k < 2; ++k) \
        acc[ai][bj][m][n] = __builtin_amdgcn_mfma_f32_16x16x32_bf16(Bt[n][k], At[m][k], acc[ai][bj][m][n], 0, 0, 0); if (PG8_PRIO) __builtin_amdgcn_s_setprio(0); } while (0)
#define PG8_WAIT_V(n) asm volatile("s_waitcnt vmcnt(" #n ")" ::: "memory")
#define PG8_WAIT_L(n) asm volatile("s_waitcnt lgkmcnt(" #n ")" ::: "memory")
#define PG8_BAR __builtin_amdgcn_s_barrier()
#define PG8_SCHED __builtin_amdgcn_sched_barrier(0)
    Unit cur, nxt; int ui = 0;
    if (!S.next(0, cur)) return;
    f32x4 acc[2][2][4][2];
#pragma unroll
    for (int a = 0; a < 2; ++a)
#pragma unroll
        for (int b = 0; b < 2; ++b)
#pragma unroll
            for (int m = 0; m < 4; ++m)
#pragma unroll
                for (int n = 0; n < 2; ++n) acc[a][b][m][n] = (f32x4){0.f, 0.f, 0.f, 0.f};
    bf16x8 At[4][2], B0[2][2], B1[2][2];
    const char* cA = (const char*)g.A + (size_t)cur.pm * tstep; const char* cB = (const char*)g.Bt + (size_t)cur.pn * tstep;
    S.a_ready(cur);
    if constexpr (SP2) {
        PG8_STAGE(PG8_SB(0, 0), cB, voffB); PG8_STAGE(PG8_SB(0, 1), cB + hstepB, voffB); PG8_STAGE(PG8_SA(0, 0), cA, voffA); PG8_STAGE(PG8_SA(0, 1), cA + hstep, voffA);
        if (wr == 1) PG8_BAR;
        PG8_WAIT_V(2); PG8_BAR;
        PG8_STAGE(PG8_SB(1, 0), cB + kstepB, voffB); PG8_STAGE(PG8_SA(1, 0), cA + kstep, voffA); PG8_STAGE(PG8_SB(1, 1), cB + hstepB + kstepB, voffB);
        PG8_WAIT_V(6); PG8_BAR;
    } else {
        PG8_STAGE(PG8_SB(0, 0), cB, voffB); PG8_STAGE(PG8_SA(0, 0), cA, voffA); PG8_STAGE(PG8_SB(0, 1), cB + hstepB, voffB); PG8_STAGE(PG8_SA(0, 1), cA + hstep, voffA);
        if (wr == 1) PG8_BAR;
        PG8_WAIT_V(4); PG8_BAR;
        PG8_STAGE(PG8_SB(1, 0), cB + kstepB, voffB); PG8_STAGE(PG8_SA(1, 0), cA + kstep, voffA); PG8_STAGE(PG8_SB(1, 1), cB + hstepB + kstepB, voffB);
        PG8_WAIT_V(6); PG8_BAR;
    }
    for (;;) {
        const bool has_next = S.next(ui + 1, nxt);
        const char* nA = has_next ? (const char*)g.A + (size_t)nxt.pm * tstep : cA; const char* nB = has_next ? (const char*)g.Bt + (size_t)nxt.pn * tstep : cB;
        for (int t = 0; t < nt; t += 2) {
            const bool last = (t == nt - 2);
            const char* a1 = cA + (size_t)(t + 1) * kstep;
            const char* a2 = last ? nA : cA + (size_t)(t + 2) * kstep; const char* b2 = last ? nB : cB + (size_t)(t + 2) * kstepB;
            const char* a3 = a2 + kstep; const char* b3 = b2 + kstepB;
            if (last && has_next) S.a_ready(nxt);
            if constexpr (SP2) {
            PG8_LDB(B0, 0, 0); PG8_LDB(B1, 0, 1); PG8_SCHED; PG8_LDA(At, 0, 0); PG8_STAGE(PG8_SA(1, 1), a1 + hstep, voffA);
            PG8_WAIT_V(8); PG8_WAIT_L(0); PG8_BAR; PG8_MMA(0, 0, At, B0); PG8_MMA(0, 1, At, B1); PG8_BAR; PG8_SCHED;
            PG8_LDA(At, 0, 1); PG8_STAGE(PG8_SB(0, 0), b2, voffB); PG8_STAGE(PG8_SB(0, 1), b2 + hstepB, voffB); PG8_STAGE(PG8_SA(0, 0), a2, voffA);
            PG8_WAIT_V(8); PG8_WAIT_L(0); PG8_BAR; PG8_MMA(1, 0, At, B0); PG8_MMA(1, 1, At, B1); PG8_BAR; PG8_SCHED;
            PG8_LDB(B0, 1, 0); PG8_LDB(B1, 1, 1); PG8_SCHED; PG8_LDA(At, 1, 0); PG8_STAGE(PG8_SA(0, 1), a2 + hstep, voffA);
            PG8_WAIT_V(8); PG8_WAIT_L(0); PG8_BAR; PG8_MMA(0, 0, At, B0); PG8_MMA(0, 1, At, B1); PG8_BAR; PG8_SCHED;
            PG8_LDA(At, 1, 1); PG8_STAGE(PG8_SB(1, 0), b3, voffB); PG8_STAGE(PG8_SB(1, 1), b3 + hstepB, voffB); PG8_STAGE(PG8_SA(1, 0), a3, voffA);
            PG8_WAIT_V(8); PG8_WAIT_L(0); PG8_BAR; PG8_MMA(1, 0, At, B0); PG8_MMA(1, 1, At, B1); PG8_BAR; PG8_SCHED;
            } else {
            PG8_LDB(B0, 0, 0); PG8_SCHED; PG8_LDA(At, 0, 0); PG8_STAGE(PG8_SA(1, 1), a1 + hstep, voffA);
            PG8_WAIT_L(8); PG8_BAR; PG8_WAIT_L(0); PG8_MMA(0, 0, At, B0); PG8_BAR; PG8_SCHED;
            PG8_LDB(B1, 0, 1); PG8_STAGE(PG8_SB(0, 0), b2, voffB);
            PG8_BAR; PG8_WAIT_L(0); PG8_MMA(0, 1, At, B1); PG8_BAR;
            PG8_LDA(At, 0, 1); PG8_STAGE(PG8_SA(0, 0), a2, voffA);
            PG8_BAR; PG8_WAIT_L(0); PG8_MMA(1, 0, At, B0); PG8_BAR; PG8_SCHED;
            PG8_STAGE(PG8_SB(0, 1), b2 + hstepB, voffB);
            PG8_WAIT_V(6); PG8_BAR; PG8_MMA(1, 1, At, B1); PG8_BAR;
            PG8_LDB(B0, 1, 0); PG8_SCHED; PG8_LDA(At, 1, 0); PG8_STAGE(PG8_SA(0, 1), a2 + hstep, voffA);
            PG8_WAIT_L(8); PG8_BAR; PG8_WAIT_L(0); PG8_MMA(0, 0, At, B0); PG8_BAR; PG8_SCHED;
            PG8_LDB(B1, 1, 1); PG8_STAGE(PG8_SB(1, 0), b3, voffB);
            PG8_BAR; PG8_WAIT_L(0); PG8_MMA(0, 1, At, B1); PG8_BAR;
            PG8_LDA(At, 1, 1); PG8_STAGE(PG8_SA(1, 0), a3, voffA);
            PG8_BAR; PG8_WAIT_L(0); PG8_MMA(1, 0, At, B0); PG8_BAR; PG8_SCHED;
            PG8_STAGE(PG8_SB(1, 1), b3 + hstepB, voffB);
            PG8_WAIT_V(6); PG8_BAR; PG8_MMA(1, 1, At, B1); PG8_BAR;
            }
        }
        if constexpr (ALIGN_EPI) { if (wr == 0) PG8_BAR; }
        if constexpr (!Epi::AFTER_DRAIN) { E(acc, cur, wr, wc, fr, fq); S.done(cur); }
        if (!has_next) break;
#pragma unroll
        for (int a = 0; a < 2; ++a)
#pragma unroll
            for (int b = 0; b < 2; ++b)
#pragma unroll
                for (int m = 0; m < 4; ++m)
#pragma unroll
                    for (int n = 0; n < 2; ++n) acc[a][b][m][n] = (f32x4){0.f, 0.f, 0.f, 0.f};
        cur = nxt; cA = nA; cB = nB; ++ui;
        if constexpr (ALIGN_EPI) { if (wr == 1) PG8_BAR; }
    }
    PG8_WAIT_V(0);
    if constexpr (!ALIGN_EPI) { if (wr == 0) PG8_BAR; }
    PG8_BAR;
    if constexpr (Epi::AFTER_DRAIN) { E.fused(acc, cur, wr, wc, fr, fq, lds, wid, lane); S.done(cur); }
#undef PG8_SA
#undef PG8_SB
#undef PG8_STAGE
#undef PG8_LDA
#undef PG8_LDB
#undef PG8_MMA
#undef PG8_WAIT_V
#undef PG8_WAIT_L
#undef PG8_BAR
#undef PG8_SCHED
}
}
#define XB_TMO      128
#define XB_XCNT(j)  (256  + 64 * (j))
#define XB_XSUB(j)  (1280 + 64 * (j))
#define XB_XGEN(j)  (2304 + 64 * (j))
#define XB_TOP      3328
#define XB_TOPGEN   3392
#define XCD_BAR_WORDS 3456
#define XB_SPIN_CAP (1u << 18)
#define LAS __attribute__((address_space(3)))

__device__ __forceinline__ unsigned xb_ld(unsigned* p)              { return __hip_atomic_load((__attribute__((address_space(1))) unsigned*)p, __ATOMIC_RELAXED, __HIP_MEMORY_SCOPE_AGENT); }
__device__ __forceinline__ unsigned xb_add(unsigned* p, unsigned v) { return __hip_atomic_fetch_add((__attribute__((address_space(1))) unsigned*)p, v, __ATOMIC_RELAXED, __HIP_MEMORY_SCOPE_AGENT); }
__device__ __forceinline__ unsigned xb_xcc_id() { return (unsigned)__builtin_amdgcn_s_getreg((3 << 11) | 20) & 0xFu; }
#define XB_SPIN(cond, bar) do { unsigned _sp = 0; while (cond) { __builtin_amdgcn_s_sleep(1); \
    if ((++_sp & 255u) == 0u) { if (xb_ld(&(bar)[XB_TMO])) break; if (_sp > XB_SPIN_CAP) { atomicAdd(&(bar)[XB_TMO], 1u); break; } } } } while (0)

struct XcdBarrier {
    unsigned* bar; unsigned x;
    volatile LAS unsigned* st;
};

__device__ __forceinline__ XcdBarrier xcd_barrier_post(unsigned* bar, volatile LAS unsigned* st) {
    XcdBarrier b; b.bar = bar; b.x = xb_xcc_id(); b.st = st;
    if (threadIdx.x == 0) (void)xb_add(&bar[XB_XCNT(b.x)], 1u);
    return b;
}
__device__ __forceinline__ void xcd_barrier_complete(unsigned* bar, unsigned x, unsigned& nloc, unsigned& nx) {
    const unsigned G = gridDim.x * gridDim.y * gridDim.z;
    unsigned sum, cnt, mine, sp = 0u;
    for (;;) {
        sum = 0u; cnt = 0u; mine = 0u;
#pragma unroll
        for (unsigned j = 0; j < 16; ++j) { const unsigned c = xb_ld(&bar[XB_XCNT(j)]); sum += c; cnt += (c > 0u) ? 1u : 0u; mine = (j == x) ? c : mine; }
        if (sum == G) break;
        __builtin_amdgcn_s_sleep(1);
        if ((++sp & 255u) == 0u) { if (xb_ld(&bar[XB_TMO])) break; if (sp > XB_SPIN_CAP) { atomicAdd(&bar[XB_TMO], 1u); break; } }
    }
    nloc = mine > 0u ? mine : 1u; nx = cnt > 0u ? cnt : 1u;
}

__device__ __forceinline__ void xcd_barrier(const XcdBarrier& b) {
    asm volatile("s_waitcnt vmcnt(0)" ::: "memory");
    __syncthreads();
    if (threadIdx.x == 0) {
        unsigned* bar = b.bar;
        __builtin_amdgcn_s_waitcnt(0);
        unsigned nloc = b.st[0], nx = b.st[1];
        if (nloc == 0u) { xcd_barrier_complete(bar, b.x, nloc, nx); b.st[0] = nloc; b.st[1] = nx; }
        const unsigned old = xb_add(&bar[XB_XSUB(b.x)], 1u);
        const unsigned gen = old / nloc;
        if (old + 1u == (gen + 1u) * nloc) {
            __builtin_amdgcn_fence(__ATOMIC_RELEASE, "agent");
            asm volatile("s_waitcnt vmcnt(0)" ::: "memory");
            const unsigned og = xb_add(&bar[XB_TOP], 1u);
            const unsigned tg = og / nx;
            if (og + 1u == (tg + 1u) * nx) xb_add(&bar[XB_TOPGEN], 1u);
            else XB_SPIN(xb_ld(&bar[XB_TOPGEN]) == tg, bar);
            __builtin_amdgcn_fence(__ATOMIC_ACQUIRE, "agent");
            xb_add(&bar[XB_XGEN(b.x)], 1u);
            asm volatile("s_waitcnt vmcnt(0)" ::: "memory");
        } else {
            XB_SPIN(xb_ld(&bar[XB_XGEN(b.x)]) == gen, bar);
            __builtin_amdgcn_fence(__ATOMIC_ACQUIRE, "agent");
            asm volatile("s_waitcnt vmcnt(0)" ::: "memory");
        }
    }
    __syncthreads();
}
constexpr int NWAVES = 8;
__device__ __forceinline__ float wave_sum(float v, int lane) {
#pragma unroll
    for (int o = 1; o < 64; o <<= 1) v += shx(v, o, lane);
    return v;
}
struct TileRegs { f32x4 v[4][8]; };
__device__ __forceinline__ void tile_load(const float* W, int N, int k0, int n0, int lane, TileRegs& t) {
    const int half = lane >> 5, nn = lane & 31, n = 4 * nn;
    const bool ok = n0 + n < N;
    const float* src = W + (size_t)k0 * N + n0 + n;
#pragma unroll
    for (int j = 0; j < 4; ++j)
#pragma unroll
        for (int r = 0; r < 8; ++r)
            t.v[j][r] = ok ? __builtin_nontemporal_load((const f32x4*)(src + (size_t)(8 * (2 * j + half) + r) * N)) : (f32x4){0.f, 0.f, 0.f, 0.f};
}
__device__ __forceinline__ void tile_to_lds(LAS unsigned* T, int lane, const TileRegs& t) {
    const int half = lane >> 5, nn = lane & 31, n = 4 * nn, sw = nn & 7;
#pragma unroll
    for (int j = 0; j < 4; ++j) { const int ch = (2 * j + half) ^ sw;
#pragma unroll
        for (int e = 0; e < 4; ++e)
            *(LAS v4u*)(T + (n + e) * 32 + 4 * ch) = (v4u){cvtpk(t.v[j][0][e], t.v[j][1][e]), cvtpk(t.v[j][2][e], t.v[j][3][e]), cvtpk(t.v[j][4][e], t.v[j][5][e]), cvtpk(t.v[j][6][e], t.v[j][7][e])}; }
    LDS_WAIT(); asm volatile("" ::: "memory");
}
__device__ __forceinline__ void tile_store(int K, int N, bf16* WT, const LAS unsigned* T, int k0, int n0, int lane) {
#pragma unroll 4
    for (int j = 0; j < 16; ++j) { const int idx = lane + 64 * j, c = idx & 7, nr = idx >> 3;
        const v4u w = *(const LAS v4u*)(T + nr * 32 + 4 * (c ^ ((nr >> 2) & 7)));
        if (n0 + nr < N) *(v4u*)(WT + tiled_off_w((size_t)(n0 + nr), k0 + 8 * c, K >> 6)) = w; }
    LDS_WAIT(); asm volatile("" ::: "memory");
}
__device__ __forceinline__ void transpose_matrix(const float* W, int K, int N, bf16* WT, LAS float* scr, int gw, int ngw, int lane, int i_lo, int i_hi) {
    const int nnt = (N + 127) / 128, nitems = (K / 64) * nnt;
    TileRegs t;
    if (i_lo < i_hi && gw + i_lo * ngw < nitems) { const int it = gw + i_lo * ngw, kb = it / nnt, nb = it - kb * nnt; tile_load(W, N, 64 * kb, 128 * nb, lane, t); }
    for (int i = i_lo; i < i_hi; ++i) { const int it = gw + i * ngw; if (it >= nitems) break; const int kb = it / nnt, nb = it - kb * nnt;
        tile_to_lds((LAS unsigned*)scr, lane, t);
        const int itn = it + ngw; if (i + 1 < i_hi && itn < nitems) { const int kbn = itn / nnt, nbn = itn - kbn * nnt; tile_load(W, N, 64 * kbn, 128 * nbn, lane, t); }
        tile_store(K, N, WT, (const LAS unsigned*)scr, 64 * kb, 128 * nb, lane); }
}
struct ConvArgs { const float* fox_w_in; const float* fox_w_out; const float* hgrn_w_in; const float* hgrn_w_out; const float* up; const float* down; };
__device__ __forceinline__ void conv_pick(unsigned char* ws, const ConvArgs& a, int q, const float*& src, bf16*& dst, int& K, int& N) {
    const int L = q >> 2, k = q & 3, j = L >> 1; const bool fox = (L & 1) == 0;
    if (k == 0) { K = DM; if (fox) { src = a.fox_w_in + (size_t)j * DM * FOX_IN; N = FOX_IN; dst = (bf16*)(ws + WS_WFIN) + (size_t)j * FOX_INP * DM; } else { src = a.hgrn_w_in + (size_t)j * DM * HG_IN; N = HG_IN; dst = (bf16*)(ws + WS_WHIN) + (size_t)j * HG_IN * DM; } }
    else if (k == 1) { K = DM; N = DM; if (fox) { src = a.fox_w_out + (size_t)j * DM * DM; dst = (bf16*)(ws + WS_WFOUT) + (size_t)j * DM * DM; } else { src = a.hgrn_w_out + (size_t)j * DM * DM; dst = (bf16*)(ws + WS_WHOUT) + (size_t)j * DM * DM; } }
    else if (k == 2) { K = DM; N = DFF; src = a.up + (size_t)L * DM * DFF; dst = (bf16*)(ws + WS_WUP) + (size_t)L * DFF * DM; }
    else { K = DFF; N = DM; src = a.down + (size_t)L * DFF * DM; dst = (bf16*)(ws + WS_WDN) + (size_t)L * DM * DFF; }
}
__device__ __forceinline__ void conv_weights(LAS unsigned char* lds, unsigned char* ws, const ConvArgs& a, int q, int vcu, int G, int part, int g) {
    const int tid = opaque_tid(), lane = tid & 63, wave = tid >> 6;
    LAS float* scr = (LAS float*)(lds + wave * 16384);
    const int gw = vcu * NWAVES + wave, ngw = G * NWAVES;
    const int L = q >> 2, k = q & 3; const bool fox = (L & 1) == 0;
    const float* src; bf16* dst; int K, N;
    conv_pick(ws, a, q, src, dst, K, N);
    const int cnt = ((K / 64) * ((N + 127) / 128) + ngw - 1) / ngw, cut = (g * cnt + 1) / 3;
    transpose_matrix(src, K, N, dst, scr, gw, ngw, lane, part == 2 ? cut : 0, part == 1 ? cut : cnt);
    if (k == 0 && fox && (part == 0 || (part == 1) == (g >= 2))) {
        const size_t n16 = (size_t)(FOX_INP - FOX_IN) * DM * 2 / 16; v4u zz = {0u, 0u, 0u, 0u}; asm volatile("" : "+v"(zz));
        for (size_t i = (size_t)(vcu * 512 + tid); i < n16; i += (size_t)G * 512) { const int kt = (int)(i / (224 * 8)), rem = (int)(i % (224 * 8)), nl = 32 + (rem >> 3), c = rem & 7;
            *(v4u*)(dst + tiled_off_w((size_t)(16384 + nl), 64 * kt + 8 * c, DM >> 6)) = zz; } }
    __syncthreads();
}
__device__ __forceinline__ void conv_tiles(LAS unsigned char* lds, unsigned char* ws, const ConvArgs& a, int q, int vcu, int G, int i_lo, int i_hi) {
    const int tid = opaque_tid(), lane = tid & 63, wave = tid >> 6;
    LAS float* scr = (LAS float*)(lds + wave * 16384);
    const float* src; bf16* dst; int K, N;
    conv_pick(ws, a, q, src, dst, K, N);
    transpose_matrix(src, K, N, dst, scr, vcu * NWAVES + wave, G * NWAVES, lane, i_lo, i_hi);
    __syncthreads();
}
constexpr int ATT_CHUNKS = 7;
__device__ __forceinline__ void conv_chunk(LAS unsigned char* lds, unsigned char* ws, const ConvArgs& a, int qbase, int c, int vcu, int G) {
    if (c == 0) conv_tiles(lds, ws, a, qbase, vcu, G, 0, 1);
    else { const int il = 2 * ((c - 1) & 1); conv_tiles(lds, ws, a, qbase + 1 + ((c - 1) >> 1), vcu, G, il, il + 2); }
}
__device__ __forceinline__ void prologue_phase(LAS unsigned char* lds, unsigned char* ws, const ConvArgs& a, const float* lb_logits, int vcu, int G) {
    conv_weights(lds, ws, a, 0, vcu, G, 0, 0);
    const int tid = opaque_tid();
    for (int c = vcu * 512 + tid; c < DM; c += G * 512) {
        float l[4], mx = -1e30f; for (int i = 0; i < 4; ++i) { l[i] = lb_logits[i * DM + c]; mx = fmaxf(mx, l[i]); }
        float s = 0.f; for (int i = 0; i < 4; ++i) { l[i] = expf(l[i] - mx); s += l[i]; }
        float* LB = (float*)(ws + WS_LB); float cum = 0.f; const float p0 = l[0] / s;
        for (int i = 0; i < 4; ++i) { cum += l[i] / s; LB[i * DM + c] = cum - p0; }
    }
}
struct RowRegs { f32x4 v[16]; };
__device__ __forceinline__ void row_load(const float* src, int row, int lane, RowRegs& r) {
    const f32x4* xr = (const f32x4*)(src + (size_t)row * DM) + lane;
#pragma unroll
    for (int j = 0; j < 16; ++j) r.v[j] = xr[64 * j];
}
template <bool TO_F32>
__device__ __forceinline__ void rms_row(const RowRegs& r, const f32x4 (&g)[16], void* dst, int row, int lane) {
    float ss = 0.f;
#pragma unroll
    for (int j = 0; j < 16; ++j) ss += (r.v[j].x * r.v[j].x + r.v[j].y * r.v[j].y) + (r.v[j].z * r.v[j].z + r.v[j].w * r.v[j].w);
    const float rstd = rsqrtf(wave_sum(ss, lane) * (1.f / DM) + NORM_EPS);
#pragma unroll
    for (int j = 0; j < 16; ++j) { const f32x4 o = r.v[j] * rstd * g[j];
        if constexpr (TO_F32) ((f32x4*)((float*)dst + (size_t)row * DM) + lane)[64 * j] = o;
        else { v2u w; w.x = cvtpk(o.x, o.y); w.y = cvtpk(o.z, o.w); ((v2u*)((bf16*)dst + (size_t)row * DM) + lane)[64 * j] = w; } }
}
template <bool TO_F32>
__device__ __forceinline__ void rms_phase(const float* src, const float* gain, void* dst, int vcu, int G) {
    const int tid = opaque_tid(), lane = tid & 63, wave = tid >> 6;
    const int gw = vcu * NWAVES + wave, ngw = G * NWAVES;
    f32x4 g[16];
#pragma unroll
    for (int j = 0; j < 16; ++j) g[j] = ((const f32x4*)gain + lane)[64 * j];
    RowRegs ra, rb;
    if (gw < SEQ) row_load(src, gw, lane, ra);
    for (int row = gw; row < SEQ; row += 2 * ngw) {
        if (row + ngw < SEQ) row_load(src, row + ngw, lane, rb);
        rms_row<TO_F32>(ra, g, dst, row, lane);
        if (row + 2 * ngw < SEQ) row_load(src, row + 2 * ngw, lane, ra);
        if (row + ngw < SEQ) rms_row<TO_F32>(rb, g, dst, row + ngw, lane);
    }
}
__device__ __forceinline__ void rms0_row(const RowRegs& r, const f32x4 (&g)[16], bf16* dst, float* part, int row, int lane) {
    float ss = 0.f;
#pragma unroll
    for (int j = 0; j < 16; ++j) { const f32x4 v = r.v[j]; ss += (v.x * v.x + v.y * v.y) + (v.z * v.z + v.w * v.w); const f32x4 o = v * g[j];
        v2u w; w.x = cvtpk(o.x, o.y); w.y = cvtpk(o.z, o.w); *(v2u*)(dst + tiled_off((size_t)row, 4 * (lane + 64 * j), DM >> 6)) = w; }
    ss = wave_sum(ss, lane);
    part[(size_t)row * 64 + lane] = lane == 0 ? ss : 0.f;
}
__device__ __forceinline__ void rms0_phase(const float* src, const float* gain, bf16* dst, float* part, int vcu, int G) {
    const int tid = opaque_tid(), lane = tid & 63, wave = tid >> 6;
    const int gw = vcu * NWAVES + wave, ngw = G * NWAVES;
    f32x4 g[16];
#pragma unroll
    for (int j = 0; j < 16; ++j) g[j] = ((const f32x4*)gain + lane)[64 * j];
    RowRegs ra, rb;
    if (gw < SEQ) row_load(src, gw, lane, ra);
    for (int row = gw; row < SEQ; row += 2 * ngw) {
        if (row + ngw < SEQ) row_load(src, row + ngw, lane, rb);
        rms0_row(ra, g, dst, part, row, lane);
        if (row + 2 * ngw < SEQ) row_load(src, row + 2 * ngw, lane, ra);
        if (row + ngw < SEQ) rms0_row(rb, g, dst, part, row + ngw, lane);
    }
}
__device__ __forceinline__ void fz_phase(LAS unsigned char* lds, const bf16* XN, const bf16* WF, const float* part, const float* fbias, float* LOGF, float* CS, int vcu, int G) {
    const int tid = opaque_tid(), lane = tid & 63, wave = __builtin_amdgcn_readfirstlane(tid >> 6), r = lane & 15, q = lane >> 4, rt = wave & 3, kh = wave >> 2;
    LAS float* red = (LAS float*)lds;
    LAS float* csw = red + 4 * 8 * 64;
    for (int blk = vcu; blk < SEQ / 64; blk += G) {
        const int row0 = blk * 64 + 16 * rt;
        const size_t khoff = (size_t)kh * 32 * 32768;
        const char* pa = (const char*)(XN + tiled_off((size_t)(row0 + r), 8 * q, DM >> 6)) + khoff;
        const char* px = (const char*)(WF + tiled_off((size_t)(16384 + r), 8 * q, DM >> 6)) + khoff;
        const char* py = (const char*)(WF + tiled_off((size_t)(16384 + 16 + r), 8 * q, DM >> 6)) + khoff;
        f32x4 acc1 = {0.f, 0.f, 0.f, 0.f}, acc2 = {0.f, 0.f, 0.f, 0.f};
        bf16x8 A0[4], X0[4], Y0[4], A1[4], X1[4], Y1[4], A2[4], X2[4], Y2[4];
#define FZ_LOAD(A_, X_, Y_, b_) do { _Pragma("unroll") for (int s_ = 0; s_ < 4; ++s_) { const size_t o_ = (size_t)(2 * (b_) + (s_ >> 1)) * 32768 + (size_t)(s_ & 1) * 1024; \
            A_[s_] = *(const bf16x8*)(pa + o_); X_[s_] = *(const bf16x8*)(px + o_); Y_[s_] = *(const bf16x8*)(py + o_); } } while (0)
#define FZ_MMA(A_, X_, Y_) do { _Pragma("unroll") for (int s_ = 0; s_ < 4; ++s_) { acc1 = __builtin_amdgcn_mfma_f32_16x16x32_bf16(X_[s_], A_[s_], acc1, 0, 0, 0); acc2 = __builtin_amdgcn_mfma_f32_16x16x32_bf16(Y_[s_], A_[s_], acc2, 0, 0, 0); } } while (0)
        FZ_LOAD(A0, X0, Y0, 0); FZ_LOAD(A1, X1, Y1, 1);
#pragma unroll 1
        for (int b = 0; b < 15; b += 3) {
            FZ_LOAD(A2, X2, Y2, b + 2); FZ_MMA(A0, X0, Y0);
            FZ_LOAD(A0, X0, Y0, b + 3); FZ_MMA(A1, X1, Y1);
            if (b + 4 < 16) FZ_LOAD(A1, X1, Y1, b + 4);
            FZ_MMA(A2, X2, Y2);
        }
        FZ_MMA(A0, X0, Y0);
#undef FZ_LOAD
#undef FZ_MMA
        if (kh == 1) {
#pragma unroll
            for (int i = 0; i < 4; ++i) { red[(rt * 8 + i) * 64 + lane] = acc1[i]; red[(rt * 8 + 4 + i) * 64 + lane] = acc2[i]; } }
        __syncthreads();
        if (kh == 0) {
#pragma unroll
            for (int i = 0; i < 4; ++i) { acc1[i] += red[(rt * 8 + i) * 64 + lane]; acc2[i] += red[(rt * 8 + 4 + i) * 64 + lane]; }
            const f32x4* pp = (const f32x4*)(part + (size_t)(row0 + r) * 64 + 16 * q);
            const f32x4 a = (pp[0] + pp[1]) + (pp[2] + pp[3]); float ssq = (a.x + a.y) + (a.z + a.w); ssq += shx(ssq, 16, lane); ssq += shx(ssq, 32, lane);
            const float rs = rsqrtf(ssq * (1.f / DM) + NORM_EPS);
            const f32x4 b0 = *(const f32x4*)(fbias + 8 * q), b1 = *(const f32x4*)(fbias + 8 * q + 4);
            f32x4 v0 = acc1 * rs + b0, v1 = acc2 * rs + b1;
#pragma unroll
            for (int jj = 0; jj < 4; ++jj) { v0[jj] = pg8::lsig(v0[jj]); v1[jj] = pg8::lsig(v1[jj]); }
            float* rowp = LOGF + (size_t)(row0 + r) * 32 + 8 * q; *(f32x4*)rowp = v0; *(f32x4*)(rowp + 4) = v1;
#pragma unroll
            for (int jj = 0; jj < 4; ++jj) {
#pragma unroll
                for (int o = 1; o < 16; o <<= 1) { v0[jj] += shx(v0[jj], o, lane); v1[jj] += shx(v1[jj], o, lane); } }
            if (r == 0) { *(LAS f32x4*)(csw + rt * 32 + 8 * q) = v0; *(LAS f32x4*)(csw + rt * 32 + 8 * q + 4) = v1; }
        }
        __syncthreads();
        if (tid < 32) CS[(size_t)blk * 32 + tid] = (csw[tid] + csw[32 + tid]) + (csw[64 + tid] + csw[96 + tid]);
        __syncthreads();
    }
}
__device__ __forceinline__ void rstd_table(LAS float* tab, const float* part, int pm0) {
    const int tid = opaque_tid(), lane = tid & 63, row = tid >> 1, half = tid & 1;
    const f32x4* p = (const f32x4*)(part + (size_t)(pm0 * 256 + row) * 64 + half * 32); f32x4 a = {0.f, 0.f, 0.f, 0.f};
#pragma unroll
    for (int i = 0; i < 8; ++i) a += p[i];
    float s = (a.x + a.y) + (a.z + a.w); s += shx(s, 1, lane);
    if (half == 0) tab[row] = rsqrtf(s * (1.f / DM) + NORM_EPS);
    __syncthreads();
}
__device__ __forceinline__ void fox_thin_phase(LAS unsigned char* lds, const float* LOGF, const float* CS, float* KB, int vcu, int G) {
    const int tid = opaque_tid(), lane = tid & 63, wave = tid >> 6;
    LAS float* red = (LAS float*)lds;
    LAS float* pre = red + 16 * 32;
    LAS float* tile = pre + 32;
    for (int blk = vcu; blk < SEQ / 64; blk += G) {
        const int r0 = blk * 64;
        { const int h = tid & 31, part = tid >> 5; float a = 0.f;
#pragma unroll 4
          for (int c = part; c < blk; c += 16) a += CS[c * 32 + h];
          red[part * 32 + h] = a; }
        { const int row = tid >> 3, c4 = tid & 7; const f32x4 v = *(const f32x4*)(LOGF + (size_t)(r0 + row) * 32 + 4 * c4);
          tile[row * 33 + 4 * c4 + 0] = v.x; tile[row * 33 + 4 * c4 + 1] = v.y; tile[row * 33 + 4 * c4 + 2] = v.z; tile[row * 33 + 4 * c4 + 3] = v.w; }
        __syncthreads();
        if (tid < 32) { float s = 0.f;
#pragma unroll
            for (int p = 0; p < 16; ++p) s += red[p * 32 + tid];
            float c = s;
            for (int r = 0; r < 64; ++r) { c += tile[r * 33 + tid]; tile[r * 33 + tid] = -c * LOG2E; } }
        __syncthreads();
        { const int h = tid >> 4, r4 = (tid & 15) * 4;
          const f32x4 o = {tile[(r4 + 0) * 33 + h], tile[(r4 + 1) * 33 + h], tile[(r4 + 2) * 33 + h], tile[(r4 + 3) * 33 + h]};
          *(f32x4*)(KB + (size_t)h * SEQ + r0 + r4) = o; }
        __syncthreads();
    }
}
__device__ __forceinline__ void jl_phase(LAS unsigned char* lds, const float* KB, const float* qg, const float* kg, int* JL, int vcu, int G) {
    const int tid = opaque_tid(), lane = tid & 63, wave = tid >> 6;
    LAS int* cnt = (LAS int*)lds;
    float gq = fmaxf(fabsf(qg[lane]), fabsf(qg[lane + 64])), gk = fmaxf(fabsf(kg[lane]), fabsf(kg[lane + 64]));
#pragma unroll
    for (int o = 1; o < 64; o <<= 1) { gq = fmaxf(gq, shx(gq, o, lane)); gk = fmaxf(gk, shx(gk, o, lane)); }
    const float TH = 48.f + 2.f * (128.f * gq * gk * QSCALE * 1.02f);
    for (int id = vcu; id < 2048; id += G) {
        const int h = id & 31, qb = 63 - (id >> 5);
        const float* kb = KB + (size_t)h * SEQ;
        const float lim = kb[qb * 256] - TH;
        const bool pred = (tid < 4 * qb) && (kb[64 * tid + 63] < lim);
        const unsigned long long bal = __ballot(pred);
        if (lane == 0) cnt[wave] = __popcll(bal);
        __syncthreads();
        if (tid == 0) { int s = 0; for (int w = 0; w < 8; ++w) s += cnt[w]; JL[id] = s; }
        __syncthreads();
    }
}
namespace fa {
constexpr int D = 128, NW = 8, QBLK = 32, KVBLK = 64, QB = NW * QBLK;
constexpr int LDQ = 128, LDO = 4096;
constexpr int SHM_V = KVBLK * D * 2, SHM_K = KVBLK * D * 2;
constexpr int OFF_WS = 2 * SHM_V + 2 * SHM_K, OFF_KB = OFF_WS + NW * 64 * 4;
constexpr int LDS_BYTES = OFF_KB + 2 * 64 * 4;
constexpr int OFF_OST = LDS_BYTES + 16 + 112;
constexpr int LDS_END = OFF_OST + NW * 8 * 132 * 4;
#define KSWZ(row, colB) ((row) * 256 + ((colB) ^ (((row) & 7) << 4)))
#define SBAR() __builtin_amdgcn_sched_barrier(0)
__device__ __forceinline__ int v_st(int k, int c) { const int kk = (k & ~0xC) | ((k & 4) << 1) | ((k & 8) >> 1); return ((kk >> 3) * 4 + (c >> 5)) * 512 + ((kk & 7) * 32 + (c & 31)) * 2; }
__device__ __forceinline__ int v_rd_base(int lane) { return ((lane & 3) << 3) | (((lane >> 2) & 3) << 6) | (((lane >> 4) & 1) << 5) | (((lane >> 5) & 1) << 8); }
constexpr int v_rd_off(int d0, int ks, int half) { return d0 * 512 + ks * 4096 + half * 2048; }
__device__ __forceinline__ int crow(int r, int hi) { return (r & 3) + 8 * (r >> 2) + 4 * hi; }
__device__ __forceinline__ bf16x8 ld8(const bf16* p) { return *reinterpret_cast<const bf16x8*>(p); }
__device__ __forceinline__ void mask_tile(f32x16& p0, f32x16& p1, int dq) {
    const float NEG = -__builtin_inff();
#pragma unroll
    for (int r = 0; r < 16; ++r) {
        const int c = (r & 3) + 8 * (r >> 2);
        if (dq - c < 0) p0[r] = NEG;
        if (dq - c - 32 < 0) p1[r] = NEG;
    }
}
__device__ __forceinline__ void partialSM(f32x16& p0, f32x16& p1, float mt) {
#pragma unroll
    for (int r = 0; r < 16; ++r) p0[r] = __builtin_amdgcn_exp2f(p0[r] - mt);
#pragma unroll
    for (int r = 0; r < 16; ++r) p1[r] = p1[r] - mt;
}
__device__ __forceinline__ void finishSM(f32x16& p0, f32x16& p1, float& l_reg, bf16x8& pa0, bf16x8& pa1, bf16x8& pa2, bf16x8& pa3) {
#pragma unroll
    for (int r = 0; r < 16; ++r) p1[r] = __builtin_amdgcn_exp2f(p1[r]);
    float ps = 0;
#pragma unroll
    for (int r = 0; r < 16; ++r) ps += p0[r];
#pragma unroll
    for (int r = 0; r < 16; ++r) ps += p1[r];
    { auto rr = __builtin_amdgcn_permlane32_swap(__float_as_uint(ps), __float_as_uint(ps), false, false);
      ps = __uint_as_float(rr[0]) + __uint_as_float(rr[1]); }
    l_reg += ps;
#define PK4(P, B_, OUT) do { unsigned a0 = cvtpk(P[B_+0], P[B_+1]), a1 = cvtpk(P[B_+2], P[B_+3]);                          \
        unsigned b0 = cvtpk(P[B_+4], P[B_+5]), b1 = cvtpk(P[B_+6], P[B_+7]);                                             \
        auto r0 = __builtin_amdgcn_permlane32_swap(a0, b0, false, false); auto r1 = __builtin_amdgcn_permlane32_swap(a1, b1, false, false); \
        v4u w = {r0[0], r1[0], r0[1], r1[1]}; OUT = *reinterpret_cast<bf16x8*>(&w); } while (0)
    PK4(p0, 0, pa0); PK4(p0, 8, pa1); PK4(p1, 0, pa2); PK4(p1, 8, pa3);
#undef PK4
}
template <int KB>
__device__ __forceinline__ void qkt(f32x16& p0, f32x16& p1, const char* K_lds, const float* kbl, int r32, int hi, const bf16x8* qr) {
#ifdef X_NOBIAS
    p0 = f32x16{}; p1 = f32x16{};
#else
    { const float* kb = kbl + KB * 64 + 4 * hi;
      const f32x4 a0 = *(const f32x4*)(kb), a1 = *(const f32x4*)(kb + 8), a2 = *(const f32x4*)(kb + 16), a3 = *(const f32x4*)(kb + 24);
      const f32x4 b0 = *(const f32x4*)(kb + 32), b1 = *(const f32x4*)(kb + 40), b2 = *(const f32x4*)(kb + 48), b3 = *(const f32x4*)(kb + 56);
      p0 = f32x16{a0[0], a0[1], a0[2], a0[3], a1[0], a1[1], a1[2], a1[3], a2[0], a2[1], a2[2], a2[3], a3[0], a3[1], a3[2], a3[3]};
      p1 = f32x16{b0[0], b0[1], b0[2], b0[3], b1[0], b1[1], b1[2], b1[3], b2[0], b2[1], b2[2], b2[3], b3[0], b3[1], b3[2], b3[3]}; }
#endif
    const char* kb4[4];
#pragma unroll
    for (int dd = 0; dd < 4; ++dd) kb4[dd] = K_lds + KB * SHM_K + KSWZ(r32, (dd * 16 + hi * 8) * 2);
#pragma unroll
    for (int d0 = 0; d0 < 8; ++d0) { const char* a = kb4[d0 & 3] + (d0 >> 2) * 128;
        bf16x8 b0 = *reinterpret_cast<const bf16x8*>(a);
        bf16x8 b1 = *reinterpret_cast<const bf16x8*>(a + 32 * 256);
        p0 = __builtin_amdgcn_mfma_f32_32x32x16_bf16(b0, qr[d0], p0, 0, 0, 0);
        p1 = __builtin_amdgcn_mfma_f32_32x32x16_bf16(b1, qr[d0], p1, 0, 0, 0); }
}
template <int VB>
__device__ __forceinline__ void pv_tile(f32x16* o, int vb0, bf16x8 pa0, bf16x8 pa1, bf16x8 pa2, bf16x8 pa3) {
#define TRRD(dst, off) asm volatile("ds_read_b64_tr_b16 %0, %1 offset:%2" : "=&v"(dst) : "v"(vb0), "i"(off) : "memory")
#define PV_D0(d0) do { s16x4 l0, l1, l2, l3, h0, h1, h2, h3; constexpr int b_ = VB * SHM_V + v_rd_off(d0, 0, 0); \
        TRRD(l0, b_); TRRD(h0, b_ + 2048); TRRD(l1, b_ + 4096); TRRD(h1, b_ + 6144); TRRD(l2, b_ + 8192); TRRD(h2, b_ + 10240); TRRD(l3, b_ + 12288); TRRD(h3, b_ + 14336); \
        asm volatile("s_waitcnt lgkmcnt(0)" ::: "memory"); SBAR();   \
        o[d0] = __builtin_amdgcn_mfma_f32_32x32x16_bf16(pa0, (bf16x8){l0[0], l0[1], l0[2], l0[3], h0[0], h0[1], h0[2], h0[3]}, o[d0], 0, 0, 0);   \
        o[d0] = __builtin_amdgcn_mfma_f32_32x32x16_bf16(pa1, (bf16x8){l1[0], l1[1], l1[2], l1[3], h1[0], h1[1], h1[2], h1[3]}, o[d0], 0, 0, 0);   \
        o[d0] = __builtin_amdgcn_mfma_f32_32x32x16_bf16(pa2, (bf16x8){l2[0], l2[1], l2[2], l2[3], h2[0], h2[1], h2[2], h2[3]}, o[d0], 0, 0, 0);   \
        o[d0] = __builtin_amdgcn_mfma_f32_32x32x16_bf16(pa3, (bf16x8){l3[0], l3[1], l3[2], l3[3], h3[0], h3[1], h3[2], h3[3]}, o[d0], 0, 0, 0); } while (0)
    PV_D0(0); PV_D0(1); PV_D0(2); PV_D0(3);
#undef PV_D0
#undef TRRD
}
struct BlockRef { const bf16* Q; const bf16* K; const bf16* V; const float* KBp; const bf16* G; bf16* O; int P0; int j0; int hcol; };
struct Seam { bf16x8 qr[8]; bf16x8 st_v0, st_v1, st_k0, st_k1; float st_b; };
#define ROWP(p, k0, rr) ((const char*)(p) + (size_t)((k0) + (rr)) * (LDQ * 2))
#define LD8V(base, off) (*reinterpret_cast<const bf16x8*>((base) + (off)))
#define VMW() asm volatile("s_waitcnt vmcnt(0)" ::: "memory")
#define VMWN(n) asm volatile("s_waitcnt vmcnt(%0)" :: "i"(n) : "memory")
#define SLOAD_H(Kp, Vp, Bp, k0) do { S.st_v0 = LD8V(ROWP(Vp, k0, 0), voff); S.st_v1 = LD8V(ROWP(Vp, k0, 32), voff);              \
                         S.st_k0 = LD8V(ROWP(Kp, k0, 0), voff); S.st_k1 = LD8V(ROWP(Kp, k0, 32), voff); \
                         if (tid < 64) S.st_b = *(const float*)((const char*)((Bp) + (k0)) + (unsigned)(tid * 4)); } while (0)
#define SWRITE_HK(bf) do { *(bf16x8*)(K_lds + (bf) * SHM_K + kws) = S.st_k0; *(bf16x8*)(K_lds + (bf) * SHM_K + kws + 32 * 256) = S.st_k1; if (tid < 64) kbl[(bf) * 64 + tid] = S.st_b; } while (0)
#define SWRITE_HV(bf) do { *(bf16x8*)(V_lds + (bf) * SHM_V + vst0) = S.st_v0; *(bf16x8*)(V_lds + (bf) * SHM_V + vst1) = S.st_v1; } while (0)
#define SWRITE_H(bf) do { SWRITE_HV(bf); SWRITE_HK(bf); } while (0)
__device__ __forceinline__ void fox_prime(const BlockRef& cur, char* lds, Seam& S) {
    const int tid = opaque_tid(), wid = __builtin_amdgcn_readfirstlane(tid >> 6), lane = tid & 63, r32 = lane & 31, hi = lane >> 5;
    const int sr = tid >> 4, sc = (tid & 15) * 8, kws = KSWZ(sr, sc * 2); char* K_lds = lds + 2 * SHM_V; float* kbl = (float*)(lds + OFF_KB);
    const unsigned voff = (unsigned)(sr * LDQ + sc) * 2u, qoff = (unsigned)(r32 * LDQ + hi * 8) * 2u;
    { const char* qb_ = (const char*)(cur.Q + (size_t)(wid * QBLK) * LDQ);
#pragma unroll
      for (int d0 = 0; d0 < 8; ++d0) S.qr[d0] = LD8V(qb_ + d0 * 32, qoff); }
    SLOAD_H(cur.K, cur.V, cur.KBp, cur.j0 * KVBLK); VMW(); SWRITE_HK(0);
    __syncthreads();
}
__device__ __forceinline__ void fox_block(const BlockRef& cur, const BlockRef& nxt, char* lds, Seam& S, float Bq) {
    const int tid = opaque_tid(), wid = __builtin_amdgcn_readfirstlane(tid >> 6), lane = tid & 63, r32 = lane & 31, hi = lane >> 5;
    const int j_lo = cur.j0, NT = (cur.P0 + QB - 1) / KVBLK + 1 - j_lo;
    const int qlo = cur.P0 + wid * QBLK, qm = qlo + r32 - 4 * hi;
    char* V_lds = lds; char* K_lds = lds + 2 * SHM_V; float* kbl = (float*)(lds + OFF_KB);
    float* ws = (float*)(lds + OFF_WS) + wid * 64; float* li_l = ws;
    float l_reg = 0; f32x16 o[4] = {};
    const float mt = cur.KBp[qlo + r32] + Bq;
    const int sr = tid >> 4, sc = (tid & 15) * 8, vst0 = v_st(sr, sc), vst1 = v_st(32 + sr, sc), kws = KSWZ(sr, sc * 2);
    const unsigned voff = (unsigned)(sr * LDQ + sc) * 2u;
    const int vb0 = (int)(uintptr_t)V_lds + v_rd_base(lane);
    const bf16* Kh = cur.K; const bf16* Vh = cur.V; const float* Bh = cur.KBp;
#define KBASE(t) ((j_lo + (t)) * KVBLK)
#define MASKT(P0_, P1_, t) do { const int kb_ = KBASE(t); if (kb_ + KVBLK - 1 > qlo) mask_tile(P0_, P1_, qm - kb_); } while (0)
    constexpr int NQL = 8;
#define SEAM_K0() do { VMWN(NQL); SWRITE_HK(0); SBAR(); } while (0)
    f32x16 pA0, pA1, pB0, pB1; bf16x8 pa0, pa1, pa2, pa3;
    SWRITE_HV(0); SBAR();
    if (NT > 1) { SLOAD_H(Kh, Vh, Bh, KBASE(1)); }
    SBAR(); qkt<0>(pA0, pA1, K_lds, kbl, r32, hi, S.qr);
    MASKT(pA0, pA1, 0); partialSM(pA0, pA1, mt);
    if (NT > 1) { VMW(); SWRITE_H(1); }
    __syncthreads();
#define HALF_STEP(PX0, PX1, PY0, PY1, t, KB, VB, SB) do {                                                      \
        if ((t) + 1 < NT) { SLOAD_H(Kh, Vh, Bh, KBASE((t) + 1)); }        \
        SBAR(); qkt<KB>(PX0, PX1, K_lds, kbl, r32, hi, S.qr);                                             \
        finishSM(PY0, PY1, l_reg, pa0, pa1, pa2, pa3); SBAR();                                                           \
        pv_tile<VB>(o, vb0, pa0, pa1, pa2, pa3); MASKT(PX0, PX1, (t)); partialSM(PX0, PX1, mt);                                        \
        __syncthreads();                                                                                                      \
        if ((t) + 1 < NT) { VMW(); SWRITE_H(SB); }                                                                          \
        __syncthreads(); } while (0)
    for (int t = 1; t + 1 < NT; t += 2) {
        HALF_STEP(pB0, pB1, pA0, pA1, t, 1, 0, 0);
        HALF_STEP(pA0, pA1, pB0, pB1, t + 1, 0, 1, 1);
    }
    const bool even = (NT & 1) == 0;
    if (even) { SBAR(); qkt<1>(pB0, pB1, K_lds, kbl, r32, hi, S.qr); SBAR(); }
    SLOAD_H(nxt.K, nxt.V, nxt.KBp, nxt.j0 * KVBLK); SBAR();
    { const int l2 = opaque_tid() & 63; const unsigned qoff = (unsigned)((l2 & 31) * LDQ + (l2 >> 5) * 8) * 2u;
      const char* qb_ = (const char*)(nxt.Q + (size_t)(wid * QBLK) * LDQ);
#pragma unroll
      for (int d0 = 0; d0 < 8; ++d0) S.qr[d0] = LD8V(qb_ + d0 * 32, qoff); }
    SBAR();
    finishSM(pA0, pA1, l_reg, pa0, pa1, pa2, pa3); SBAR();
    pv_tile<0>(o, vb0, pa0, pa1, pa2, pa3);
    if (even) { MASKT(pB0, pB1, NT - 1); partialSM(pB0, pB1, mt); __syncthreads();
        finishSM(pB0, pB1, l_reg, pa0, pa1, pa2, pa3); SBAR(); pv_tile<1>(o, vb0, pa0, pa1, pa2, pa3); }
    SBAR(); SEAM_K0();
    if (hi == 0) li_l[r32] = l_reg; asm volatile("s_waitcnt lgkmcnt(0)" ::: "memory");
    { const int l3 = opaque_tid() & 63, er = l3 >> 4, ec = l3 & 15;
      const bf16* Gp = cur.G + (size_t)(wid * QBLK + er) * LDQ + 8 * ec;
      bf16* Op = cur.O; const size_t orow0 = (size_t)(cur.P0 + wid * QBLK + er); const int ocol = cur.hcol + 8 * ec;
      v4u gt[4][2];
#pragma unroll
      for (int ps = 0; ps < 4; ++ps)
#pragma unroll
          for (int k = 0; k < 2; ++k) gt[ps][k] = *(const v4u*)(Gp + (size_t)(8 * ps + 4 * k) * LDQ);
      float* ost = (float*)(lds + OFF_OST) + wid * (8 * 132);
      const int wofs = (4 * (l3 >> 5)) * 132 + (l3 & 31);
#pragma unroll
      for (int ps = 0; ps < 4; ++ps) {
#pragma unroll
          for (int rr = 0; rr < 4; ++rr) { const int r = 4 * ps + rr; const float rl = __builtin_amdgcn_rcpf(li_l[crow(r, hi)]);
#pragma unroll
              for (int d0 = 0; d0 < 4; ++d0) ost[wofs + rr * 132 + d0 * 32] = o[d0][r] * rl; }
          asm volatile("s_waitcnt lgkmcnt(0)" ::: "memory");
#pragma unroll
          for (int k = 0; k < 2; ++k) { const float* sp = ost + (er + 4 * k) * 132 + 8 * ec; const f32x4 x0 = *(const f32x4*)sp, x1 = *(const f32x4*)(sp + 4); const v4u g = gt[ps][k];
              v4u w; w.x = cvtpk(x0[0] * bflo(g.x), x0[1] * bfhi(g.x)); w.y = cvtpk(x0[2] * bflo(g.y), x0[3] * bfhi(g.y)); w.z = cvtpk(x1[0] * bflo(g.z), x1[1] * bfhi(g.z)); w.w = cvtpk(x1[2] * bflo(g.w), x1[3] * bfhi(g.w));
              *(v4u*)(Op + tiled_off(orow0 + 8 * ps + 4 * k, ocol, LDO >> 6)) = w; }
          asm volatile("s_waitcnt lgkmcnt(0)" ::: "memory"); } }
    __syncthreads();
#undef KBASE
#undef MASKT
#undef SEAM_K0
#undef HALF_STEP
}
__device__ __forceinline__ void fox_rewrite_k0(char* lds, const Seam& S) {
    const int tid = opaque_tid(); const int sr = tid >> 4, sc = (tid & 15) * 8, kws = KSWZ(sr, sc * 2); char* K_lds = lds + 2 * SHM_V; float* kbl = (float*)(lds + OFF_KB);
    SWRITE_HK(0); __syncthreads();
}
#undef ROWP
#undef LD8V
#undef VMWN
#undef SLOAD_H
#undef SWRITE_HK
#undef SWRITE_HV
#undef SWRITE_H
__device__ __forceinline__ BlockRef mk_ref(const bf16* PROJ, const float* KBg, bf16* MO, const int* JL, int id) {
    const int bh = id & 31, qb = 63 - (id >> 5);
    BlockRef r; r.Q = PROJ + ((size_t)bh * SEQ + qb * QB) * D; r.K = PROJ + ((size_t)(32 + bh) * SEQ) * D; r.V = PROJ + ((size_t)(64 + bh) * SEQ) * D; r.KBp = KBg + (size_t)bh * SEQ;
    r.G = PROJ + ((size_t)(96 + bh) * SEQ + qb * QB) * D; r.O = MO; r.hcol = bh * D; r.P0 = qb * QB; r.j0 = JL[id]; return r;
}
__device__ __forceinline__ void attn_phase(char* lds, const bf16* PROJ, const float* KBg, bf16* MO, const int* JL, unsigned* qctr, const float* qg, const float* kg, unsigned char* ws, const ConvArgs& ca, int qbase, int nchunks, int vcu, int G) {
    constexpr int total = 32 * 64;
    const int tid = opaque_tid();
    float Bq;
    { const int l_ = tid & 63; float gq = fmaxf(fabsf(qg[l_]), fabsf(qg[l_ + 64])), gk = fmaxf(fabsf(kg[l_]), fabsf(kg[l_ + 64]));
#pragma unroll
      for (int o_ = 1; o_ < 64; o_ <<= 1) { gq = fmaxf(gq, shx(gq, o_, l_)); gk = fmaxf(gk, shx(gk, o_, l_)); }
      Bq = 128.f * gq * gk * QSCALE * 1.02f; }
    volatile int* slot = (volatile int*)(lds + LDS_BYTES);
    if (tid == 0) slot[0] = (int)__hip_atomic_fetch_add((GAS unsigned*)qctr, 1u, __ATOMIC_RELAXED, __HIP_MEMORY_SCOPE_AGENT);
    __syncthreads();
    int id = __builtin_amdgcn_readfirstlane(slot[0]);
    int cc = 0;
    if (id < total) {
        BlockRef cur = mk_ref(PROJ, KBg, MO, JL, id);
        Seam S;
        fox_prime(cur, lds, S);
        for (;;) {
            if (tid == 0) slot[1] = (int)__hip_atomic_fetch_add((GAS unsigned*)qctr, 1u, __ATOMIC_RELAXED, __HIP_MEMORY_SCOPE_AGENT);
            __syncthreads();
            const int idn = __builtin_amdgcn_readfirstlane(slot[1]);
            const bool last = idn >= total;
            const BlockRef nxt = last ? cur : mk_ref(PROJ, KBg, MO, JL, idn);
            fox_block(cur, nxt, lds, S, Bq);
            if (last) break;
            cur = nxt;
            if (cc < nchunks) { __syncthreads(); conv_chunk((LAS unsigned char*)lds, ws, ca, qbase, cc, vcu, G); ++cc; fox_rewrite_k0(lds, S); }
        }
    }
    __syncthreads();
    for (; cc < nchunks; ++cc) conv_chunk((LAS unsigned char*)lds, ws, ca, qbase, cc, vcu, G);
}
#undef VMW
}
namespace hg {
constexpr int CH = 64, NCH = SEQ / CH;
constexpr size_t AOFF = (size_t)32 * SEQ * DH / 2;
constexpr int PK = 144;
constexpr int PQ = 272;
__device__ __forceinline__ f32x4 mma(bf16x8 bfrag, bf16x8 afrag, f32x4 acc) { return __builtin_amdgcn_mfma_f32_16x16x32_bf16(bfrag, afrag, acc, 0, 0, 0); }
__device__ __forceinline__ bf16x8 ldsfrag(const LAS unsigned char* base, int row, int pitch, int kbyte) { return *(const LAS bf16x8*)(base + row * pitch + kbyte); }

typedef float f32x2 __attribute__((ext_vector_type(2)));
typedef _Float16 f16x2 __attribute__((ext_vector_type(2)));
__device__ __forceinline__ float ex2(float x) { return __builtin_amdgcn_exp2f(x); }
__device__ __forceinline__ unsigned ldg2(const _Float16* p) { return *(const unsigned*)p; }
__device__ __forceinline__ f32x2 h2f(unsigned w) { const f16x2 h = __builtin_bit_cast(f16x2, w); return (f32x2){(float)h[0], (float)h[1]}; }
__device__ __forceinline__ void b1_phase(LAS unsigned char* lds, const bf16* PROJ, const _Float16* Gg, bf16* UT, float* DEC, int vcu, int G) {
    const int tid = opaque_tid(), lane = tid & 63, wave = __builtin_amdgcn_readfirstlane(tid >> 6), cp = tid & 63, seg = wave, r = lane & 15, q = lane >> 4;
    LAS unsigned char* KT = lds;
    LAS unsigned char* VT = lds + 128 * PK;
    LAS float* segtot = (LAS float*)(lds + 2 * 128 * PK);
    unsigned nb[8], nk[8], nv[8];
#define B1_LOAD(u_) do { const int c_ = (u_) >> 5, h_ = (u_) & 31; const int rw_ = c_ * CH + 8 * seg; \
        _Pragma("unroll") for (int j = 0; j < 8; ++j) { nb[j] = ldg2(Gg + ((size_t)h_ * SEQ + rw_ + j) * DH + 2 * cp); const unsigned* p_ = (const unsigned*)(PROJ + (((size_t)32 + h_) * SEQ + rw_ + j) * DH + 2 * cp); nk[j] = p_[0]; nv[j] = p_[AOFF]; } } while (0)
    if (vcu < NCH * NH) B1_LOAD(NCH * NH - 1 - vcu);
    for (int it = vcu; it < NCH * NH; it += G) {
        const int u = NCH * NH - 1 - it;
        f32x2 b[8]; unsigned kk[8], vv[8];
#pragma unroll
        for (int j = 0; j < 8; ++j) { b[j] = h2f(nb[j]); kk[j] = nk[j]; vv[j] = nv[j]; }
#pragma unroll
        for (int j = 1; j < 8; ++j) b[j] += b[j - 1];
        *(LAS f32x2*)(segtot + seg * 128 + 2 * cp) = b[7];
        __syncthreads();
        f32x2 off = {0.f, 0.f}, total = {0.f, 0.f};
#pragma unroll
        for (int s2 = 0; s2 < 8; ++s2) { const f32x2 t = *(const LAS f32x2*)(segtot + s2 * 128 + 2 * cp); total += t; if (s2 < seg) off += t; }
        const f32x2 rem = total - off;
        unsigned k0w[4], k1w[4], v0w[4], v1w[4];
#pragma unroll
        for (int i = 0; i < 4; ++i) { const int ja = 2 * i, jb = 2 * i + 1;
            k0w[i] = cvtpk(bflo(kk[ja]) * ex2(rem.x - b[ja].x), bflo(kk[jb]) * ex2(rem.x - b[jb].x)); k1w[i] = cvtpk(bfhi(kk[ja]) * ex2(rem.y - b[ja].y), bfhi(kk[jb]) * ex2(rem.y - b[jb].y));
            v0w[i] = (vv[ja] & 0xffffu) | (vv[jb] << 16); v1w[i] = (vv[ja] >> 16) | (vv[jb] & 0xffff0000u); }
        *(LAS v4u*)(KT + (2 * cp) * PK + 16 * seg) = (v4u){k0w[0], k0w[1], k0w[2], k0w[3]}; *(LAS v4u*)(KT + (2 * cp + 1) * PK + 16 * seg) = (v4u){k1w[0], k1w[1], k1w[2], k1w[3]};
        *(LAS v4u*)(VT + (2 * cp) * PK + 16 * seg) = (v4u){v0w[0], v0w[1], v0w[2], v0w[3]}; *(LAS v4u*)(VT + (2 * cp + 1) * PK + 16 * seg) = (v4u){v1w[0], v1w[1], v1w[2], v1w[3]};
        if (seg == 0) *(f32x2*)(DEC + (size_t)u * 128 + 2 * cp) = (f32x2){ex2(total.x), ex2(total.y)};
        if (u - G >= 0) B1_LOAD(u - G);
        __syncthreads();
        const bf16x8 a0 = ldsfrag(VT, 16 * wave + r, PK, 16 * q), a1 = ldsfrag(VT, 16 * wave + r, PK, 64 + 16 * q);
        bf16* up = UT + ((size_t)u * 128 + 16 * wave + r) * 128 + 4 * q;
#pragma unroll
        for (int nt = 0; nt < 8; ++nt) { f32x4 acc = {0.f, 0.f, 0.f, 0.f};
            acc = mma(ldsfrag(KT, 16 * nt + r, PK, 16 * q), a0, acc); acc = mma(ldsfrag(KT, 16 * nt + r, PK, 64 + 16 * q), a1, acc);
            v2u w; w.x = cvtpk(acc[0], acc[1]); w.y = cvtpk(acc[2], acc[3]); *(v2u*)(up + 16 * nt) = w; }
    }
#undef B1_LOAD
}
__device__ __forceinline__ void b2_phase(const bf16* UT, const float* DEC, bf16* ST, int vcu, int G) {
    constexpr int BT = 8;
    for (int gid = vcu * 512 + opaque_tid(); gid < NH * 128 * 32; gid += G * 512) {
        const int h = gid >> 12, dv = (gid >> 5) & 127, dk4 = (gid & 31) * 4;
        f32x4 st = {0.f, 0.f, 0.f, 0.f};
        const size_t eo = ((size_t)h * 128 + dv) * 128 + dk4, estep = (size_t)NH * 128 * 128;
        const size_t dofs = (size_t)h * 128 + dk4, dstep = (size_t)NH * 128;
        v2u uwa[BT], uwb[BT]; f32x4 dda[BT], ddb[BT];
#define B2_LOAD(uw_, dd_, c0_) do { _Pragma("unroll") for (int i = 0; i < BT; ++i) { uw_[i] = *(const v2u*)(UT + eo + (size_t)((c0_) + i) * estep); dd_[i] = *(const f32x4*)(DEC + dofs + (size_t)((c0_) + i) * dstep); } } while (0)
#define B2_RUN(uw_, dd_, c0_) do { _Pragma("unroll") for (int i = 0; i < BT; ++i) { const f32x4 uu = {bflo(uw_[i].x), bfhi(uw_[i].x), bflo(uw_[i].y), bfhi(uw_[i].y)}; \
            v2u w; w.x = cvtpk(st.x, st.y); w.y = cvtpk(st.z, st.w); *(v2u*)(ST + eo + (size_t)((c0_) + i) * estep) = w; st = dd_[i] * st + uu; } } while (0)
        B2_LOAD(uwa, dda, 0);
        for (int c = 0; c < NCH; c += 2 * BT) {
            B2_LOAD(uwb, ddb, c + BT);
            B2_RUN(uwa, dda, c);
            if (c + 2 * BT < NCH) B2_LOAD(uwa, dda, c + 2 * BT);
            B2_RUN(uwb, ddb, c + BT);
        }
#undef B2_LOAD
#undef B2_RUN
    }
}
constexpr int B3_QT = 0, B3_QH = B3_QT + 64 * PQ, B3_KH = B3_QH + 64 * PQ  , B3_VT = B3_KH + 160 * PQ, B3_P = B3_VT + 128 * PK, B3_SEG = B3_P + 64 * PK, B3_RS = B3_SEG + 4096, B3_END = B3_RS + 512;
__device__ __forceinline__ int kh_base(int I) { return 16 * (I * (I + 1) / 2); }
__device__ __forceinline__ void b3_phase(LAS unsigned char* lds, const bf16* PROJ, const _Float16* Gg, const bf16* ST, const float* ogain, bf16* MO, int vcu, int G) {
    const int tid = opaque_tid(), lane = tid & 63, wave = __builtin_amdgcn_readfirstlane(tid >> 6), cp = tid & 63, seg = wave, r = lane & 15, q = lane >> 4;
    LAS unsigned char* QT = lds + B3_QT; LAS unsigned char* QH = lds + B3_QH; LAS unsigned char* KH = lds + B3_KH; LAS unsigned char* VT = lds + B3_VT; LAS unsigned char* PP = lds + B3_P;
    LAS float* segtot = (LAS float*)(lds + B3_SEG); LAS float* rs = (LAS float*)(lds + B3_RS);
    unsigned nb[8], nq[8], nk[8], nv[8];
#define B3_LOAD(u_) do { const int c_ = (u_) >> 5, h_ = (u_) & 31; const int rw_ = c_ * CH + 8 * seg; \
        _Pragma("unroll") for (int j = 0; j < 8; ++j) { nb[j] = ldg2(Gg + ((size_t)h_ * SEQ + rw_ + j) * DH + 2 * cp); const unsigned* p_ = (const unsigned*)(PROJ + ((size_t)h_ * SEQ + rw_ + j) * DH + 2 * cp); nq[j] = p_[0]; nk[j] = p_[AOFF]; nv[j] = p_[2 * AOFF]; } } while (0)
    f32x4 og[4];
#pragma unroll
    for (int nt = 0; nt < 4; ++nt) og[nt] = *(const f32x4*)(ogain + 64 * (wave >> 2) + 16 * nt + 4 * q);
    if (vcu < NCH * NH) B3_LOAD(NCH * NH - 1 - vcu);
    for (int it = vcu; it < NCH * NH; it += G) {
        const int u = NCH * NH - 1 - it;
        const int c = u >> 5, h = u & 31;
        const int mt = wave & 3, nh = wave >> 2;
        const size_t orow = (size_t)(c * CH + 16 * mt + r);
        v2u gtv[4];
#pragma unroll
        for (int nt = 0; nt < 4; ++nt) gtv[nt] = *(const v2u*)(PROJ + (((size_t)96 + h) * SEQ + orow) * DH + 64 * nh + 16 * nt + 4 * q);
        f32x2 b[8]; unsigned qq[8], kk[8], vv[8];
#pragma unroll
        for (int j = 0; j < 8; ++j) { b[j] = h2f(nb[j]); qq[j] = nq[j]; kk[j] = nk[j]; vv[j] = nv[j]; }
#pragma unroll
        for (int j = 1; j < 8; ++j) b[j] += b[j - 1];
        *(LAS f32x2*)(segtot + seg * 128 + 2 * cp) = b[7];
        __syncthreads();
        f32x2 st[8];
#pragma unroll
        for (int s2 = 0; s2 < 8; ++s2) st[s2] = *(const LAS f32x2*)(segtot + s2 * 128 + 2 * cp);
        const int I0 = seg >> 1;
        f32x2 off = {0.f, 0.f};
#pragma unroll
        for (int s2 = 0; s2 < 8; ++s2) if (s2 < seg) off += st[s2];
        f32x2 lsb[8];
        { f32x2 hb = {0.f, 0.f};
#pragma unroll
          for (int s2 = 0; s2 < 8; s2 += 2) if (s2 + 1 == seg) hb = st[s2];
#pragma unroll
          for (int j = 0; j < 8; ++j) lsb[j] = hb + b[j]; }
        f32x2 hbq = off;
#pragma unroll
        for (int s2 = 0; s2 < 8; s2 += 2) if (s2 + 1 == seg) hbq -= st[s2];
        const float eq0 = ex2(hbq.x), eq1 = ex2(hbq.y);
        f32x2 em[8];
#pragma unroll
        for (int j = 0; j < 8; ++j) { const float q0 = bflo(qq[j]), q1 = bfhi(qq[j]); const int row = 8 * seg + j;
            const float h0 = q0 * ex2(lsb[j].x), h1 = q1 * ex2(lsb[j].y); em[j] = (f32x2){ex2(-lsb[j].x), ex2(-lsb[j].y)};
            *(LAS unsigned*)(QT + row * PQ + 4 * cp) = cvtpk(h0 * eq0, h1 * eq1);
            *(LAS unsigned*)(QH + row * PQ + 4 * cp) = cvtpk(h0, h1); }
        { f32x2 d = {0.f, 0.f};
#pragma unroll
          for (int I = 0; I < 4; ++I) { if (I >= I0) {
                const float ed0 = ex2(d.x), ed1 = ex2(d.y);
#pragma unroll
                for (int j = 0; j < 8; ++j) *(LAS unsigned*)(KH + (kh_base(I) + 8 * seg + j) * PQ + 4 * cp) = cvtpk(bflo(kk[j]) * em[j].x * ed0, bfhi(kk[j]) * em[j].y * ed1);
                d += st[2 * I] + st[2 * I + 1]; } } }
        { unsigned v0w[4], v1w[4];
#pragma unroll
          for (int i = 0; i < 4; ++i) { const int ja = 2 * i, jb = 2 * i + 1; v0w[i] = (vv[ja] & 0xffffu) | (vv[jb] << 16); v1w[i] = (vv[ja] >> 16) | (vv[jb] & 0xffff0000u); }
          *(LAS v4u*)(VT + (2 * cp) * PK + 16 * seg) = (v4u){v0w[0], v0w[1], v0w[2], v0w[3]}; *(LAS v4u*)(VT + (2 * cp + 1) * PK + 16 * seg) = (v4u){v1w[0], v1w[1], v1w[2], v1w[3]}; }
        bf16x8 sf[4][4];
        { const bf16* stp = ST + ((size_t)u * 128 + 64 * nh + r) * 128 + 8 * q;
#pragma unroll
          for (int nt = 0; nt < 4; ++nt)
#pragma unroll
              for (int ks = 0; ks < 4; ++ks) sf[nt][ks] = *(const bf16x8*)(stp + (size_t)(16 * nt) * 128 + 32 * ks); }
        if (u - G >= 0) B3_LOAD(u - G);
        __syncthreads();
#pragma unroll
        for (int tt = 0; tt < 2; ++tt) { const int tile = wave * 2 + tt, I = tile >> 2, J = tile & 3;
            f32x4 acc = {0.f, 0.f, 0.f, 0.f};
            if (J <= I) {
#pragma unroll
                for (int ks = 0; ks < 4; ++ks) acc = mma(ldsfrag(KH, kh_base(I) + 16 * J + r, PQ, 64 * ks + 16 * q), ldsfrag(QH, 16 * I + r, PQ, 64 * ks + 16 * q), acc);
                if (J == I) {
#pragma unroll
                    for (int i = 0; i < 4; ++i) if (4 * q + i > r) acc[i] = 0.f; }
            }
            v2u w; w.x = cvtpk(acc[0], acc[1]); w.y = cvtpk(acc[2], acc[3]);
            *(LAS v2u*)(PP + (16 * I + r) * PK + (16 * J + 4 * q) * 2) = w; }
        __syncthreads();
        f32x4 acc[4];
        const bf16x8 pa0 = ldsfrag(PP, 16 * mt + r, PK, 16 * q), pa1 = ldsfrag(PP, 16 * mt + r, PK, 64 + 16 * q);
        bf16x8 qa[4];
#pragma unroll
        for (int ks = 0; ks < 4; ++ks) qa[ks] = ldsfrag(QT, 16 * mt + r, PQ, 64 * ks + 16 * q);
#pragma unroll
        for (int nt = 0; nt < 4; ++nt) { f32x4 a = {0.f, 0.f, 0.f, 0.f};
            a = mma(ldsfrag(VT, 64 * nh + 16 * nt + r, PK, 16 * q), pa0, a); a = mma(ldsfrag(VT, 64 * nh + 16 * nt + r, PK, 64 + 16 * q), pa1, a);
#pragma unroll
            for (int ks = 0; ks < 4; ++ks) a = mma(sf[nt][ks], qa[ks], a);
            acc[nt] = a; }
        float ss = 0.f;
#pragma unroll
        for (int nt = 0; nt < 4; ++nt) ss += (acc[nt][0] * acc[nt][0] + acc[nt][1] * acc[nt][1]) + (acc[nt][2] * acc[nt][2] + acc[nt][3] * acc[nt][3]);
        ss += shx(ss, 16, lane); ss += shx(ss, 32, lane);
        if (q == 0) rs[nh * 64 + 16 * mt + r] = ss;
        __syncthreads();
        const float rstd = rsqrtf((rs[16 * mt + r] + rs[64 + 16 * mt + r]) * (1.f / 128.f) + NORM_EPS);
#pragma unroll
        for (int nt = 0; nt < 4; ++nt) { const int dv = 64 * nh + 16 * nt + 4 * q;
            const f32x4 g = og[nt]; const v2u gt = gtv[nt];
            v2u w; w.x = cvtpk(acc[nt][0] * rstd * g.x * bflo(gt.x), acc[nt][1] * rstd * g.y * bfhi(gt.x)); w.y = cvtpk(acc[nt][2] * rstd * g.z * bflo(gt.y), acc[nt][3] * rstd * g.w * bfhi(gt.y));
            *(v2u*)(MO + tiled_off(orow, h * DH + dv, DM >> 6)) = w; }
    }
#undef B3_LOAD
}
}
constexpr int RING_BYTES = 131072;
constexpr int MISC_OFF = RING_BYTES + 320;
constexpr int LDS_BYTES = 147456;
#ifndef DOWN_WGM
#define DOWN_WGM 2
#endif
constexpr int CW_BAR = 4096;
constexpr int CW_Q = 8192;
static_assert(fa::LDS_END <= RING_BYTES && fa::OFF_OST % 16 == 0 && hg::B3_END <= RING_BYTES, "phase scratch fits the ring region");
static_assert(WS_END <= (size_t)4096 * MiB, "workspace map");

constexpr int PH_FINAL = 49, PH_END = 50;
struct Args { const float* in[15]; float* out; unsigned char* ws; int ph_lo, ph_hi; };
static_assert(sizeof(Args) == 15 * 8 + 8 + 8 + 4 + 4, "Args has no padding bytes");

__global__ void __launch_bounds__(NWAVES * 64, 2) trunk_fwd(Args args) {
    extern __shared__ __attribute__((aligned(16))) unsigned char lds_raw[];
    LAS unsigned char* lds = (LAS unsigned char*)lds_raw;
    volatile LAS unsigned* MISC = (volatile LAS unsigned*)(lds + MISC_OFF);
    const int tid = threadIdx.x;
    const int G = gridDim.x, bx = blockIdx.x;
    const int vcu = (G % 8 == 0) ? (bx % 8) * (G / 8) + bx / 8 : bx;
    for (int u = tid; u < (LDS_BYTES - RING_BYTES) / 4; u += NWAVES * 64) ((LAS unsigned*)(lds + RING_BYTES))[u] = 0u;
    __syncthreads();
    if ((tid & 63) == 0) ((volatile LAS int*)(lds + WAVE_TAB_OFF))[hw_wave_slot()] = tid >> 6;
    __syncthreads();
    const int lo = args.ph_lo, hi = args.ph_hi;
#if MK_PER_PHASE
#define GRID_BAR(p) do { } while (0)
#else
    XcdBarrier bar = xcd_barrier_post((unsigned*)(args.ws + WS_CTL) + CW_BAR, MISC + 8);
#define GRID_BAR(p) do { if ((p) + 1 < hi) { XcdBarrier b_ = bar; asm volatile("" : "+s"(b_.bar), "+s"(b_.x)); xcd_barrier(b_); } } while (0)
#endif
#ifndef ONLY_SITE
#define ONLY_SITE -1
#endif
#define EN(s) (ONLY_SITE == -1 || ONLY_SITE == (s))
#ifndef DUP_SITE
#define DUP_SITE -1
#endif
#define DUP(s) (DUP_SITE == (s))
#define IN(k) (lo <= (k) && (k) < hi)
#ifndef STAGGER_US
#define STAGGER_US 0
#endif
#define STAGGER() do { if (STAGGER_US > 0) { const unsigned long long t0_ = __builtin_amdgcn_s_memrealtime(), dl_ = (unsigned long long)(bx & 7) * (STAGGER_US * 100ull); while (__builtin_amdgcn_s_memrealtime() - t0_ < dl_) __builtin_amdgcn_s_sleep(4); } } while (0)
#define OPQ(v) ({ int o_ = (v); asm volatile("" : "+s"(o_)); o_; })
#define WSP() ({ GAS unsigned char* w_ = (GAS unsigned char*)args.ws; asm volatile("" : "+s"(w_)); (unsigned char*)w_; })
#define INP(i) ({ const GAS float* p_ = (const GAS float*)args.in[i]; asm volatile("" : "+s"(p_)); (const float*)p_; })
    LAS float* RTAB = (LAS float*)(lds + RING_BYTES + 1024);
#define P_H ((float*)(WSP() + WS_H))
#define P_XN ((bf16*)(WSP() + WS_XN))
#define P_MO ((bf16*)(WSP() + WS_MO))
#define P_PROJ ((bf16*)(WSP() + WS_PROJ))
#define P_G ((_Float16*)(WSP() + WS_G))
#define P_UT ((bf16*)(WSP() + WS_UT))
#define P_ST ((bf16*)(WSP() + WS_ST))
#define P_LOGF ((float*)(WSP() + WS_LOGF))
#define P_KB ((float*)(WSP() + WS_KB))
#define P_DEC ((float*)(WSP() + WS_DEC))
#define P_LB ((const float*)(WSP() + WS_LB))
#define P_JL ((int*)(WSP() + WS_LB + 512 * 1024))
#define P_CS ((float*)(WSP() + WS_LB + 768 * 1024))
#define P_PART ((float*)(WSP() + WS_PART))

    if (EN(0) && IN(0)) {
        ConvArgs ca{INP(1), INP(2), INP(6), INP(7), INP(12), INP(13)};
        prologue_phase(lds, WSP(), ca, INP(9), OPQ(vcu), OPQ(G));
        GRID_BAR(0);
    }
#ifndef FZ_PHASE
#define FZ_PHASE 1
#endif
#ifndef ATT_HOST
#define ATT_HOST 1
#endif
#define HOSTED(m) (ATT_HOST && (((m) - 1) & 7) < 4)
#define CONV_PRE(q) do { if ((q) + 1 < 4 * DEPTH && !HOSTED((q) + 1) && (bx & 3)) { ConvArgs ca_{INP(1), INP(2), INP(6), INP(7), INP(12), INP(13)}; conv_weights(lds, WSP(), ca_, OPQ((q) + 1), OPQ(vcu), OPQ(G), 1, OPQ(bx & 3)); } } while (0)
#define CONV_POST(q) do { if ((q) + 1 < 4 * DEPTH && !HOSTED((q) + 1) && (bx & 3) != 3) { ConvArgs ca_{INP(1), INP(2), INP(6), INP(7), INP(12), INP(13)}; conv_weights(lds, WSP(), ca_, OPQ((q) + 1), OPQ(vcu), OPQ(G), 2, OPQ(bx & 3)); } } while (0)
    for (int L = 0; L < DEPTH; ++L) {
        const int pb = 1 + 12 * L, j = L >> 1; const bool fox = (L & 1) == 0;
        if (EN(1) && L == 0 && IN(pb + 0)) { rms0_phase(INP(0), INP(10), P_XN, P_PART, OPQ(vcu), OPQ(G)); GRID_BAR(pb + 0); }
        if (fox) {
            if (EN(2) && IN(pb + 1)) {
                unsigned char* w = WSP();
                pg8::Gemm g{(const bf16*)(w + WS_XN), (const bf16*)(w + WS_WFIN) + (size_t)j * FOX_INP * DM, SEQ, FZ_PHASE ? 4 * DM : FOX_INP, DM}; pg8::StaticOrder S; S.init(SEQ, FZ_PHASE ? 4 * DM : FOX_INP, OPQ(G), OPQ(bx));
                pg8::Unit u0; S.next(0, u0); rstd_table(RTAB, (const float*)(w + WS_PART), u0.pm);
                pg8::EpiFox E{(bf16*)(w + WS_PROJ), 16384, (float*)(w + WS_LOGF), INP(5) + j * NH, (float*)(w + WS_LB + 768 * 1024), pg8::RowScale{RTAB, u0.pm, (const float*)(w + WS_PART)}, INP(3) + j * DH, INP(4) + j * DH, (LAS float*)(lds + RING_BYTES + 4096), QSCALE};
                CONV_PRE(4 * L); pg8::gemm_phase<pg8::EpiFox, pg8::StaticOrder, true, true>(lds, g, S, E); CONV_POST(4 * L);
                if (!FZ_PHASE) GRID_BAR(pb + 1);
            }
            if (FZ_PHASE && EN(15) && IN(pb + 1)) { unsigned char* w = WSP(); __syncthreads();
                int fzb = vcu; if (G == 256) { pg8::StaticOrder S; S.init(SEQ, 4 * DM, OPQ(G), OPQ(bx)); pg8::Unit u0; S.next(0, u0); fzb = u0.pm * 4 + ((bx >> 3) >> 3); }
                fz_phase(lds, (const bf16*)(w + WS_XN), (const bf16*)(w + WS_WFIN) + (size_t)OPQ(j) * FOX_INP * DM, (const float*)(w + WS_PART), INP(5) + OPQ(j) * NH, (float*)(w + WS_LOGF), (float*)(w + WS_LB + 768 * 1024), OPQ(fzb), OPQ(G));
                GRID_BAR(pb + 1); }
            if (EN(3) && IN(pb + 2)) { fox_thin_phase(lds, P_LOGF, P_CS, P_KB, OPQ(vcu), OPQ(G)); GRID_BAR(pb + 2); }
            if (EN(14) && IN(pb + 3)) { jl_phase(lds, P_KB, INP(3) + j * DH, INP(4) + j * DH, P_JL, OPQ(vcu), OPQ(G)); GRID_BAR(pb + 3); }
            if (EN(4) && IN(pb + 4)) { unsigned char* w = WSP(); ConvArgs ca_{INP(1), INP(2), INP(6), INP(7), INP(12), INP(13)}; fa::attn_phase((char*)lds_raw, (const bf16*)(w + WS_PROJ), (const float*)(w + WS_KB), (bf16*)(w + WS_MO), (const int*)(w + WS_LB + 512 * 1024), (unsigned*)(w + WS_CTL) + CW_Q + 64 * j, INP(3) + j * DH, INP(4) + j * DH, w, ca_, OPQ(4 * L + 1), ATT_HOST ? ATT_CHUNKS : 0, OPQ(vcu), OPQ(G)); GRID_BAR(pb + 4);
                if (DUP(4)) { fa::attn_phase((char*)lds_raw, (const bf16*)(w + WS_PROJ), (const float*)(w + WS_KB), (bf16*)(w + WS_MO), (const int*)(w + WS_LB + 512 * 1024), (unsigned*)(w + WS_CTL) + CW_Q + 64 * (j + 2), INP(3) + j * DH, INP(4) + j * DH, w, ca_, OPQ(4 * L + 1), 0, OPQ(vcu), OPQ(G)); GRID_BAR(pb + 4); } }
        } else {
            if (EN(5) && IN(pb + 1)) {
                unsigned char* w = WSP();
                pg8::Gemm g{(const bf16*)(w + WS_XN), (const bf16*)(w + WS_WHIN) + (size_t)j * HG_IN * DM, SEQ, HG_IN, DM}; pg8::StaticOrder S; S.init(SEQ, HG_IN, OPQ(G), OPQ(bx));
                pg8::Unit u0; S.next(0, u0); rstd_table(RTAB, (const float*)(w + WS_PART), u0.pm);
                pg8::EpiHgrn E{(bf16*)(w + WS_PROJ), 16384, (_Float16*)(w + WS_G), (const float*)(w + WS_LB) + (size_t)L * DM, pg8::RowScale{RTAB, u0.pm, (const float*)(w + WS_PART)}};
                CONV_PRE(4 * L); pg8::gemm_phase<pg8::EpiHgrn, pg8::StaticOrder, true, true>(lds, g, S, E); CONV_POST(4 * L);
                GRID_BAR(pb + 1);
            }
            if (EN(6) && IN(pb + 2)) { hg::b1_phase(lds, P_PROJ, P_G, P_UT, P_DEC, OPQ(vcu), OPQ(G)); GRID_BAR(pb + 2); }
            if (EN(7) && IN(pb + 3)) { hg::b2_phase(P_UT, P_DEC, P_ST, OPQ(vcu), OPQ(G)); GRID_BAR(pb + 3); }
            if (EN(8) && IN(pb + 4)) { hg::b3_phase(lds, P_PROJ, P_G, P_ST, INP(8) + j * DH, P_MO, OPQ(vcu), OPQ(G)); GRID_BAR(pb + 4); }
            if (DUP(6)) { hg::b1_phase(lds, P_PROJ, P_G, P_UT, P_DEC, OPQ(vcu), OPQ(G)); GRID_BAR(pb + 2); hg::b2_phase(P_UT, P_DEC, P_ST, OPQ(vcu), OPQ(G)); GRID_BAR(pb + 3); hg::b3_phase(lds, P_PROJ, P_G, P_ST, INP(8) + j * DH, P_MO, OPQ(vcu), OPQ(G)); GRID_BAR(pb + 4); }
        }
        if (EN(9) && IN(pb + 5)) {
            unsigned char* w = WSP();
            const bf16* W = fox ? (const bf16*)(w + WS_WFOUT) + (size_t)j * DM * DM : (const bf16*)(w + WS_WHOUT) + (size_t)j * DM * DM;
            pg8::Gemm g{(const bf16*)(w + WS_MO), W, SEQ, DM, DM}; pg8::StaticOrder S; S.init(SEQ, DM, OPQ(G), OPQ(bx));
            pg8::EpiRes E{L == 0 ? INP(0) : (const float*)(w + WS_H), (float*)(w + WS_H), DM, (bf16*)(w + WS_XN), INP(11) + (size_t)L * DM, (float*)(w + WS_PART)};
            CONV_PRE(4 * L + 1); pg8::gemm_phase<pg8::EpiRes, pg8::StaticOrder, true, true>(lds, g, S, E); CONV_POST(4 * L + 1);
            GRID_BAR(pb + 5);
        }
        if (EN(11) && IN(pb + 7)) {
            unsigned char* w = WSP();
            pg8::Gemm g{(const bf16*)(w + WS_XN), (const bf16*)(w + WS_WUP) + (size_t)L * DFF * DM, SEQ, DFF, DM}; pg8::StaticOrder S; S.init(SEQ, DFF, OPQ(G), OPQ(bx));
            pg8::Unit u0; S.next(0, u0); rstd_table(RTAB, (const float*)(w + WS_PART), u0.pm);
            pg8::EpiSqRelu E{(bf16*)(w + WS_PROJ), DFF, pg8::RowScale{RTAB, u0.pm, (const float*)(w + WS_PART)}};
            CONV_PRE(4 * L + 2); pg8::gemm_phase<pg8::EpiSqRelu, pg8::StaticOrder, true, true>(lds, g, S, E); CONV_POST(4 * L + 2);
            GRID_BAR(pb + 7);
        }
        if (EN(12) && IN(pb + 8)) {
            unsigned char* w = WSP();
            pg8::Gemm g{(const bf16*)(w + WS_PROJ), (const bf16*)(w + WS_WDN) + (size_t)L * DM * DFF, SEQ, DM, DFF}; pg8::StaticOrder S; S.init(SEQ, DM, OPQ(G), OPQ(bx), DOWN_WGM);
            pg8::EpiRes E{(const float*)(w + WS_H), (float*)(w + WS_H), DM, L + 1 < DEPTH ? (bf16*)(w + WS_XN) : nullptr, INP(10) + (size_t)(L + 1 < DEPTH ? L + 1 : 0) * DM, (float*)(w + WS_PART)};
            CONV_PRE(4 * L + 3); pg8::gemm_phase<pg8::EpiRes, pg8::StaticOrder, true, true>(lds, g, S, E); CONV_POST(4 * L + 3);
            GRID_BAR(pb + 8);
        }
    }
    if (EN(13) && IN(PH_FINAL)) rms_phase<true>(P_H, INP(14), args.out, OPQ(vcu), OPQ(G));
#undef IN
#undef GRID_BAR
}

extern "C" void kernel_launch(void* const* d_in, const int* in_sizes, int n_in, void* d_out, int out_size, void* d_ws, size_t ws_size, hipStream_t stream) {
    static int grid = 0;
    if (grid == 0) {
        if (n_in != 15 || in_sizes[0] != SEQ * DM || out_size != SEQ * DM || ws_size < WS_END) { fprintf(stderr, "kernel_launch: unexpected shapes (n_in %d, in0 %d, out %d, ws %zu < %zu)\n", n_in, n_in > 0 ? in_sizes[0] : -1, out_size, ws_size, (size_t)WS_END); grid = -1; return; }
        int dev = 0, cus = 0, per_cu = 0;
        if (hipGetDevice(&dev) != hipSuccess || hipDeviceGetAttribute(&cus, hipDeviceAttributeMultiprocessorCount, dev) != hipSuccess) { grid = -1; return; }
        if (hipFuncSetAttribute((const void*)trunk_fwd, hipFuncAttributeMaxDynamicSharedMemorySize, LDS_BYTES) != hipSuccess) { fprintf(stderr, "kernel_launch: hipFuncSetAttribute failed\n"); grid = -1; return; }
        if (hipOccupancyMaxActiveBlocksPerMultiprocessor(&per_cu, (const void*)trunk_fwd, NWAVES * 64, LDS_BYTES) != hipSuccess || per_cu < 1) fprintf(stderr, "kernel_launch: occupancy query says %d\n", per_cu);
        (void)hipGetLastError();
        grid = cus;
    }
    if (grid < 0) return;
    if (hipMemsetAsync((char*)d_ws + WS_CTL, 0, CTL_ZERO_BYTES, stream) != hipSuccess) return;
    Args a{};
    for (int i = 0; i < 15; ++i) a.in[i] = (const float*)d_in[i];
    a.out = (float*)d_out; a.ws = (unsigned char*)d_ws;
#if MK_PER_PHASE
    for (int p = 0; p < PH_END; ++p) {
        bool valid = (p == 0) || (p == PH_FINAL);
        if (p >= 1 && p < PH_FINAL) { const int L = (p - 1) / 12, k = (p - 1) % 12; const bool fox = (L & 1) == 0; valid = (k <= 8) && (k != 6) && (k != 0 || L == 0); }
        if (!valid) continue;
        a.ph_lo = p; a.ph_hi = p + 1;
        hipLaunchKernelGGL(trunk_fwd, dim3(grid), dim3(NWAVES * 64), LDS_BYTES, stream, a);
    }
#else
    a.ph_lo = 0; a.ph_hi = PH_END;
    hipLaunchKernelGGL(trunk_fwd, dim3(grid), dim3(NWAVES * 64), LDS_BYTES, stream, a);
#endif
}
```

```cpp
#define MK_PER_PHASE 0
#define DUP_SITE -1
#include <hip/hip_runtime.h>
#include <hip/hip_bf16.h>
#include <cstdio>
#include <cstdint>

#ifndef MK_PER_PHASE
#define MK_PER_PHASE 0
#endif

constexpr int SEQ = 16384, DM = 4096, DFF = 16384, NH = 32, DH = 128, DEPTH = 4;
constexpr int FOX_IN = 4 * DM + NH;
constexpr int FOX_INP = 65 * 256;
constexpr int HG_IN = 4 * DM;
constexpr float NORM_EPS = 1e-6f;
constexpr float LOG2E = 1.4426950408889634f;
constexpr float QSCALE = 0.08838834764831845f * LOG2E;

constexpr size_t MiB = 1u << 20;
constexpr size_t WS_CTL = 0, CTL_ZERO_BYTES = 1 * MiB;
constexpr size_t WS_WFIN = 1 * MiB;
constexpr size_t WS_WFOUT = WS_WFIN + 260 * MiB;
constexpr size_t WS_WHIN = WS_WFOUT + 64 * MiB;
constexpr size_t WS_WHOUT = WS_WHIN + 256 * MiB;
constexpr size_t WS_WUP = WS_WHOUT + 64 * MiB;
constexpr size_t WS_WDN = WS_WUP + 512 * MiB;
constexpr size_t WS_H = WS_WDN + 512 * MiB;
constexpr size_t WS_XN = WS_H + 256 * MiB;
constexpr size_t WS_MO = WS_XN + 128 * MiB;
constexpr size_t WS_PROJ = WS_MO + 128 * MiB;
constexpr size_t WS_G = WS_PROJ + 512 * MiB;
constexpr size_t WS_UT = WS_G + 256 * MiB;
constexpr size_t WS_HID = WS_UT;
constexpr size_t WS_ST = WS_UT + 512 * MiB;
constexpr size_t WS_LOGF = WS_ST + 256 * MiB;
constexpr size_t WS_KB = WS_LOGF + 2 * MiB;
constexpr size_t WS_DEC = WS_KB + 2 * MiB;
constexpr size_t WS_LB = WS_DEC + 4 * MiB;
constexpr size_t WS_PART = WS_LB + 1 * MiB;
constexpr size_t WS_END = WS_PART + 4 * MiB;

#define GAS __attribute__((address_space(1)))
#define LAS __attribute__((address_space(3)))
typedef unsigned short bf16;
typedef unsigned v4u __attribute__((ext_vector_type(4)));
typedef unsigned v2u __attribute__((ext_vector_type(2)));
typedef float f32x4 __attribute__((ext_vector_type(4)));
typedef float f32x16 __attribute__((ext_vector_type(16)));
typedef short bf16x8 __attribute__((ext_vector_type(8)));
typedef short s16x4 __attribute__((ext_vector_type(4)));
#define LDS_WAIT() asm volatile("s_waitcnt lgkmcnt(0)" ::: "memory")
#define VM_WAIT() asm volatile("s_waitcnt vmcnt(0)" ::: "memory")
typedef float f32x2_t __attribute__((ext_vector_type(2)));
typedef __bf16 bf16x2_t __attribute__((ext_vector_type(2)));
__device__ __forceinline__ unsigned cvtpk(float lo, float hi) { const f32x2_t v = {lo, hi}; return __builtin_bit_cast(unsigned, __builtin_convertvector(v, bf16x2_t)); }
__device__ __forceinline__ float bflo(unsigned w) { return __uint_as_float(w << 16); }
__device__ __forceinline__ float bfhi(unsigned w) { return __uint_as_float(w & 0xffff0000u); }
__device__ __forceinline__ float bf2f(bf16 b) { return __uint_as_float(((unsigned)b) << 16); }
__device__ __forceinline__ bf16 f2bf(float f) { return (bf16)(cvtpk(f, 0.f) & 0xffffu); }
__device__ __forceinline__ float fexp(float x) { return __builtin_amdgcn_exp2f(x * LOG2E); }
__device__ __forceinline__ float sigmoidf_(float x) { return __builtin_amdgcn_rcpf(1.f + fexp(-x)); }
constexpr int WAVE_TAB_OFF = 131072 + 2048;
__device__ __forceinline__ unsigned hw_wave_slot() { return (unsigned)__builtin_amdgcn_s_getreg((5 << 11) | 4) & 63u; }
__device__ __forceinline__ int opaque_tid() {
    extern __shared__ __attribute__((aligned(16))) unsigned char dyn_lds_[];
    int l; asm volatile("v_mbcnt_lo_u32_b32 %0, -1, 0\n\tv_mbcnt_hi_u32_b32 %0, -1, %0" : "=v"(l));
    const int w = __builtin_amdgcn_readfirstlane(((const volatile LAS int*)((LAS unsigned char*)dyn_lds_ + WAVE_TAB_OFF))[hw_wave_slot()]);
    return (w << 6) | l;
}
__device__ __forceinline__ float shx(float v, int o, int lane) { return __int_as_float(__builtin_amdgcn_ds_bpermute((lane ^ o) << 2, __float_as_int(v))); }
__host__ __device__ __forceinline__ int img_byte(int r, int c) { const int st = (r >> 4) * 2 + (c >> 5), rr = r & 15, cc = c & 31, ob = rr * 64 + cc * 2; return st * 1024 + (ob ^ (((ob >> 9) & 1) << 5)); }
__host__ __device__ __forceinline__ size_t tiled_off(size_t row, int col, int nkt) { const int rl = (int)(row & 255);
    return (((row >> 8) * (size_t)nkt + (size_t)(col >> 6)) << 14) + (size_t)((rl >> 7) * 8192 + (img_byte(rl & 127, col & 63) >> 1)); }
__host__ __device__ __forceinline__ size_t tiled_off_w(size_t n, int k, int nkt) { const int w = (int)(n & 31), rho = 16 * ((w >> 2) & 1) + 4 * (w >> 3) + (w & 3);
    return tiled_off((n & ~(size_t)31) + (size_t)rho, k, nkt); }
namespace pg8 {
#define PG8_LAS __attribute__((address_space(3)))
typedef unsigned short bf16_t;
typedef short bf16x8 __attribute__((ext_vector_type(8)));
typedef float f32x4 __attribute__((ext_vector_type(4)));
typedef unsigned u32x4 __attribute__((ext_vector_type(4)));
constexpr int BM = 256, BK = 64, HALF = 128, HTB = HALF * BK * 2  , STAGE_BYTES = 8 * HTB, NXCD = 8, WGM = 8;

__host__ __device__ __forceinline__ int lds_byte(int r, int c) { const int st = (r >> 4) * 2 + (c >> 5), rr = r & 15, cc = c & 31, ob = rr * 64 + cc * 2; return st * 1024 + (ob ^ (((ob >> 9) & 1) << 5)); }
__host__ __device__ __forceinline__ void stage_rc(int b, int& R, int& C) { const int st = b / 1024, sb = b % 1024, swz = sb ^ (((sb >> 9) & 1) << 5); R = (st >> 1) * 16 + swz / 64; C = (st & 1) * 32 + (swz % 64) / 2; }
__host__ __device__ __forceinline__ int perm32(int rho) { const int n = rho >> 4, i = rho & 15; return 8 * (i >> 2) + 4 * n + (i & 3); }

struct Unit { int pm, pn; };
struct Gemm { const bf16_t* A; const bf16_t* Bt; int M, N, K; };

struct StaticOrder {
    int nM, nN, nwg, G, c, wgm;
    __host__ __device__ __forceinline__ void init(int M, int N, int G_, int c_, int wgm_ = WGM) { nM = M / BM; nN = N / BM; nwg = nM * nN; G = G_; c = c_; wgm = wgm_; }
    __host__ __device__ __forceinline__ bool next(int i, Unit& u) const {
        const long L = (long)i * G + c; if (L >= nwg) return false;
        int wgid = (int)L; { const int q = nwg / NXCD, r = nwg % NXCD, xcd = wgid % NXCD, off = wgid / NXCD; wgid = (xcd < r ? xcd * (q + 1) : r * (q + 1) + (xcd - r) * q) + off; }
        const int nig = wgm * nN, gid = wgid / nig, fm = gid * wgm, gsz = (nM - fm) < wgm ? (nM - fm) : wgm;
        u.pm = fm + ((wgid % nig) % gsz); u.pn = (wgid % nig) / gsz; return true;
    }
    __device__ __forceinline__ void a_ready(const Unit&) const {}
    __device__ __forceinline__ void done(const Unit&) const {}
};
#ifndef EPI_NT
#define EPI_NT 0
#endif
#if EPI_NT
#define STORE_NT(p, v) __builtin_nontemporal_store((v), (p))
#else
#define STORE_NT(p, v) (*(p) = (v))
#endif
__device__ __forceinline__ unsigned cvt_pk_bf16(float lo, float hi) { return ::cvtpk(lo, hi); }
__device__ __forceinline__ float lsig(float z) { return fminf(z, 0.f) - 0.6931471805599453f * __builtin_amdgcn_logf(1.f + __builtin_amdgcn_exp2f(-1.4426950408889634f * fabsf(z))); }
__device__ __forceinline__ float sigm(float x) { return __builtin_amdgcn_rcpf(1.f + __builtin_amdgcn_exp2f(-1.4426950408889634f * x)); }

struct RowScale {
    const PG8_LAS float* tab; int pm0; const float* part;
    __device__ __forceinline__ float get(const Unit& u, int rowin) const {
        if (u.pm == pm0) return tab[rowin];
        int ri = rowin; asm volatile("" : "+v"(ri));
        const f32x4* p = (const f32x4*)(part + (size_t)(u.pm * BM + ri) * 64); f32x4 a = {0.f, 0.f, 0.f, 0.f};
#pragma unroll 1
        for (int i = 0; i < 16; ++i) a += p[i];
        return rsqrtf(((a.x + a.y) + (a.z + a.w)) * (1.f / 4096.f) + 1e-6f);
    }
};
struct EpiRes {
    static constexpr bool PERM = true, AFTER_DRAIN = false;
    const float* base; float* out; int ldc; bf16_t* xn; const float* gain; float* part;
    __device__ __forceinline__ void operator()(const f32x4 (&acc)[2][2][4][2], const Unit& u, int wr, int wc, int fr_, int fq_) const {
        int fr = fr_, fq = fq_; asm volatile("" : "+v"(fr), "+v"(fq));
        const int row0 = u.pm * BM + wr * 64 + fr, col0 = u.pn * BM + wc * 32 + 8 * fq, lane = fq * 16 + fr;
        f32x4 g0[2], g1[2];
        if (xn) {
#pragma unroll
            for (int bj = 0; bj < 2; ++bj) { g0[bj] = *(const f32x4*)(gain + col0 + bj * HALF); g1[bj] = *(const f32x4*)(gain + col0 + bj * HALF + 4); } }
#pragma unroll
        for (int ai = 0; ai < 2; ++ai) {
            f32x4 b0[4][2], b1[4][2];
#pragma unroll
            for (int m = 0; m < 4; ++m) { const size_t off = (size_t)(row0 + ai * HALF + m * 16) * ldc + col0;
#pragma unroll
                for (int bj = 0; bj < 2; ++bj) { b0[m][bj] = *(const f32x4*)(base + off + bj * HALF); b1[m][bj] = *(const f32x4*)(base + off + bj * HALF + 4); } }
#pragma unroll
            for (int m = 0; m < 4; ++m) { const size_t row = (size_t)(row0 + ai * HALF + m * 16); const size_t off = row * ldc + col0;
                float ss = 0.f;
#pragma unroll
                for (int bj = 0; bj < 2; ++bj) { const f32x4 h0 = b0[m][bj] + acc[ai][bj][m][0], h1 = b1[m][bj] + acc[ai][bj][m][1];
                    STORE_NT((f32x4*)(out + off + bj * HALF), h0); STORE_NT((f32x4*)(out + off + bj * HALF + 4), h1);
                    if (xn) { ss += ((h0[0] * h0[0] + h0[1] * h0[1]) + (h0[2] * h0[2] + h0[3] * h0[3])) + ((h1[0] * h1[0] + h1[1] * h1[1]) + (h1[2] * h1[2] + h1[3] * h1[3]));
                        const f32x4 x0 = h0 * g0[bj], x1 = h1 * g1[bj];
                        u32x4 w; w.x = cvt_pk_bf16(x0[0], x0[1]); w.y = cvt_pk_bf16(x0[2], x0[3]); w.z = cvt_pk_bf16(x1[0], x1[1]); w.w = cvt_pk_bf16(x1[2], x1[3]);
                        STORE_NT((u32x4*)(xn + ::tiled_off(row, col0 + bj * HALF, ldc >> 6)), w); } }
                if (xn) { ss += ::shx(ss, 16, lane); ss += ::shx(ss, 32, lane); if (fq == 0) part[row * 64 + u.pn * 4 + wc] = ss; } }
            asm volatile("" ::: "memory"); }
    }
};
struct EpiSqRelu {
    static constexpr bool PERM = true, AFTER_DRAIN = false;
    bf16_t* O; int ldc; RowScale rsc;
    __device__ __forceinline__ void operator()(const f32x4 (&acc)[2][2][4][2], const Unit& u, int wr, int wc, int fr_, int fq_) const {
        int fr = fr_, fq = fq_; asm volatile("" : "+v"(fr), "+v"(fq));
        const int row0 = u.pm * BM + wr * 64 + fr, col0 = u.pn * BM + wc * 32 + 8 * fq;
#pragma unroll
        for (int ai = 0; ai < 2; ++ai)
#pragma unroll
            for (int m = 0; m < 4; ++m) { bf16_t* rowp = O + ::tiled_off((size_t)(row0 + ai * HALF + m * 16), col0, ldc >> 6); const float rs = rsc.get(u, wr * 64 + fr + ai * HALF + m * 16);
#pragma unroll
                for (int bj = 0; bj < 2; ++bj) { f32x4 v0 = acc[ai][bj][m][0] * rs, v1 = acc[ai][bj][m][1] * rs;
#pragma unroll
                    for (int j = 0; j < 4; ++j) { const float a = fmaxf(v0[j], 0.f), b = fmaxf(v1[j], 0.f); v0[j] = a * a; v1[j] = b * b; }
                    u32x4 w; w.x = cvt_pk_bf16(v0[0], v0[1]); w.y = cvt_pk_bf16(v0[2], v0[3]); w.z = cvt_pk_bf16(v1[0], v1[1]); w.w = cvt_pk_bf16(v1[2], v1[3]);
                    STORE_NT((u32x4*)(rowp + (size_t)bj * (2 * 16384)), w); } }
    }
};
struct EpiFox {
    static constexpr bool PERM = true, AFTER_DRAIN = false;
    bf16_t* P; int ldc; float* logf; const float* fbias; float* cs; RowScale rsc; const float* qg; const float* kg; PG8_LAS float* qkt; float QS;
    __device__ __forceinline__ void operator()(const f32x4 (&acc)[2][2][4][2], const Unit& u, int wr, int wc, int fr_, int fq_) const {
        int fr = fr_, fq = fq_; asm volatile("" : "+v"(fr), "+v"(fq));
        const int row0 = u.pm * BM + wr * 64 + fr;
        if (u.pn < 32) {
            const int col0 = u.pn * BM + wc * 32 + 8 * fq, lane = fq * 16 + fr; const bool isq = u.pn < 16;
            const float* gs = (isq ? qg : kg) + wc * 32 + 8 * fq; const float sc = isq ? QS : 1.f;
            const f32x4 g0 = *(const f32x4*)gs * sc, g1 = *(const f32x4*)(gs + 4) * sc;
#pragma unroll
            for (int ai = 0; ai < 2; ++ai)
#pragma unroll
                for (int m = 0; m < 4; ++m) { const int rowin = ai * 64 + m * 16 + fr; const float rs = rsc.get(u, wr * 64 + fr + ai * HALF + m * 16);
#pragma unroll
                    for (int bj = 0; bj < 2; ++bj) { const f32x4 v0 = acc[ai][bj][m][0] * rs, v1 = acc[ai][bj][m][1] * rs;
                        float ss = ((v0[0] * v0[0] + v0[1] * v0[1]) + (v0[2] * v0[2] + v0[3] * v0[3])) + ((v1[0] * v1[0] + v1[1] * v1[1]) + (v1[2] * v1[2] + v1[3] * v1[3]));
                        ss += ::shx(ss, 16, lane); ss += ::shx(ss, 32, lane);
                        if (fq == 0) qkt[(((wr * 128 + rowin) * 2 + bj) << 2) + wc] = ss; } }
            asm volatile("s_waitcnt lgkmcnt(0)" ::: "memory"); __builtin_amdgcn_s_barrier(); asm volatile("" ::: "memory");
#pragma unroll
            for (int ai = 0; ai < 2; ++ai)
#pragma unroll
                for (int m = 0; m < 4; ++m) { const int rowin = ai * 64 + m * 16 + fr; const float rs = rsc.get(u, wr * 64 + fr + ai * HALF + m * 16);
                    bf16_t* rowp = P + (((size_t)(u.pn >> 4) * 32 + (u.pn & 15) * 2) * 16384 + (size_t)(row0 + ai * HALF + m * 16)) * 128 + wc * 32 + 8 * fq;
#pragma unroll
                    for (int bj = 0; bj < 2; ++bj) { const f32x4 t = *(const PG8_LAS f32x4*)(qkt + (((wr * 128 + rowin) * 2 + bj) << 2));
                        const float r2 = rs * rsqrtf(((t[0] + t[1]) + (t[2] + t[3])) * (1.f / 128.f) + 1e-6f);
                        const f32x4 v0 = acc[ai][bj][m][0] * r2 * g0, v1 = acc[ai][bj][m][1] * r2 * g1;
                        u32x4 w; w.x = cvt_pk_bf16(v0[0], v0[1]); w.y = cvt_pk_bf16(v0[2], v0[3]); w.z = cvt_pk_bf16(v1[0], v1[1]); w.w = cvt_pk_bf16(v1[2], v1[3]);
                        STORE_NT((u32x4*)(rowp + (size_t)bj * ((size_t)16384 * 128)), w); } }
        } else if (u.pn < 64) {
            const int col0 = u.pn * BM + wc * 32 + 8 * fq; const bool gate = u.pn >= 48;
#pragma unroll
            for (int ai = 0; ai < 2; ++ai)
#pragma unroll
                for (int m = 0; m < 4; ++m) { bf16_t* rowp = P + (((size_t)(u.pn >> 4) * 32 + (u.pn & 15) * 2) * 16384 + (size_t)(row0 + ai * HALF + m * 16)) * 128 + wc * 32 + 8 * fq; const float rs = rsc.get(u, wr * 64 + fr + ai * HALF + m * 16);
#pragma unroll
                    for (int bj = 0; bj < 2; ++bj) { f32x4 v0 = acc[ai][bj][m][0] * rs, v1 = acc[ai][bj][m][1] * rs;
                        if (gate) {
#pragma unroll
                            for (int j = 0; j < 4; ++j) { v0[j] = sigm(v0[j]); v1[j] = sigm(v1[j]); } }
                        u32x4 w; w.x = cvt_pk_bf16(v0[0], v0[1]); w.y = cvt_pk_bf16(v0[2], v0[3]); w.z = cvt_pk_bf16(v1[0], v1[1]); w.w = cvt_pk_bf16(v1[2], v1[3]);
                        STORE_NT((u32x4*)(rowp + (size_t)bj * ((size_t)16384 * 128)), w); } }
        } else if (wc == 0) {
            const f32x4 b0 = *(const f32x4*)(fbias + 8 * fq), b1 = *(const f32x4*)(fbias + 8 * fq + 4);
            const int lane = fq * 16 + fr;
#pragma unroll
            for (int ai = 0; ai < 2; ++ai) {
                f32x4 s0 = {0.f, 0.f, 0.f, 0.f}, s1 = {0.f, 0.f, 0.f, 0.f};
#pragma unroll
                for (int m = 0; m < 4; ++m) { float* rowp = logf + (size_t)(row0 + ai * HALF + m * 16) * 32 + 8 * fq; const float rs = rsc.get(u, wr * 64 + fr + ai * HALF + m * 16);
                    f32x4 v0 = acc[ai][0][m][0] * rs + b0, v1 = acc[ai][0][m][1] * rs + b1;
#pragma unroll
                    for (int j = 0; j < 4; ++j) { v0[j] = lsig(v0[j]); v1[j] = lsig(v1[j]); }
                    *(f32x4*)rowp = v0; *(f32x4*)(rowp + 4) = v1; s0 += v0; s1 += v1; }
#pragma unroll
                for (int j = 0; j < 4; ++j) {
#pragma unroll
                    for (int o = 1; o < 16; o <<= 1) { s0[j] += ::shx(s0[j], o, lane); s1[j] += ::shx(s1[j], o, lane); } }
                if (fr == 0) { float* cp = cs + (size_t)(u.pm * 4 + ai * 2 + wr) * 32 + 8 * fq; *(f32x4*)cp = s0; *(f32x4*)(cp + 4) = s1; }
                asm volatile("" ::: "memory"); }
        }
    }
};
struct EpiHgrn {
    static constexpr bool PERM = true, AFTER_DRAIN = false;
    bf16_t* P; int ldc; _Float16* G; const float* lb; RowScale rsc;
    __device__ __forceinline__ void operator()(const f32x4 (&acc)[2][2][4][2], const Unit& u, int wr, int wc, int fr_, int fq_) const {
        int fr = fr_, fq = fq_; asm volatile("" : "+v"(fr), "+v"(fq));
        constexpr size_t HSTR = (size_t)16384 * 128;
        const int row0 = u.pm * BM + wr * 64 + fr, col0 = u.pn * BM + wc * 32 + 8 * fq; const int kind = u.pn >> 4, hd0 = (u.pn & 15) * 2, dcol = wc * 32 + 8 * fq;
        if (kind == 1) {
            const int gc0 = col0 - 4096;
            f32x4 l0[2], l1[2];
#pragma unroll
            for (int bj = 0; bj < 2; ++bj) { l0[bj] = *(const f32x4*)(lb + gc0 + bj * HALF); l1[bj] = *(const f32x4*)(lb + gc0 + bj * HALF + 4); }
#pragma unroll
            for (int ai = 0; ai < 2; ++ai)
#pragma unroll
                for (int m = 0; m < 4; ++m) { const size_t r = (size_t)(row0 + ai * HALF + m * 16); bf16_t* rowp = P + (((size_t)1 * 32 + hd0) * 16384 + r) * 128 + dcol; _Float16* gp = G + ((size_t)hd0 * 16384 + r) * 128 + dcol; const float rs = rsc.get(u, wr * 64 + fr + ai * HALF + m * 16);
#pragma unroll
                    for (int bj = 0; bj < 2; ++bj) { f32x4 v0 = acc[ai][bj][m][0] * rs, v1 = acc[ai][bj][m][1] * rs, g0, g1;
#pragma unroll
                        for (int j = 0; j < 4; ++j) { const float f0 = l0[bj][j] + (1.f - l0[bj][j]) * sigm(v0[j]), f1 = l1[bj][j] + (1.f - l1[bj][j]) * sigm(v1[j]);
                            g0[j] = log2f(f0); g1[j] = log2f(f1); v0[j] = 1.f - f0; v1[j] = 1.f - f1; }
                        u32x4 w; w.x = cvt_pk_bf16(v0[0], v0[1]); w.y = cvt_pk_bf16(v0[2], v0[3]); w.z = cvt_pk_bf16(v1[0], v1[1]); w.w = cvt_pk_bf16(v1[2], v1[3]);
                        STORE_NT((u32x4*)(rowp + (size_t)bj * HSTR), w); { typedef _Float16 h2 __attribute__((ext_vector_type(2))); typedef float f2 __attribute__((ext_vector_type(2)));
                          u32x4 gw; gw.x = __builtin_bit_cast(unsigned, __builtin_convertvector((f2){g0[0], g0[1]}, h2)); gw.y = __builtin_bit_cast(unsigned, __builtin_convertvector((f2){g0[2], g0[3]}, h2));
                          gw.z = __builtin_bit_cast(unsigned, __builtin_convertvector((f2){g1[0], g1[1]}, h2)); gw.w = __builtin_bit_cast(unsigned, __builtin_convertvector((f2){g1[2], g1[3]}, h2));
                          STORE_NT((u32x4*)(gp + (size_t)bj * HSTR), gw); } } }
        } else {
            const bool act = kind != 2;
#pragma unroll
            for (int ai = 0; ai < 2; ++ai)
#pragma unroll
                for (int m = 0; m < 4; ++m) { bf16_t* rowp = P + (((size_t)kind * 32 + hd0) * 16384 + (size_t)(row0 + ai * HALF + m * 16)) * 128 + dcol; const float rs = rsc.get(u, wr * 64 + fr + ai * HALF + m * 16);
#pragma unroll
                    for (int bj = 0; bj < 2; ++bj) { f32x4 v0 = acc[ai][bj][m][0] * rs, v1 = acc[ai][bj][m][1] * rs;
                        if (act) {
#pragma unroll
                            for (int j = 0; j < 4; ++j) { v0[j] = v0[j] * sigm(v0[j]); v1[j] = v1[j] * sigm(v1[j]); } }
                        u32x4 w; w.x = cvt_pk_bf16(v0[0], v0[1]); w.y = cvt_pk_bf16(v0[2], v0[3]); w.z = cvt_pk_bf16(v1[0], v1[1]); w.w = cvt_pk_bf16(v1[2], v1[3]);
                        STORE_NT((u32x4*)(rowp + (size_t)bj * HSTR), w); } }
        }
    }
};
template <class Epi, class Sched, bool ALIGN_EPI = false, bool SP2 = false>
__device__ __forceinline__ void gemm_phase(PG8_LAS unsigned char* lds, const Gemm g, const Sched& S, const Epi& E) {
    const int tid = opaque_tid(), wid = __builtin_amdgcn_readfirstlane(tid >> 6), lane = tid & 63, wr = wid >> 2, wc = wid & 3, fr = lane & 15, fq = lane >> 4;
    const int K = g.K, nt = K / BK;
    unsigned voffA[2], voffB[2];
    static_assert(Epi::PERM, "the weights are stored with the PERM row order baked in");
#pragma unroll
    for (int i = 0; i < 2; ++i) { voffA[i] = (unsigned)(tid * 16 + i * 8192); voffB[i] = voffA[i]; }
    const size_t kstep = (size_t)BM * BK * 2, hstep = (size_t)HALF * BK * 2;
    const size_t tstep = (size_t)BM * K * 2;
    const size_t kstepB = kstep, hstepB = hstep;
    const unsigned ldsw = (unsigned)wid * 1024u;
    const int aoff = lds_byte(wr * 64 + fr, fq * 8), boff = lds_byte(wc * 32 + fr, fq * 8);
#define PG8_SA(b, h) (((b) * 2 + (h)) * HTB)
#define PG8_SB(b, h) ((4 + (b) * 2 + (h)) * HTB)
#define PG8_STAGE(bufoff, gbase, voff) do { _Pragma("unroll") for (int _i = 0; _i < 2; ++_i) \
        __builtin_amdgcn_global_load_lds((const unsigned*)((const char*)(gbase) + (voff)[_i]), (PG8_LAS unsigned*)(lds + (bufoff) + ldsw + _i * 8192), 16, 0, 0); } while (0)
#define PG8_LDA(dst, b, h) do { _Pragma("unroll") for (int m = 0; m < 4; ++m) _Pragma("unroll") for (int k = 0; k < 2; ++k) dst[m][k] = *(const PG8_LAS bf16x8*)(lds + PG8_SA(b, h) + aoff + m * 2048 + k * 1024); } while (0)
#define PG8_LDB(dst, b, h) do { _Pragma("unroll") for (int n = 0; n < 2; ++n) _Pragma("unroll") for (int k = 0; k < 2; ++k) dst[n][k] = *(const PG8_LAS bf16x8*)(lds + PG8_SB(b, h) + boff + n * 2048 + k * 1024); } while (0)
#ifndef PG8_PRIO
#define PG8_PRIO 1
#endif
#define PG8_MMA(ai, bj, At, Bt) do { if (PG8_PRIO) __builtin_amdgcn_s_setprio(1); _Pragma("unroll") for (int m = 0; m < 4; ++m) _Pragma("unroll") for (int n = 0; n < 2; ++n) _Pragma("unroll") for (int k = 0; k < 2; ++k) \
        acc[ai][bj][m][n] = __builtin_amdgcn_mfma_f32_16x16x32_bf16(Bt[n][k], At[m][k], acc[ai][bj][m][n], 0, 0, 0); if (PG8_PRIO) __builtin_amdgcn_s_setprio(0); } while (0)
#define PG8_WAIT_V(n) asm volatile("s_waitcnt vmcnt(" #n ")" ::: "memory")
#define PG8_WAIT_L(n) asm volatile("s_waitcnt lgkmcnt(" #n ")" ::: "memory")
#define PG8_BAR __builtin_amdgcn_s_barrier()
#define PG8_SCHED __builtin_amdgcn_sched_barrier(0)
    Unit cur, nxt; int ui = 0;
    if (!S.next(0, cur)) return;
    f32x4 acc[2][2][4][2];
#pragma unroll
    for (int a = 0; a < 2; ++a)
#pragma unroll
        for (int b = 0; b < 2; ++b)
#pragma unroll
            for (int m = 0; m < 4; ++m)
#pragma unroll
                for (int n = 0; n < 2; ++n) acc[a][b][m][n] = (f32x4){0.f, 0.f, 0.f, 0.f};
    bf16x8 At[4][2], B0[2][2], B1[2][2];
    const char* cA = (const char*)g.A + (size_t)cur.pm * tstep; const char* cB = (const char*)g.Bt + (size_t)cur.pn * tstep;
    S.a_ready(cur);
    if constexpr (SP2) {
        PG8_STAGE(PG8_SB(0, 0), cB, voffB); PG8_STAGE(PG8_SB(0, 1), cB + hstepB, voffB); PG8_STAGE(PG8_SA(0, 0), cA, voffA); PG8_STAGE(PG8_SA(0, 1), cA + hstep, voffA);
        if (wr == 1) PG8_BAR;
        PG8_WAIT_V(2); PG8_BAR;
        PG8_STAGE(PG8_SB(1, 0), cB + kstepB, voffB); PG8_STAGE(PG8_SA(1, 0), cA + kstep, voffA); PG8_STAGE(PG8_SB(1, 1), cB + hstepB + kstepB, voffB);
        PG8_WAIT_V(6); PG8_BAR;
    } else {
        PG8_STAGE(PG8_SB(0, 0), cB, voffB); PG8_STAGE(PG8_SA(0, 0), cA, voffA); PG8_STAGE(PG8_SB(0, 1), cB + hstepB, voffB); PG8_STAGE(PG8_SA(0, 1), cA + hstep, voffA);
        if (wr == 1) PG8_BAR;
        PG8_WAIT_V(4); PG8_BAR;
        PG8_STAGE(PG8_SB(1, 0), cB + kstepB, voffB); PG8_STAGE(PG8_SA(1, 0), cA + kstep, voffA); PG8_STAGE(PG8_SB(1, 1), cB + hstepB + kstepB, voffB);
        PG8_WAIT_V(6); PG8_BAR;
    }
    for (;;) {
        const bool has_next = S.next(ui + 1, nxt);
        const char* nA = has_next ? (const char*)g.A + (size_t)nxt.pm * tstep : cA; const char* nB = has_next ? (const char*)g.Bt + (size_t)nxt.pn * tstep : cB;
        for (int t = 0; t < nt; t += 2) {
            const bool last = (t == nt - 2);
            const char* a1 = cA + (size_t)(t + 1) * kstep;
            const char* a2 = last ? nA : cA + (size_t)(t + 2) * kstep; const char* b2 = last ? nB : cB + (size_t)(t + 2) * kstepB;
            const char* a3 = a2 + kstep; const char* b3 = b2 + kstepB;
            if (last && has_next) S.a_ready(nxt);
            if constexpr (SP2) {
            PG8_LDB(B0, 0, 0); PG8_LDB(B1, 0, 1); PG8_SCHED; PG8_LDA(At, 0, 0); PG8_STAGE(PG8_SA(1, 1), a1 + hstep, voffA);
            PG8_WAIT_V(8); PG8_WAIT_L(0); PG8_BAR; PG8_MMA(0, 0, At, B0); PG8_MMA(0, 1, At, B1); PG8_BAR; PG8_SCHED;
            PG8_LDA(At, 0, 1); PG8_STAGE(PG8_SB(0, 0), b2, voffB); PG8_STAGE(PG8_SB(0, 1), b2 + hstepB, voffB); PG8_STAGE(PG8_SA(0, 0), a2, voffA);
            PG8_WAIT_V(8); PG8_WAIT_L(0); PG8_BAR; PG8_MMA(1, 0, At, B0); PG8_MMA(1, 1, At, B1); PG8_BAR; PG8_SCHED;
            PG8_LDB(B0, 1, 0); PG8_LDB(B1, 1, 1); PG8_SCHED; PG8_LDA(At, 1, 0); PG8_STAGE(PG8_SA(0, 1), a2 + hstep, voffA);
            PG8_WAIT_V(8); PG8_WAIT_L(0); PG8_BAR; PG8_MMA(0, 0, At, B0); PG8_MMA(0, 1, At, B1); PG8_BAR; PG8_SCHED;
            PG8_LDA(At, 1, 1); PG8_STAGE(PG8_SB(1, 0), b3, voffB); PG8_STAGE(PG8_SB(1, 1), b3 + hstepB, voffB); PG8_STAGE(PG8_SA(1, 0), a3, voffA);
            PG8_WAIT_V(8); PG8_WAIT_L(0); PG8_BAR; PG8_MMA(1, 0, At, B0); PG8_MMA(1, 1, At, B1); PG8_BAR; PG8_SCHED;
            } else {
            PG8_LDB(B0, 0, 0); PG8_SCHED; PG8_LDA(At, 0, 0); PG8_STAGE(PG8_SA(1, 1), a1 + hstep, voffA);
            PG8_WAIT_L(8); PG8_BAR; PG8_WAIT_L(0); PG8_MMA(0, 0, At, B0); PG8_BAR; PG8_SCHED;
            PG8_LDB(B1, 0, 1); PG8_STAGE(PG8_SB(0, 0), b2, voffB);
            PG8_BAR; PG8_WAIT_L(0); PG8_MMA(0, 1, At, B1); PG8_BAR;
            PG8_LDA(At, 0, 1); PG8_STAGE(PG8_SA(0, 0), a2, voffA);
            PG8_BAR; PG8_WAIT_L(0); PG8_MMA(1, 0, At, B0); PG8_BAR; PG8_SCHED;
            PG8_STAGE(PG8_SB(0, 1), b2 + hstepB, voffB);
            PG8_WAIT_V(6); PG8_BAR; PG8_MMA(1, 1, At, B1); PG8_BAR;
            PG8_LDB(B0, 1, 0); PG8_SCHED; PG8_LDA(At, 1, 0); PG8_STAGE(PG8_SA(0, 1), a2 + hstep, voffA);
            PG8_WAIT_L(8); PG8_BAR; PG8_WAIT_L(0); PG8_MMA(0, 0, At, B0); PG8_BAR; PG8_SCHED;
            PG8_LDB(B1, 1, 1); PG8_STAGE(PG8_SB(1, 0), b3, voffB);
            PG8_BAR; PG8_WAIT_L(0); PG8_MMA(0, 1, At, B1); PG8_BAR;
            PG8_LDA(At, 1, 1); PG8_STAGE(PG8_SA(1, 0), a3, voffA);
            PG8_BAR; PG8_WAIT_L(0); PG8_MMA(1, 0, At, B0); PG8_BAR; PG8_SCHED;
            PG8_STAGE(PG8_SB(1, 1), b3 + hstepB, voffB);
            PG8_WAIT_V(6); PG8_BAR; PG8_MMA(1, 1, At, B1); PG8_BAR;
            }
        }
        if constexpr (ALIGN_EPI) { if (wr == 0) PG8_BAR; }
        if constexpr (!Epi::AFTER_DRAIN) { E(acc, cur, wr, wc, fr, fq); S.done(cur); }
        if (!has_next) break;
#pragma unroll
        for (int a = 0; a < 2; ++a)
#pragma unroll
            for (int b = 0; b < 2; ++b)
#pragma unroll
                for (int m = 0; m < 4; ++m)
#pragma unroll
                    for (int n = 0; n < 2; ++n) acc[a][b][m][n] = (f32x4){0.f, 0.f, 0.f, 0.f};
        cur = nxt; cA = nA; cB = nB; ++ui;
        if constexpr (ALIGN_EPI) { if (wr == 1) PG8_BAR; }
    }
    PG8_WAIT_V(0);
    if constexpr (!ALIGN_EPI) { if (wr == 0) PG8_BAR; }
    PG8_BAR;
    if constexpr (Epi::AFTER_DRAIN) { E.fused(acc, cur, wr, wc, fr, fq, lds, wid, lane); S.done(cur); }
#undef PG8_SA
#undef PG8_SB
#undef PG8_STAGE
#undef PG8_LDA
#undef PG8_LDB
#undef PG8_MMA
#undef PG8_WAIT_V
#undef PG8_WAIT_L
#undef PG8_BAR
#undef PG8_SCHED
}
}
#define XB_TMO      128
#define XB_XCNT(j)  (256  + 64 * (j))
#define XB_XSUB(j)  (1280 + 64 * (j))
#define XB_XGEN(j)  (2304 + 64 * (j))
#define XB_TOP      3328
#define XB_TOPGEN   3392
#define XCD_BAR_WORDS 3456
#define XB_SPIN_CAP (1u << 18)
#define LAS __attribute__((address_space(3)))

__device__ __forceinline__ unsigned xb_ld(unsigned* p)              { return __hip_atomic_load((__attribute__((address_space(1))) unsigned*)p, __ATOMIC_RELAXED, __HIP_MEMORY_SCOPE_AGENT); }
__device__ __forceinline__ unsigned xb_add(unsigned* p, unsigned v) { return __hip_atomic_fetch_add((__attribute__((address_space(1))) unsigned*)p, v, __ATOMIC_RELAXED, __HIP_MEMORY_SCOPE_AGENT); }
__device__ __forceinline__ unsigned xb_xcc_id() { return (unsigned)__builtin_amdgcn_s_getreg((3 << 11) | 20) & 0xFu; }
#define XB_SPIN(cond, bar) do { unsigned _sp = 0; while (cond) { __builtin_amdgcn_s_sleep(1); \
    if ((++_sp & 255u) == 0u) { if (xb_ld(&(bar)[XB_TMO])) break; if (_sp > XB_SPIN_CAP) { atomicAdd(&(bar)[XB_TMO], 1u); break; } } } } while (0)

struct XcdBarrier {
    unsigned* bar; unsigned x;
    volatile LAS unsigned* st;
};

__device__ __forceinline__ XcdBarrier xcd_barrier_post(unsigned* bar, volatile LAS unsigned* st) {
    XcdBarrier b; b.bar = bar; b.x = xb_xcc_id(); b.st = st;
    if (threadIdx.x == 0) (void)xb_add(&bar[XB_XCNT(b.x)], 1u);
    return b;
}
__device__ __forceinline__ void xcd_barrier_complete(unsigned* bar, unsigned x, unsigned& nloc, unsigned& nx) {
    const unsigned G = gridDim.x * gridDim.y * gridDim.z;
    unsigned sum, cnt, mine, sp = 0u;
    for (;;) {
        sum = 0u; cnt = 0u; mine = 0u;
#pragma unroll
        for (unsigned j = 0; j < 16; ++j) { const unsigned c = xb_ld(&bar[XB_XCNT(j)]); sum += c; cnt += (c > 0u) ? 1u : 0u; mine = (j == x) ? c : mine; }
        if (sum == G) break;
        __builtin_amdgcn_s_sleep(1);
        if ((++sp & 255u) == 0u) { if (xb_ld(&bar[XB_TMO])) break; if (sp > XB_SPIN_CAP) { atomicAdd(&bar[XB_TMO], 1u); break; } }
    }
    nloc = mine > 0u ? mine : 1u; nx = cnt > 0u ? cnt : 1u;
}

__device__ __forceinline__ void xcd_barrier(const XcdBarrier& b) {
    asm volatile("s_waitcnt vmcnt(0)" ::: "memory");
    __syncthreads();
    if (threadIdx.x == 0) {
        unsigned* bar = b.bar;
        __builtin_amdgcn_s_waitcnt(0);
        unsigned nloc = b.st[0], nx = b.st[1];
        if (nloc == 0u) { xcd_barrier_complete(bar, b.x, nloc, nx); b.st[0] = nloc; b.st[1] = nx; }
        const unsigned old = xb_add(&bar[XB_XSUB(b.x)], 1u);
        const unsigned gen = old / nloc;
        if (old + 1u == (gen + 1u) * nloc) {
            __builtin_amdgcn_fence(__ATOMIC_RELEASE, "agent");
            asm volatile("s_waitcnt vmcnt(0)" ::: "memory");
            const unsigned og = xb_add(&bar[XB_TOP], 1u);
            const unsigned tg = og / nx;
            if (og + 1u == (tg + 1u) * nx) xb_add(&bar[XB_TOPGEN], 1u);
            else XB_SPIN(xb_ld(&bar[XB_TOPGEN]) == tg, bar);
            __builtin_amdgcn_fence(__ATOMIC_ACQUIRE, "agent");
            xb_add(&bar[XB_XGEN(b.x)], 1u);
            asm volatile("s_waitcnt vmcnt(0)" ::: "memory");
        } else {
            XB_SPIN(xb_ld(&bar[XB_XGEN(b.x)]) == gen, bar);
            __builtin_amdgcn_fence(__ATOMIC_ACQUIRE, "agent");
            asm volatile("s_waitcnt vmcnt(0)" ::: "memory");
        }
    }
    __syncthreads();
}

#define XB_LSUB(j)  (8192 + 64 * (j))
#define XB_LGEN(j)  (9216 + 64 * (j))
#define XB_XID      10240
__device__ __forceinline__ void xcd_local_barrier(const XcdBarrier& b) {
    asm volatile("s_waitcnt vmcnt(0)" ::: "memory");
    __syncthreads();
    if (threadIdx.x == 0) {
        unsigned* bar = b.bar;
        __builtin_amdgcn_s_waitcnt(0);
        unsigned nloc = b.st[0]; if (nloc == 0u) nloc = 1u;
        const unsigned old = xb_add(&bar[XB_LSUB(b.x)], 1u);
        const unsigned gen = old / nloc;
        if (old + 1u == (gen + 1u) * nloc) xb_add(&bar[XB_LGEN(b.x)], 1u);
        else XB_SPIN(xb_ld(&bar[XB_LGEN(b.x)]) == gen, bar);
        __builtin_amdgcn_fence(__ATOMIC_ACQUIRE, "agent");
        asm volatile("s_waitcnt vmcnt(0)" ::: "memory");
    }
    __syncthreads();
}
__device__ __forceinline__ int xcd_groups_local(unsigned* bar) {
    int ok = 1;
    if (gridDim.x != 256u) ok = 0;
    else if (threadIdx.x < 256u) { const unsigned v = xb_ld(&bar[XB_XID + threadIdx.x]), ref = xb_ld(&bar[XB_XID + (threadIdx.x & 7u)]); ok = (v != 0u && v == ref) ? 1 : 0; }
    return __syncthreads_and(ok);
}
constexpr int NWAVES = 8;
__device__ __forceinline__ float wave_sum(float v, int lane) {
#pragma unroll
    for (int o = 1; o < 64; o <<= 1) v += shx(v, o, lane);
    return v;
}
struct TileRegs { f32x4 v[4][8]; };
__device__ __forceinline__ void tile_load(const float* W, int N, int k0, int n0, int lane, TileRegs& t) {
    const int half = lane >> 5, nn = lane & 31, n = 4 * nn;
    const bool ok = n0 + n < N;
    const float* src = W + (size_t)k0 * N + n0 + n;
#pragma unroll
    for (int j = 0; j < 4; ++j)
#pragma unroll
        for (int r = 0; r < 8; ++r)
            t.v[j][r] = ok ? __builtin_nontemporal_load((const f32x4*)(src + (size_t)(8 * (2 * j + half) + r) * N)) : (f32x4){0.f, 0.f, 0.f, 0.f};
}
__device__ __forceinline__ void tile_to_lds(LAS unsigned* T, int lane, const TileRegs& t) {
    const int half = lane >> 5, nn = lane & 31, n = 4 * nn, sw = nn & 7;
#pragma unroll
    for (int j = 0; j < 4; ++j) { const int ch = (2 * j + half) ^ sw;
#pragma unroll
        for (int e = 0; e < 4; ++e)
            *(LAS v4u*)(T + (n + e) * 32 + 4 * ch) = (v4u){cvtpk(t.v[j][0][e], t.v[j][1][e]), cvtpk(t.v[j][2][e], t.v[j][3][e]), cvtpk(t.v[j][4][e], t.v[j][5][e]), cvtpk(t.v[j][6][e], t.v[j][7][e])}; }
    LDS_WAIT(); asm volatile("" ::: "memory");
}
__device__ __forceinline__ void tile_store(int K, int N, bf16* WT, const LAS unsigned* T, int k0, int n0, int lane) {
#pragma unroll 4
    for (int j = 0; j < 16; ++j) { const int idx = lane + 64 * j, c = idx & 7, nr = idx >> 3;
        const v4u w = *(const LAS v4u*)(T + nr * 32 + 4 * (c ^ ((nr >> 2) & 7)));
        if (n0 + nr < N) *(v4u*)(WT + tiled_off_w((size_t)(n0 + nr), k0 + 8 * c, K >> 6)) = w; }
    LDS_WAIT(); asm volatile("" ::: "memory");
}
__device__ __forceinline__ void transpose_matrix(const float* W, int K, int N, bf16* WT, LAS float* scr, int gw, int ngw, int lane, int i_lo, int i_hi) {
    const int nnt = (N + 127) / 128, nitems = (K / 64) * nnt;
    TileRegs t;
    if (i_lo < i_hi && gw + i_lo * ngw < nitems) { const int it = gw + i_lo * ngw, kb = it / nnt, nb = it - kb * nnt; tile_load(W, N, 64 * kb, 128 * nb, lane, t); }
    for (int i = i_lo; i < i_hi; ++i) { const int it = gw + i * ngw; if (it >= nitems) break; const int kb = it / nnt, nb = it - kb * nnt;
        tile_to_lds((LAS unsigned*)scr, lane, t);
        const int itn = it + ngw; if (i + 1 < i_hi && itn < nitems) { const int kbn = itn / nnt, nbn = itn - kbn * nnt; tile_load(W, N, 64 * kbn, 128 * nbn, lane, t); }
        tile_store(K, N, WT, (const LAS unsigned*)scr, 64 * kb, 128 * nb, lane); }
}
struct ConvArgs { const float* fox_w_in; const float* fox_w_out; const float* hgrn_w_in; const float* hgrn_w_out; const float* up; const float* down; };
__device__ __forceinline__ void conv_pick(unsigned char* ws, const ConvArgs& a, int q, const float*& src, bf16*& dst, int& K, int& N) {
    const int L = q >> 2, k = q & 3, j = L >> 1; const bool fox = (L & 1) == 0;
    if (k == 0) { K = DM; if (fox) { src = a.fox_w_in + (size_t)j * DM * FOX_IN; N = FOX_IN; dst = (bf16*)(ws + WS_WFIN) + (size_t)j * FOX_INP * DM; } else { src = a.hgrn_w_in + (size_t)j * DM * HG_IN; N = HG_IN; dst = (bf16*)(ws + WS_WHIN) + (size_t)j * HG_IN * DM; } }
    else if (k == 1) { K = DM; N = DM; if (fox) { src = a.fox_w_out + (size_t)j * DM * DM; dst = (bf16*)(ws + WS_WFOUT) + (size_t)j * DM * DM; } else { src = a.hgrn_w_out + (size_t)j * DM * DM; dst = (bf16*)(ws + WS_WHOUT) + (size_t)j * DM * DM; } }
    else if (k == 2) { K = DM; N = DFF; src = a.up + (size_t)L * DM * DFF; dst = (bf16*)(ws + WS_WUP) + (size_t)L * DFF * DM; }
    else { K = DFF; N = DM; src = a.down + (size_t)L * DFF * DM; dst = (bf16*)(ws + WS_WDN) + (size_t)L * DM * DFF; }
}
__device__ __forceinline__ void conv_weights(LAS unsigned char* lds, unsigned char* ws, const ConvArgs& a, int q, int vcu, int G, int part, int g) {
    const int tid = opaque_tid(), lane = tid & 63, wave = tid >> 6;
    LAS float* scr = (LAS float*)(lds + wave * 16384);
    const int gw = vcu * NWAVES + wave, ngw = G * NWAVES;
    const int L = q >> 2, k = q & 3; const bool fox = (L & 1) == 0;
    const float* src; bf16* dst; int K, N;
    conv_pick(ws, a, q, src, dst, K, N);
    const int cnt = ((K / 64) * ((N + 127) / 128) + ngw - 1) / ngw, cut = (g * cnt + 1) / 3;
    transpose_matrix(src, K, N, dst, scr, gw, ngw, lane, part == 2 ? cut : 0, part == 1 ? cut : cnt);
    if (k == 0 && fox && (part == 0 || (part == 1) == (g >= 2))) {
        const size_t n16 = (size_t)(FOX_INP - FOX_IN) * DM * 2 / 16; v4u zz = {0u, 0u, 0u, 0u}; asm volatile("" : "+v"(zz));
        for (size_t i = (size_t)(vcu * 512 + tid); i < n16; i += (size_t)G * 512) { const int kt = (int)(i / (224 * 8)), rem = (int)(i % (224 * 8)), nl = 32 + (rem >> 3), c = rem & 7;
            *(v4u*)(dst + tiled_off_w((size_t)(16384 + nl), 64 * kt + 8 * c, DM >> 6)) = zz; } }
    __syncthreads();
}
__device__ __forceinline__ void conv_tiles(LAS unsigned char* lds, unsigned char* ws, const ConvArgs& a, int q, int vcu, int G, int i_lo, int i_hi) {
    const int tid = opaque_tid(), lane = tid & 63, wave = tid >> 6;
    LAS float* scr = (LAS float*)(lds + wave * 16384);
    const float* src; bf16* dst; int K, N;
    conv_pick(ws, a, q, src, dst, K, N);
    transpose_matrix(src, K, N, dst, scr, vcu * NWAVES + wave, G * NWAVES, lane, i_lo, i_hi);
    __syncthreads();
}
#ifndef ATT_ALL
#define ATT_ALL 1
#endif
__device__ __forceinline__ void conv_chunk(LAS unsigned char* lds, unsigned char* ws, const ConvArgs& a, int qbase, int c, int vcu, int G) {
    int base = qbase; if (c >= 7) { c -= 7; base += 4; }
    if (c == 0) conv_tiles(lds, ws, a, base, vcu, G, 0, 1);
    else if (c == 7) conv_tiles(lds, ws, a, base + 3, vcu, G, 4, 5);
    else { const int il = 2 * ((c - 1) & 1); conv_tiles(lds, ws, a, base + 1 + ((c - 1) >> 1), vcu, G, il, il + 2); }
}
__device__ __forceinline__ int att_chunks(int qbase, int qend) { const int nm = qend - qbase;
    return nm <= 0 ? 0 : nm <= 4 ? 7 : nm == 8 ? 15 : 12; }
__device__ __forceinline__ void prologue_phase(LAS unsigned char* lds, unsigned char* ws, const ConvArgs& a, const float* lb_logits, int vcu, int G) {
    conv_weights(lds, ws, a, 0, vcu, G, 0, 0);
    const int tid = opaque_tid();
    for (int c = vcu * 512 + tid; c < DM; c += G * 512) {
        float l[4], mx = -1e30f; for (int i = 0; i < 4; ++i) { l[i] = lb_logits[i * DM + c]; mx = fmaxf(mx, l[i]); }
        float s = 0.f; for (int i = 0; i < 4; ++i) { l[i] = expf(l[i] - mx); s += l[i]; }
        float* LB = (float*)(ws + WS_LB); float cum = 0.f; const float p0 = l[0] / s;
        for (int i = 0; i < 4; ++i) { cum += l[i] / s; LB[i * DM + c] = cum - p0; }
    }
}
struct RowRegs { f32x4 v[16]; };
__device__ __forceinline__ void row_load(const float* src, int row, int lane, RowRegs& r) {
    const f32x4* xr = (const f32x4*)(src + (size_t)row * DM) + lane;
#pragma unroll
    for (int j = 0; j < 16; ++j) r.v[j] = xr[64 * j];
}
template <bool TO_F32>
__device__ __forceinline__ void rms_row(const RowRegs& r, const f32x4 (&g)[16], void* dst, int row, int lane) {
    float ss = 0.f;
#pragma unroll
    for (int j = 0; j < 16; ++j) ss += (r.v[j].x * r.v[j].x + r.v[j].y * r.v[j].y) + (r.v[j].z * r.v[j].z + r.v[j].w * r.v[j].w);
    const float rstd = rsqrtf(wave_sum(ss, lane) * (1.f / DM) + NORM_EPS);
#pragma unroll
    for (int j = 0; j < 16; ++j) { const f32x4 o = r.v[j] * rstd * g[j];
        if constexpr (TO_F32) ((f32x4*)((float*)dst + (size_t)row * DM) + lane)[64 * j] = o;
        else { v2u w; w.x = cvtpk(o.x, o.y); w.y = cvtpk(o.z, o.w); ((v2u*)((bf16*)dst + (size_t)row * DM) + lane)[64 * j] = w; } }
}
template <bool TO_F32>
__device__ __forceinline__ void rms_phase(const float* src, const float* gain, void* dst, int vcu, int G) {
    const int tid = opaque_tid(), lane = tid & 63, wave = tid >> 6;
    const int gw = vcu * NWAVES + wave, ngw = G * NWAVES;
    f32x4 g[16];
#pragma unroll
    for (int j = 0; j < 16; ++j) g[j] = ((const f32x4*)gain + lane)[64 * j];
    RowRegs ra, rb;
    if (gw < SEQ) row_load(src, gw, lane, ra);
    for (int row = gw; row < SEQ; row += 2 * ngw) {
        if (row + ngw < SEQ) row_load(src, row + ngw, lane, rb);
        rms_row<TO_F32>(ra, g, dst, row, lane);
        if (row + 2 * ngw < SEQ) row_load(src, row + 2 * ngw, lane, ra);
        if (row + ngw < SEQ) rms_row<TO_F32>(rb, g, dst, row + ngw, lane);
    }
}
__device__ __forceinline__ void rms0_row(const RowRegs& r, const f32x4 (&g)[16], bf16* dst, float* part, int row, int lane) {
    float ss = 0.f;
#pragma unroll
    for (int j = 0; j < 16; ++j) { const f32x4 v = r.v[j]; ss += (v.x * v.x + v.y * v.y) + (v.z * v.z + v.w * v.w); const f32x4 o = v * g[j];
        v2u w; w.x = cvtpk(o.x, o.y); w.y = cvtpk(o.z, o.w); *(v2u*)(dst + tiled_off((size_t)row, 4 * (lane + 64 * j), DM >> 6)) = w; }
    ss = wave_sum(ss, lane);
    part[(size_t)row * 64 + lane] = lane == 0 ? ss : 0.f;
}
__device__ __forceinline__ void rms0_phase(const float* src, const float* gain, bf16* dst, float* part, int vcu, int G) {
    const int tid = opaque_tid(), lane = tid & 63, wave = tid >> 6;
    const int gw = vcu * NWAVES + wave, ngw = G * NWAVES;
    f32x4 g[16];
#pragma unroll
    for (int j = 0; j < 16; ++j) g[j] = ((const f32x4*)gain + lane)[64 * j];
    RowRegs ra, rb;
    if (gw < SEQ) row_load(src, gw, lane, ra);
    for (int row = gw; row < SEQ; row += 2 * ngw) {
        if (row + ngw < SEQ) row_load(src, row + ngw, lane, rb);
        rms0_row(ra, g, dst, part, row, lane);
        if (row + 2 * ngw < SEQ) row_load(src, row + 2 * ngw, lane, ra);
        if (row + ngw < SEQ) rms0_row(rb, g, dst, part, row + ngw, lane);
    }
}
__device__ __forceinline__ void fz_phase(LAS unsigned char* lds, const bf16* XN, const bf16* WF, const float* part, const float* fbias, float* LOGF, float* CS, int vcu, int G) {
    const int tid = opaque_tid(), lane = tid & 63, wave = __builtin_amdgcn_readfirstlane(tid >> 6), r = lane & 15, q = lane >> 4, rt = wave & 3, kh = wave >> 2;
    LAS float* red = (LAS float*)lds;
    LAS float* csw = red + 4 * 8 * 64;
    for (int blk = vcu; blk < SEQ / 64; blk += G) {
        const int row0 = blk * 64 + 16 * rt;
        const size_t khoff = (size_t)kh * 32 * 32768;
        const char* pa = (const char*)(XN + tiled_off((size_t)(row0 + r), 8 * q, DM >> 6)) + khoff;
        const char* px = (const char*)(WF + tiled_off((size_t)(16384 + r), 8 * q, DM >> 6)) + khoff;
        const char* py = (const char*)(WF + tiled_off((size_t)(16384 + 16 + r), 8 * q, DM >> 6)) + khoff;
        f32x4 acc1 = {0.f, 0.f, 0.f, 0.f}, acc2 = {0.f, 0.f, 0.f, 0.f};
        bf16x8 A0[4], X0[4], Y0[4], A1[4], X1[4], Y1[4], A2[4], X2[4], Y2[4];
#define FZ_LOAD(A_, X_, Y_, b_) do { _Pragma("unroll") for (int s_ = 0; s_ < 4; ++s_) { const size_t o_ = (size_t)(2 * (b_) + (s_ >> 1)) * 32768 + (size_t)(s_ & 1) * 1024; \
            A_[s_] = *(const bf16x8*)(pa + o_); X_[s_] = *(const bf16x8*)(px + o_); Y_[s_] = *(const bf16x8*)(py + o_); } } while (0)
#define FZ_MMA(A_, X_, Y_) do { _Pragma("unroll") for (int s_ = 0; s_ < 4; ++s_) { acc1 = __builtin_amdgcn_mfma_f32_16x16x32_bf16(X_[s_], A_[s_], acc1, 0, 0, 0); acc2 = __builtin_amdgcn_mfma_f32_16x16x32_bf16(Y_[s_], A_[s_], acc2, 0, 0, 0); } } while (0)
        FZ_LOAD(A0, X0, Y0, 0); FZ_LOAD(A1, X1, Y1, 1);
#pragma unroll 1
        for (int b = 0; b < 15; b += 3) {
            FZ_LOAD(A2, X2, Y2, b + 2); FZ_MMA(A0, X0, Y0);
            FZ_LOAD(A0, X0, Y0, b + 3); FZ_MMA(A1, X1, Y1);
            if (b + 4 < 16) FZ_LOAD(A1, X1, Y1, b + 4);
            FZ_MMA(A2, X2, Y2);
        }
        FZ_MMA(A0, X0, Y0);
#undef FZ_LOAD
#undef FZ_MMA
        if (kh == 1) {
#pragma unroll
            for (int i = 0; i < 4; ++i) { red[(rt * 8 + i) * 64 + lane] = acc1[i]; red[(rt * 8 + 4 + i) * 64 + lane] = acc2[i]; } }
        __syncthreads();
        if (kh == 0) {
#pragma unroll
            for (int i = 0; i < 4; ++i) { acc1[i] += red[(rt * 8 + i) * 64 + lane]; acc2[i] += red[(rt * 8 + 4 + i) * 64 + lane]; }
            const f32x4* pp = (const f32x4*)(part + (size_t)(row0 + r) * 64 + 16 * q);
            const f32x4 a = (pp[0] + pp[1]) + (pp[2] + pp[3]); float ssq = (a.x + a.y) + (a.z + a.w); ssq += shx(ssq, 16, lane); ssq += shx(ssq, 32, lane);
            const float rs = rsqrtf(ssq * (1.f / DM) + NORM_EPS);
            const f32x4 b0 = *(const f32x4*)(fbias + 8 * q), b1 = *(const f32x4*)(fbias + 8 * q + 4);
            f32x4 v0 = acc1 * rs + b0, v1 = acc2 * rs + b1;
#pragma unroll
            for (int jj = 0; jj < 4; ++jj) { v0[jj] = pg8::lsig(v0[jj]); v1[jj] = pg8::lsig(v1[jj]); }
            float* rowp = LOGF + (size_t)(row0 + r) * 32 + 8 * q; *(f32x4*)rowp = v0; *(f32x4*)(rowp + 4) = v1;
#pragma unroll
            for (int jj = 0; jj < 4; ++jj) {
#pragma unroll
                for (int o = 1; o < 16; o <<= 1) { v0[jj] += shx(v0[jj], o, lane); v1[jj] += shx(v1[jj], o, lane); } }
            if (r == 0) { *(LAS f32x4*)(csw + rt * 32 + 8 * q) = v0; *(LAS f32x4*)(csw + rt * 32 + 8 * q + 4) = v1; }
        }
        __syncthreads();
        if (tid < 32) CS[(size_t)blk * 32 + tid] = (csw[tid] + csw[32 + tid]) + (csw[64 + tid] + csw[96 + tid]);
        __syncthreads();
    }
}
__device__ __forceinline__ void rstd_table(LAS float* tab, const float* part, int pm0) {
    const int tid = opaque_tid(), lane = tid & 63, row = tid >> 1, half = tid & 1;
    const f32x4* p = (const f32x4*)(part + (size_t)(pm0 * 256 + row) * 64 + half * 32); f32x4 a = {0.f, 0.f, 0.f, 0.f};
#pragma unroll
    for (int i = 0; i < 8; ++i) a += p[i];
    float s = (a.x + a.y) + (a.z + a.w); s += shx(s, 1, lane);
    if (half == 0) tab[row] = rsqrtf(s * (1.f / DM) + NORM_EPS);
    __syncthreads();
}
__device__ __forceinline__ void fox_thin_phase(LAS unsigned char* lds, const float* LOGF, const float* CS, float* KB, int vcu, int G) {
    const int tid = opaque_tid(), lane = tid & 63, wave = tid >> 6;
    LAS float* red = (LAS float*)lds;
    LAS float* pre = red + 16 * 32;
    LAS float* tile = pre + 32;
    for (int blk = vcu; blk < SEQ / 64; blk += G) {
        const int r0 = blk * 64;
        { const int h = tid & 31, part = tid >> 5; float a = 0.f;
#pragma unroll 4
          for (int c = part; c < blk; c += 16) a += CS[c * 32 + h];
          red[part * 32 + h] = a; }
        { const int row = tid >> 3, c4 = tid & 7; const f32x4 v = *(const f32x4*)(LOGF + (size_t)(r0 + row) * 32 + 4 * c4);
          tile[row * 33 + 4 * c4 + 0] = v.x; tile[row * 33 + 4 * c4 + 1] = v.y; tile[row * 33 + 4 * c4 + 2] = v.z; tile[row * 33 + 4 * c4 + 3] = v.w; }
        __syncthreads();
        if (tid < 32) { float s = 0.f;
#pragma unroll
            for (int p = 0; p < 16; ++p) s += red[p * 32 + tid];
            float c = s;
            for (int r = 0; r < 64; ++r) { c += tile[r * 33 + tid]; tile[r * 33 + tid] = -c * LOG2E; } }
        __syncthreads();
        { const int h = tid >> 4, r4 = (tid & 15) * 4;
          const f32x4 o = {tile[(r4 + 0) * 33 + h], tile[(r4 + 1) * 33 + h], tile[(r4 + 2) * 33 + h], tile[(r4 + 3) * 33 + h]};
          *(f32x4*)(KB + (size_t)h * SEQ + r0 + r4) = o; }
        __syncthreads();
    }
}
__device__ __forceinline__ void jl_phase(LAS unsigned char* lds, const float* KB, const float* qg, const float* kg, int* JL, int vcu, int G) {
    const int tid = opaque_tid(), lane = tid & 63, wave = tid >> 6;
    LAS int* cnt = (LAS int*)lds;
    float gq = fmaxf(fabsf(qg[lane]), fabsf(qg[lane + 64])), gk = fmaxf(fabsf(kg[lane]), fabsf(kg[lane + 64]));
#pragma unroll
    for (int o = 1; o < 64; o <<= 1) { gq = fmaxf(gq, shx(gq, o, lane)); gk = fmaxf(gk, shx(gk, o, lane)); }
    const float TH = 48.f + 2.f * (128.f * gq * gk * QSCALE * 1.02f);
    for (int id = vcu; id < 2048; id += G) {
        const int h = id & 31, qb = 63 - (id >> 5);
        const float* kb = KB + (size_t)h * SEQ;
        const float lim = kb[qb * 256] - TH;
        const bool pred = (tid < 4 * qb) && (kb[64 * tid + 63] < lim);
        const unsigned long long bal = __ballot(pred);
        if (lane == 0) cnt[wave] = __popcll(bal);
        __syncthreads();
        if (tid == 0) { int s = 0; for (int w = 0; w < 8; ++w) s += cnt[w]; JL[id] = s; }
        __syncthreads();
    }
}
namespace fa {
constexpr int D = 128, NW = 8, QBLK = 32, KVBLK = 64, QB = NW * QBLK;
constexpr int LDQ = 128, LDO = 4096;
constexpr int SHM_V = KVBLK * D * 2, SHM_K = KVBLK * D * 2;
constexpr int OFF_WS = 2 * SHM_V + 2 * SHM_K, OFF_KB = OFF_WS + NW * 64 * 4;
constexpr int LDS_BYTES = OFF_KB + 2 * 64 * 4;
constexpr int OFF_OST = LDS_BYTES + 16 + 112;
constexpr int LDS_END = OFF_OST + NW * 8 * 132 * 4;
#define KSWZ(row, colB) ((row) * 256 + ((colB) ^ (((row) & 7) << 4)))
#define SBAR() __builtin_amdgcn_sched_barrier(0)
__device__ __forceinline__ int v_st(int k, int c) { const int kk = (k & ~0xC) | ((k & 4) << 1) | ((k & 8) >> 1); return ((kk >> 3) * 4 + (c >> 5)) * 512 + ((kk & 7) * 32 + (c & 31)) * 2; }
__device__ __forceinline__ int v_rd_base(int lane) { return ((lane & 3) << 3) | (((lane >> 2) & 3) << 6) | (((lane >> 4) & 1) << 5) | (((lane >> 5) & 1) << 8); }
constexpr int v_rd_off(int d0, int ks, int half) { return d0 * 512 + ks * 4096 + half * 2048; }
__device__ __forceinline__ int crow(int r, int hi) { return (r & 3) + 8 * (r >> 2) + 4 * hi; }
__device__ __forceinline__ bf16x8 ld8(const bf16* p) { return *reinterpret_cast<const bf16x8*>(p); }
__device__ __forceinline__ void mask_tile(f32x16& p0, f32x16& p1, int dq) {
    const float NEG = -__builtin_inff();
#pragma unroll
    for (int r = 0; r < 16; ++r) {
        const int c = (r & 3) + 8 * (r >> 2);
        if (dq - c < 0) p0[r] = NEG;
        if (dq - c - 32 < 0) p1[r] = NEG;
    }
}
__device__ __forceinline__ void partialSM(f32x16& p0, f32x16& p1, float mt) {
#pragma unroll
    for (int r = 0; r < 16; ++r) p0[r] = __builtin_amdgcn_exp2f(p0[r] - mt);
#pragma unroll
    for (int r = 0; r < 16; ++r) p1[r] = p1[r] - mt;
}
__device__ __forceinline__ void finishSM(f32x16& p0, f32x16& p1, float& l_reg, bf16x8& pa0, bf16x8& pa1, bf16x8& pa2, bf16x8& pa3) {
#pragma unroll
    for (int r = 0; r < 16; ++r) p1[r] = __builtin_amdgcn_exp2f(p1[r]);
    float ps = 0;
#pragma unroll
    for (int r = 0; r < 16; ++r) ps += p0[r];
#pragma unroll
    for (int r = 0; r < 16; ++r) ps += p1[r];
    { auto rr = __builtin_amdgcn_permlane32_swap(__float_as_uint(ps), __float_as_uint(ps), false, false);
      ps = __uint_as_float(rr[0]) + __uint_as_float(rr[1]); }
    l_reg += ps;
#define PK4(P, B_, OUT) do { unsigned a0 = cvtpk(P[B_+0], P[B_+1]), a1 = cvtpk(P[B_+2], P[B_+3]);                          \
        unsigned b0 = cvtpk(P[B_+4], P[B_+5]), b1 = cvtpk(P[B_+6], P[B_+7]);                                             \
        auto r0 = __builtin_amdgcn_permlane32_swap(a0, b0, false, false); auto r1 = __builtin_amdgcn_permlane32_swap(a1, b1, false, false); \
        v4u w = {r0[0], r1[0], r0[1], r1[1]}; OUT = *reinterpret_cast<bf16x8*>(&w); } while (0)
    PK4(p0, 0, pa0); PK4(p0, 8, pa1); PK4(p1, 0, pa2); PK4(p1, 8, pa3);
#undef PK4
}
template <int KB>
__device__ __forceinline__ void qkt(f32x16& p0, f32x16& p1, const char* K_lds, const float* kbl, int r32, int hi, const bf16x8* qr) {
#ifdef X_NOBIAS
    p0 = f32x16{}; p1 = f32x16{};
#else
    { const float* kb = kbl + KB * 64 + 4 * hi;
      const f32x4 a0 = *(const f32x4*)(kb), a1 = *(const f32x4*)(kb + 8), a2 = *(const f32x4*)(kb + 16), a3 = *(const f32x4*)(kb + 24);
      const f32x4 b0 = *(const f32x4*)(kb + 32), b1 = *(const f32x4*)(kb + 40), b2 = *(const f32x4*)(kb + 48), b3 = *(const f32x4*)(kb + 56);
      p0 = f32x16{a0[0], a0[1], a0[2], a0[3], a1[0], a1[1], a1[2], a1[3], a2[0], a2[1], a2[2], a2[3], a3[0], a3[1], a3[2], a3[3]};
      p1 = f32x16{b0[0], b0[1], b0[2], b0[3], b1[0], b1[1], b1[2], b1[3], b2[0], b2[1], b2[2], b2[3], b3[0], b3[1], b3[2], b3[3]}; }
#endif
    const char* kb4[4];
#pragma unroll
    for (int dd = 0; dd < 4; ++dd) kb4[dd] = K_lds + KB * SHM_K + KSWZ(r32, (dd * 16 + hi * 8) * 2);
#pragma unroll
    for (int d0 = 0; d0 < 8; ++d0) { const char* a = kb4[d0 & 3] + (d0 >> 2) * 128;
        bf16x8 b0 = *reinterpret_cast<const bf16x8*>(a);
        bf16x8 b1 = *reinterpret_cast<const bf16x8*>(a + 32 * 256);
        p0 = __builtin_amdgcn_mfma_f32_32x32x16_bf16(b0, qr[d0], p0, 0, 0, 0);
        p1 = __builtin_amdgcn_mfma_f32_32x32x16_bf16(b1, qr[d0], p1, 0, 0, 0); }
}
template <int VB>
__device__ __forceinline__ void pv_tile(f32x16* o, int vb0, bf16x8 pa0, bf16x8 pa1, bf16x8 pa2, bf16x8 pa3) {
#define TRRD(dst, off) asm volatile("ds_read_b64_tr_b16 %0, %1 offset:%2" : "=&v"(dst) : "v"(vb0), "i"(off) : "memory")
#define PV_D0(d0) do { s16x4 l0, l1, l2, l3, h0, h1, h2, h3; constexpr int b_ = VB * SHM_V + v_rd_off(d0, 0, 0); \
        TRRD(l0, b_); TRRD(h0, b_ + 2048); TRRD(l1, b_ + 4096); TRRD(h1, b_ + 6144); TRRD(l2, b_ + 8192); TRRD(h2, b_ + 10240); TRRD(l3, b_ + 12288); TRRD(h3, b_ + 14336); \
        asm volatile("s_waitcnt lgkmcnt(0)" ::: "memory"); SBAR();   \
        o[d0] = __builtin_amdgcn_mfma_f32_32x32x16_bf16(pa0, (bf16x8){l0[0], l0[1], l0[2], l0[3], h0[0], h0[1], h0[2], h0[3]}, o[d0], 0, 0, 0);   \
        o[d0] = __builtin_amdgcn_mfma_f32_32x32x16_bf16(pa1, (bf16x8){l1[0], l1[1], l1[2], l1[3], h1[0], h1[1], h1[2], h1[3]}, o[d0], 0, 0, 0);   \
        o[d0] = __builtin_amdgcn_mfma_f32_32x32x16_bf16(pa2, (bf16x8){l2[0], l2[1], l2[2], l2[3], h2[0], h2[1], h2[2], h2[3]}, o[d0], 0, 0, 0);   \
        o[d0] = __builtin_amdgcn_mfma_f32_32x32x16_bf16(pa3, (bf16x8){l3[0], l3[1], l3[2], l3[3], h3[0], h3[1], h3[2], h3[3]}, o[d0], 0, 0, 0); } while (0)
    PV_D0(0); PV_D0(1); PV_D0(2); PV_D0(3);
#undef PV_D0
#undef TRRD
}
struct BlockRef { const bf16* Q; const bf16* K; const bf16* V; const float* KBp; const bf16* G; bf16* O; int P0; int j0; int hcol; };
struct Seam { bf16x8 qr[8]; bf16x8 st_v0, st_v1, st_k0, st_k1; float st_b; };
#define ROWP(p, k0, rr) ((const char*)(p) + (size_t)((k0) + (rr)) * (LDQ * 2))
#define LD8V(base, off) (*reinterpret_cast<const bf16x8*>((base) + (off)))
#define VMW() asm volatile("s_waitcnt vmcnt(0)" ::: "memory")
#define VMWN(n) asm volatile("s_waitcnt vmcnt(%0)" :: "i"(n) : "memory")
#define SLOAD_H(Kp, Vp, Bp, k0) do { S.st_v0 = LD8V(ROWP(Vp, k0, 0), voff); S.st_v1 = LD8V(ROWP(Vp, k0, 32), voff);              \
                         S.st_k0 = LD8V(ROWP(Kp, k0, 0), voff); S.st_k1 = LD8V(ROWP(Kp, k0, 32), voff); \
                         if (tid < 64) S.st_b = *(const float*)((const char*)((Bp) + (k0)) + (unsigned)(tid * 4)); } while (0)
#define SWRITE_HK(bf) do { *(bf16x8*)(K_lds + (bf) * SHM_K + kws) = S.st_k0; *(bf16x8*)(K_lds + (bf) * SHM_K + kws + 32 * 256) = S.st_k1; if (tid < 64) kbl[(bf) * 64 + tid] = S.st_b; } while (0)
#define SWRITE_HV(bf) do { *(bf16x8*)(V_lds + (bf) * SHM_V + vst0) = S.st_v0; *(bf16x8*)(V_lds + (bf) * SHM_V + vst1) = S.st_v1; } while (0)
#define SWRITE_H(bf) do { SWRITE_HV(bf); SWRITE_HK(bf); } while (0)
__device__ __forceinline__ void fox_prime(const BlockRef& cur, char* lds, Seam& S) {
    const int tid = opaque_tid(), wid = __builtin_amdgcn_readfirstlane(tid >> 6), lane = tid & 63, r32 = lane & 31, hi = lane >> 5;
    const int sr = tid >> 4, sc = (tid & 15) * 8, kws = KSWZ(sr, sc * 2); char* K_lds = lds + 2 * SHM_V; float* kbl = (float*)(lds + OFF_KB);
    const unsigned voff = (unsigned)(sr * LDQ + sc) * 2u, qoff = (unsigned)(r32 * LDQ + hi * 8) * 2u;
    { const char* qb_ = (const char*)(cur.Q + (size_t)(wid * QBLK) * LDQ);
#pragma unroll
      for (int d0 = 0; d0 < 8; ++d0) S.qr[d0] = LD8V(qb_ + d0 * 32, qoff); }
    SLOAD_H(cur.K, cur.V, cur.KBp, cur.j0 * KVBLK); VMW(); SWRITE_HK(0);
    __syncthreads();
}
__device__ __forceinline__ void fox_block(const BlockRef& cur, const BlockRef& nxt, char* lds, Seam& S, float Bq) {
    const int tid = opaque_tid(), wid = __builtin_amdgcn_readfirstlane(tid >> 6), lane = tid & 63, r32 = lane & 31, hi = lane >> 5;
    const int j_lo = cur.j0, NT = (cur.P0 + QB - 1) / KVBLK + 1 - j_lo;
    const int qlo = cur.P0 + wid * QBLK, qm = qlo + r32 - 4 * hi;
    char* V_lds = lds; char* K_lds = lds + 2 * SHM_V; float* kbl = (float*)(lds + OFF_KB);
    float* ws = (float*)(lds + OFF_WS) + wid * 64; float* li_l = ws;
    float l_reg = 0; f32x16 o[4] = {};
    const float mt = cur.KBp[qlo + r32] + Bq;
    const int sr = tid >> 4, sc = (tid & 15) * 8, vst0 = v_st(sr, sc), vst1 = v_st(32 + sr, sc), kws = KSWZ(sr, sc * 2);
    const unsigned voff = (unsigned)(sr * LDQ + sc) * 2u;
    const int vb0 = (int)(uintptr_t)V_lds + v_rd_base(lane);
    const bf16* Kh = cur.K; const bf16* Vh = cur.V; const float* Bh = cur.KBp;
#define KBASE(t) ((j_lo + (t)) * KVBLK)
#define MASKT(P0_, P1_, t) do { const int kb_ = KBASE(t); if (kb_ + KVBLK - 1 > qlo) mask_tile(P0_, P1_, qm - kb_); } while (0)
    constexpr int NQL = 8;
#define SEAM_K0() do { VMWN(NQL); SWRITE_HK(0); SBAR(); } while (0)
    f32x16 pA0, pA1, pB0, pB1; bf16x8 pa0, pa1, pa2, pa3;
    SWRITE_HV(0); SBAR();
    if (NT > 1) { SLOAD_H(Kh, Vh, Bh, KBASE(1)); }
    SBAR(); qkt<0>(pA0, pA1, K_lds, kbl, r32, hi, S.qr);
    MASKT(pA0, pA1, 0); partialSM(pA0, pA1, mt);
    if (NT > 1) { VMW(); SWRITE_H(1); }
    __syncthreads();
#define HALF_STEP(PX0, PX1, PY0, PY1, t, KB, VB, SB) do {                                                      \
        if ((t) + 1 < NT) { SLOAD_H(Kh, Vh, Bh, KBASE((t) + 1)); }        \
        SBAR(); qkt<KB>(PX0, PX1, K_lds, kbl, r32, hi, S.qr);                                             \
        finishSM(PY0, PY1, l_reg, pa0, pa1, pa2, pa3); SBAR();                                                           \
        pv_tile<VB>(o, vb0, pa0, pa1, pa2, pa3); MASKT(PX0, PX1, (t)); partialSM(PX0, PX1, mt);                                        \
        __syncthreads();                                                                                                      \
        if ((t) + 1 < NT) { VMW(); SWRITE_H(SB); }                                                                          \
        __syncthreads(); } while (0)
    for (int t = 1; t + 1 < NT; t += 2) {
        HALF_STEP(pB0, pB1, pA0, pA1, t, 1, 0, 0);
        HALF_STEP(pA0, pA1, pB0, pB1, t + 1, 0, 1, 1);
    }
    const bool even = (NT & 1) == 0;
    if (even) { SBAR(); qkt<1>(pB0, pB1, K_lds, kbl, r32, hi, S.qr); SBAR(); }
    SLOAD_H(nxt.K, nxt.V, nxt.KBp, nxt.j0 * KVBLK); SBAR();
    { const int l2 = opaque_tid() & 63; const unsigned qoff = (unsigned)((l2 & 31) * LDQ + (l2 >> 5) * 8) * 2u;
      const char* qb_ = (const char*)(nxt.Q + (size_t)(wid * QBLK) * LDQ);
#pragma unroll
      for (int d0 = 0; d0 < 8; ++d0) S.qr[d0] = LD8V(qb_ + d0 * 32, qoff); }
    SBAR();
    finishSM(pA0, pA1, l_reg, pa0, pa1, pa2, pa3); SBAR();
    pv_tile<0>(o, vb0, pa0, pa1, pa2, pa3);
    if (even) { MASKT(pB0, pB1, NT - 1); partialSM(pB0, pB1, mt); __syncthreads();
        finishSM(pB0, pB1, l_reg, pa0, pa1, pa2, pa3); SBAR(); pv_tile<1>(o, vb0, pa0, pa1, pa2, pa3); }
    SBAR(); SEAM_K0();
    if (hi == 0) li_l[r32] = l_reg; asm volatile("s_waitcnt lgkmcnt(0)" ::: "memory");
    { const int l3 = opaque_tid() & 63, er = l3 >> 4, ec = l3 & 15;
      const bf16* Gp = cur.G + (size_t)(wid * QBLK + er) * LDQ + 8 * ec;
      bf16* Op = cur.O; const size_t orow0 = (size_t)(cur.P0 + wid * QBLK + er); const int ocol = cur.hcol + 8 * ec;
      v4u gt[4][2];
#pragma unroll
      for (int ps = 0; ps < 4; ++ps)
#pragma unroll
          for (int k = 0; k < 2; ++k) gt[ps][k] = *(const v4u*)(Gp + (size_t)(8 * ps + 4 * k) * LDQ);
      float* ost = (float*)(lds + OFF_OST) + wid * (8 * 132);
      const int wofs = (4 * (l3 >> 5)) * 132 + (l3 & 31);
#pragma unroll
      for (int ps = 0; ps < 4; ++ps) {
#pragma unroll
          for (int rr = 0; rr < 4; ++rr) { const int r = 4 * ps + rr; const float rl = __builtin_amdgcn_rcpf(li_l[crow(r, hi)]);
#pragma unroll
              for (int d0 = 0; d0 < 4; ++d0) ost[wofs + rr * 132 + d0 * 32] = o[d0][r] * rl; }
          asm volatile("s_waitcnt lgkmcnt(0)" ::: "memory");
#pragma unroll
          for (int k = 0; k < 2; ++k) { const float* sp = ost + (er + 4 * k) * 132 + 8 * ec; const f32x4 x0 = *(const f32x4*)sp, x1 = *(const f32x4*)(sp + 4); const v4u g = gt[ps][k];
              v4u w; w.x = cvtpk(x0[0] * bflo(g.x), x0[1] * bfhi(g.x)); w.y = cvtpk(x0[2] * bflo(g.y), x0[3] * bfhi(g.y)); w.z = cvtpk(x1[0] * bflo(g.z), x1[1] * bfhi(g.z)); w.w = cvtpk(x1[2] * bflo(g.w), x1[3] * bfhi(g.w));
              *(v4u*)(Op + tiled_off(orow0 + 8 * ps + 4 * k, ocol, LDO >> 6)) = w; }
          asm volatile("s_waitcnt lgkmcnt(0)" ::: "memory"); } }
    __syncthreads();
#undef KBASE
#undef MASKT
#undef SEAM_K0
#undef HALF_STEP
}
__device__ __forceinline__ void fox_rewrite_k0(char* lds, const Seam& S) {
    const int tid = opaque_tid(); const int sr = tid >> 4, sc = (tid & 15) * 8, kws = KSWZ(sr, sc * 2); char* K_lds = lds + 2 * SHM_V; float* kbl = (float*)(lds + OFF_KB);
    SWRITE_HK(0); __syncthreads();
}
#undef ROWP
#undef LD8V
#undef VMWN
#undef SLOAD_H
#undef SWRITE_HK
#undef SWRITE_HV
#undef SWRITE_H
__device__ __forceinline__ BlockRef mk_ref(const bf16* PROJ, const float* KBg, bf16* MO, const int* JL, int id) {
    const int bh = id & 31, qb = 63 - (id >> 5);
    BlockRef r; r.Q = PROJ + ((size_t)bh * SEQ + qb * QB) * D; r.K = PROJ + ((size_t)(32 + bh) * SEQ) * D; r.V = PROJ + ((size_t)(64 + bh) * SEQ) * D; r.KBp = KBg + (size_t)bh * SEQ;
    r.G = PROJ + ((size_t)(96 + bh) * SEQ + qb * QB) * D; r.O = MO; r.hcol = bh * D; r.P0 = qb * QB; r.j0 = JL[id]; return r;
}
__device__ __forceinline__ void attn_phase(char* lds, const bf16* PROJ, const float* KBg, bf16* MO, const int* JL, unsigned* qctr, const float* qg, const float* kg, unsigned char* ws, const ConvArgs& ca, int qbase, int qend, int vcu, int G) {
    constexpr int total = 32 * 64;
    const int tid = opaque_tid();
    float Bq;
    { const int l_ = tid & 63; float gq = fmaxf(fabsf(qg[l_]), fabsf(qg[l_ + 64])), gk = fmaxf(fabsf(kg[l_]), fabsf(kg[l_ + 64]));
#pragma unroll
      for (int o_ = 1; o_ < 64; o_ <<= 1) { gq = fmaxf(gq, shx(gq, o_, l_)); gk = fmaxf(gk, shx(gk, o_, l_)); }
      Bq = 128.f * gq * gk * QSCALE * 1.02f; }
    volatile int* slot = (volatile int*)(lds + LDS_BYTES);
    if (tid == 0) slot[0] = (int)__hip_atomic_fetch_add((GAS unsigned*)qctr, 1u, __ATOMIC_RELAXED, __HIP_MEMORY_SCOPE_AGENT);
    __syncthreads();
    int id = __builtin_amdgcn_readfirstlane(slot[0]);
    const int nchunks = att_chunks(qbase, qend);
    int cc = 0;
    if (id < total) {
        BlockRef cur = mk_ref(PROJ, KBg, MO, JL, id);
        Seam S;
        fox_prime(cur, lds, S);
        for (;;) {
            if (tid == 0) slot[1] = (int)__hip_atomic_fetch_add((GAS unsigned*)qctr, 1u, __ATOMIC_RELAXED, __HIP_MEMORY_SCOPE_AGENT);
            __syncthreads();
            const int idn = __builtin_amdgcn_readfirstlane(slot[1]);
            const bool last = idn >= total;
            const BlockRef nxt = last ? cur : mk_ref(PROJ, KBg, MO, JL, idn);
            fox_block(cur, nxt, lds, S, Bq);
            if (last) break;
            cur = nxt;
            if (cc < nchunks) { __syncthreads(); conv_chunk((LAS unsigned char*)lds, ws, ca, qbase, cc, vcu, G); ++cc; if (nchunks > 7 && cc < nchunks) { conv_chunk((LAS unsigned char*)lds, ws, ca, qbase, cc, vcu, G); ++cc; } fox_rewrite_k0(lds, S); }
        }
    }
    __syncthreads();
#pragma unroll 1
    for (; cc < nchunks; ++cc) conv_chunk((LAS unsigned char*)lds, ws, ca, qbase, cc, vcu, G);
}
#undef VMW
}
namespace hg {
constexpr int CH = 64, NCH = SEQ / CH;
constexpr size_t AOFF = (size_t)32 * SEQ * DH / 2;
constexpr int PK = 144;
constexpr int PQ = 272;
__device__ __forceinline__ f32x4 mma(bf16x8 bfrag, bf16x8 afrag, f32x4 acc) { return __builtin_amdgcn_mfma_f32_16x16x32_bf16(bfrag, afrag, acc, 0, 0, 0); }
__device__ __forceinline__ bf16x8 ldsfrag(const LAS unsigned char* base, int row, int pitch, int kbyte) { return *(const LAS bf16x8*)(base + row * pitch + kbyte); }

typedef float f32x2 __attribute__((ext_vector_type(2)));
typedef _Float16 f16x2 __attribute__((ext_vector_type(2)));
__device__ __forceinline__ float ex2(float x) { return __builtin_amdgcn_exp2f(x); }
__device__ __forceinline__ unsigned ldg2(const _Float16* p) { return *(const unsigned*)p; }
__device__ __forceinline__ f32x2 h2f(unsigned w) { const f16x2 h = __builtin_bit_cast(f16x2, w); return (f32x2){(float)h[0], (float)h[1]}; }
__device__ __forceinline__ void b1_phase(LAS unsigned char* lds, const bf16* PROJ, const _Float16* Gg, bf16* UT, float* DEC, int vcu, int G) {
    const int tid = opaque_tid(), lane = tid & 63, wave = __builtin_amdgcn_readfirstlane(tid >> 6), cp = tid & 63, seg = wave, r = lane & 15, q = lane >> 4;
    LAS unsigned char* KT = lds;
    LAS unsigned char* VT = lds + 128 * PK;
    LAS float* segtot = (LAS float*)(lds + 2 * 128 * PK);
    unsigned nb[8], nk[8], nv[8];
#define B1_LOAD(u_) do { const int c_ = (u_) >> 5, h_ = (u_) & 31; const int rw_ = c_ * CH + 8 * seg; \
        _Pragma("unroll") for (int j = 0; j < 8; ++j) { nb[j] = ldg2(Gg + ((size_t)h_ * SEQ + rw_ + j) * DH + 2 * cp); const unsigned* p_ = (const unsigned*)(PROJ + (((size_t)32 + h_) * SEQ + rw_ + j) * DH + 2 * cp); nk[j] = p_[0]; nv[j] = p_[AOFF]; } } while (0)
    if (vcu < NCH * NH) B1_LOAD(NCH * NH - 1 - vcu);
    for (int it = vcu; it < NCH * NH; it += G) {
        const int u = NCH * NH - 1 - it;
        f32x2 b[8]; unsigned kk[8], vv[8];
#pragma unroll
        for (int j = 0; j < 8; ++j) { b[j] = h2f(nb[j]); kk[j] = nk[j]; vv[j] = nv[j]; }
#pragma unroll
        for (int j = 1; j < 8; ++j) b[j] += b[j - 1];
        *(LAS f32x2*)(segtot + seg * 128 + 2 * cp) = b[7];
        __syncthreads();
        f32x2 off = {0.f, 0.f}, total = {0.f, 0.f};
#pragma unroll
        for (int s2 = 0; s2 < 8; ++s2) { const f32x2 t = *(const LAS f32x2*)(segtot + s2 * 128 + 2 * cp); total += t; if (s2 < seg) off += t; }
        const f32x2 rem = total - off;
        unsigned k0w[4], k1w[4], v0w[4], v1w[4];
#pragma unroll
        for (int i = 0; i < 4; ++i) { const int ja = 2 * i, jb = 2 * i + 1;
            k0w[i] = cvtpk(bflo(kk[ja]) * ex2(rem.x - b[ja].x), bflo(kk[jb]) * ex2(rem.x - b[jb].x)); k1w[i] = cvtpk(bfhi(kk[ja]) * ex2(rem.y - b[ja].y), bfhi(kk[jb]) * ex2(rem.y - b[jb].y));
            v0w[i] = (vv[ja] & 0xffffu) | (vv[jb] << 16); v1w[i] = (vv[ja] >> 16) | (vv[jb] & 0xffff0000u); }
        *(LAS v4u*)(KT + (2 * cp) * PK + 16 * seg) = (v4u){k0w[0], k0w[1], k0w[2], k0w[3]}; *(LAS v4u*)(KT + (2 * cp + 1) * PK + 16 * seg) = (v4u){k1w[0], k1w[1], k1w[2], k1w[3]};
        *(LAS v4u*)(VT + (2 * cp) * PK + 16 * seg) = (v4u){v0w[0], v0w[1], v0w[2], v0w[3]}; *(LAS v4u*)(VT + (2 * cp + 1) * PK + 16 * seg) = (v4u){v1w[0], v1w[1], v1w[2], v1w[3]};
        if (seg == 0) *(f32x2*)(DEC + (size_t)u * 128 + 2 * cp) = (f32x2){ex2(total.x), ex2(total.y)};
        if (u - G >= 0) B1_LOAD(u - G);
        __syncthreads();
        const bf16x8 a0 = ldsfrag(VT, 16 * wave + r, PK, 16 * q), a1 = ldsfrag(VT, 16 * wave + r, PK, 64 + 16 * q);
        bf16* up = UT + ((size_t)u * 128 + 16 * wave + r) * 128 + 4 * q;
#pragma unroll
        for (int nt = 0; nt < 8; ++nt) { f32x4 acc = {0.f, 0.f, 0.f, 0.f};
            acc = mma(ldsfrag(KT, 16 * nt + r, PK, 16 * q), a0, acc); acc = mma(ldsfrag(KT, 16 * nt + r, PK, 64 + 16 * q), a1, acc);
            v2u w; w.x = cvtpk(acc[0], acc[1]); w.y = cvtpk(acc[2], acc[3]); *(v2u*)(up + 16 * nt) = w; }
    }
#undef B1_LOAD
}
__device__ __forceinline__ void b2_phase(const bf16* UT, const float* DEC, bf16* ST, int vcu, int G) {
    constexpr int BT = 8;
    for (int gid = vcu * 512 + opaque_tid(); gid < NH * 128 * 32; gid += G * 512) {
        const int h = gid >> 12, dv = (gid >> 5) & 127, dk4 = (gid & 31) * 4;
        f32x4 st = {0.f, 0.f, 0.f, 0.f};
        const size_t eo = ((size_t)h * 128 + dv) * 128 + dk4, estep = (size_t)NH * 128 * 128;
        const size_t dofs = (size_t)h * 128 + dk4, dstep = (size_t)NH * 128;
        v2u uwa[BT], uwb[BT]; f32x4 dda[BT], ddb[BT];
#define B2_LOAD(uw_, dd_, c0_) do { _Pragma("unroll") for (int i = 0; i < BT; ++i) { uw_[i] = *(const v2u*)(UT + eo + (size_t)((c0_) + i) * estep); dd_[i] = *(const f32x4*)(DEC + dofs + (size_t)((c0_) + i) * dstep); } } while (0)
#define B2_RUN(uw_, dd_, c0_) do { _Pragma("unroll") for (int i = 0; i < BT; ++i) { const f32x4 uu = {bflo(uw_[i].x), bfhi(uw_[i].x), bflo(uw_[i].y), bfhi(uw_[i].y)}; \
            v2u w; w.x = cvtpk(st.x, st.y); w.y = cvtpk(st.z, st.w); *(v2u*)(ST + eo + (size_t)((c0_) + i) * estep) = w; st = dd_[i] * st + uu; } } while (0)
        B2_LOAD(uwa, dda, 0);
        for (int c = 0; c < NCH; c += 2 * BT) {
            B2_LOAD(uwb, ddb, c + BT);
            B2_RUN(uwa, dda, c);
            if (c + 2 * BT < NCH) B2_LOAD(uwa, dda, c + 2 * BT);
            B2_RUN(uwb, ddb, c + BT);
        }
#undef B2_LOAD
#undef B2_RUN
    }
}
constexpr int B3_QT = 0, B3_QH = B3_QT + 64 * PQ, B3_KH = B3_QH + 64 * PQ  , B3_VT = B3_KH + 160 * PQ, B3_P = B3_VT + 128 * PK, B3_SEG = B3_P + 64 * PK, B3_RS = B3_SEG + 4096, B3_END = B3_RS + 512;
__device__ __forceinline__ int kh_base(int I) { return 16 * (I * (I + 1) / 2); }
__device__ __forceinline__ void b3_phase(LAS unsigned char* lds, const bf16* PROJ, const _Float16* Gg, const bf16* ST, const float* ogain, bf16* MO, int vcu, int G) {
    const int tid = opaque_tid(), lane = tid & 63, wave = __builtin_amdgcn_readfirstlane(tid >> 6), cp = tid & 63, seg = wave, r = lane & 15, q = lane >> 4;
    LAS unsigned char* QT = lds + B3_QT; LAS unsigned char* QH = lds + B3_QH; LAS unsigned char* KH = lds + B3_KH; LAS unsigned char* VT = lds + B3_VT; LAS unsigned char* PP = lds + B3_P;
    LAS float* segtot = (LAS float*)(lds + B3_SEG); LAS float* rs = (LAS float*)(lds + B3_RS);
    unsigned nb[8], nq[8], nk[8], nv[8];
#define B3_LOAD(u_) do { const int c_ = (u_) >> 5, h_ = (u_) & 31; const int rw_ = c_ * CH + 8 * seg; \
        _Pragma("unroll") for (int j = 0; j < 8; ++j) { nb[j] = ldg2(Gg + ((size_t)h_ * SEQ + rw_ + j) * DH + 2 * cp); const unsigned* p_ = (const unsigned*)(PROJ + ((size_t)h_ * SEQ + rw_ + j) * DH + 2 * cp); nq[j] = p_[0]; nk[j] = p_[AOFF]; nv[j] = p_[2 * AOFF]; } } while (0)
    f32x4 og[4];
#pragma unroll
    for (int nt = 0; nt < 4; ++nt) og[nt] = *(const f32x4*)(ogain + 64 * (wave >> 2) + 16 * nt + 4 * q);
    if (vcu < NCH * NH) B3_LOAD(NCH * NH - 1 - vcu);
    for (int it = vcu; it < NCH * NH; it += G) {
        const int u = NCH * NH - 1 - it;
        const int c = u >> 5, h = u & 31;
        const int mt = wave & 3, nh = wave >> 2;
        const size_t orow = (size_t)(c * CH + 16 * mt + r);
        v2u gtv[4];
#pragma unroll
        for (int nt = 0; nt < 4; ++nt) gtv[nt] = *(const v2u*)(PROJ + (((size_t)96 + h) * SEQ + orow) * DH + 64 * nh + 16 * nt + 4 * q);
        f32x2 b[8]; unsigned qq[8], kk[8], vv[8];
#pragma unroll
        for (int j = 0; j < 8; ++j) { b[j] = h2f(nb[j]); qq[j] = nq[j]; kk[j] = nk[j]; vv[j] = nv[j]; }
#pragma unroll
        for (int j = 1; j < 8; ++j) b[j] += b[j - 1];
        *(LAS f32x2*)(segtot + seg * 128 + 2 * cp) = b[7];
        __syncthreads();
        f32x2 st[8];
#pragma unroll
        for (int s2 = 0; s2 < 8; ++s2) st[s2] = *(const LAS f32x2*)(segtot + s2 * 128 + 2 * cp);
        const int I0 = seg >> 1;
        f32x2 off = {0.f, 0.f};
#pragma unroll
        for (int s2 = 0; s2 < 8; ++s2) if (s2 < seg) off += st[s2];
        f32x2 lsb[8];
        { f32x2 hb = {0.f, 0.f};
#pragma unroll
          for (int s2 = 0; s2 < 8; s2 += 2) if (s2 + 1 == seg) hb = st[s2];
#pragma unroll
          for (int j = 0; j < 8; ++j) lsb[j] = hb + b[j]; }
        f32x2 hbq = off;
#pragma unroll
        for (int s2 = 0; s2 < 8; s2 += 2) if (s2 + 1 == seg) hbq -= st[s2];
        const float eq0 = ex2(hbq.x), eq1 = ex2(hbq.y);
        f32x2 em[8];
#pragma unroll
        for (int j = 0; j < 8; ++j) { const float q0 = bflo(qq[j]), q1 = bfhi(qq[j]); const int row = 8 * seg + j;
            const float h0 = q0 * ex2(lsb[j].x), h1 = q1 * ex2(lsb[j].y); em[j] = (f32x2){ex2(-lsb[j].x), ex2(-lsb[j].y)};
            *(LAS unsigned*)(QT + row * PQ + 4 * cp) = cvtpk(h0 * eq0, h1 * eq1);
            *(LAS unsigned*)(QH + row * PQ + 4 * cp) = cvtpk(h0, h1); }
        { f32x2 d = {0.f, 0.f};
#pragma unroll
          for (int I = 0; I < 4; ++I) { if (I >= I0) {
                const float ed0 = ex2(d.x), ed1 = ex2(d.y);
#pragma unroll
                for (int j = 0; j < 8; ++j) *(LAS unsigned*)(KH + (kh_base(I) + 8 * seg + j) * PQ + 4 * cp) = cvtpk(bflo(kk[j]) * em[j].x * ed0, bfhi(kk[j]) * em[j].y * ed1);
                d += st[2 * I] + st[2 * I + 1]; } } }
        { unsigned v0w[4], v1w[4];
#pragma unroll
          for (int i = 0; i < 4; ++i) { const int ja = 2 * i, jb = 2 * i + 1; v0w[i] = (vv[ja] & 0xffffu) | (vv[jb] << 16); v1w[i] = (vv[ja] >> 16) | (vv[jb] & 0xffff0000u); }
          *(LAS v4u*)(VT + (2 * cp) * PK + 16 * seg) = (v4u){v0w[0], v0w[1], v0w[2], v0w[3]}; *(LAS v4u*)(VT + (2 * cp + 1) * PK + 16 * seg) = (v4u){v1w[0], v1w[1], v1w[2], v1w[3]}; }
        bf16x8 sf[4][4];
        { const bf16* stp = ST + ((size_t)u * 128 + 64 * nh + r) * 128 + 8 * q;
#pragma unroll
          for (int nt = 0; nt < 4; ++nt)
#pragma unroll
              for (int ks = 0; ks < 4; ++ks) sf[nt][ks] = *(const bf16x8*)(stp + (size_t)(16 * nt) * 128 + 32 * ks); }
        if (u - G >= 0) B3_LOAD(u - G);
        __syncthreads();
#pragma unroll
        for (int tt = 0; tt < 2; ++tt) { const int tile = wave * 2 + tt, I = tile >> 2, J = tile & 3;
            f32x4 acc = {0.f, 0.f, 0.f, 0.f};
            if (J <= I) {
#pragma unroll
                for (int ks = 0; ks < 4; ++ks) acc = mma(ldsfrag(KH, kh_base(I) + 16 * J + r, PQ, 64 * ks + 16 * q), ldsfrag(QH, 16 * I + r, PQ, 64 * ks + 16 * q), acc);
                if (J == I) {
#pragma unroll
                    for (int i = 0; i < 4; ++i) if (4 * q + i > r) acc[i] = 0.f; }
            }
            v2u w; w.x = cvtpk(acc[0], acc[1]); w.y = cvtpk(acc[2], acc[3]);
            *(LAS v2u*)(PP + (16 * I + r) * PK + (16 * J + 4 * q) * 2) = w; }
        __syncthreads();
        f32x4 acc[4];
        const bf16x8 pa0 = ldsfrag(PP, 16 * mt + r, PK, 16 * q), pa1 = ldsfrag(PP, 16 * mt + r, PK, 64 + 16 * q);
        bf16x8 qa[4];
#pragma unroll
        for (int ks = 0; ks < 4; ++ks) qa[ks] = ldsfrag(QT, 16 * mt + r, PQ, 64 * ks + 16 * q);
#pragma unroll
        for (int nt = 0; nt < 4; ++nt) { f32x4 a = {0.f, 0.f, 0.f, 0.f};
            a = mma(ldsfrag(VT, 64 * nh + 16 * nt + r, PK, 16 * q), pa0, a); a = mma(ldsfrag(VT, 64 * nh + 16 * nt + r, PK, 64 + 16 * q), pa1, a);
#pragma unroll
            for (int ks = 0; ks < 4; ++ks) a = mma(sf[nt][ks], qa[ks], a);
            acc[nt] = a; }
        float ss = 0.f;
#pragma unroll
        for (int nt = 0; nt < 4; ++nt) ss += (acc[nt][0] * acc[nt][0] + acc[nt][1] * acc[nt][1]) + (acc[nt][2] * acc[nt][2] + acc[nt][3] * acc[nt][3]);
        ss += shx(ss, 16, lane); ss += shx(ss, 32, lane);
        if (q == 0) rs[nh * 64 + 16 * mt + r] = ss;
        __syncthreads();
        const float rstd = rsqrtf((rs[16 * mt + r] + rs[64 + 16 * mt + r]) * (1.f / 128.f) + NORM_EPS);
#pragma unroll
        for (int nt = 0; nt < 4; ++nt) { const int dv = 64 * nh + 16 * nt + 4 * q;
            const f32x4 g = og[nt]; const v2u gt = gtv[nt];
            v2u w; w.x = cvtpk(acc[nt][0] * rstd * g.x * bflo(gt.x), acc[nt][1] * rstd * g.y * bfhi(gt.x)); w.y = cvtpk(acc[nt][2] * rstd * g.z * bflo(gt.y), acc[nt][3] * rstd * g.w * bfhi(gt.y));
            *(v2u*)(MO + tiled_off(orow, h * DH + dv, DM >> 6)) = w; }
    }
#undef B3_LOAD
}
}
constexpr int RING_BYTES = 131072;
constexpr int MISC_OFF = RING_BYTES + 320;
constexpr int LDS_BYTES = 147456;
#ifndef DOWN_WGM
#define DOWN_WGM 2
#endif
constexpr int CW_BAR = 4096;
constexpr int CW_Q = 8192;
static_assert(fa::LDS_END <= RING_BYTES && fa::OFF_OST % 16 == 0 && hg::B3_END <= RING_BYTES, "phase scratch fits the ring region");
static_assert(WS_END <= (size_t)4096 * MiB, "workspace map");

constexpr int PH_FINAL = 49, PH_END = 50;
struct Args { const float* in[15]; float* out; unsigned char* ws; int ph_lo, ph_hi; };
static_assert(sizeof(Args) == 15 * 8 + 8 + 8 + 4 + 4, "Args has no padding bytes");

__global__ void __launch_bounds__(NWAVES * 64, 2) trunk_fwd(Args args) {
    extern __shared__ __attribute__((aligned(16))) unsigned char lds_raw[];
    LAS unsigned char* lds = (LAS unsigned char*)lds_raw;
    volatile LAS unsigned* MISC = (volatile LAS unsigned*)(lds + MISC_OFF);
    const int tid = threadIdx.x;
    const int G = gridDim.x, bx = blockIdx.x;
    const int vcu = (G % 8 == 0) ? (bx % 8) * (G / 8) + bx / 8 : bx;
    for (int u = tid; u < (LDS_BYTES - RING_BYTES) / 4; u += NWAVES * 64) ((LAS unsigned*)(lds + RING_BYTES))[u] = 0u;
    __syncthreads();
    if ((tid & 63) == 0) ((volatile LAS int*)(lds + WAVE_TAB_OFF))[hw_wave_slot()] = tid >> 6;
    __syncthreads();
    const int lo = args.ph_lo, hi = args.ph_hi;
#if MK_PER_PHASE
#define GRID_BAR(p) do { } while (0)
#else
    XcdBarrier bar = xcd_barrier_post((unsigned*)(args.ws + WS_CTL) + CW_BAR, MISC + 8);
    if (tid == 0) ((GAS unsigned*)((unsigned*)(args.ws + WS_CTL) + CW_BAR))[XB_XID + bx] = bar.x + 1u;
#ifndef LOCAL_SEAMS
#define LOCAL_SEAMS 1
#endif
#define LOCAL_BAR(p) do { if ((p) + 1 < hi) { XcdBarrier b_ = bar; asm volatile("" : "+s"(b_.bar), "+s"(b_.x)); if (LOCAL_SEAMS && MISC[10]) xcd_local_barrier(b_); else xcd_barrier(b_); } } while (0)
#define GRID_BAR(p) do { if ((p) + 1 < hi) { XcdBarrier b_ = bar; asm volatile("" : "+s"(b_.bar), "+s"(b_.x)); xcd_barrier(b_); } } while (0)
#endif
#ifndef ONLY_SITE
#define ONLY_SITE -1
#endif
#define EN(s) (ONLY_SITE == -1 || ONLY_SITE == (s))
#ifndef DUP_SITE
#define DUP_SITE -1
#endif
#define DUP(s) (DUP_SITE == (s))
#define IN(k) (lo <= (k) && (k) < hi)
#ifndef STAGGER_US
#define STAGGER_US 0
#endif
#define STAGGER() do { if (STAGGER_US > 0) { const unsigned long long t0_ = __builtin_amdgcn_s_memrealtime(), dl_ = (unsigned long long)(bx & 7) * (STAGGER_US * 100ull); while (__builtin_amdgcn_s_memrealtime() - t0_ < dl_) __builtin_amdgcn_s_sleep(4); } } while (0)
#define OPQ(v) ({ int o_ = (v); asm volatile("" : "+s"(o_)); o_; })
#define WSP() ({ GAS unsigned char* w_ = (GAS unsigned char*)args.ws; asm volatile("" : "+s"(w_)); (unsigned char*)w_; })
#define INP(i) ({ const GAS float* p_ = (const GAS float*)args.in[i]; asm volatile("" : "+s"(p_)); (const float*)p_; })
    LAS float* RTAB = (LAS float*)(lds + RING_BYTES + 1024);
#define P_H ((float*)(WSP() + WS_H))
#define P_XN ((bf16*)(WSP() + WS_XN))
#define P_MO ((bf16*)(WSP() + WS_MO))
#define P_PROJ ((bf16*)(WSP() + WS_PROJ))
#define P_G ((_Float16*)(WSP() + WS_G))
#define P_UT ((bf16*)(WSP() + WS_UT))
#define P_ST ((bf16*)(WSP() + WS_ST))
#define P_LOGF ((float*)(WSP() + WS_LOGF))
#define P_KB ((float*)(WSP() + WS_KB))
#define P_DEC ((float*)(WSP() + WS_DEC))
#define P_LB ((const float*)(WSP() + WS_LB))
#define P_JL ((int*)(WSP() + WS_LB + 512 * 1024))
#define P_CS ((float*)(WSP() + WS_LB + 768 * 1024))
#define P_PART ((float*)(WSP() + WS_PART))

    if (EN(0) && IN(0)) {
        ConvArgs ca{INP(1), INP(2), INP(6), INP(7), INP(12), INP(13)};
        prologue_phase(lds, WSP(), ca, INP(9), OPQ(vcu), OPQ(G));
        GRID_BAR(0);
        if (LOCAL_SEAMS && 1 < hi) { const int ok_ = xcd_groups_local((unsigned*)(WSP() + WS_CTL) + CW_BAR); if (tid == 0) MISC[10] = (unsigned)ok_; __syncthreads(); }
    }
#ifndef FZ_PHASE
#define FZ_PHASE 1
#endif
#ifndef ATT_HOST
#define ATT_HOST 1
#endif
#define HOSTED(m) (ATT_HOST && (ATT_ALL || (((m) - 1) & 7) < 4))
#define CONV_PRE(q) do { if ((q) + 1 < 4 * DEPTH && !HOSTED((q) + 1) && (bx & 3)) { ConvArgs ca_{INP(1), INP(2), INP(6), INP(7), INP(12), INP(13)}; conv_weights(lds, WSP(), ca_, OPQ((q) + 1), OPQ(vcu), OPQ(G), 1, OPQ(bx & 3)); } } while (0)
#define CONV_POST(q) do { if ((q) + 1 < 4 * DEPTH && !HOSTED((q) + 1) && (bx & 3) != 3) { ConvArgs ca_{INP(1), INP(2), INP(6), INP(7), INP(12), INP(13)}; conv_weights(lds, WSP(), ca_, OPQ((q) + 1), OPQ(vcu), OPQ(G), 2, OPQ(bx & 3)); } } while (0)
    for (int L = 0; L < DEPTH; ++L) {
        const int pb = 1 + 12 * L, j = L >> 1; const bool fox = (L & 1) == 0;
        if (EN(1) && L == 0 && IN(pb + 0)) { rms0_phase(INP(0), INP(10), P_XN, P_PART, OPQ(vcu), OPQ(G)); GRID_BAR(pb + 0); }
        if (fox) {
            if (EN(2) && IN(pb + 1)) {
                unsigned char* w = WSP();
                pg8::Gemm g{(const bf16*)(w + WS_XN), (const bf16*)(w + WS_WFIN) + (size_t)j * FOX_INP * DM, SEQ, FZ_PHASE ? 4 * DM : FOX_INP, DM}; pg8::StaticOrder S; S.init(SEQ, FZ_PHASE ? 4 * DM : FOX_INP, OPQ(G), OPQ(bx));
                pg8::Unit u0; S.next(0, u0); rstd_table(RTAB, (const float*)(w + WS_PART), u0.pm);
                pg8::EpiFox E{(bf16*)(w + WS_PROJ), 16384, (float*)(w + WS_LOGF), INP(5) + j * NH, (float*)(w + WS_LB + 768 * 1024), pg8::RowScale{RTAB, u0.pm, (const float*)(w + WS_PART)}, INP(3) + j * DH, INP(4) + j * DH, (LAS float*)(lds + RING_BYTES + 4096), QSCALE};
                CONV_PRE(4 * L); pg8::gemm_phase<pg8::EpiFox, pg8::StaticOrder, true, true>(lds, g, S, E); CONV_POST(4 * L);
                if (!FZ_PHASE) GRID_BAR(pb + 1);
            }
            if (FZ_PHASE && EN(15) && IN(pb + 1)) { unsigned char* w = WSP(); __syncthreads();
                int fzb = vcu; if (G == 256) { pg8::StaticOrder S; S.init(SEQ, 4 * DM, OPQ(G), OPQ(bx)); pg8::Unit u0; S.next(0, u0); fzb = u0.pm * 4 + ((bx >> 3) >> 3); }
                fz_phase(lds, (const bf16*)(w + WS_XN), (const bf16*)(w + WS_WFIN) + (size_t)OPQ(j) * FOX_INP * DM, (const float*)(w + WS_PART), INP(5) + OPQ(j) * NH, (float*)(w + WS_LOGF), (float*)(w + WS_LB + 768 * 1024), OPQ(fzb), OPQ(G));
                GRID_BAR(pb + 1); }
            if (EN(3) && IN(pb + 2)) { fox_thin_phase(lds, P_LOGF, P_CS, P_KB, OPQ(vcu), OPQ(G)); GRID_BAR(pb + 2); }
            if (EN(14) && IN(pb + 3)) { jl_phase(lds, P_KB, INP(3) + j * DH, INP(4) + j * DH, P_JL, OPQ(vcu), OPQ(G)); GRID_BAR(pb + 3); }
            if (EN(4) && IN(pb + 4)) { unsigned char* w = WSP(); ConvArgs ca_{INP(1), INP(2), INP(6), INP(7), INP(12), INP(13)}; fa::attn_phase((char*)lds_raw, (const bf16*)(w + WS_PROJ), (const float*)(w + WS_KB), (bf16*)(w + WS_MO), (const int*)(w + WS_LB + 512 * 1024), (unsigned*)(w + WS_CTL) + CW_Q + 64 * j, INP(3) + j * DH, INP(4) + j * DH, w, ca_, OPQ(4 * L + 1), OPQ(ATT_HOST ? (ATT_ALL ? (4 * L + 9 < 4 * DEPTH ? 4 * L + 9 : 4 * DEPTH) : 4 * L + 5) : 4 * L + 1), OPQ(vcu), OPQ(G)); GRID_BAR(pb + 4);
                if (DUP(4)) { fa::attn_phase((char*)lds_raw, (const bf16*)(w + WS_PROJ), (const float*)(w + WS_KB), (bf16*)(w + WS_MO), (const int*)(w + WS_LB + 512 * 1024), (unsigned*)(w + WS_CTL) + CW_Q + 64 * (j + 2), INP(3) + j * DH, INP(4) + j * DH, w, ca_, OPQ(4 * L + 1), OPQ(4 * L + 1), OPQ(vcu), OPQ(G)); GRID_BAR(pb + 4); } }
        } else {
            if (EN(5) && IN(pb + 1)) {
                unsigned char* w = WSP();
                pg8::Gemm g{(const bf16*)(w + WS_XN), (const bf16*)(w + WS_WHIN) + (size_t)j * HG_IN * DM, SEQ, HG_IN, DM}; pg8::StaticOrder S; S.init(SEQ, HG_IN, OPQ(G), OPQ(bx));
                pg8::Unit u0; S.next(0, u0); rstd_table(RTAB, (const float*)(w + WS_PART), u0.pm);
                pg8::EpiHgrn E{(bf16*)(w + WS_PROJ), 16384, (_Float16*)(w + WS_G), (const float*)(w + WS_LB) + (size_t)L * DM, pg8::RowScale{RTAB, u0.pm, (const float*)(w + WS_PART)}};
                CONV_PRE(4 * L); pg8::gemm_phase<pg8::EpiHgrn, pg8::StaticOrder, true, true>(lds, g, S, E); CONV_POST(4 * L);
                GRID_BAR(pb + 1);
            }
            if (EN(6) && IN(pb + 2)) { hg::b1_phase(lds, P_PROJ, P_G, P_UT, P_DEC, OPQ(vcu), OPQ(G)); GRID_BAR(pb + 2); }
            if (EN(7) && IN(pb + 3)) { hg::b2_phase(P_UT, P_DEC, P_ST, OPQ(vcu), OPQ(G)); GRID_BAR(pb + 3); }
            if (EN(8) && IN(pb + 4)) { hg::b3_phase(lds, P_PROJ, P_G, P_ST, INP(8) + j * DH, P_MO, OPQ(vcu), OPQ(G)); GRID_BAR(pb + 4); }
            if (DUP(6)) { hg::b1_phase(lds, P_PROJ, P_G, P_UT, P_DEC, OPQ(vcu), OPQ(G)); GRID_BAR(pb + 2); hg::b2_phase(P_UT, P_DEC, P_ST, OPQ(vcu), OPQ(G)); GRID_BAR(pb + 3); hg::b3_phase(lds, P_PROJ, P_G, P_ST, INP(8) + j * DH, P_MO, OPQ(vcu), OPQ(G)); GRID_BAR(pb + 4); }
        }
        if (EN(9) && IN(pb + 5)) {
            unsigned char* w = WSP();
            const bf16* W = fox ? (const bf16*)(w + WS_WFOUT) + (size_t)j * DM * DM : (const bf16*)(w + WS_WHOUT) + (size_t)j * DM * DM;
            pg8::Gemm g{(const bf16*)(w + WS_MO), W, SEQ, DM, DM}; pg8::StaticOrder S; S.init(SEQ, DM, OPQ(G), OPQ(bx));
            pg8::EpiRes E{L == 0 ? INP(0) : (const float*)(w + WS_H), (float*)(w + WS_H), DM, (bf16*)(w + WS_XN), INP(11) + (size_t)L * DM, (float*)(w + WS_PART)};
            CONV_PRE(4 * L + 1); pg8::gemm_phase<pg8::EpiRes, pg8::StaticOrder, true, true>(lds, g, S, E); CONV_POST(4 * L + 1);
            LOCAL_BAR(pb + 5);
        }
        if (EN(11) && IN(pb + 7)) {
            unsigned char* w = WSP();
            pg8::Gemm g{(const bf16*)(w + WS_XN), (const bf16*)(w + WS_WUP) + (size_t)L * DFF * DM, SEQ, DFF, DM}; pg8::StaticOrder S; S.init(SEQ, DFF, OPQ(G), OPQ(bx));
            pg8::Unit u0; S.next(0, u0); rstd_table(RTAB, (const float*)(w + WS_PART), u0.pm);
            pg8::EpiSqRelu E{(bf16*)(w + WS_HID), DFF, pg8::RowScale{RTAB, u0.pm, (const float*)(w + WS_PART)}};
            CONV_PRE(4 * L + 2); pg8::gemm_phase<pg8::EpiSqRelu, pg8::StaticOrder, true, true>(lds, g, S, E); CONV_POST(4 * L + 2);
            LOCAL_BAR(pb + 7);
        }
        if (EN(12) && IN(pb + 8)) {
            unsigned char* w = WSP();
            pg8::Gemm g{(const bf16*)(w + WS_HID), (const bf16*)(w + WS_WDN) + (size_t)L * DM * DFF, SEQ, DM, DFF}; pg8::StaticOrder S; S.init(SEQ, DM, OPQ(G), OPQ(bx), DOWN_WGM);
            pg8::EpiRes E{(const float*)(w + WS_H), (float*)(w + WS_H), DM, L + 1 < DEPTH ? (bf16*)(w + WS_XN) : nullptr, INP(10) + (size_t)(L + 1 < DEPTH ? L + 1 : 0) * DM, (float*)(w + WS_PART)};
            CONV_PRE(4 * L + 3); pg8::gemm_phase<pg8::EpiRes, pg8::StaticOrder, true, true>(lds, g, S, E); CONV_POST(4 * L + 3);
            if (L + 1 < DEPTH) LOCAL_BAR(pb + 8); else GRID_BAR(pb + 8);
        }
    }
    if (EN(13) && IN(PH_FINAL)) rms_phase<true>(P_H, INP(14), args.out, OPQ(vcu), OPQ(G));
#undef IN
#undef GRID_BAR
}

extern "C" void kernel_launch(void* const* d_in, const int* in_sizes, int n_in, void* d_out, int out_size, void* d_ws, size_t ws_size, hipStream_t stream) {
    static int grid = 0;
    if (grid == 0) {
        if (n_in != 15 || in_sizes[0] != SEQ * DM || out_size != SEQ * DM || ws_size < WS_END) { fprintf(stderr, "kernel_launch: unexpected shapes (n_in %d, in0 %d, out %d, ws %zu < %zu)\n", n_in, n_in > 0 ? in_sizes[0] : -1, out_size, ws_size, (size_t)WS_END); grid = -1; return; }
        int dev = 0, cus = 0, per_cu = 0;
        if (hipGetDevice(&dev) != hipSuccess || hipDeviceGetAttribute(&cus, hipDeviceAttributeMultiprocessorCount, dev) != hipSuccess) { grid = -1; return; }
        if (hipFuncSetAttribute((const void*)trunk_fwd, hipFuncAttributeMaxDynamicSharedMemorySize, LDS_BYTES) != hipSuccess) { fprintf(stderr, "kernel_launch: hipFuncSetAttribute failed\n"); grid = -1; return; }
        if (hipOccupancyMaxActiveBlocksPerMultiprocessor(&per_cu, (const void*)trunk_fwd, NWAVES * 64, LDS_BYTES) != hipSuccess || per_cu < 1) fprintf(stderr, "kernel_launch: occupancy query says %d\n", per_cu);
        (void)hipGetLastError();
        grid = cus;
    }
    if (grid < 0) return;
    if (hipMemsetAsync((char*)d_ws + WS_CTL, 0, CTL_ZERO_BYTES, stream) != hipSuccess) return;
    Args a{};
    for (int i = 0; i < 15; ++i) a.in[i] = (const float*)d_in[i];
    a.out = (float*)d_out; a.ws = (unsigned char*)d_ws;
#if MK_PER_PHASE
    for (int p = 0; p < PH_END; ++p) {
        bool valid = (p == 0) || (p == PH_FINAL);
        if (p >= 1 && p < PH_FINAL) { const int L = (p - 1) / 12, k = (p - 1) % 12; const bool fox = (L & 1) == 0; valid = (k <= 8) && (k != 6) && (k != 0 || L == 0); }
        if (!valid) continue;
        a.ph_lo = p; a.ph_hi = p + 1;
        hipLaunchKernelGGL(trunk_fwd, dim3(grid), dim3(NWAVES * 64), LDS_BYTES, stream, a);
    }
#else
    a.ph_lo = 0; a.ph_hi = PH_END;
    hipLaunchKernelGGL(trunk_fwd, dim3(grid), dim3(NWAVES * 64), LDS_BYTES, stream, a);
#endif
}
```

```cpp
#define MK_PER_PHASE 0
#define DUP_SITE -1
#include <hip/hip_runtime.h>
#include <hip/hip_bf16.h>
#include <cstdio>
#include <cstdint>

#ifndef MK_PER_PHASE
#define MK_PER_PHASE 0
#endif

constexpr int SEQ = 16384, DM = 4096, DFF = 16384, NH = 32, DH = 128, DEPTH = 4;
constexpr int FOX_IN = 4 * DM + NH;
constexpr int FOX_INP = 65 * 256;
constexpr int HG_IN = 4 * DM;
constexpr float NORM_EPS = 1e-6f;
constexpr float LOG2E = 1.4426950408889634f;
constexpr float QSCALE = 0.08838834764831845f * LOG2E;

constexpr size_t MiB = 1u << 20;
constexpr size_t WS_CTL = 0, CTL_ZERO_BYTES = 1 * MiB;
constexpr size_t WS_WFIN = 1 * MiB;
constexpr size_t WS_WFOUT = WS_WFIN + 260 * MiB;
constexpr size_t WS_WHIN = WS_WFOUT + 64 * MiB;
constexpr size_t WS_WHOUT = WS_WHIN + 256 * MiB;
constexpr size_t WS_WUP = WS_WHOUT + 64 * MiB;
constexpr size_t WS_WDN = WS_WUP + 512 * MiB;
constexpr size_t WS_H = WS_WDN + 512 * MiB;
constexpr size_t WS_XN = WS_H + 256 * MiB;
constexpr size_t WS_MO = WS_XN + 128 * MiB;
constexpr size_t WS_PROJ = WS_MO + 128 * MiB;
constexpr size_t WS_G = WS_PROJ + 512 * MiB;
constexpr size_t WS_UT = WS_G + 256 * MiB;
constexpr size_t WS_ST = WS_UT + 256 * MiB;
constexpr size_t WS_LOGF = WS_ST + 256 * MiB;
constexpr size_t WS_KB = WS_LOGF + 2 * MiB;
constexpr size_t WS_DEC = WS_KB + 2 * MiB;
constexpr size_t WS_LB = WS_DEC + 4 * MiB;
constexpr size_t WS_PART = WS_LB + 1 * MiB;
constexpr size_t WS_HID = WS_PART + 4 * MiB;
constexpr size_t WS_END = WS_HID + 512 * MiB;

#define GAS __attribute__((address_space(1)))
#define LAS __attribute__((address_space(3)))
typedef unsigned short bf16;
typedef unsigned v4u __attribute__((ext_vector_type(4)));
typedef unsigned v2u __attribute__((ext_vector_type(2)));
typedef float f32x4 __attribute__((ext_vector_type(4)));
typedef float f32x16 __attribute__((ext_vector_type(16)));
typedef short bf16x8 __attribute__((ext_vector_type(8)));
typedef short s16x4 __attribute__((ext_vector_type(4)));
#define LDS_WAIT() asm volatile("s_waitcnt lgkmcnt(0)" ::: "memory")
#define VM_WAIT() asm volatile("s_waitcnt vmcnt(0)" ::: "memory")
typedef float f32x2_t __attribute__((ext_vector_type(2)));
typedef __bf16 bf16x2_t __attribute__((ext_vector_type(2)));
__device__ __forceinline__ unsigned cvtpk(float lo, float hi) { const f32x2_t v = {lo, hi}; return __builtin_bit_cast(unsigned, __builtin_convertvector(v, bf16x2_t)); }
__device__ __forceinline__ float bflo(unsigned w) { return __uint_as_float(w << 16); }
__device__ __forceinline__ float bfhi(unsigned w) { return __uint_as_float(w & 0xffff0000u); }
__device__ __forceinline__ float bf2f(bf16 b) { return __uint_as_float(((unsigned)b) << 16); }
__device__ __forceinline__ bf16 f2bf(float f) { return (bf16)(cvtpk(f, 0.f) & 0xffffu); }
__device__ __forceinline__ float fexp(float x) { return __builtin_amdgcn_exp2f(x * LOG2E); }
__device__ __forceinline__ float sigmoidf_(float x) { return __builtin_amdgcn_rcpf(1.f + fexp(-x)); }
constexpr int WAVE_TAB_OFF = 131072 + 2048;
__device__ __forceinline__ unsigned hw_wave_slot() { return (unsigned)__builtin_amdgcn_s_getreg((5 << 11) | 4) & 63u; }
__device__ __forceinline__ int opaque_tid() {
    extern __shared__ __attribute__((aligned(16))) unsigned char dyn_lds_[];
    int l; asm volatile("v_mbcnt_lo_u32_b32 %0, -1, 0\n\tv_mbcnt_hi_u32_b32 %0, -1, %0" : "=v"(l));
    const int w = __builtin_amdgcn_readfirstlane(((const volatile LAS int*)((LAS unsigned char*)dyn_lds_ + WAVE_TAB_OFF))[hw_wave_slot()]);
    return (w << 6) | l;
}
__device__ __forceinline__ float shx(float v, int o, int lane) { return __int_as_float(__builtin_amdgcn_ds_bpermute((lane ^ o) << 2, __float_as_int(v))); }
__host__ __device__ __forceinline__ int img_byte(int r, int c) { const int st = (r >> 4) * 2 + (c >> 5), rr = r & 15, cc = c & 31, ob = rr * 64 + cc * 2; return st * 1024 + (ob ^ (((ob >> 9) & 1) << 5)); }
__host__ __device__ __forceinline__ size_t tiled_off(size_t row, int col, int nkt) { const int rl = (int)(row & 255);
    return (((row >> 8) * (size_t)nkt + (size_t)(col >> 6)) << 14) + (size_t)((rl >> 7) * 8192 + (img_byte(rl & 127, col & 63) >> 1)); }
__host__ __device__ __forceinline__ size_t tiled_off_w(size_t n, int k, int nkt) { const int w = (int)(n & 31), rho = 16 * ((w >> 2) & 1) + 4 * (w >> 3) + (w & 3);
    return tiled_off((n & ~(size_t)31) + (size_t)rho, k, nkt); }
namespace pg8 {
#define PG8_LAS __attribute__((address_space(3)))
typedef unsigned short bf16_t;
typedef short bf16x8 __attribute__((ext_vector_type(8)));
typedef float f32x4 __attribute__((ext_vector_type(4)));
typedef unsigned u32x4 __attribute__((ext_vector_type(4)));
constexpr int BM = 256, BK = 64, HALF = 128, HTB = HALF * BK * 2  , STAGE_BYTES = 8 * HTB, NXCD = 8, WGM = 8;

__host__ __device__ __forceinline__ int lds_byte(int r, int c) { const int st = (r >> 4) * 2 + (c >> 5), rr = r & 15, cc = c & 31, ob = rr * 64 + cc * 2; return st * 1024 + (ob ^ (((ob >> 9) & 1) << 5)); }
__host__ __device__ __forceinline__ void stage_rc(int b, int& R, int& C) { const int st = b / 1024, sb = b % 1024, swz = sb ^ (((sb >> 9) & 1) << 5); R = (st >> 1) * 16 + swz / 64; C = (st & 1) * 32 + (swz % 64) / 2; }
__host__ __device__ __forceinline__ int perm32(int rho) { const int n = rho >> 4, i = rho & 15; return 8 * (i >> 2) + 4 * n + (i & 3); }

struct Unit { int pm, pn; };
struct Gemm { const bf16_t* A; const bf16_t* Bt; int M, N, K; };

struct StaticOrder {
    int nM, nN, nwg, G, c, wgm;
    __host__ __device__ __forceinline__ void init(int M, int N, int G_, int c_, int wgm_ = WGM) { nM = M / BM; nN = N / BM; nwg = nM * nN; G = G_; c = c_; wgm = wgm_; }
    __host__ __device__ __forceinline__ bool next(int i, Unit& u) const {
        const long L = (long)i * G + c; if (L >= nwg) return false;
        int wgid = (int)L; { const int q = nwg / NXCD, r = nwg % NXCD, xcd = wgid % NXCD, off = wgid / NXCD; wgid = (xcd < r ? xcd * (q + 1) : r * (q + 1) + (xcd - r) * q) + off; }
        const int nig = wgm * nN, gid = wgid / nig, fm = gid * wgm, gsz = (nM - fm) < wgm ? (nM - fm) : wgm;
        u.pm = fm + ((wgid % nig) % gsz); u.pn = (wgid % nig) / gsz; return true;
    }
    __device__ __forceinline__ void a_ready(const Unit&) const {}
    __device__ __forceinline__ void done(const Unit&) const {}
};
#ifndef EPI_NT
#define EPI_NT 0
#endif
#if EPI_NT
#define STORE_NT(p, v) __builtin_nontemporal_store((v), (p))
#else
#define STORE_NT(p, v) (*(p) = (v))
#endif
__device__ __forceinline__ unsigned cvt_pk_bf16(float lo, float hi) { return ::cvtpk(lo, hi); }
__device__ __forceinline__ float lsig(float z) { return fminf(z, 0.f) - 0.6931471805599453f * __builtin_amdgcn_logf(1.f + __builtin_amdgcn_exp2f(-1.4426950408889634f * fabsf(z))); }
__device__ __forceinline__ float sigm(float x) { return __builtin_amdgcn_rcpf(1.f + __builtin_amdgcn_exp2f(-1.4426950408889634f * x)); }

struct RowScale {
    const PG8_LAS float* tab; int pm0; const float* part;
    __device__ __forceinline__ float get(const Unit& u, int rowin) const {
        if (u.pm == pm0) return tab[rowin];
        int ri = rowin; asm volatile("" : "+v"(ri));
        const f32x4* p = (const f32x4*)(part + (size_t)(u.pm * BM + ri) * 64); f32x4 a = {0.f, 0.f, 0.f, 0.f};
#pragma unroll 1
        for (int i = 0; i < 16; ++i) a += p[i];
        return rsqrtf(((a.x + a.y) + (a.z + a.w)) * (1.f / 4096.f) + 1e-6f);
    }
};
struct EpiRes {
    static constexpr bool PERM = true, AFTER_DRAIN = false;
    const float* base; float* out; int ldc; bf16_t* xn; const float* gain; float* part;
    __device__ __forceinline__ void operator()(const f32x4 (&acc)[2][2][4][2], const Unit& u, int wr, int wc, int fr_, int fq_) const {
        int fr = fr_, fq = fq_; asm volatile("" : "+v"(fr), "+v"(fq));
        const int row0 = u.pm * BM + wr * 64 + fr, col0 = u.pn * BM + wc * 32 + 8 * fq, lane = fq * 16 + fr;
        f32x4 g0[2], g1[2];
        if (xn) {
#pragma unroll
            for (int bj = 0; bj < 2; ++bj) { g0[bj] = *(const f32x4*)(gain + col0 + bj * HALF); g1[bj] = *(const f32x4*)(gain + col0 + bj * HALF + 4); } }
#pragma unroll
        for (int ai = 0; ai < 2; ++ai) {
            f32x4 b0[4][2], b1[4][2];
#pragma unroll
            for (int m = 0; m < 4; ++m) { const size_t off = (size_t)(row0 + ai * HALF + m * 16) * ldc + col0;
#pragma unroll
                for (int bj = 0; bj < 2; ++bj) { b0[m][bj] = *(const f32x4*)(base + off + bj * HALF); b1[m][bj] = *(const f32x4*)(base + off + bj * HALF + 4); } }
#pragma unroll
            for (int m = 0; m < 4; ++m) { const size_t row = (size_t)(row0 + ai * HALF + m * 16); const size_t off = row * ldc + col0;
                float ss = 0.f;
#pragma unroll
                for (int bj = 0; bj < 2; ++bj) { const f32x4 h0 = b0[m][bj] + acc[ai][bj][m][0], h1 = b1[m][bj] + acc[ai][bj][m][1];
                    STORE_NT((f32x4*)(out + off + bj * HALF), h0); STORE_NT((f32x4*)(out + off + bj * HALF + 4), h1);
                    if (xn) { ss += ((h0[0] * h0[0] + h0[1] * h0[1]) + (h0[2] * h0[2] + h0[3] * h0[3])) + ((h1[0] * h1[0] + h1[1] * h1[1]) + (h1[2] * h1[2] + h1[3] * h1[3]));
                        const f32x4 x0 = h0 * g0[bj], x1 = h1 * g1[bj];
                        u32x4 w; w.x = cvt_pk_bf16(x0[0], x0[1]); w.y = cvt_pk_bf16(x0[2], x0[3]); w.z = cvt_pk_bf16(x1[0], x1[1]); w.w = cvt_pk_bf16(x1[2], x1[3]);
                        STORE_NT((u32x4*)(xn + ::tiled_off(row, col0 + bj * HALF, ldc >> 6)), w); } }
                if (xn) { ss += ::shx(ss, 16, lane); ss += ::shx(ss, 32, lane); if (fq == 0) part[row * 64 + u.pn * 4 + wc] = ss; } }
            asm volatile("" ::: "memory"); }
    }
};
struct EpiSqRelu {
    static constexpr bool PERM = true, AFTER_DRAIN = false;
    bf16_t* O; int ldc; RowScale rsc;
    __device__ __forceinline__ void operator()(const f32x4 (&acc)[2][2][4][2], const Unit& u, int wr, int wc, int fr_, int fq_) const {
        int fr = fr_, fq = fq_; asm volatile("" : "+v"(fr), "+v"(fq));
        const int row0 = u.pm * BM + wr * 64 + fr, col0 = u.pn * BM + wc * 32 + 8 * fq;
#pragma unroll
        for (int ai = 0; ai < 2; ++ai)
#pragma unroll
            for (int m = 0; m < 4; ++m) { bf16_t* rowp = O + ::tiled_off((size_t)(row0 + ai * HALF + m * 16), col0, ldc >> 6); const float rs = rsc.get(u, wr * 64 + fr + ai * HALF + m * 16);
#pragma unroll
                for (int bj = 0; bj < 2; ++bj) { f32x4 v0 = acc[ai][bj][m][0] * rs, v1 = acc[ai][bj][m][1] * rs;
#pragma unroll
                    for (int j = 0; j < 4; ++j) { const float a = fmaxf(v0[j], 0.f), b = fmaxf(v1[j], 0.f); v0[j] = a * a; v1[j] = b * b; }
                    u32x4 w; w.x = cvt_pk_bf16(v0[0], v0[1]); w.y = cvt_pk_bf16(v0[2], v0[3]); w.z = cvt_pk_bf16(v1[0], v1[1]); w.w = cvt_pk_bf16(v1[2], v1[3]);
                    STORE_NT((u32x4*)(rowp + (size_t)bj * (2 * 16384)), w); } }
    }
};
struct EpiFox {
    static constexpr bool PERM = true, AFTER_DRAIN = false;
    bf16_t* P; int ldc; float* logf; const float* fbias; float* cs; RowScale rsc; const float* qg; const float* kg; PG8_LAS float* qkt; float QS;
    __device__ __forceinline__ void operator()(const f32x4 (&acc)[2][2][4][2], const Unit& u, int wr, int wc, int fr_, int fq_) const {
        int fr = fr_, fq = fq_; asm volatile("" : "+v"(fr), "+v"(fq));
        const int row0 = u.pm * BM + wr * 64 + fr;
        if (u.pn < 32) {
            const int col0 = u.pn * BM + wc * 32 + 8 * fq, lane = fq * 16 + fr; const bool isq = u.pn < 16;
            const float* gs = (isq ? qg : kg) + wc * 32 + 8 * fq; const float sc = isq ? QS : 1.f;
            const f32x4 g0 = *(const f32x4*)gs * sc, g1 = *(const f32x4*)(gs + 4) * sc;
#pragma unroll
            for (int ai = 0; ai < 2; ++ai)
#pragma unroll
                for (int m = 0; m < 4; ++m) { const int rowin = ai * 64 + m * 16 + fr; const float rs = rsc.get(u, wr * 64 + fr + ai * HALF + m * 16);
#pragma unroll
                    for (int bj = 0; bj < 2; ++bj) { const f32x4 v0 = acc[ai][bj][m][0] * rs, v1 = acc[ai][bj][m][1] * rs;
                        float ss = ((v0[0] * v0[0] + v0[1] * v0[1]) + (v0[2] * v0[2] + v0[3] * v0[3])) + ((v1[0] * v1[0] + v1[1] * v1[1]) + (v1[2] * v1[2] + v1[3] * v1[3]));
                        ss += ::shx(ss, 16, lane); ss += ::shx(ss, 32, lane);
                        if (fq == 0) qkt[(((wr * 128 + rowin) * 2 + bj) << 2) + wc] = ss; } }
            asm volatile("s_waitcnt lgkmcnt(0)" ::: "memory"); __builtin_amdgcn_s_barrier(); asm volatile("" ::: "memory");
#pragma unroll
            for (int ai = 0; ai < 2; ++ai)
#pragma unroll
                for (int m = 0; m < 4; ++m) { const int rowin = ai * 64 + m * 16 + fr; const float rs = rsc.get(u, wr * 64 + fr + ai * HALF + m * 16);
                    bf16_t* rowp = P + (((size_t)(u.pn >> 4) * 32 + (u.pn & 15) * 2) * 16384 + (size_t)(row0 + ai * HALF + m * 16)) * 128 + wc * 32 + 8 * fq;
#pragma unroll
                    for (int bj = 0; bj < 2; ++bj) { const f32x4 t = *(const PG8_LAS f32x4*)(qkt + (((wr * 128 + rowin) * 2 + bj) << 2));
                        const float r2 = rs * rsqrtf(((t[0] + t[1]) + (t[2] + t[3])) * (1.f / 128.f) + 1e-6f);
                        const f32x4 v0 = acc[ai][bj][m][0] * r2 * g0, v1 = acc[ai][bj][m][1] * r2 * g1;
                        u32x4 w; w.x = cvt_pk_bf16(v0[0], v0[1]); w.y = cvt_pk_bf16(v0[2], v0[3]); w.z = cvt_pk_bf16(v1[0], v1[1]); w.w = cvt_pk_bf16(v1[2], v1[3]);
                        STORE_NT((u32x4*)(rowp + (size_t)bj * ((size_t)16384 * 128)), w); } }
        } else if (u.pn < 64) {
            const int col0 = u.pn * BM + wc * 32 + 8 * fq; const bool gate = u.pn >= 48;
#pragma unroll
            for (int ai = 0; ai < 2; ++ai)
#pragma unroll
                for (int m = 0; m < 4; ++m) { bf16_t* rowp = P + (((size_t)(u.pn >> 4) * 32 + (u.pn & 15) * 2) * 16384 + (size_t)(row0 + ai * HALF + m * 16)) * 128 + wc * 32 + 8 * fq; const float rs = rsc.get(u, wr * 64 + fr + ai * HALF + m * 16);
#pragma unroll
                    for (int bj = 0; bj < 2; ++bj) { f32x4 v0 = acc[ai][bj][m][0] * rs, v1 = acc[ai][bj][m][1] * rs;
                        if (gate) {
#pragma unroll
                            for (int j = 0; j < 4; ++j) { v0[j] = sigm(v0[j]); v1[j] = sigm(v1[j]); } }
                        u32x4 w; w.x = cvt_pk_bf16(v0[0], v0[1]); w.y = cvt_pk_bf16(v0[2], v0[3]); w.z = cvt_pk_bf16(v1[0], v1[1]); w.w = cvt_pk_bf16(v1[2], v1[3]);
                        STORE_NT((u32x4*)(rowp + (size_t)bj * ((size_t)16384 * 128)), w); } }
        } else if (wc == 0) {
            const f32x4 b0 = *(const f32x4*)(fbias + 8 * fq), b1 = *(const f32x4*)(fbias + 8 * fq + 4);
            const int lane = fq * 16 + fr;
#pragma unroll
            for (int ai = 0; ai < 2; ++ai) {
                f32x4 s0 = {0.f, 0.f, 0.f, 0.f}, s1 = {0.f, 0.f, 0.f, 0.f};
#pragma unroll
                for (int m = 0; m < 4; ++m) { float* rowp = logf + (size_t)(row0 + ai * HALF + m * 16) * 32 + 8 * fq; const float rs = rsc.get(u, wr * 64 + fr + ai * HALF + m * 16);
                    f32x4 v0 = acc[ai][0][m][0] * rs + b0, v1 = acc[ai][0][m][1] * rs + b1;
#pragma unroll
                    for (int j = 0; j < 4; ++j) { v0[j] = lsig(v0[j]); v1[j] = lsig(v1[j]); }
                    *(f32x4*)rowp = v0; *(f32x4*)(rowp + 4) = v1; s0 += v0; s1 += v1; }
#pragma unroll
                for (int j = 0; j < 4; ++j) {
#pragma unroll
                    for (int o = 1; o < 16; o <<= 1) { s0[j] += ::shx(s0[j], o, lane); s1[j] += ::shx(s1[j], o, lane); } }
                if (fr == 0) { float* cp = cs + (size_t)(u.pm * 4 + ai * 2 + wr) * 32 + 8 * fq; *(f32x4*)cp = s0; *(f32x4*)(cp + 4) = s1; }
                asm volatile("" ::: "memory"); }
        }
    }
};
struct EpiHgrn {
    static constexpr bool PERM = true, AFTER_DRAIN = false;
    bf16_t* P; int ldc; _Float16* G; const float* lb; RowScale rsc;
    __device__ __forceinline__ void operator()(const f32x4 (&acc)[2][2][4][2], const Unit& u, int wr, int wc, int fr_, int fq_) const {
        int fr = fr_, fq = fq_; asm volatile("" : "+v"(fr), "+v"(fq));
        constexpr size_t HSTR = (size_t)16384 * 128;
        const int row0 = u.pm * BM + wr * 64 + fr, col0 = u.pn * BM + wc * 32 + 8 * fq; const int kind = u.pn >> 4, hd0 = (u.pn & 15) * 2, dcol = wc * 32 + 8 * fq;
        if (kind == 1) {
            const int gc0 = col0 - 4096;
            f32x4 l0[2], l1[2];
#pragma unroll
            for (int bj = 0; bj < 2; ++bj) { l0[bj] = *(const f32x4*)(lb + gc0 + bj * HALF); l1[bj] = *(const f32x4*)(lb + gc0 + bj * HALF + 4); }
#pragma unroll
            for (int ai = 0; ai < 2; ++ai)
#pragma unroll
                for (int m = 0; m < 4; ++m) { const size_t r = (size_t)(row0 + ai * HALF + m * 16); bf16_t* rowp = P + (((size_t)1 * 32 + hd0) * 16384 + r) * 128 + dcol; _Float16* gp = G + ((size_t)hd0 * 16384 + r) * 128 + dcol; const float rs = rsc.get(u, wr * 64 + fr + ai * HALF + m * 16);
#pragma unroll
                    for (int bj = 0; bj < 2; ++bj) { f32x4 v0 = acc[ai][bj][m][0] * rs, v1 = acc[ai][bj][m][1] * rs, g0, g1;
#pragma unroll
                        for (int j = 0; j < 4; ++j) { const float f0 = l0[bj][j] + (1.f - l0[bj][j]) * sigm(v0[j]), f1 = l1[bj][j] + (1.f - l1[bj][j]) * sigm(v1[j]);
                            g0[j] = log2f(f0); g1[j] = log2f(f1); v0[j] = 1.f - f0; v1[j] = 1.f - f1; }
                        u32x4 w; w.x = cvt_pk_bf16(v0[0], v0[1]); w.y = cvt_pk_bf16(v0[2], v0[3]); w.z = cvt_pk_bf16(v1[0], v1[1]); w.w = cvt_pk_bf16(v1[2], v1[3]);
                        STORE_NT((u32x4*)(rowp + (size_t)bj * HSTR), w); { typedef _Float16 h2 __attribute__((ext_vector_type(2))); typedef float f2 __attribute__((ext_vector_type(2)));
                          u32x4 gw; gw.x = __builtin_bit_cast(unsigned, __builtin_convertvector((f2){g0[0], g0[1]}, h2)); gw.y = __builtin_bit_cast(unsigned, __builtin_convertvector((f2){g0[2], g0[3]}, h2));
                          gw.z = __builtin_bit_cast(unsigned, __builtin_convertvector((f2){g1[0], g1[1]}, h2)); gw.w = __builtin_bit_cast(unsigned, __builtin_convertvector((f2){g1[2], g1[3]}, h2));
                          STORE_NT((u32x4*)(gp + (size_t)bj * HSTR), gw); } } }
        } else {
            const bool act = kind != 2;
#pragma unroll
            for (int ai = 0; ai < 2; ++ai)
#pragma unroll
                for (int m = 0; m < 4; ++m) { bf16_t* rowp = P + (((size_t)kind * 32 + hd0) * 16384 + (size_t)(row0 + ai * HALF + m * 16)) * 128 + dcol; const float rs = rsc.get(u, wr * 64 + fr + ai * HALF + m * 16);
#pragma unroll
                    for (int bj = 0; bj < 2; ++bj) { f32x4 v0 = acc[ai][bj][m][0] * rs, v1 = acc[ai][bj][m][1] * rs;
                        if (act) {
#pragma unroll
                            for (int j = 0; j < 4; ++j) { v0[j] = v0[j] * sigm(v0[j]); v1[j] = v1[j] * sigm(v1[j]); } }
                        u32x4 w; w.x = cvt_pk_bf16(v0[0], v0[1]); w.y = cvt_pk_bf16(v0[2], v0[3]); w.z = cvt_pk_bf16(v1[0], v1[1]); w.w = cvt_pk_bf16(v1[2], v1[3]);
                        STORE_NT((u32x4*)(rowp + (size_t)bj * HSTR), w); } }
        }
    }
};
template <class Epi, class Sched, bool ALIGN_EPI = false, bool SP2 = false>
__device__ __forceinline__ void gemm_phase(PG8_LAS unsigned char* lds, const Gemm g, const Sched& S, const Epi& E) {
    const int tid = opaque_tid(), wid = __builtin_amdgcn_readfirstlane(tid >> 6), lane = tid & 63, wr = wid >> 2, wc = wid & 3, fr = lane & 15, fq = lane >> 4;
    const int K = g.K, nt = K / BK;
    unsigned voffA[2], voffB[2];
    static_assert(Epi::PERM, "the weights are stored with the PERM row order baked in");
#pragma unroll
    for (int i = 0; i < 2; ++i) { voffA[i] = (unsigned)(tid * 16 + i * 8192); voffB[i] = voffA[i]; }
    const size_t kstep = (size_t)BM * BK * 2, hstep = (size_t)HALF * BK * 2;
    const size_t tstep = (size_t)BM * K * 2;
    const size_t kstepB = kstep, hstepB = hstep;
    const unsigned ldsw = (unsigned)wid * 1024u;
    const int aoff = lds_byte(wr * 64 + fr, fq * 8), boff = lds_byte(wc * 32 + fr, fq * 8);
#define PG8_SA(b, h) (((b) * 2 + (h)) * HTB)
#define PG8_SB(b, h) ((4 + (b) * 2 + (h)) * HTB)
#define PG8_STAGE(bufoff, gbase, voff) do { _Pragma("unroll") for (int _i = 0; _i < 2; ++_i) \
        __builtin_amdgcn_global_load_lds((const unsigned*)((const char*)(gbase) + (voff)[_i]), (PG8_LAS unsigned*)(lds + (bufoff) + ldsw + _i * 8192), 16, 0, 0); } while (0)
#define PG8_LDA(dst, b, h) do { _Pragma("unroll") for (int m = 0; m < 4; ++m) _Pragma("unroll") for (int k = 0; k < 2; ++k) dst[m][k] = *(const PG8_LAS bf16x8*)(lds + PG8_SA(b, h) + aoff + m * 2048 + k * 1024); } while (0)
#define PG8_LDB(dst, b, h) do { _Pragma("unroll") for (int n = 0; n < 2; ++n) _Pragma("unroll") for (int k = 0; k < 2; ++k) dst[n][k] = *(const PG8_LAS bf16x8*)(lds + PG8_SB(b, h) + boff + n * 2048 + k * 1024); } while (0)
#ifndef PG8_PRIO
#define PG8_PRIO 1
#endif
#define PG8_MMA(ai, bj, At, Bt) do { if (PG8_PRIO) __builtin_amdgcn_s_setprio(1); _Pragma("unroll") for (int m = 0; m < 4; ++m) _Pragma("unroll") for (int n = 0; n < 2; ++n) _Pragma("unroll") for (int k = 0; k < 2; ++k) \
        acc[ai][bj][m][n] = __builtin_amdgcn_mfma_f32_16x16x32_bf16(Bt[n][k], At[m][k], acc[ai][bj][m][n], 0, 0, 0); if (PG8_PRIO) __builtin_amdgcn_s_setprio(0); } while (0)
#define PG8_WAIT_V(n) asm volatile("s_waitcnt vmcnt(" #n ")" ::: "memory")
#define PG8_WAIT_L(n) asm volatile("s_waitcnt lgkmcnt(" #n ")" ::: "memory")
#define PG8_BAR __builtin_amdgcn_s_barrier()
#define PG8_SCHED __builtin_amdgcn_sched_barrier(0)
    Unit cur, nxt; int ui = 0;
    if (!S.next(0, cur)) return;
    f32x4 acc[2][2][4][2];
#pragma unroll
    for (int a = 0; a < 2; ++a)
#pragma unroll
        for (int b = 0; b < 2; ++b)
#pragma unroll
            for (int m = 0; m < 4; ++m)
#pragma unroll
                for (int n = 0; n < 2; ++n) acc[a][b][m][n] = (f32x4){0.f, 0.f, 0.f, 0.f};
    bf16x8 At[4][2], B0[2][2], B1[2][2];
    const char* cA = (const char*)g.A + (size_t)cur.pm * tstep; const char* cB = (const char*)g.Bt + (size_t)cur.pn * tstep;
    S.a_ready(cur);
    if constexpr (SP2) {
        PG8_STAGE(PG8_SB(0, 0), cB, voffB); PG8_STAGE(PG8_SB(0, 1), cB + hstepB, voffB); PG8_STAGE(PG8_SA(0, 0), cA, voffA); PG8_STAGE(PG8_SA(0, 1), cA + hstep, voffA);
        if (wr == 1) PG8_BAR;
        PG8_WAIT_V(2); PG8_BAR;
        PG8_STAGE(PG8_SB(1, 0), cB + kstepB, voffB); PG8_STAGE(PG8_SA(1, 0), cA + kstep, voffA); PG8_STAGE(PG8_SB(1, 1), cB + hstepB + kstepB, voffB);
        PG8_WAIT_V(6); PG8_BAR;
    } else {
        PG8_STAGE(PG8_SB(0, 0), cB, voffB); PG8_STAGE(PG8_SA(0, 0), cA, voffA); PG8_STAGE(PG8_SB(0, 1), cB + hstepB, voffB); PG8_STAGE(PG8_SA(0, 1), cA + hstep, voffA);
        if (wr == 1) PG8_BAR;
        PG8_WAIT_V(4); PG8_BAR;
        PG8_STAGE(PG8_SB(1, 0), cB + kstepB, voffB); PG8_STAGE(PG8_SA(1, 0), cA + kstep, voffA); PG8_STAGE(PG8_SB(1, 1), cB + hstepB + kstepB, voffB);
        PG8_WAIT_V(6); PG8_BAR;
    }
    for (;;) {
        const bool has_next = S.next(ui + 1, nxt);
        const char* nA = has_next ? (const char*)g.A + (size_t)nxt.pm * tstep : cA; const char* nB = has_next ? (const char*)g.Bt + (size_t)nxt.pn * tstep : cB;
        for (int t = 0; t < nt; t += 2) {
            const bool last = (t == nt - 2);
            const char* a1 = cA + (size_t)(t + 1) * kstep;
            const char* a2 = last ? nA : cA + (size_t)(t + 2) * kstep; const char* b2 = last ? nB : cB + (size_t)(t + 2) * kstepB;
            const char* a3 = a2 + kstep; const char* b3 = b2 + kstepB;
            if (last && has_next) S.a_ready(nxt);
            if constexpr (SP2) {
            PG8_LDB(B0, 0, 0); PG8_LDB(B1, 0, 1); PG8_SCHED; PG8_LDA(At, 0, 0); PG8_STAGE(PG8_SA(1, 1), a1 + hstep, voffA);
            PG8_WAIT_V(8); PG8_WAIT_L(0); PG8_BAR; PG8_MMA(0, 0, At, B0); PG8_MMA(0, 1, At, B1); PG8_BAR; PG8_SCHED;
            PG8_LDA(At, 0, 1); PG8_STAGE(PG8_SB(0, 0), b2, voffB); PG8_STAGE(PG8_SB(0, 1), b2 + hstepB, voffB); PG8_STAGE(PG8_SA(0, 0), a2, voffA);
            PG8_WAIT_V(8); PG8_WAIT_L(0); PG8_BAR; PG8_MMA(1, 0, At, B0); PG8_MMA(1, 1, At, B1); PG8_BAR; PG8_SCHED;
            PG8_LDB(B0, 1, 0); PG8_LDB(B1, 1, 1); PG8_SCHED; PG8_LDA(At, 1, 0); PG8_STAGE(PG8_SA(0, 1), a2 + hstep, voffA);
            PG8_WAIT_V(8); PG8_WAIT_L(0); PG8_BAR; PG8_MMA(0, 0, At, B0); PG8_MMA(0, 1, At, B1); PG8_BAR; PG8_SCHED;
            PG8_LDA(At, 1, 1); PG8_STAGE(PG8_SB(1, 0), b3, voffB); PG8_STAGE(PG8_SB(1, 1), b3 + hstepB, voffB); PG8_STAGE(PG8_SA(1, 0), a3, voffA);
            PG8_WAIT_V(8); PG8_WAIT_L(0); PG8_BAR; PG8_MMA(1, 0, At, B0); PG8_MMA(1, 1, At, B1); PG8_BAR; PG8_SCHED;
            } else {
            PG8_LDB(B0, 0, 0); PG8_SCHED; PG8_LDA(At, 0, 0); PG8_STAGE(PG8_SA(1, 1), a1 + hstep, voffA);
            PG8_WAIT_L(8); PG8_BAR; PG8_WAIT_L(0); PG8_MMA(0, 0, At, B0); PG8_BAR; PG8_SCHED;
            PG8_LDB(B1, 0, 1); PG8_STAGE(PG8_SB(0, 0), b2, voffB);
            PG8_BAR; PG8_WAIT_L(0); PG8_MMA(0, 1, At, B1); PG8_BAR;
            PG8_LDA(At, 0, 1); PG8_STAGE(PG8_SA(0, 0), a2, voffA);
            PG8_BAR; PG8_WAIT_L(0); PG8_MMA(1, 0, At, B0); PG8_BAR; PG8_SCHED;
            PG8_STAGE(PG8_SB(0, 1), b2 + hstepB, voffB);
            PG8_WAIT_V(6); PG8_BAR; PG8_MMA(1, 1, At, B1); PG8_BAR;
            PG8_LDB(B0, 1, 0); PG8_SCHED; PG8_LDA(At, 1, 0); PG8_STAGE(PG8_SA(0, 1), a2 + hstep, voffA);
            PG8_WAIT_L(8); PG8_BAR; PG8_WAIT_L(0); PG8_MMA(0, 0, At, B0); PG8_BAR; PG8_SCHED;
            PG8_LDB(B1, 1, 1); PG8_STAGE(PG8_SB(1, 0), b3, voffB);
            PG8_BAR; PG8_WAIT_L(0); PG8_MMA(0, 1, At, B1); PG8_BAR;
            PG8_LDA(At, 1, 1); PG8_STAGE(PG8_SA(1, 0), a3, voffA);
            PG8_BAR; PG8_WAIT_L(0); PG8_MMA(1, 0, At, B0); PG8_BAR; PG8_SCHED;
            PG8_STAGE(PG8_SB(1, 1), b3 + hstepB, voffB);
            PG8_WAIT_V(6); PG8_BAR; PG8_MMA(1, 1, At, B1); PG8_BAR;
            }
        }
        if constexpr (ALIGN_EPI) { if (wr == 0) PG8_BAR; }
        if constexpr (!Epi::AFTER_DRAIN) { E(acc, cur, wr, wc, fr, fq); S.done(cur); }
        if (!has_next) break;
#pragma unroll
        for (int a = 0; a < 2; ++a)
#pragma unroll
            for (int b = 0; b < 2; ++b)
#pragma unroll
                for (int m = 0; m < 4; ++m)
#pragma unroll
                    for (int n = 0; n < 2; ++n) acc[a][b][m][n] = (f32x4){0.f, 0.f, 0.f, 0.f};
        cur = nxt; cA = nA; cB = nB; ++ui;
        if constexpr (ALIGN_EPI) { if (wr == 1) PG8_BAR; }
    }
    PG8_WAIT_V(0);
    if constexpr (!ALIGN_EPI) { if (wr == 0) PG8_BAR; }
    PG8_BAR;
    if constexpr (Epi::AFTER_DRAIN) { E.fused(acc, cur, wr, wc, fr, fq, lds, wid, lane); S.done(cur); }
#undef PG8_SA
#undef PG8_SB
#undef PG8_STAGE
#undef PG8_LDA
#undef PG8_LDB
#undef PG8_MMA
#undef PG8_WAIT_V
#undef PG8_WAIT_L
#undef PG8_BAR
#undef PG8_SCHED
}
}
#define XB_TMO      128
#define XB_XCNT(j)  (256  + 64 * (j))
#define XB_XSUB(j)  (1280 + 64 * (j))
#define XB_XGEN(j)  (2304 + 64 * (j))
#define XB_TOP      3328
#define XB_TOPGEN   3392
#define XCD_BAR_WORDS 3456
#define XB_SPIN_CAP (1u << 18)
#define LAS __attribute__((address_space(3)))

__device__ __forceinline__ unsigned xb_ld(unsigned* p)              { return __hip_atomic_load((__attribute__((address_space(1))) unsigned*)p, __ATOMIC_RELAXED, __HIP_MEMORY_SCOPE_AGENT); }
__device__ __forceinline__ unsigned xb_add(unsigned* p, unsigned v) { return __hip_atomic_fetch_add((__attribute__((address_space(1))) unsigned*)p, v, __ATOMIC_RELAXED, __HIP_MEMORY_SCOPE_AGENT); }
__device__ __forceinline__ unsigned xb_xcc_id() { return (unsigned)__builtin_amdgcn_s_getreg((3 << 11) | 20) & 0xFu; }
#define XB_SPIN(cond, bar) do { unsigned _sp = 0; while (cond) { __builtin_amdgcn_s_sleep(1); \
    if ((++_sp & 255u) == 0u) { if (xb_ld(&(bar)[XB_TMO])) break; if (_sp > XB_SPIN_CAP) { atomicAdd(&(bar)[XB_TMO], 1u); break; } } } } while (0)

struct XcdBarrier {
    unsigned* bar; unsigned x;
    volatile LAS unsigned* st;
};

__device__ __forceinline__ XcdBarrier xcd_barrier_post(unsigned* bar, volatile LAS unsigned* st) {
    XcdBarrier b; b.bar = bar; b.x = xb_xcc_id(); b.st = st;
    if (threadIdx.x == 0) (void)xb_add(&bar[XB_XCNT(b.x)], 1u);
    return b;
}
__device__ __forceinline__ void xcd_barrier_complete(unsigned* bar, unsigned x, unsigned& nloc, unsigned& nx) {
    const unsigned G = gridDim.x * gridDim.y * gridDim.z;
    unsigned sum, cnt, mine, sp = 0u;
    for (;;) {
        sum = 0u; cnt = 0u; mine = 0u;
#pragma unroll
        for (unsigned j = 0; j < 16; ++j) { const unsigned c = xb_ld(&bar[XB_XCNT(j)]); sum += c; cnt += (c > 0u) ? 1u : 0u; mine = (j == x) ? c : mine; }
        if (sum == G) break;
        __builtin_amdgcn_s_sleep(1);
        if ((++sp & 255u) == 0u) { if (xb_ld(&bar[XB_TMO])) break; if (sp > XB_SPIN_CAP) { atomicAdd(&bar[XB_TMO], 1u); break; } }
    }
    nloc = mine > 0u ? mine : 1u; nx = cnt > 0u ? cnt : 1u;
}

__device__ __forceinline__ void xcd_barrier(const XcdBarrier& b) {
    asm volatile("s_waitcnt vmcnt(0)" ::: "memory");
    __syncthreads();
    if (threadIdx.x == 0) {
        unsigned* bar = b.bar;
        __builtin_amdgcn_s_waitcnt(0);
        unsigned nloc = b.st[0], nx = b.st[1];
        if (nloc == 0u) { xcd_barrier_complete(bar, b.x, nloc, nx); b.st[0] = nloc; b.st[1] = nx; }
        const unsigned old = xb_add(&bar[XB_XSUB(b.x)], 1u);
        const unsigned gen = old / nloc;
        if (old + 1u == (gen + 1u) * nloc) {
            __builtin_amdgcn_fence(__ATOMIC_RELEASE, "agent");
            asm volatile("s_waitcnt vmcnt(0)" ::: "memory");
            const unsigned og = xb_add(&bar[XB_TOP], 1u);
            const unsigned tg = og / nx;
            if (og + 1u == (tg + 1u) * nx) xb_add(&bar[XB_TOPGEN], 1u);
            else XB_SPIN(xb_ld(&bar[XB_TOPGEN]) == tg, bar);
            __builtin_amdgcn_fence(__ATOMIC_ACQUIRE, "agent");
            xb_add(&bar[XB_XGEN(b.x)], 1u);
            asm volatile("s_waitcnt vmcnt(0)" ::: "memory");
        } else {
            XB_SPIN(xb_ld(&bar[XB_XGEN(b.x)]) == gen, bar);
            __builtin_amdgcn_fence(__ATOMIC_ACQUIRE, "agent");
            asm volatile("s_waitcnt vmcnt(0)" ::: "memory");
        }
    }
    __syncthreads();
}

#define XB_LSUB(j)  (8192 + 64 * (j))
#define XB_LGEN(j)  (9216 + 64 * (j))
#define XB_XID      10240
__device__ __forceinline__ void xcd_local_barrier(const XcdBarrier& b) {
    asm volatile("s_waitcnt vmcnt(0)" ::: "memory");
    __syncthreads();
    if (threadIdx.x == 0) {
        unsigned* bar = b.bar;
        __builtin_amdgcn_s_waitcnt(0);
        unsigned nloc = b.st[0]; if (nloc == 0u) nloc = 1u;
        const unsigned old = xb_add(&bar[XB_LSUB(b.x)], 1u);
        const unsigned gen = old / nloc;
        if (old + 1u == (gen + 1u) * nloc) xb_add(&bar[XB_LGEN(b.x)], 1u);
        else XB_SPIN(xb_ld(&bar[XB_LGEN(b.x)]) == gen, bar);
        __builtin_amdgcn_fence(__ATOMIC_ACQUIRE, "agent");
        asm volatile("s_waitcnt vmcnt(0)" ::: "memory");
    }
    __syncthreads();
}
__device__ __forceinline__ int xcd_groups_local(unsigned* bar) {
    int ok = 1;
    if (gridDim.x != 256u) ok = 0;
    else if (threadIdx.x < 256u) { const unsigned v = xb_ld(&bar[XB_XID + threadIdx.x]), ref = xb_ld(&bar[XB_XID + (threadIdx.x & 7u)]); ok = (v != 0u && v == ref) ? 1 : 0; }
    return __syncthreads_and(ok);
}
constexpr int NWAVES = 8;
__device__ __forceinline__ float wave_sum(float v, int lane) {
#pragma unroll
    for (int o = 1; o < 64; o <<= 1) v += shx(v, o, lane);
    return v;
}
struct TileRegs { f32x4 v[4][8]; };
__device__ __forceinline__ void tile_load(const float* W, int N, int k0, int n0, int lane, TileRegs& t) {
    const int half = lane >> 5, nn = lane & 31, n = 4 * nn;
    const bool ok = n0 + n < N;
    const float* src = W + (size_t)k0 * N + n0 + n;
#pragma unroll
    for (int j = 0; j < 4; ++j)
#pragma unroll
        for (int r = 0; r < 8; ++r)
            t.v[j][r] = ok ? __builtin_nontemporal_load((const f32x4*)(src + (size_t)(8 * (2 * j + half) + r) * N)) : (f32x4){0.f, 0.f, 0.f, 0.f};
}
__device__ __forceinline__ void tile_to_lds(LAS unsigned* T, int lane, const TileRegs& t) {
    const int half = lane >> 5, nn = lane & 31, n = 4 * nn, sw = nn & 7;
#pragma unroll
    for (int j = 0; j < 4; ++j) { const int ch = (2 * j + half) ^ sw;
#pragma unroll
        for (int e = 0; e < 4; ++e)
            *(LAS v4u*)(T + (n + e) * 32 + 4 * ch) = (v4u){cvtpk(t.v[j][0][e], t.v[j][1][e]), cvtpk(t.v[j][2][e], t.v[j][3][e]), cvtpk(t.v[j][4][e], t.v[j][5][e]), cvtpk(t.v[j][6][e], t.v[j][7][e])}; }
    LDS_WAIT(); asm volatile("" ::: "memory");
}
__device__ __forceinline__ void tile_store(int K, int N, bf16* WT, const LAS unsigned* T, int k0, int n0, int lane) {
#pragma unroll 4
    for (int j = 0; j < 16; ++j) { const int idx = lane + 64 * j, c = idx & 7, nr = idx >> 3;
        const v4u w = *(const LAS v4u*)(T + nr * 32 + 4 * (c ^ ((nr >> 2) & 7)));
        if (n0 + nr < N) *(v4u*)(WT + tiled_off_w((size_t)(n0 + nr), k0 + 8 * c, K >> 6)) = w; }
    LDS_WAIT(); asm volatile("" ::: "memory");
}
__device__ __forceinline__ void transpose_matrix(const float* W, int K, int N, bf16* WT, LAS float* scr, int gw, int ngw, int lane, int i_lo, int i_hi) {
    const int nnt = (N + 127) / 128, nitems = (K / 64) * nnt;
    TileRegs t;
    if (i_lo < i_hi && gw + i_lo * ngw < nitems) { const int it = gw + i_lo * ngw, kb = it / nnt, nb = it - kb * nnt; tile_load(W, N, 64 * kb, 128 * nb, lane, t); }
    for (int i = i_lo; i < i_hi; ++i) { const int it = gw + i * ngw; if (it >= nitems) break; const int kb = it / nnt, nb = it - kb * nnt;
        tile_to_lds((LAS unsigned*)scr, lane, t);
        const int itn = it + ngw; if (i + 1 < i_hi && itn < nitems) { const int kbn = itn / nnt, nbn = itn - kbn * nnt; tile_load(W, N, 64 * kbn, 128 * nbn, lane, t); }
        tile_store(K, N, WT, (const LAS unsigned*)scr, 64 * kb, 128 * nb, lane); }
}
struct ConvArgs { const float* fox_w_in; const float* fox_w_out; const float* hgrn_w_in; const float* hgrn_w_out; const float* up; const float* down; };
__device__ __forceinline__ void conv_pick(unsigned char* ws, const ConvArgs& a, int q, const float*& src, bf16*& dst, int& K, int& N) {
    const int L = q >> 2, k = q & 3, j = L >> 1; const bool fox = (L & 1) == 0;
    if (k == 0) { K = DM; if (fox) { src = a.fox_w_in + (size_t)j * DM * FOX_IN; N = FOX_IN; dst = (bf16*)(ws + WS_WFIN) + (size_t)j * FOX_INP * DM; } else { src = a.hgrn_w_in + (size_t)j * DM * HG_IN; N = HG_IN; dst = (bf16*)(ws + WS_WHIN) + (size_t)j * HG_IN * DM; } }
    else if (k == 1) { K = DM; N = DM; if (fox) { src = a.fox_w_out + (size_t)j * DM * DM; dst = (bf16*)(ws + WS_WFOUT) + (size_t)j * DM * DM; } else { src = a.hgrn_w_out + (size_t)j * DM * DM; dst = (bf16*)(ws + WS_WHOUT) + (size_t)j * DM * DM; } }
    else if (k == 2) { K = DM; N = DFF; src = a.up + (size_t)L * DM * DFF; dst = (bf16*)(ws + WS_WUP) + (size_t)L * DFF * DM; }
    else { K = DFF; N = DM; src = a.down + (size_t)L * DFF * DM; dst = (bf16*)(ws + WS_WDN) + (size_t)L * DM * DFF; }
}
__device__ __forceinline__ void conv_weights(LAS unsigned char* lds, unsigned char* ws, const ConvArgs& a, int q, int vcu, int G, int part, int g) {
    const int tid = opaque_tid(), lane = tid & 63, wave = tid >> 6;
    LAS float* scr = (LAS float*)(lds + wave * 16384);
    const int gw = vcu * NWAVES + wave, ngw = G * NWAVES;
    const int L = q >> 2, k = q & 3; const bool fox = (L & 1) == 0;
    const float* src; bf16* dst; int K, N;
    conv_pick(ws, a, q, src, dst, K, N);
    const int cnt = ((K / 64) * ((N + 127) / 128) + ngw - 1) / ngw, cut = (g * cnt + 1) / 3;
    transpose_matrix(src, K, N, dst, scr, gw, ngw, lane, part == 2 ? cut : 0, part == 1 ? cut : cnt);
    if (k == 0 && fox && (part == 0 || (part == 1) == (g >= 2))) {
        const size_t n16 = (size_t)(FOX_INP - FOX_IN) * DM * 2 / 16; v4u zz = {0u, 0u, 0u, 0u}; asm volatile("" : "+v"(zz));
        for (size_t i = (size_t)(vcu * 512 + tid); i < n16; i += (size_t)G * 512) { const int kt = (int)(i / (224 * 8)), rem = (int)(i % (224 * 8)), nl = 32 + (rem >> 3), c = rem & 7;
            *(v4u*)(dst + tiled_off_w((size_t)(16384 + nl), 64 * kt + 8 * c, DM >> 6)) = zz; } }
    __syncthreads();
}
__device__ __forceinline__ void conv_tiles(LAS unsigned char* lds, unsigned char* ws, const ConvArgs& a, int q, int vcu, int G, int i_lo, int i_hi) {
    const int tid = opaque_tid(), lane = tid & 63, wave = tid >> 6;
    LAS float* scr = (LAS float*)(lds + wave * 16384);
    const float* src; bf16* dst; int K, N;
    conv_pick(ws, a, q, src, dst, K, N);
    transpose_matrix(src, K, N, dst, scr, vcu * NWAVES + wave, G * NWAVES, lane, i_lo, i_hi);
    __syncthreads();
}
#ifndef ATT_ALL
#define ATT_ALL 1
#endif
__device__ __forceinline__ void conv_chunk(LAS unsigned char* lds, unsigned char* ws, const ConvArgs& a, int qbase, int c, int vcu, int G) {
    int base = qbase; if (c >= 7) { c -= 7; base += 4; }
    if (c == 0) conv_tiles(lds, ws, a, base, vcu, G, 0, 1);
    else if (c == 7) conv_tiles(lds, ws, a, base + 3, vcu, G, 4, 5);
    else { const int il = 2 * ((c - 1) & 1); conv_tiles(lds, ws, a, base + 1 + ((c - 1) >> 1), vcu, G, il, il + 2); }
}
__device__ __forceinline__ int att_chunks(int qbase, int qend) { const int nm = qend - qbase;
    return nm <= 0 ? 0 : nm <= 4 ? 7 : nm == 8 ? 15 : 12; }
__device__ __forceinline__ void prologue_phase(LAS unsigned char* lds, unsigned char* ws, const ConvArgs& a, const float* lb_logits, int vcu, int G) {
    conv_weights(lds, ws, a, 0, vcu, G, 0, 0);
    const int tid = opaque_tid();
    for (int c = vcu * 512 + tid; c < DM; c += G * 512) {
        float l[4], mx = -1e30f; for (int i = 0; i < 4; ++i) { l[i] = lb_logits[i * DM + c]; mx = fmaxf(mx, l[i]); }
        float s = 0.f; for (int i = 0; i < 4; ++i) { l[i] = expf(l[i] - mx); s += l[i]; }
        float* LB = (float*)(ws + WS_LB); float cum = 0.f; const float p0 = l[0] / s;
        for (int i = 0; i < 4; ++i) { cum += l[i] / s; LB[i * DM + c] = cum - p0; }
    }
}
struct RowRegs { f32x4 v[16]; };
__device__ __forceinline__ int row_of(int sidx) { return ((sidx & 0x700) << 3) | (((sidx >> 11) & 7) << 8) | (sidx & 255); }
__device__ __forceinline__ void row_load(const float* src, int row, int lane, RowRegs& r) {
    const f32x4* xr = (const f32x4*)(src + (size_t)row * DM) + lane;
#pragma unroll
    for (int j = 0; j < 16; ++j) r.v[j] = xr[64 * j];
}
template <bool TO_F32>
__device__ __forceinline__ void rms_row(const RowRegs& r, const f32x4 (&g)[16], void* dst, int row, int lane) {
    float ss = 0.f;
#pragma unroll
    for (int j = 0; j < 16; ++j) ss += (r.v[j].x * r.v[j].x + r.v[j].y * r.v[j].y) + (r.v[j].z * r.v[j].z + r.v[j].w * r.v[j].w);
    const float rstd = rsqrtf(wave_sum(ss, lane) * (1.f / DM) + NORM_EPS);
#pragma unroll
    for (int j = 0; j < 16; ++j) { const f32x4 o = r.v[j] * rstd * g[j];
        if constexpr (TO_F32) ((f32x4*)((float*)dst + (size_t)row * DM) + lane)[64 * j] = o;
        else { v2u w; w.x = cvtpk(o.x, o.y); w.y = cvtpk(o.z, o.w); ((v2u*)((bf16*)dst + (size_t)row * DM) + lane)[64 * j] = w; } }
}
template <bool TO_F32>
__device__ __forceinline__ void rms_phase(const float* src, const float* gain, void* dst, int vcu, int G) {
    const int tid = opaque_tid(), lane = tid & 63, wave = tid >> 6;
    const int gw = vcu * NWAVES + wave, ngw = G * NWAVES;
    f32x4 g[16];
#pragma unroll
    for (int j = 0; j < 16; ++j) g[j] = ((const f32x4*)gain + lane)[64 * j];
    RowRegs ra, rb;
    if (gw < SEQ) row_load(src, row_of(gw), lane, ra);
    for (int row = gw; row < SEQ; row += 2 * ngw) {
        if (row + ngw < SEQ) row_load(src, row_of(row + ngw), lane, rb);
        rms_row<TO_F32>(ra, g, dst, row_of(row), lane);
        if (row + 2 * ngw < SEQ) row_load(src, row_of(row + 2 * ngw), lane, ra);
        if (row + ngw < SEQ) rms_row<TO_F32>(rb, g, dst, row_of(row + ngw), lane);
    }
}
__device__ __forceinline__ void rms0_row(const RowRegs& r, const f32x4 (&g)[16], bf16* dst, float* part, int row, int lane) {
    float ss = 0.f;
#pragma unroll
    for (int j = 0; j < 16; ++j) { const f32x4 v = r.v[j]; ss += (v.x * v.x + v.y * v.y) + (v.z * v.z + v.w * v.w); const f32x4 o = v * g[j];
        v2u w; w.x = cvtpk(o.x, o.y); w.y = cvtpk(o.z, o.w); *(v2u*)(dst + tiled_off((size_t)row, 4 * (lane + 64 * j), DM >> 6)) = w; }
    ss = wave_sum(ss, lane);
    part[(size_t)row * 64 + lane] = lane == 0 ? ss : 0.f;
}
__device__ __forceinline__ void rms0_phase(const float* src, const float* gain, bf16* dst, float* part, int vcu, int G) {
    const int tid = opaque_tid(), lane = tid & 63, wave = tid >> 6;
    const int gw = vcu * NWAVES + wave, ngw = G * NWAVES;
    f32x4 g[16];
#pragma unroll
    for (int j = 0; j < 16; ++j) g[j] = ((const f32x4*)gain + lane)[64 * j];
    RowRegs ra, rb;
    if (gw < SEQ) row_load(src, row_of(gw), lane, ra);
    for (int row = gw; row < SEQ; row += 2 * ngw) {
        if (row + ngw < SEQ) row_load(src, row_of(row + ngw), lane, rb);
        rms0_row(ra, g, dst, part, row_of(row), lane);
        if (row + 2 * ngw < SEQ) row_load(src, row_of(row + 2 * ngw), lane, ra);
        if (row + ngw < SEQ) rms0_row(rb, g, dst, part, row_of(row + ngw), lane);
    }
}
__device__ __forceinline__ void fz_phase(LAS unsigned char* lds, const bf16* XN, const bf16* WF, const float* part, const float* fbias, float* LOGF, float* CS, int vcu, int G) {
    const int tid = opaque_tid(), lane = tid & 63, wave = __builtin_amdgcn_readfirstlane(tid >> 6), r = lane & 15, q = lane >> 4, rt = wave & 3, kh = wave >> 2;
    LAS float* red = (LAS float*)lds;
    LAS float* csw = red + 4 * 8 * 64;
    for (int blk = vcu; blk < SEQ / 64; blk += G) {
        const int row0 = blk * 64 + 16 * rt;
        const size_t khoff = (size_t)kh * 32 * 32768;
        const char* pa = (const char*)(XN + tiled_off((size_t)(row0 + r), 8 * q, DM >> 6)) + khoff;
        const char* px = (const char*)(WF + tiled_off((size_t)(16384 + r), 8 * q, DM >> 6)) + khoff;
        const char* py = (const char*)(WF + tiled_off((size_t)(16384 + 16 + r), 8 * q, DM >> 6)) + khoff;
        f32x4 acc1 = {0.f, 0.f, 0.f, 0.f}, acc2 = {0.f, 0.f, 0.f, 0.f};
        bf16x8 A0[4], X0[4], Y0[4], A1[4], X1[4], Y1[4], A2[4], X2[4], Y2[4];
#define FZ_LOAD(A_, X_, Y_, b_) do { _Pragma("unroll") for (int s_ = 0; s_ < 4; ++s_) { const size_t o_ = (size_t)(2 * (b_) + (s_ >> 1)) * 32768 + (size_t)(s_ & 1) * 1024; \
            A_[s_] = *(const bf16x8*)(pa + o_); X_[s_] = *(const bf16x8*)(px + o_); Y_[s_] = *(const bf16x8*)(py + o_); } } while (0)
#define FZ_MMA(A_, X_, Y_) do { _Pragma("unroll") for (int s_ = 0; s_ < 4; ++s_) { acc1 = __builtin_amdgcn_mfma_f32_16x16x32_bf16(X_[s_], A_[s_], acc1, 0, 0, 0); acc2 = __builtin_amdgcn_mfma_f32_16x16x32_bf16(Y_[s_], A_[s_], acc2, 0, 0, 0); } } while (0)
        FZ_LOAD(A0, X0, Y0, 0); FZ_LOAD(A1, X1, Y1, 1);
#pragma unroll 1
        for (int b = 0; b < 15; b += 3) {
            FZ_LOAD(A2, X2, Y2, b + 2); FZ_MMA(A0, X0, Y0);
            FZ_LOAD(A0, X0, Y0, b + 3); FZ_MMA(A1, X1, Y1);
            if (b + 4 < 16) FZ_LOAD(A1, X1, Y1, b + 4);
            FZ_MMA(A2, X2, Y2);
        }
        FZ_MMA(A0, X0, Y0);
#undef FZ_LOAD
#undef FZ_MMA
        if (kh == 1) {
#pragma unroll
            for (int i = 0; i < 4; ++i) { red[(rt * 8 + i) * 64 + lane] = acc1[i]; red[(rt * 8 + 4 + i) * 64 + lane] = acc2[i]; } }
        __syncthreads();
        if (kh == 0) {
#pragma unroll
            for (int i = 0; i < 4; ++i) { acc1[i] += red[(rt * 8 + i) * 64 + lane]; acc2[i] += red[(rt * 8 + 4 + i) * 64 + lane]; }
            const f32x4* pp = (const f32x4*)(part + (size_t)(row0 + r) * 64 + 16 * q);
            const f32x4 a = (pp[0] + pp[1]) + (pp[2] + pp[3]); float ssq = (a.x + a.y) + (a.z + a.w); ssq += shx(ssq, 16, lane); ssq += shx(ssq, 32, lane);
            const float rs = rsqrtf(ssq * (1.f / DM) + NORM_EPS);
            const f32x4 b0 = *(const f32x4*)(fbias + 8 * q), b1 = *(const f32x4*)(fbias + 8 * q + 4);
            f32x4 v0 = acc1 * rs + b0, v1 = acc2 * rs + b1;
#pragma unroll
            for (int jj = 0; jj < 4; ++jj) { v0[jj] = pg8::lsig(v0[jj]); v1[jj] = pg8::lsig(v1[jj]); }
            float* rowp = LOGF + (size_t)(row0 + r) * 32 + 8 * q; *(f32x4*)rowp = v0; *(f32x4*)(rowp + 4) = v1;
#pragma unroll
            for (int jj = 0; jj < 4; ++jj) {
#pragma unroll
                for (int o = 1; o < 16; o <<= 1) { v0[jj] += shx(v0[jj], o, lane); v1[jj] += shx(v1[jj], o, lane); } }
            if (r == 0) { *(LAS f32x4*)(csw + rt * 32 + 8 * q) = v0; *(LAS f32x4*)(csw + rt * 32 + 8 * q + 4) = v1; }
        }
        __syncthreads();
        if (tid < 32) CS[(size_t)blk * 32 + tid] = (csw[tid] + csw[32 + tid]) + (csw[64 + tid] + csw[96 + tid]);
        __syncthreads();
    }
}
__device__ __forceinline__ void rstd_table(LAS float* tab, const float* part, int pm0) {
    const int tid = opaque_tid(), lane = tid & 63, row = tid >> 1, half = tid & 1;
    const f32x4* p = (const f32x4*)(part + (size_t)(pm0 * 256 + row) * 64 + half * 32); f32x4 a = {0.f, 0.f, 0.f, 0.f};
#pragma unroll
    for (int i = 0; i < 8; ++i) a += p[i];
    float s = (a.x + a.y) + (a.z + a.w); s += shx(s, 1, lane);
    if (half == 0) tab[row] = rsqrtf(s * (1.f / DM) + NORM_EPS);
    __syncthreads();
}
__device__ __forceinline__ void fox_thin_phase(LAS unsigned char* lds, const float* LOGF, const float* CS, float* KB, int vcu, int G) {
    const int tid = opaque_tid(), lane = tid & 63, wave = tid >> 6;
    LAS float* red = (LAS float*)lds;
    LAS float* pre = red + 16 * 32;
    LAS float* tile = pre + 32;
    for (int blk = vcu; blk < SEQ / 64; blk += G) {
        const int r0 = blk * 64;
        { const int h = tid & 31, part = tid >> 5; float a = 0.f;
#pragma unroll 4
          for (int c = part; c < blk; c += 16) a += CS[c * 32 + h];
          red[part * 32 + h] = a; }
        { const int row = tid >> 3, c4 = tid & 7; const f32x4 v = *(const f32x4*)(LOGF + (size_t)(r0 + row) * 32 + 4 * c4);
          tile[row * 33 + 4 * c4 + 0] = v.x; tile[row * 33 + 4 * c4 + 1] = v.y; tile[row * 33 + 4 * c4 + 2] = v.z; tile[row * 33 + 4 * c4 + 3] = v.w; }
        __syncthreads();
        if (tid < 32) { float s = 0.f;
#pragma unroll
            for (int p = 0; p < 16; ++p) s += red[p * 32 + tid];
            float c = s;
            for (int r = 0; r < 64; ++r) { c += tile[r * 33 + tid]; tile[r * 33 + tid] = -c * LOG2E; } }
        __syncthreads();
        { const int h = tid >> 4, r4 = (tid & 15) * 4;
          const f32x4 o = {tile[(r4 + 0) * 33 + h], tile[(r4 + 1) * 33 + h], tile[(r4 + 2) * 33 + h], tile[(r4 + 3) * 33 + h]};
          *(f32x4*)(KB + (size_t)h * SEQ + r0 + r4) = o; }
        __syncthreads();
    }
}
__device__ __forceinline__ void jl_phase(LAS unsigned char* lds, const float* KB, const float* qg, const float* kg, int* JL, int vcu, int G) {
    const int tid = opaque_tid(), lane = tid & 63, wave = tid >> 6;
    LAS int* cnt = (LAS int*)lds;
    float gq = fmaxf(fabsf(qg[lane]), fabsf(qg[lane + 64])), gk = fmaxf(fabsf(kg[lane]), fabsf(kg[lane + 64]));
#pragma unroll
    for (int o = 1; o < 64; o <<= 1) { gq = fmaxf(gq, shx(gq, o, lane)); gk = fmaxf(gk, shx(gk, o, lane)); }
    const float TH = 48.f + 2.f * (128.f * gq * gk * QSCALE * 1.02f);
    for (int id = vcu; id < 2048; id += G) {
        const int h = id & 31, qb = 63 - (id >> 5);
        const float* kb = KB + (size_t)h * SEQ;
        const float lim = kb[qb * 256] - TH;
        const bool pred = (tid < 4 * qb) && (kb[64 * tid + 63] < lim);
        const unsigned long long bal = __ballot(pred);
        if (lane == 0) cnt[wave] = __popcll(bal);
        __syncthreads();
        if (tid == 0) { int s = 0; for (int w = 0; w < 8; ++w) s += cnt[w]; JL[id] = s; }
        __syncthreads();
    }
}
namespace fa {
constexpr int D = 128, NW = 8, QBLK = 32, KVBLK = 64, QB = NW * QBLK;
constexpr int LDQ = 128, LDO = 4096;
constexpr int SHM_V = KVBLK * D * 2, SHM_K = KVBLK * D * 2;
constexpr int OFF_WS = 2 * SHM_V + 2 * SHM_K, OFF_KB = OFF_WS + NW * 64 * 4;
constexpr int LDS_BYTES = OFF_KB + 2 * 64 * 4;
constexpr int OFF_OST = LDS_BYTES + 16 + 112;
constexpr int LDS_END = OFF_OST + NW * 8 * 132 * 4;
#define KSWZ(row, colB) ((row) * 256 + ((colB) ^ (((row) & 7) << 4)))
#define SBAR() __builtin_amdgcn_sched_barrier(0)
__device__ __forceinline__ int v_st(int k, int c) { const int kk = (k & ~0xC) | ((k & 4) << 1) | ((k & 8) >> 1); return ((kk >> 3) * 4 + (c >> 5)) * 512 + ((kk & 7) * 32 + (c & 31)) * 2; }
__device__ __forceinline__ int v_rd_base(int lane) { return ((lane & 3) << 3) | (((lane >> 2) & 3) << 6) | (((lane >> 4) & 1) << 5) | (((lane >> 5) & 1) << 8); }
constexpr int v_rd_off(int d0, int ks, int half) { return d0 * 512 + ks * 4096 + half * 2048; }
__device__ __forceinline__ int crow(int r, int hi) { return (r & 3) + 8 * (r >> 2) + 4 * hi; }
__device__ __forceinline__ bf16x8 ld8(const bf16* p) { return *reinterpret_cast<const bf16x8*>(p); }
__device__ __forceinline__ void mask_tile(f32x16& p0, f32x16& p1, int dq) {
    const float NEG = -__builtin_inff();
#pragma unroll
    for (int r = 0; r < 16; ++r) {
        const int c = (r & 3) + 8 * (r >> 2);
        if (dq - c < 0) p0[r] = NEG;
        if (dq - c - 32 < 0) p1[r] = NEG;
    }
}
__device__ __forceinline__ void partialSM(f32x16& p0, f32x16& p1, float mt) {
#pragma unroll
    for (int r = 0; r < 16; ++r) p0[r] = __builtin_amdgcn_exp2f(p0[r] - mt);
#pragma unroll
    for (int r = 0; r < 16; ++r) p1[r] = p1[r] - mt;
}
__device__ __forceinline__ void finishSM(f32x16& p0, f32x16& p1, float& l_reg, bf16x8& pa0, bf16x8& pa1, bf16x8& pa2, bf16x8& pa3) {
#pragma unroll
    for (int r = 0; r < 16; ++r) p1[r] = __builtin_amdgcn_exp2f(p1[r]);
    float ps = 0;
#pragma unroll
    for (int r = 0; r < 16; ++r) ps += p0[r];
#pragma unroll
    for (int r = 0; r < 16; ++r) ps += p1[r];
    { auto rr = __builtin_amdgcn_permlane32_swap(__float_as_uint(ps), __float_as_uint(ps), false, false);
      ps = __uint_as_float(rr[0]) + __uint_as_float(rr[1]); }
    l_reg += ps;
#define PK4(P, B_, OUT) do { unsigned a0 = cvtpk(P[B_+0], P[B_+1]), a1 = cvtpk(P[B_+2], P[B_+3]);                          \
        unsigned b0 = cvtpk(P[B_+4], P[B_+5]), b1 = cvtpk(P[B_+6], P[B_+7]);                                             \
        auto r0 = __builtin_amdgcn_permlane32_swap(a0, b0, false, false); auto r1 = __builtin_amdgcn_permlane32_swap(a1, b1, false, false); \
        v4u w = {r0[0], r1[0], r0[1], r1[1]}; OUT = *reinterpret_cast<bf16x8*>(&w); } while (0)
    PK4(p0, 0, pa0); PK4(p0, 8, pa1); PK4(p1, 0, pa2); PK4(p1, 8, pa3);
#undef PK4
}
template <int KB>
__device__ __forceinline__ void qkt(f32x16& p0, f32x16& p1, const char* K_lds, const float* kbl, int r32, int hi, const bf16x8* qr) {
#ifdef X_NOBIAS
    p0 = f32x16{}; p1 = f32x16{};
#else
    { const float* kb = kbl + KB * 64 + 4 * hi;
      const f32x4 a0 = *(const f32x4*)(kb), a1 = *(const f32x4*)(kb + 8), a2 = *(const f32x4*)(kb + 16), a3 = *(const f32x4*)(kb + 24);
      const f32x4 b0 = *(const f32x4*)(kb + 32), b1 = *(const f32x4*)(kb + 40), b2 = *(const f32x4*)(kb + 48), b3 = *(const f32x4*)(kb + 56);
      p0 = f32x16{a0[0], a0[1], a0[2], a0[3], a1[0], a1[1], a1[2], a1[3], a2[0], a2[1], a2[2], a2[3], a3[0], a3[1], a3[2], a3[3]};
      p1 = f32x16{b0[0], b0[1], b0[2], b0[3], b1[0], b1[1], b1[2], b1[3], b2[0], b2[1], b2[2], b2[3], b3[0], b3[1], b3[2], b3[3]}; }
#endif
    const char* kb4[4];
#pragma unroll
    for (int dd = 0; dd < 4; ++dd) kb4[dd] = K_lds + KB * SHM_K + KSWZ(r32, (dd * 16 + hi * 8) * 2);
#pragma unroll
    for (int d0 = 0; d0 < 8; ++d0) { const char* a = kb4[d0 & 3] + (d0 >> 2) * 128;
        bf16x8 b0 = *reinterpret_cast<const bf16x8*>(a);
        bf16x8 b1 = *reinterpret_cast<const bf16x8*>(a + 32 * 256);
        p0 = __builtin_amdgcn_mfma_f32_32x32x16_bf16(b0, qr[d0], p0, 0, 0, 0);
        p1 = __builtin_amdgcn_mfma_f32_32x32x16_bf16(b1, qr[d0], p1, 0, 0, 0); }
}
template <int VB>
__device__ __forceinline__ void pv_tile(f32x16* o, int vb0, bf16x8 pa0, bf16x8 pa1, bf16x8 pa2, bf16x8 pa3) {
#define TRRD(dst, off) asm volatile("ds_read_b64_tr_b16 %0, %1 offset:%2" : "=&v"(dst) : "v"(vb0), "i"(off) : "memory")
#define PV_D0(d0) do { s16x4 l0, l1, l2, l3, h0, h1, h2, h3; constexpr int b_ = VB * SHM_V + v_rd_off(d0, 0, 0); \
        TRRD(l0, b_); TRRD(h0, b_ + 2048); TRRD(l1, b_ + 4096); TRRD(h1, b_ + 6144); TRRD(l2, b_ + 8192); TRRD(h2, b_ + 10240); TRRD(l3, b_ + 12288); TRRD(h3, b_ + 14336); \
        asm volatile("s_waitcnt lgkmcnt(0)" ::: "memory"); SBAR();   \
        o[d0] = __builtin_amdgcn_mfma_f32_32x32x16_bf16(pa0, (bf16x8){l0[0], l0[1], l0[2], l0[3], h0[0], h0[1], h0[2], h0[3]}, o[d0], 0, 0, 0);   \
        o[d0] = __builtin_amdgcn_mfma_f32_32x32x16_bf16(pa1, (bf16x8){l1[0], l1[1], l1[2], l1[3], h1[0], h1[1], h1[2], h1[3]}, o[d0], 0, 0, 0);   \
        o[d0] = __builtin_amdgcn_mfma_f32_32x32x16_bf16(pa2, (bf16x8){l2[0], l2[1], l2[2], l2[3], h2[0], h2[1], h2[2], h2[3]}, o[d0], 0, 0, 0);   \
        o[d0] = __builtin_amdgcn_mfma_f32_32x32x16_bf16(pa3, (bf16x8){l3[0], l3[1], l3[2], l3[3], h3[0], h3[1], h3[2], h3[3]}, o[d0], 0, 0, 0); } while (0)
    PV_D0(0); PV_D0(1); PV_D0(2); PV_D0(3);
#undef PV_D0
#undef TRRD
}
struct BlockRef { const bf16* Q; const bf16* K; const bf16* V; const float* KBp; const bf16* G; bf16* O; int P0; int j0; int hcol; };
struct Seam { bf16x8 qr[8]; bf16x8 st_v0, st_v1, st_k0, st_k1; float st_b; };
#define ROWP(p, k0, rr) ((const char*)(p) + (size_t)((k0) + (rr)) * (LDQ * 2))
#define LD8V(base, off) (*reinterpret_cast<const bf16x8*>((base) + (off)))
#define VMW() asm volatile("s_waitcnt vmcnt(0)" ::: "memory")
#define VMWN(n) asm volatile("s_waitcnt vmcnt(%0)" :: "i"(n) : "memory")
#define SLOAD_H(Kp, Vp, Bp, k0) do { S.st_v0 = LD8V(ROWP(Vp, k0, 0), voff); S.st_v1 = LD8V(ROWP(Vp, k0, 32), voff);              \
                         S.st_k0 = LD8V(ROWP(Kp, k0, 0), voff); S.st_k1 = LD8V(ROWP(Kp, k0, 32), voff); \
                         if (tid < 64) S.st_b = *(const float*)((const char*)((Bp) + (k0)) + (unsigned)(tid * 4)); } while (0)
#define SWRITE_HK(bf) do { *(bf16x8*)(K_lds + (bf) * SHM_K + kws) = S.st_k0; *(bf16x8*)(K_lds + (bf) * SHM_K + kws + 32 * 256) = S.st_k1; if (tid < 64) kbl[(bf) * 64 + tid] = S.st_b; } while (0)
#define SWRITE_HV(bf) do { *(bf16x8*)(V_lds + (bf) * SHM_V + vst0) = S.st_v0; *(bf16x8*)(V_lds + (bf) * SHM_V + vst1) = S.st_v1; } while (0)
#define SWRITE_H(bf) do { SWRITE_HV(bf); SWRITE_HK(bf); } while (0)
__device__ __forceinline__ void fox_prime(const BlockRef& cur, char* lds, Seam& S) {
    const int tid = opaque_tid(), wid = __builtin_amdgcn_readfirstlane(tid >> 6), lane = tid & 63, r32 = lane & 31, hi = lane >> 5;
    const int sr = tid >> 4, sc = (tid & 15) * 8, kws = KSWZ(sr, sc * 2); char* K_lds = lds + 2 * SHM_V; float* kbl = (float*)(lds + OFF_KB);
    const unsigned voff = (unsigned)(sr * LDQ + sc) * 2u, qoff = (unsigned)(r32 * LDQ + hi * 8) * 2u;
    { const char* qb_ = (const char*)(cur.Q + (size_t)(wid * QBLK) * LDQ);
#pragma unroll
      for (int d0 = 0; d0 < 8; ++d0) S.qr[d0] = LD8V(qb_ + d0 * 32, qoff); }
    SLOAD_H(cur.K, cur.V, cur.KBp, cur.j0 * KVBLK); VMW(); SWRITE_HK(0);
    __syncthreads();
}
__device__ __forceinline__ void fox_block(const BlockRef& cur, const BlockRef& nxt, char* lds, Seam& S, float Bq) {
    const int tid = opaque_tid(), wid = __builtin_amdgcn_readfirstlane(tid >> 6), lane = tid & 63, r32 = lane & 31, hi = lane >> 5;
    const int j_lo = cur.j0, NT = (cur.P0 + QB - 1) / KVBLK + 1 - j_lo;
    const int qlo = cur.P0 + wid * QBLK, qm = qlo + r32 - 4 * hi;
    char* V_lds = lds; char* K_lds = lds + 2 * SHM_V; float* kbl = (float*)(lds + OFF_KB);
    float* ws = (float*)(lds + OFF_WS) + wid * 64; float* li_l = ws;
    float l_reg = 0; f32x16 o[4] = {};
    const float mt = cur.KBp[qlo + r32] + Bq;
    const int sr = tid >> 4, sc = (tid & 15) * 8, vst0 = v_st(sr, sc), vst1 = v_st(32 + sr, sc), kws = KSWZ(sr, sc * 2);
    const unsigned voff = (unsigned)(sr * LDQ + sc) * 2u;
    const int vb0 = (int)(uintptr_t)V_lds + v_rd_base(lane);
    const bf16* Kh = cur.K; const bf16* Vh = cur.V; const float* Bh = cur.KBp;
#define KBASE(t) ((j_lo + (t)) * KVBLK)
#define MASKT(P0_, P1_, t) do { const int kb_ = KBASE(t); if (kb_ + KVBLK - 1 > qlo) mask_tile(P0_, P1_, qm - kb_); } while (0)
    constexpr int NQL = 8;
#define SEAM_K0() do { VMWN(NQL); SWRITE_HK(0); SBAR(); } while (0)
    f32x16 pA0, pA1, pB0, pB1; bf16x8 pa0, pa1, pa2, pa3;
    SWRITE_HV(0); SBAR();
    if (NT > 1) { SLOAD_H(Kh, Vh, Bh, KBASE(1)); }
    SBAR(); qkt<0>(pA0, pA1, K_lds, kbl, r32, hi, S.qr);
    MASKT(pA0, pA1, 0); partialSM(pA0, pA1, mt);
    if (NT > 1) { VMW(); SWRITE_H(1); }
    __syncthreads();
#define HALF_STEP(PX0, PX1, PY0, PY1, t, KB, VB, SB) do {                                                      \
        if ((t) + 1 < NT) { SLOAD_H(Kh, Vh, Bh, KBASE((t) + 1)); }        \
        SBAR(); qkt<KB>(PX0, PX1, K_lds, kbl, r32, hi, S.qr);                                             \
        finishSM(PY0, PY1, l_reg, pa0, pa1, pa2, pa3); SBAR();                                                           \
        pv_tile<VB>(o, vb0, pa0, pa1, pa2, pa3); MASKT(PX0, PX1, (t)); partialSM(PX0, PX1, mt);                                        \
        __syncthreads();                                                                                                      \
        if ((t) + 1 < NT) { VMW(); SWRITE_H(SB); }                                                                          \
        __syncthreads(); } while (0)
    for (int t = 1; t + 1 < NT; t += 2) {
        HALF_STEP(pB0, pB1, pA0, pA1, t, 1, 0, 0);
        HALF_STEP(pA0, pA1, pB0, pB1, t + 1, 0, 1, 1);
    }
    const bool even = (NT & 1) == 0;
    if (even) { SBAR(); qkt<1>(pB0, pB1, K_lds, kbl, r32, hi, S.qr); SBAR(); }
    SLOAD_H(nxt.K, nxt.V, nxt.KBp, nxt.j0 * KVBLK); SBAR();
    { const int l2 = opaque_tid() & 63; const unsigned qoff = (unsigned)((l2 & 31) * LDQ + (l2 >> 5) * 8) * 2u;
      const char* qb_ = (const char*)(nxt.Q + (size_t)(wid * QBLK) * LDQ);
#pragma unroll
      for (int d0 = 0; d0 < 8; ++d0) S.qr[d0] = LD8V(qb_ + d0 * 32, qoff); }
    SBAR();
    finishSM(pA0, pA1, l_reg, pa0, pa1, pa2, pa3); SBAR();
    pv_tile<0>(o, vb0, pa0, pa1, pa2, pa3);
    if (even) { MASKT(pB0, pB1, NT - 1); partialSM(pB0, pB1, mt); __syncthreads();
        finishSM(pB0, pB1, l_reg, pa0, pa1, pa2, pa3); SBAR(); pv_tile<1>(o, vb0, pa0, pa1, pa2, pa3); }
    SBAR(); SEAM_K0();
    if (hi == 0) li_l[r32] = l_reg; asm volatile("s_waitcnt lgkmcnt(0)" ::: "memory");
    { const int l3 = opaque_tid() & 63, er = l3 >> 4, ec = l3 & 15;
      const bf16* Gp = cur.G + (size_t)(wid * QBLK + er) * LDQ + 8 * ec;
      bf16* Op = cur.O; const size_t orow0 = (size_t)(cur.P0 + wid * QBLK + er); const int ocol = cur.hcol + 8 * ec;
      v4u gt[4][2];
#pragma unroll
      for (int ps = 0; ps < 4; ++ps)
#pragma unroll
          for (int k = 0; k < 2; ++k) gt[ps][k] = *(const v4u*)(Gp + (size_t)(8 * ps + 4 * k) * LDQ);
      float* ost = (float*)(lds + OFF_OST) + wid * (8 * 132);
      const int wofs = (4 * (l3 >> 5)) * 132 + (l3 & 31);
#pragma unroll
      for (int ps = 0; ps < 4; ++ps) {
#pragma unroll
          for (int rr = 0; rr < 4; ++rr) { const int r = 4 * ps + rr; const float rl = __builtin_amdgcn_rcpf(li_l[crow(r, hi)]);
#pragma unroll
              for (int d0 = 0; d0 < 4; ++d0) ost[wofs + rr * 132 + d0 * 32] = o[d0][r] * rl; }
          asm volatile("s_waitcnt lgkmcnt(0)" ::: "memory");
#pragma unroll
          for (int k = 0; k < 2; ++k) { const float* sp = ost + (er + 4 * k) * 132 + 8 * ec; const f32x4 x0 = *(const f32x4*)sp, x1 = *(const f32x4*)(sp + 4); const v4u g = gt[ps][k];
              v4u w; w.x = cvtpk(x0[0] * bflo(g.x), x0[1] * bfhi(g.x)); w.y = cvtpk(x0[2] * bflo(g.y), x0[3] * bfhi(g.y)); w.z = cvtpk(x1[0] * bflo(g.z), x1[1] * bfhi(g.z)); w.w = cvtpk(x1[2] * bflo(g.w), x1[3] * bfhi(g.w));
              *(v4u*)(Op + tiled_off(orow0 + 8 * ps + 4 * k, ocol, LDO >> 6)) = w; }
          asm volatile("s_waitcnt lgkmcnt(0)" ::: "memory"); } }
    __syncthreads();
#undef KBASE
#undef MASKT
#undef SEAM_K0
#undef HALF_STEP
}
__device__ __forceinline__ void fox_rewrite_k0(char* lds, const Seam& S) {
    const int tid = opaque_tid(); const int sr = tid >> 4, sc = (tid & 15) * 8, kws = KSWZ(sr, sc * 2); char* K_lds = lds + 2 * SHM_V; float* kbl = (float*)(lds + OFF_KB);
    SWRITE_HK(0); __syncthreads();
}
#undef ROWP
#undef LD8V
#undef VMWN
#undef SLOAD_H
#undef SWRITE_HK
#undef SWRITE_HV
#undef SWRITE_H
__device__ __forceinline__ BlockRef mk_ref(const bf16* PROJ, const float* KBg, bf16* MO, const int* JL, int id) {
    const int bh = id & 31, qb = 63 - (id >> 5);
    BlockRef r; r.Q = PROJ + ((size_t)bh * SEQ + qb * QB) * D; r.K = PROJ + ((size_t)(32 + bh) * SEQ) * D; r.V = PROJ + ((size_t)(64 + bh) * SEQ) * D; r.KBp = KBg + (size_t)bh * SEQ;
    r.G = PROJ + ((size_t)(96 + bh) * SEQ + qb * QB) * D; r.O = MO; r.hcol = bh * D; r.P0 = qb * QB; r.j0 = JL[id]; return r;
}
__device__ __forceinline__ void attn_phase(char* lds, const bf16* PROJ, const float* KBg, bf16* MO, const int* JL, unsigned* qctr, const float* qg, const float* kg, unsigned char* ws, const ConvArgs& ca, int qbase, int qend, int vcu, int G) {
    constexpr int total = 32 * 64;
    const int tid = opaque_tid();
    float Bq;
    { const int l_ = tid & 63; float gq = fmaxf(fabsf(qg[l_]), fabsf(qg[l_ + 64])), gk = fmaxf(fabsf(kg[l_]), fabsf(kg[l_ + 64]));
#pragma unroll
      for (int o_ = 1; o_ < 64; o_ <<= 1) { gq = fmaxf(gq, shx(gq, o_, l_)); gk = fmaxf(gk, shx(gk, o_, l_)); }
      Bq = 128.f * gq * gk * QSCALE * 1.02f; }
    volatile int* slot = (volatile int*)(lds + LDS_BYTES);
    if (tid == 0) slot[0] = (int)__hip_atomic_fetch_add((GAS unsigned*)qctr, 1u, __ATOMIC_RELAXED, __HIP_MEMORY_SCOPE_AGENT);
    __syncthreads();
    int id = __builtin_amdgcn_readfirstlane(slot[0]);
    const int nchunks = att_chunks(qbase, qend);
    int cc = 0;
    if (id < total) {
        BlockRef cur = mk_ref(PROJ, KBg, MO, JL, id);
        Seam S;
        fox_prime(cur, lds, S);
        for (;;) {
            if (tid == 0) slot[1] = (int)__hip_atomic_fetch_add((GAS unsigned*)qctr, 1u, __ATOMIC_RELAXED, __HIP_MEMORY_SCOPE_AGENT);
            __syncthreads();
            const int idn = __builtin_amdgcn_readfirstlane(slot[1]);
            const bool last = idn >= total;
            const BlockRef nxt = last ? cur : mk_ref(PROJ, KBg, MO, JL, idn);
            fox_block(cur, nxt, lds, S, Bq);
            if (last) break;
            cur = nxt;
            if (cc < nchunks) { __syncthreads(); conv_chunk((LAS unsigned char*)lds, ws, ca, qbase, cc, vcu, G); ++cc; if (nchunks > 7 && cc < nchunks) { conv_chunk((LAS unsigned char*)lds, ws, ca, qbase, cc, vcu, G); ++cc; } fox_rewrite_k0(lds, S); }
        }
    }
    __syncthreads();
#pragma unroll 1
    for (; cc < nchunks; ++cc) conv_chunk((LAS unsigned char*)lds, ws, ca, qbase, cc, vcu, G);
}
#undef VMW
}
namespace hg {
constexpr int CH = 64, NCH = SEQ / CH;
constexpr size_t AOFF = (size_t)32 * SEQ * DH / 2;
constexpr int PK = 144;
constexpr int PQ = 272;
__device__ __forceinline__ f32x4 mma(bf16x8 bfrag, bf16x8 afrag, f32x4 acc) { return __builtin_amdgcn_mfma_f32_16x16x32_bf16(bfrag, afrag, acc, 0, 0, 0); }
__device__ __forceinline__ bf16x8 ldsfrag(const LAS unsigned char* base, int row, int pitch, int kbyte) { return *(const LAS bf16x8*)(base + row * pitch + kbyte); }

__device__ __forceinline__ int hg_units(int vcu, int G) { return G == 256 ? 32 : (vcu < NCH * NH ? (NCH * NH - 1 - vcu) / G + 1 : 0); }
__device__ __forceinline__ int hg_unit(int vcu, int G, int i) { return G == 256 ? (((32 * (vcu >> 5) + 31 - i) << 5) | (vcu & 31)) : NCH * NH - 1 - (vcu + i * G); }
typedef float f32x2 __attribute__((ext_vector_type(2)));
typedef _Float16 f16x2 __attribute__((ext_vector_type(2)));
__device__ __forceinline__ float ex2(float x) { return __builtin_amdgcn_exp2f(x); }
__device__ __forceinline__ unsigned ldg2(const _Float16* p) { return *(const unsigned*)p; }
__device__ __forceinline__ f32x2 h2f(unsigned w) { const f16x2 h = __builtin_bit_cast(f16x2, w); return (f32x2){(float)h[0], (float)h[1]}; }
__device__ __forceinline__ void b1_phase(LAS unsigned char* lds, const bf16* PROJ, const _Float16* Gg, bf16* UT, float* DEC, int vcu, int G) {
    const int tid = opaque_tid(), lane = tid & 63, wave = __builtin_amdgcn_readfirstlane(tid >> 6), cp = tid & 63, seg = wave, r = lane & 15, q = lane >> 4;
    LAS unsigned char* KT = lds;
    LAS unsigned char* VT = lds + 128 * PK;
    LAS float* segtot = (LAS float*)(lds + 2 * 128 * PK);
    unsigned nb[8], nk[8], nv[8];
#define B1_LOAD(u_) do { const int c_ = (u_) >> 5, h_ = (u_) & 31; const int rw_ = c_ * CH + 8 * seg; \
        _Pragma("unroll") for (int j = 0; j < 8; ++j) { nb[j] = ldg2(Gg + ((size_t)h_ * SEQ + rw_ + j) * DH + 2 * cp); const unsigned* p_ = (const unsigned*)(PROJ + (((size_t)32 + h_) * SEQ + rw_ + j) * DH + 2 * cp); nk[j] = p_[0]; nv[j] = p_[AOFF]; } } while (0)
    const int nun = hg_units(vcu, G);
    if (nun > 0) B1_LOAD(hg_unit(vcu, G, 0));
    for (int iu = 0; iu < nun; ++iu) {
        const int u = hg_unit(vcu, G, iu);
        f32x2 b[8]; unsigned kk[8], vv[8];
#pragma unroll
        for (int j = 0; j < 8; ++j) { b[j] = h2f(nb[j]); kk[j] = nk[j]; vv[j] = nv[j]; }
#pragma unroll
        for (int j = 1; j < 8; ++j) b[j] += b[j - 1];
        *(LAS f32x2*)(segtot + seg * 128 + 2 * cp) = b[7];
        __syncthreads();
        f32x2 off = {0.f, 0.f}, total = {0.f, 0.f};
#pragma unroll
        for (int s2 = 0; s2 < 8; ++s2) { const f32x2 t = *(const LAS f32x2*)(segtot + s2 * 128 + 2 * cp); total += t; if (s2 < seg) off += t; }
        const f32x2 rem = total - off;
        unsigned k0w[4], k1w[4], v0w[4], v1w[4];
#pragma unroll
        for (int i = 0; i < 4; ++i) { const int ja = 2 * i, jb = 2 * i + 1;
            k0w[i] = cvtpk(bflo(kk[ja]) * ex2(rem.x - b[ja].x), bflo(kk[jb]) * ex2(rem.x - b[jb].x)); k1w[i] = cvtpk(bfhi(kk[ja]) * ex2(rem.y - b[ja].y), bfhi(kk[jb]) * ex2(rem.y - b[jb].y));
            v0w[i] = (vv[ja] & 0xffffu) | (vv[jb] << 16); v1w[i] = (vv[ja] >> 16) | (vv[jb] & 0xffff0000u); }
        *(LAS v4u*)(KT + (2 * cp) * PK + 16 * seg) = (v4u){k0w[0], k0w[1], k0w[2], k0w[3]}; *(LAS v4u*)(KT + (2 * cp + 1) * PK + 16 * seg) = (v4u){k1w[0], k1w[1], k1w[2], k1w[3]};
        *(LAS v4u*)(VT + (2 * cp) * PK + 16 * seg) = (v4u){v0w[0], v0w[1], v0w[2], v0w[3]}; *(LAS v4u*)(VT + (2 * cp + 1) * PK + 16 * seg) = (v4u){v1w[0], v1w[1], v1w[2], v1w[3]};
        if (seg == 0) *(f32x2*)(DEC + (size_t)u * 128 + 2 * cp) = (f32x2){ex2(total.x), ex2(total.y)};
        if (iu + 1 < nun) B1_LOAD(hg_unit(vcu, G, iu + 1));
        __syncthreads();
        const bf16x8 a0 = ldsfrag(VT, 16 * wave + r, PK, 16 * q), a1 = ldsfrag(VT, 16 * wave + r, PK, 64 + 16 * q);
        bf16* up = UT + ((size_t)u * 128 + 16 * wave + r) * 128 + 4 * q;
#pragma unroll
        for (int nt = 0; nt < 8; ++nt) { f32x4 acc = {0.f, 0.f, 0.f, 0.f};
            acc = mma(ldsfrag(KT, 16 * nt + r, PK, 16 * q), a0, acc); acc = mma(ldsfrag(KT, 16 * nt + r, PK, 64 + 16 * q), a1, acc);
            v2u w; w.x = cvtpk(acc[0], acc[1]); w.y = cvtpk(acc[2], acc[3]); *(v2u*)(up + 16 * nt) = w; }
    }
#undef B1_LOAD
}
__device__ __forceinline__ void b2_phase(const bf16* UT, const float* DEC, bf16* ST, int vcu, int G) {
    constexpr int BT = 8;
    for (int gid = vcu * 512 + opaque_tid(); gid < NH * 128 * 32; gid += G * 512) {
        const int h = gid >> 12, dv = (gid >> 5) & 127, dk4 = (gid & 31) * 4;
        f32x4 st = {0.f, 0.f, 0.f, 0.f};
        const size_t eo = ((size_t)h * 128 + dv) * 128 + dk4, estep = (size_t)NH * 128 * 128;
        const size_t dofs = (size_t)h * 128 + dk4, dstep = (size_t)NH * 128;
        v2u uwa[BT], uwb[BT]; f32x4 dda[BT], ddb[BT];
#define B2_LOAD(uw_, dd_, c0_) do { _Pragma("unroll") for (int i = 0; i < BT; ++i) { uw_[i] = *(const v2u*)(UT + eo + (size_t)((c0_) + i) * estep); dd_[i] = *(const f32x4*)(DEC + dofs + (size_t)((c0_) + i) * dstep); } } while (0)
#define B2_RUN(uw_, dd_, c0_) do { _Pragma("unroll") for (int i = 0; i < BT; ++i) { const f32x4 uu = {bflo(uw_[i].x), bfhi(uw_[i].x), bflo(uw_[i].y), bfhi(uw_[i].y)}; \
            v2u w; w.x = cvtpk(st.x, st.y); w.y = cvtpk(st.z, st.w); *(v2u*)(ST + eo + (size_t)((c0_) + i) * estep) = w; st = dd_[i] * st + uu; } } while (0)
        B2_LOAD(uwa, dda, 0);
        for (int c = 0; c < NCH; c += 2 * BT) {
            B2_LOAD(uwb, ddb, c + BT);
            B2_RUN(uwa, dda, c);
            if (c + 2 * BT < NCH) B2_LOAD(uwa, dda, c + 2 * BT);
            B2_RUN(uwb, ddb, c + BT);
        }
#undef B2_LOAD
#undef B2_RUN
    }
}
constexpr int B3_QT = 0, B3_QH = B3_QT + 64 * PQ, B3_KH = B3_QH + 64 * PQ  , B3_VT = B3_KH + 160 * PQ, B3_P = B3_VT + 128 * PK, B3_SEG = B3_P + 64 * PK, B3_RS = B3_SEG + 4096, B3_END = B3_RS + 512;
__device__ __forceinline__ int kh_base(int I) { return 16 * (I * (I + 1) / 2); }
__device__ __forceinline__ void b3_phase(LAS unsigned char* lds, const bf16* PROJ, const _Float16* Gg, const bf16* ST, const float* ogain, bf16* MO, int vcu, int G) {
    const int tid = opaque_tid(), lane = tid & 63, wave = __builtin_amdgcn_readfirstlane(tid >> 6), cp = tid & 63, seg = wave, r = lane & 15, q = lane >> 4;
    LAS unsigned char* QT = lds + B3_QT; LAS unsigned char* QH = lds + B3_QH; LAS unsigned char* KH = lds + B3_KH; LAS unsigned char* VT = lds + B3_VT; LAS unsigned char* PP = lds + B3_P;
    LAS float* segtot = (LAS float*)(lds + B3_SEG); LAS float* rs = (LAS float*)(lds + B3_RS);
    unsigned nb[8], nq[8], nk[8], nv[8];
#define B3_LOAD(u_) do { const int c_ = (u_) >> 5, h_ = (u_) & 31; const int rw_ = c_ * CH + 8 * seg; \
        _Pragma("unroll") for (int j = 0; j < 8; ++j) { nb[j] = ldg2(Gg + ((size_t)h_ * SEQ + rw_ + j) * DH + 2 * cp); const unsigned* p_ = (const unsigned*)(PROJ + ((size_t)h_ * SEQ + rw_ + j) * DH + 2 * cp); nq[j] = p_[0]; nk[j] = p_[AOFF]; nv[j] = p_[2 * AOFF]; } } while (0)
    f32x4 og[4];
#pragma unroll
    for (int nt = 0; nt < 4; ++nt) og[nt] = *(const f32x4*)(ogain + 64 * (wave >> 2) + 16 * nt + 4 * q);
    const int nun = hg_units(vcu, G);
    if (nun > 0) B3_LOAD(hg_unit(vcu, G, 0));
    for (int iu = 0; iu < nun; ++iu) {
        const int u = hg_unit(vcu, G, iu);
        const int c = u >> 5, h = u & 31;
        const int mt = wave & 3, nh = wave >> 2;
        const size_t orow = (size_t)(c * CH + 16 * mt + r);
        v2u gtv[4];
#pragma unroll
        for (int nt = 0; nt < 4; ++nt) gtv[nt] = *(const v2u*)(PROJ + (((size_t)96 + h) * SEQ + orow) * DH + 64 * nh + 16 * nt + 4 * q);
        f32x2 b[8]; unsigned qq[8], kk[8], vv[8];
#pragma unroll
        for (int j = 0; j < 8; ++j) { b[j] = h2f(nb[j]); qq[j] = nq[j]; kk[j] = nk[j]; vv[j] = nv[j]; }
#pragma unroll
        for (int j = 1; j < 8; ++j) b[j] += b[j - 1];
        *(LAS f32x2*)(segtot + seg * 128 + 2 * cp) = b[7];
        __syncthreads();
        f32x2 st[8];
#pragma unroll
        for (int s2 = 0; s2 < 8; ++s2) st[s2] = *(const LAS f32x2*)(segtot + s2 * 128 + 2 * cp);
        const int I0 = seg >> 1;
        f32x2 off = {0.f, 0.f};
#pragma unroll
        for (int s2 = 0; s2 < 8; ++s2) if (s2 < seg) off += st[s2];
        f32x2 lsb[8];
        { f32x2 hb = {0.f, 0.f};
#pragma unroll
          for (int s2 = 0; s2 < 8; s2 += 2) if (s2 + 1 == seg) hb = st[s2];
#pragma unroll
          for (int j = 0; j < 8; ++j) lsb[j] = hb + b[j]; }
        f32x2 hbq = off;
#pragma unroll
        for (int s2 = 0; s2 < 8; s2 += 2) if (s2 + 1 == seg) hbq -= st[s2];
        const float eq0 = ex2(hbq.x), eq1 = ex2(hbq.y);
        f32x2 em[8];
#pragma unroll
        for (int j = 0; j < 8; ++j) { const float q0 = bflo(qq[j]), q1 = bfhi(qq[j]); const int row = 8 * seg + j;
            const float h0 = q0 * ex2(lsb[j].x), h1 = q1 * ex2(lsb[j].y); em[j] = (f32x2){ex2(-lsb[j].x), ex2(-lsb[j].y)};
            *(LAS unsigned*)(QT + row * PQ + 4 * cp) = cvtpk(h0 * eq0, h1 * eq1);
            *(LAS unsigned*)(QH + row * PQ + 4 * cp) = cvtpk(h0, h1); }
        { f32x2 d = {0.f, 0.f};
#pragma unroll
          for (int I = 0; I < 4; ++I) { if (I >= I0) {
                const float ed0 = ex2(d.x), ed1 = ex2(d.y);
#pragma unroll
                for (int j = 0; j < 8; ++j) *(LAS unsigned*)(KH + (kh_base(I) + 8 * seg + j) * PQ + 4 * cp) = cvtpk(bflo(kk[j]) * em[j].x * ed0, bfhi(kk[j]) * em[j].y * ed1);
                d += st[2 * I] + st[2 * I + 1]; } } }
        { unsigned v0w[4], v1w[4];
#pragma unroll
          for (int i = 0; i < 4; ++i) { const int ja = 2 * i, jb = 2 * i + 1; v0w[i] = (vv[ja] & 0xffffu) | (vv[jb] << 16); v1w[i] = (vv[ja] >> 16) | (vv[jb] & 0xffff0000u); }
          *(LAS v4u*)(VT + (2 * cp) * PK + 16 * seg) = (v4u){v0w[0], v0w[1], v0w[2], v0w[3]}; *(LAS v4u*)(VT + (2 * cp + 1) * PK + 16 * seg) = (v4u){v1w[0], v1w[1], v1w[2], v1w[3]}; }
        bf16x8 sf[4][4];
        { const bf16* stp = ST + ((size_t)u * 128 + 64 * nh + r) * 128 + 8 * q;
#pragma unroll
          for (int nt = 0; nt < 4; ++nt)
#pragma unroll
              for (int ks = 0; ks < 4; ++ks) sf[nt][ks] = *(const bf16x8*)(stp + (size_t)(16 * nt) * 128 + 32 * ks); }
        if (iu + 1 < nun) B3_LOAD(hg_unit(vcu, G, iu + 1));
        __syncthreads();
#pragma unroll
        for (int tt = 0; tt < 2; ++tt) { const int tile = wave * 2 + tt, I = tile >> 2, J = tile & 3;
            f32x4 acc = {0.f, 0.f, 0.f, 0.f};
            if (J <= I) {
#pragma unroll
                for (int ks = 0; ks < 4; ++ks) acc = mma(ldsfrag(KH, kh_base(I) + 16 * J + r, PQ, 64 * ks + 16 * q), ldsfrag(QH, 16 * I + r, PQ, 64 * ks + 16 * q), acc);
                if (J == I) {
#pragma unroll
                    for (int i = 0; i < 4; ++i) if (4 * q + i > r) acc[i] = 0.f; }
            }
            v2u w; w.x = cvtpk(acc[0], acc[1]); w.y = cvtpk(acc[2], acc[3]);
            *(LAS v2u*)(PP + (16 * I + r) * PK + (16 * J + 4 * q) * 2) = w; }
        __syncthreads();
        f32x4 acc[4];
        const bf16x8 pa0 = ldsfrag(PP, 16 * mt + r, PK, 16 * q), pa1 = ldsfrag(PP, 16 * mt + r, PK, 64 + 16 * q);
        bf16x8 qa[4];
#pragma unroll
        for (int ks = 0; ks < 4; ++ks) qa[ks] = ldsfrag(QT, 16 * mt + r, PQ, 64 * ks + 16 * q);
#pragma unroll
        for (int nt = 0; nt < 4; ++nt) { f32x4 a = {0.f, 0.f, 0.f, 0.f};
            a = mma(ldsfrag(VT, 64 * nh + 16 * nt + r, PK, 16 * q), pa0, a); a = mma(ldsfrag(VT, 64 * nh + 16 * nt + r, PK, 64 + 16 * q), pa1, a);
#pragma unroll
            for (int ks = 0; ks < 4; ++ks) a = mma(sf[nt][ks], qa[ks], a);
            acc[nt] = a; }
        float ss = 0.f;
#pragma unroll
        for (int nt = 0; nt < 4; ++nt) ss += (acc[nt][0] * acc[nt][0] + acc[nt][1] * acc[nt][1]) + (acc[nt][2] * acc[nt][2] + acc[nt][3] * acc[nt][3]);
        ss += shx(ss, 16, lane); ss += shx(ss, 32, lane);
        if (q == 0) rs[nh * 64 + 16 * mt + r] = ss;
        __syncthreads();
        const float rstd = rsqrtf((rs[16 * mt + r] + rs[64 + 16 * mt + r]) * (1.f / 128.f) + NORM_EPS);
#pragma unroll
        for (int nt = 0; nt < 4; ++nt) { const int dv = 64 * nh + 16 * nt + 4 * q;
            const f32x4 g = og[nt]; const v2u gt = gtv[nt];
            v2u w; w.x = cvtpk(acc[nt][0] * rstd * g.x * bflo(gt.x), acc[nt][1] * rstd * g.y * bfhi(gt.x)); w.y = cvtpk(acc[nt][2] * rstd * g.z * bflo(gt.y), acc[nt][3] * rstd * g.w * bfhi(gt.y));
            *(v2u*)(MO + tiled_off(orow, h * DH + dv, DM >> 6)) = w; }
    }
#undef B3_LOAD
}
}
constexpr int RING_BYTES = 131072;
constexpr int MISC_OFF = RING_BYTES + 320;
constexpr int LDS_BYTES = 147456;
#ifndef DOWN_WGM
#define DOWN_WGM 2
#endif
constexpr int CW_BAR = 4096;
constexpr int CW_Q = 8192;
static_assert(fa::LDS_END <= RING_BYTES && fa::OFF_OST % 16 == 0 && hg::B3_END <= RING_BYTES, "phase scratch fits the ring region");
static_assert(WS_END <= (size_t)4096 * MiB, "workspace map");

constexpr int PH_FINAL = 49, PH_END = 50;
struct Args { const float* in[15]; float* out; unsigned char* ws; int ph_lo, ph_hi; };
static_assert(sizeof(Args) == 15 * 8 + 8 + 8 + 4 + 4, "Args has no padding bytes");

__global__ void __launch_bounds__(NWAVES * 64, 2) trunk_fwd(Args args) {
    extern __shared__ __attribute__((aligned(16))) unsigned char lds_raw[];
    LAS unsigned char* lds = (LAS unsigned char*)lds_raw;
    volatile LAS unsigned* MISC = (volatile LAS unsigned*)(lds + MISC_OFF);
    const int tid = threadIdx.x;
    const int G = gridDim.x, bx = blockIdx.x;
    const int vcu = (G % 8 == 0) ? (bx % 8) * (G / 8) + bx / 8 : bx;
    for (int u = tid; u < (LDS_BYTES - RING_BYTES) / 4; u += NWAVES * 64) ((LAS unsigned*)(lds + RING_BYTES))[u] = 0u;
    __syncthreads();
    if ((tid & 63) == 0) ((volatile LAS int*)(lds + WAVE_TAB_OFF))[hw_wave_slot()] = tid >> 6;
    __syncthreads();
    const int lo = args.ph_lo, hi = args.ph_hi;
#if MK_PER_PHASE
#define GRID_BAR(p) do { } while (0)
#else
    XcdBarrier bar = xcd_barrier_post((unsigned*)(args.ws + WS_CTL) + CW_BAR, MISC + 8);
    if (tid == 0) ((GAS unsigned*)((unsigned*)(args.ws + WS_CTL) + CW_BAR))[XB_XID + bx] = bar.x + 1u;
#ifndef LOCAL_SEAMS
#define LOCAL_SEAMS 1
#endif
#define LOCAL_BAR(p) do { if ((p) + 1 < hi) { XcdBarrier b_ = bar; asm volatile("" : "+s"(b_.bar), "+s"(b_.x)); if (LOCAL_SEAMS && MISC[10]) xcd_local_barrier(b_); else xcd_barrier(b_); } } while (0)
#define GRID_BAR(p) do { if ((p) + 1 < hi) { XcdBarrier b_ = bar; asm volatile("" : "+s"(b_.bar), "+s"(b_.x)); xcd_barrier(b_); } } while (0)
#endif
#ifndef ONLY_SITE
#define ONLY_SITE -1
#endif
#define EN(s) (ONLY_SITE == -1 || ONLY_SITE == (s))
#ifndef DUP_SITE
#define DUP_SITE -1
#endif
#define DUP(s) (DUP_SITE == (s))
#define IN(k) (lo <= (k) && (k) < hi)
#ifndef STAGGER_US
#define STAGGER_US 0
#endif
#define STAGGER() do { if (STAGGER_US > 0) { const unsigned long long t0_ = __builtin_amdgcn_s_memrealtime(), dl_ = (unsigned long long)(bx & 7) * (STAGGER_US * 100ull); while (__builtin_amdgcn_s_memrealtime() - t0_ < dl_) __builtin_amdgcn_s_sleep(4); } } while (0)
#define OPQ(v) ({ int o_ = (v); asm volatile("" : "+s"(o_)); o_; })
#define WSP() ({ GAS unsigned char* w_ = (GAS unsigned char*)args.ws; asm volatile("" : "+s"(w_)); (unsigned char*)w_; })
#define INP(i) ({ const GAS float* p_ = (const GAS float*)args.in[i]; asm volatile("" : "+s"(p_)); (const float*)p_; })
    LAS float* RTAB = (LAS float*)(lds + RING_BYTES + 1024);
#define P_H ((float*)(WSP() + WS_H))
#define P_XN ((bf16*)(WSP() + WS_XN))
#define P_MO ((bf16*)(WSP() + WS_MO))
#define P_PROJ ((bf16*)(WSP() + WS_PROJ))
#define P_G ((_Float16*)(WSP() + WS_G))
#define P_UT ((bf16*)(WSP() + WS_UT))
#define P_ST ((bf16*)(WSP() + WS_ST))
#define P_LOGF ((float*)(WSP() + WS_LOGF))
#define P_KB ((float*)(WSP() + WS_KB))
#define P_DEC ((float*)(WSP() + WS_DEC))
#define P_LB ((const float*)(WSP() + WS_LB))
#define P_JL ((int*)(WSP() + WS_LB + 512 * 1024))
#define P_CS ((float*)(WSP() + WS_LB + 768 * 1024))
#define P_PART ((float*)(WSP() + WS_PART))

    if (EN(0) && IN(0)) {
        ConvArgs ca{INP(1), INP(2), INP(6), INP(7), INP(12), INP(13)};
        prologue_phase(lds, WSP(), ca, INP(9), OPQ(vcu), OPQ(G));
        GRID_BAR(0);
        if (LOCAL_SEAMS && 1 < hi) { const int ok_ = xcd_groups_local((unsigned*)(WSP() + WS_CTL) + CW_BAR); if (tid == 0) MISC[10] = (unsigned)ok_; __syncthreads(); }
    }
#ifndef FZ_PHASE
#define FZ_PHASE 1
#endif
#ifndef ATT_HOST
#define ATT_HOST 1
#endif
#define HOSTED(m) (ATT_HOST && (ATT_ALL || (((m) - 1) & 7) < 4))
#define CONV_PRE(q) do { if ((q) + 1 < 4 * DEPTH && !HOSTED((q) + 1) && (bx & 3)) { ConvArgs ca_{INP(1), INP(2), INP(6), INP(7), INP(12), INP(13)}; conv_weights(lds, WSP(), ca_, OPQ((q) + 1), OPQ(vcu), OPQ(G), 1, OPQ(bx & 3)); } } while (0)
#define CONV_POST(q) do { if ((q) + 1 < 4 * DEPTH && !HOSTED((q) + 1) && (bx & 3) != 3) { ConvArgs ca_{INP(1), INP(2), INP(6), INP(7), INP(12), INP(13)}; conv_weights(lds, WSP(), ca_, OPQ((q) + 1), OPQ(vcu), OPQ(G), 2, OPQ(bx & 3)); } } while (0)
    for (int L = 0; L < DEPTH; ++L) {
        const int pb = 1 + 12 * L, j = L >> 1; const bool fox = (L & 1) == 0;
        if (EN(1) && L == 0 && IN(pb + 0)) { rms0_phase(INP(0), INP(10), P_XN, P_PART, OPQ(vcu), OPQ(G)); LOCAL_BAR(pb + 0); }
        if (fox) {
            if (EN(2) && IN(pb + 1)) {
                unsigned char* w = WSP();
                pg8::Gemm g{(const bf16*)(w + WS_XN), (const bf16*)(w + WS_WFIN) + (size_t)j * FOX_INP * DM, SEQ, FZ_PHASE ? 4 * DM : FOX_INP, DM}; pg8::StaticOrder S; S.init(SEQ, FZ_PHASE ? 4 * DM : FOX_INP, OPQ(G), OPQ(bx));
                pg8::Unit u0; S.next(0, u0); rstd_table(RTAB, (const float*)(w + WS_PART), u0.pm);
                pg8::EpiFox E{(bf16*)(w + WS_PROJ), 16384, (float*)(w + WS_LOGF), INP(5) + j * NH, (float*)(w + WS_LB + 768 * 1024), pg8::RowScale{RTAB, u0.pm, (const float*)(w + WS_PART)}, INP(3) + j * DH, INP(4) + j * DH, (LAS float*)(lds + RING_BYTES + 4096), QSCALE};
                CONV_PRE(4 * L); pg8::gemm_phase<pg8::EpiFox, pg8::StaticOrder, true, true>(lds, g, S, E); CONV_POST(4 * L);
                if (!FZ_PHASE) GRID_BAR(pb + 1);
            }
            if (FZ_PHASE && EN(15) && IN(pb + 1)) { unsigned char* w = WSP(); __syncthreads();
                int fzb = vcu; if (G == 256) { pg8::StaticOrder S; S.init(SEQ, 4 * DM, OPQ(G), OPQ(bx)); pg8::Unit u0; S.next(0, u0); fzb = u0.pm * 4 + ((bx >> 3) >> 3); }
                fz_phase(lds, (const bf16*)(w + WS_XN), (const bf16*)(w + WS_WFIN) + (size_t)OPQ(j) * FOX_INP * DM, (const float*)(w + WS_PART), INP(5) + OPQ(j) * NH, (float*)(w + WS_LOGF), (float*)(w + WS_LB + 768 * 1024), OPQ(fzb), OPQ(G));
                GRID_BAR(pb + 1); }
            if (EN(3) && IN(pb + 2)) { fox_thin_phase(lds, P_LOGF, P_CS, P_KB, OPQ(vcu), OPQ(G)); GRID_BAR(pb + 2); }
            if (EN(14) && IN(pb + 3)) { jl_phase(lds, P_KB, INP(3) + j * DH, INP(4) + j * DH, P_JL, OPQ(vcu), OPQ(G)); GRID_BAR(pb + 3); }
            if (EN(4) && IN(pb + 4)) { unsigned char* w = WSP(); ConvArgs ca_{INP(1), INP(2), INP(6), INP(7), INP(12), INP(13)}; fa::attn_phase((char*)lds_raw, (const bf16*)(w + WS_PROJ), (const float*)(w + WS_KB), (bf16*)(w + WS_MO), (const int*)(w + WS_LB + 512 * 1024), (unsigned*)(w + WS_CTL) + CW_Q + 64 * j, INP(3) + j * DH, INP(4) + j * DH, w, ca_, OPQ(4 * L + 1), OPQ(ATT_HOST ? (ATT_ALL ? (4 * L + 9 < 4 * DEPTH ? 4 * L + 9 : 4 * DEPTH) : 4 * L + 5) : 4 * L + 1), OPQ(vcu), OPQ(G)); GRID_BAR(pb + 4);
                if (DUP(4)) { fa::attn_phase((char*)lds_raw, (const bf16*)(w + WS_PROJ), (const float*)(w + WS_KB), (bf16*)(w + WS_MO), (const int*)(w + WS_LB + 512 * 1024), (unsigned*)(w + WS_CTL) + CW_Q + 64 * (j + 2), INP(3) + j * DH, INP(4) + j * DH, w, ca_, OPQ(4 * L + 1), OPQ(4 * L + 1), OPQ(vcu), OPQ(G)); GRID_BAR(pb + 4); } }
        } else {
            if (EN(5) && IN(pb + 1)) {
                unsigned char* w = WSP();
                pg8::Gemm g{(const bf16*)(w + WS_XN), (const bf16*)(w + WS_WHIN) + (size_t)j * HG_IN * DM, SEQ, HG_IN, DM}; pg8::StaticOrder S; S.init(SEQ, HG_IN, OPQ(G), OPQ(bx));
                pg8::Unit u0; S.next(0, u0); rstd_table(RTAB, (const float*)(w + WS_PART), u0.pm);
                pg8::EpiHgrn E{(bf16*)(w + WS_PROJ), 16384, (_Float16*)(w + WS_G), (const float*)(w + WS_LB) + (size_t)L * DM, pg8::RowScale{RTAB, u0.pm, (const float*)(w + WS_PART)}};
                CONV_PRE(4 * L); pg8::gemm_phase<pg8::EpiHgrn, pg8::StaticOrder, true, true>(lds, g, S, E); CONV_POST(4 * L);
                LOCAL_BAR(pb + 1);
            }
            if (EN(6) && IN(pb + 2)) { hg::b1_phase(lds, P_PROJ, P_G, P_UT, P_DEC, OPQ(vcu), OPQ(G)); GRID_BAR(pb + 2); }
            if (EN(7) && IN(pb + 3)) { hg::b2_phase(P_UT, P_DEC, P_ST, OPQ(vcu), OPQ(G)); GRID_BAR(pb + 3); }
            if (EN(8) && IN(pb + 4)) { hg::b3_phase(lds, P_PROJ, P_G, P_ST, INP(8) + j * DH, P_MO, OPQ(vcu), OPQ(G)); LOCAL_BAR(pb + 4); }
            if (DUP(6)) { hg::b1_phase(lds, P_PROJ, P_G, P_UT, P_DEC, OPQ(vcu), OPQ(G)); GRID_BAR(pb + 2); hg::b2_phase(P_UT, P_DEC, P_ST, OPQ(vcu), OPQ(G)); GRID_BAR(pb + 3); hg::b3_phase(lds, P_PROJ, P_G, P_ST, INP(8) + j * DH, P_MO, OPQ(vcu), OPQ(G)); GRID_BAR(pb + 4); }
        }
        if (EN(9) && IN(pb + 5)) {
            unsigned char* w = WSP();
            const bf16* W = fox ? (const bf16*)(w + WS_WFOUT) + (size_t)j * DM * DM : (const bf16*)(w + WS_WHOUT) + (size_t)j * DM * DM;
            pg8::Gemm g{(const bf16*)(w + WS_MO), W, SEQ, DM, DM}; pg8::StaticOrder S; S.init(SEQ, DM, OPQ(G), OPQ(bx));
            pg8::EpiRes E{L == 0 ? INP(0) : (const float*)(w + WS_H), (float*)(w + WS_H), DM, (bf16*)(w + WS_XN), INP(11) + (size_t)L * DM, (float*)(w + WS_PART)};
            CONV_PRE(4 * L + 1); pg8::gemm_phase<pg8::EpiRes, pg8::StaticOrder, true, true>(lds, g, S, E); CONV_POST(4 * L + 1);
            LOCAL_BAR(pb + 5);
        }
        if (EN(11) && IN(pb + 7)) {
            unsigned char* w = WSP();
            pg8::Gemm g{(const bf16*)(w + WS_XN), (const bf16*)(w + WS_WUP) + (size_t)L * DFF * DM, SEQ, DFF, DM}; pg8::StaticOrder S; S.init(SEQ, DFF, OPQ(G), OPQ(bx));
            pg8::Unit u0; S.next(0, u0); rstd_table(RTAB, (const float*)(w + WS_PART), u0.pm);
            pg8::EpiSqRelu E{(bf16*)(w + WS_HID), DFF, pg8::RowScale{RTAB, u0.pm, (const float*)(w + WS_PART)}};
            CONV_PRE(4 * L + 2); pg8::gemm_phase<pg8::EpiSqRelu, pg8::StaticOrder, true, true>(lds, g, S, E); CONV_POST(4 * L + 2);
            LOCAL_BAR(pb + 7);
        }
        if (EN(12) && IN(pb + 8)) {
            unsigned char* w = WSP();
            pg8::Gemm g{(const bf16*)(w + WS_HID), (const bf16*)(w + WS_WDN) + (size_t)L * DM * DFF, SEQ, DM, DFF}; pg8::StaticOrder S; S.init(SEQ, DM, OPQ(G), OPQ(bx), DOWN_WGM);
            pg8::EpiRes E{(const float*)(w + WS_H), (float*)(w + WS_H), DM, L + 1 < DEPTH ? (bf16*)(w + WS_XN) : nullptr, INP(10) + (size_t)(L + 1 < DEPTH ? L + 1 : 0) * DM, (float*)(w + WS_PART)};
            CONV_PRE(4 * L + 3); pg8::gemm_phase<pg8::EpiRes, pg8::StaticOrder, true, true>(lds, g, S, E); CONV_POST(4 * L + 3);
            LOCAL_BAR(pb + 8);
        }
    }
    if (EN(13) && IN(PH_FINAL)) rms_phase<true>(P_H, INP(14), args.out, OPQ(vcu), OPQ(G));
#undef IN
#undef GRID_BAR
}

extern "C" void kernel_launch(void* const* d_in, const int* in_sizes, int n_in, void* d_out, int out_size, void* d_ws, size_t ws_size, hipStream_t stream) {
    static int grid = 0;
    if (grid == 0) {
        if (n_in != 15 || in_sizes[0] != SEQ * DM || out_size != SEQ * DM || ws_size < WS_END) { fprintf(stderr, "kernel_launch: unexpected shapes (n_in %d, in0 %d, out %d, ws %zu < %zu)\n", n_in, n_in > 0 ? in_sizes[0] : -1, out_size, ws_size, (size_t)WS_END); grid = -1; return; }
        int dev = 0, cus = 0, per_cu = 0;
        if (hipGetDevice(&dev) != hipSuccess || hipDeviceGetAttribute(&cus, hipDeviceAttributeMultiprocessorCount, dev) != hipSuccess) { grid = -1; return; }
        if (hipFuncSetAttribute((const void*)trunk_fwd, hipFuncAttributeMaxDynamicSharedMemorySize, LDS_BYTES) != hipSuccess) { fprintf(stderr, "kernel_launch: hipFuncSetAttribute failed\n"); grid = -1; return; }
        if (hipOccupancyMaxActiveBlocksPerMultiprocessor(&per_cu, (const void*)trunk_fwd, NWAVES * 64, LDS_BYTES) != hipSuccess || per_cu < 1) fprintf(stderr, "kernel_launch: occupancy query says %d\n", per_cu);
        (void)hipGetLastError();
        grid = cus;
    }
    if (grid < 0) return;
    if (hipMemsetAsync((char*)d_ws + WS_CTL, 0, CTL_ZERO_BYTES, stream) != hipSuccess) return;
    Args a{};
    for (int i = 0; i < 15; ++i) a.in[i] = (const float*)d_in[i];
    a.out = (float*)d_out; a.ws = (unsigned char*)d_ws;
#if MK_PER_PHASE
    for (int p = 0; p < PH_END; ++p) {
        bool valid = (p == 0) || (p == PH_FINAL);
        if (p >= 1 && p < PH_FINAL) { const int L = (p - 1) / 12, k = (p - 1) % 12; const bool fox = (L & 1) == 0; valid = (k <= 8) && (k != 6) && (k != 0 || L == 0); }
        if (!valid) continue;
        a.ph_lo = p; a.ph_hi = p + 1;
        hipLaunchKernelGGL(trunk_fwd, dim3(grid), dim3(NWAVES * 64), LDS_BYTES, stream, a);
    }
#else
    a.ph_lo = 0; a.ph_hi = PH_END;
    hipLaunchKernelGGL(trunk_fwd, dim3(grid), dim3(NWAVES * 64), LDS_BYTES, stream, a);
#endif
}
```

```cpp
#define MK_PER_PHASE 0
#define DUP_SITE -1
#include <hip/hip_runtime.h>
#include <hip/hip_bf16.h>
#include <cstdio>
#include <cstdint>

#ifndef MK_PER_PHASE
#define MK_PER_PHASE 0
#endif

constexpr int SEQ = 16384, DM = 4096, DFF = 16384, NH = 32, DH = 128, DEPTH = 4;
constexpr int FOX_IN = 4 * DM + NH;
constexpr int FOX_INP = 65 * 256;
constexpr int HG_IN = 4 * DM;
constexpr float NORM_EPS = 1e-6f;
constexpr float LOG2E = 1.4426950408889634f;
constexpr float QSCALE = 0.08838834764831845f * LOG2E;

constexpr size_t MiB = 1u << 20;
constexpr size_t WS_CTL = 0, CTL_ZERO_BYTES = 1 * MiB;
constexpr size_t WS_WFIN = 1 * MiB;
constexpr size_t WS_WFOUT = WS_WFIN + 260 * MiB;
constexpr size_t WS_WHIN = WS_WFOUT + 64 * MiB;
constexpr size_t WS_WHOUT = WS_WHIN + 256 * MiB;
constexpr size_t WS_WUP = WS_WHOUT + 64 * MiB;
constexpr size_t WS_WDN = WS_WUP + 512 * MiB;
constexpr size_t WS_H = WS_WDN + 512 * MiB;
constexpr size_t WS_XN = WS_H + 256 * MiB;
constexpr size_t WS_MO = WS_XN + 128 * MiB;
constexpr size_t WS_PROJ = WS_MO + 128 * MiB;
constexpr size_t WS_G = WS_PROJ + 512 * MiB;
constexpr size_t WS_UT = WS_G + 256 * MiB;
constexpr size_t WS_ST = WS_UT + 256 * MiB;
constexpr size_t WS_LOGF = WS_ST + 256 * MiB;
constexpr size_t WS_KB = WS_LOGF + 2 * MiB;
constexpr size_t WS_DEC = WS_KB + 2 * MiB;
constexpr size_t WS_LB = WS_DEC + 4 * MiB;
constexpr size_t WS_PART = WS_LB + 1 * MiB;
constexpr size_t WS_HID = WS_PART + 4 * MiB;
constexpr size_t WS_END = WS_HID + 512 * MiB;

#define GAS __attribute__((address_space(1)))
#define LAS __attribute__((address_space(3)))
typedef unsigned short bf16;
typedef unsigned v4u __attribute__((ext_vector_type(4)));
typedef unsigned v2u __attribute__((ext_vector_type(2)));
typedef float f32x4 __attribute__((ext_vector_type(4)));
typedef float f32x16 __attribute__((ext_vector_type(16)));
typedef short bf16x8 __attribute__((ext_vector_type(8)));
typedef short s16x4 __attribute__((ext_vector_type(4)));
#define LDS_WAIT() asm volatile("s_waitcnt lgkmcnt(0)" ::: "memory")
#define VM_WAIT() asm volatile("s_waitcnt vmcnt(0)" ::: "memory")
typedef float f32x2_t __attribute__((ext_vector_type(2)));
typedef __bf16 bf16x2_t __attribute__((ext_vector_type(2)));
__device__ __forceinline__ unsigned cvtpk(float lo, float hi) { const f32x2_t v = {lo, hi}; return __builtin_bit_cast(unsigned, __builtin_convertvector(v, bf16x2_t)); }
__device__ __forceinline__ float bflo(unsigned w) { return __uint_as_float(w << 16); }
__device__ __forceinline__ float bfhi(unsigned w) { return __uint_as_float(w & 0xffff0000u); }
__device__ __forceinline__ float bf2f(bf16 b) { return __uint_as_float(((unsigned)b) << 16); }
__device__ __forceinline__ bf16 f2bf(float f) { return (bf16)(cvtpk(f, 0.f) & 0xffffu); }
__device__ __forceinline__ float fexp(float x) { return __builtin_amdgcn_exp2f(x * LOG2E); }
__device__ __forceinline__ float sigmoidf_(float x) { return __builtin_amdgcn_rcpf(1.f + fexp(-x)); }
constexpr int WAVE_TAB_OFF = 131072 + 2048;
__device__ __forceinline__ unsigned hw_wave_slot() { return (unsigned)__builtin_amdgcn_s_getreg((5 << 11) | 4) & 63u; }
__device__ __forceinline__ int opaque_tid() {
    extern __shared__ __attribute__((aligned(16))) unsigned char dyn_lds_[];
    int l; asm volatile("v_mbcnt_lo_u32_b32 %0, -1, 0\n\tv_mbcnt_hi_u32_b32 %0, -1, %0" : "=v"(l));
    const int w = __builtin_amdgcn_readfirstlane(((const volatile LAS int*)((LAS unsigned char*)dyn_lds_ + WAVE_TAB_OFF))[hw_wave_slot()]);
    return (w << 6) | l;
}
__device__ __forceinline__ float shx(float v, int o, int lane) { return __int_as_float(__builtin_amdgcn_ds_bpermute((lane ^ o) << 2, __float_as_int(v))); }
__host__ __device__ __forceinline__ int img_byte(int r, int c) { const int st = (r >> 4) * 2 + (c >> 5), rr = r & 15, cc = c & 31, ob = rr * 64 + cc * 2; return st * 1024 + (ob ^ (((ob >> 9) & 1) << 5)); }
__host__ __device__ __forceinline__ size_t tiled_off(size_t row, int col, int nkt) { const int rl = (int)(row & 255);
    return (((row >> 8) * (size_t)nkt + (size_t)(col >> 6)) << 14) + (size_t)((rl >> 7) * 8192 + (img_byte(rl & 127, col & 63) >> 1)); }
__host__ __device__ __forceinline__ size_t tiled_off_w(size_t n, int k, int nkt) { const int w = (int)(n & 31), rho = 16 * ((w >> 2) & 1) + 4 * (w >> 3) + (w & 3);
    return tiled_off((n & ~(size_t)31) + (size_t)rho, k, nkt); }
namespace pg8 {
#define PG8_LAS __attribute__((address_space(3)))
typedef unsigned short bf16_t;
typedef short bf16x8 __attribute__((ext_vector_type(8)));
typedef float f32x4 __attribute__((ext_vector_type(4)));
typedef unsigned u32x4 __attribute__((ext_vector_type(4)));
constexpr int BM = 256, BK = 64, HALF = 128, HTB = HALF * BK * 2  , STAGE_BYTES = 8 * HTB, NXCD = 8, WGM = 8;

__host__ __device__ __forceinline__ int lds_byte(int r, int c) { const int st = (r >> 4) * 2 + (c >> 5), rr = r & 15, cc = c & 31, ob = rr * 64 + cc * 2; return st * 1024 + (ob ^ (((ob >> 9) & 1) << 5)); }
__host__ __device__ __forceinline__ void stage_rc(int b, int& R, int& C) { const int st = b / 1024, sb = b % 1024, swz = sb ^ (((sb >> 9) & 1) << 5); R = (st >> 1) * 16 + swz / 64; C = (st & 1) * 32 + (swz % 64) / 2; }
__host__ __device__ __forceinline__ int perm32(int rho) { const int n = rho >> 4, i = rho & 15; return 8 * (i >> 2) + 4 * n + (i & 3); }

struct Unit { int pm, pn; };
struct Gemm { const bf16_t* A; const bf16_t* Bt; int M, N, K; };

struct StaticOrder {
    int nM, nN, nwg, G, c, wgm;
    __host__ __device__ __forceinline__ void init(int M, int N, int G_, int c_, int wgm_ = WGM) { nM = M / BM; nN = N / BM; nwg = nM * nN; G = G_; c = c_; wgm = wgm_; }
    __host__ __device__ __forceinline__ bool next(int i, Unit& u) const {
        const long L = (long)i * G + c; if (L >= nwg) return false;
        int wgid = (int)L; { const int q = nwg / NXCD, r = nwg % NXCD, xcd = wgid % NXCD, off = wgid / NXCD; wgid = (xcd < r ? xcd * (q + 1) : r * (q + 1) + (xcd - r) * q) + off; }
        const int nig = wgm * nN, gid = wgid / nig, fm = gid * wgm, gsz = (nM - fm) < wgm ? (nM - fm) : wgm;
        u.pm = fm + ((wgid % nig) % gsz); u.pn = (wgid % nig) / gsz; return true;
    }
    __device__ __forceinline__ void a_ready(const Unit&) const {}
    __device__ __forceinline__ void done(const Unit&) const {}
};
#ifndef EPI_NT
#define EPI_NT 0
#endif
#if EPI_NT
#define STORE_NT(p, v) __builtin_nontemporal_store((v), (p))
#else
#define STORE_NT(p, v) (*(p) = (v))
#endif
__device__ __forceinline__ unsigned cvt_pk_bf16(float lo, float hi) { return ::cvtpk(lo, hi); }
__device__ __forceinline__ float lsig(float z) { return fminf(z, 0.f) - 0.6931471805599453f * __builtin_amdgcn_logf(1.f + __builtin_amdgcn_exp2f(-1.4426950408889634f * fabsf(z))); }
__device__ __forceinline__ float sigm(float x) { return __builtin_amdgcn_rcpf(1.f + __builtin_amdgcn_exp2f(-1.4426950408889634f * x)); }

struct RowScale {
    const PG8_LAS float* tab; int pm0; const float* part;
    __device__ __forceinline__ float get(const Unit& u, int rowin) const {
        if (u.pm == pm0) return tab[rowin];
        int ri = rowin; asm volatile("" : "+v"(ri));
        const f32x4* p = (const f32x4*)(part + (size_t)(u.pm * BM + ri) * 64); f32x4 a = {0.f, 0.f, 0.f, 0.f};
#pragma unroll 1
        for (int i = 0; i < 16; ++i) a += p[i];
        return rsqrtf(((a.x + a.y) + (a.z + a.w)) * (1.f / 4096.f) + 1e-6f);
    }
};
struct EpiRes {
    static constexpr bool PERM = true, AFTER_DRAIN = false;
    const float* base; float* out; int ldc; bf16_t* xn; const float* gain; float* part;
    __device__ __forceinline__ void operator()(const f32x4 (&acc)[2][2][4][2], const Unit& u, int wr, int wc, int fr_, int fq_) const {
        int fr = fr_, fq = fq_; asm volatile("" : "+v"(fr), "+v"(fq));
        const int row0 = u.pm * BM + wr * 64 + fr, col0 = u.pn * BM + wc * 32 + 8 * fq, lane = fq * 16 + fr;
        f32x4 g0[2], g1[2];
        if (xn) {
#pragma unroll
            for (int bj = 0; bj < 2; ++bj) { g0[bj] = *(const f32x4*)(gain + col0 + bj * HALF); g1[bj] = *(const f32x4*)(gain + col0 + bj * HALF + 4); } }
#pragma unroll
        for (int ai = 0; ai < 2; ++ai) {
            f32x4 b0[4][2], b1[4][2];
#pragma unroll
            for (int m = 0; m < 4; ++m) { const size_t off = (size_t)(row0 + ai * HALF + m * 16) * ldc + col0;
#pragma unroll
                for (int bj = 0; bj < 2; ++bj) { b0[m][bj] = *(const f32x4*)(base + off + bj * HALF); b1[m][bj] = *(const f32x4*)(base + off + bj * HALF + 4); } }
#pragma unroll
            for (int m = 0; m < 4; ++m) { const size_t row = (size_t)(row0 + ai * HALF + m * 16); const size_t off = row * ldc + col0;
                float ss = 0.f;
#pragma unroll
                for (int bj = 0; bj < 2; ++bj) { const f32x4 h0 = b0[m][bj] + acc[ai][bj][m][0], h1 = b1[m][bj] + acc[ai][bj][m][1];
                    STORE_NT((f32x4*)(out + off + bj * HALF), h0); STORE_NT((f32x4*)(out + off + bj * HALF + 4), h1);
                    if (xn) { ss += ((h0[0] * h0[0] + h0[1] * h0[1]) + (h0[2] * h0[2] + h0[3] * h0[3])) + ((h1[0] * h1[0] + h1[1] * h1[1]) + (h1[2] * h1[2] + h1[3] * h1[3]));
                        const f32x4 x0 = h0 * g0[bj], x1 = h1 * g1[bj];
                        u32x4 w; w.x = cvt_pk_bf16(x0[0], x0[1]); w.y = cvt_pk_bf16(x0[2], x0[3]); w.z = cvt_pk_bf16(x1[0], x1[1]); w.w = cvt_pk_bf16(x1[2], x1[3]);
                        STORE_NT((u32x4*)(xn + ::tiled_off(row, col0 + bj * HALF, ldc >> 6)), w); } }
                if (xn) { ss += ::shx(ss, 16, lane); ss += ::shx(ss, 32, lane); if (fq == 0) part[row * 64 + u.pn * 4 + wc] = ss; } }
            asm volatile("" ::: "memory"); }
    }
};
struct EpiSqRelu {
    static constexpr bool PERM = true, AFTER_DRAIN = false;
    bf16_t* O; int ldc; RowScale rsc;
    __device__ __forceinline__ void operator()(const f32x4 (&acc)[2][2][4][2], const Unit& u, int wr, int wc, int fr_, int fq_) const {
        int fr = fr_, fq = fq_; asm volatile("" : "+v"(fr), "+v"(fq));
        const int row0 = u.pm * BM + wr * 64 + fr, col0 = u.pn * BM + wc * 32 + 8 * fq;
#pragma unroll
        for (int ai = 0; ai < 2; ++ai)
#pragma unroll
            for (int m = 0; m < 4; ++m) { bf16_t* rowp = O + ::tiled_off((size_t)(row0 + ai * HALF + m * 16), col0, ldc >> 6); const float rs = rsc.get(u, wr * 64 + fr + ai * HALF + m * 16);
#pragma unroll
                for (int bj = 0; bj < 2; ++bj) { f32x4 v0 = acc[ai][bj][m][0] * rs, v1 = acc[ai][bj][m][1] * rs;
#pragma unroll
                    for (int j = 0; j < 4; ++j) { const float a = fmaxf(v0[j], 0.f), b = fmaxf(v1[j], 0.f); v0[j] = a * a; v1[j] = b * b; }
                    u32x4 w; w.x = cvt_pk_bf16(v0[0], v0[1]); w.y = cvt_pk_bf16(v0[2], v0[3]); w.z = cvt_pk_bf16(v1[0], v1[1]); w.w = cvt_pk_bf16(v1[2], v1[3]);
                    STORE_NT((u32x4*)(rowp + (size_t)bj * (2 * 16384)), w); } }
    }
};
struct EpiFox {
    static constexpr bool PERM = true, AFTER_DRAIN = false;
    bf16_t* P; int ldc; float* logf; const float* fbias; float* cs; RowScale rsc; const float* qg; const float* kg; PG8_LAS float* qkt; float QS;
    __device__ __forceinline__ void operator()(const f32x4 (&acc)[2][2][4][2], const Unit& u, int wr, int wc, int fr_, int fq_) const {
        int fr = fr_, fq = fq_; asm volatile("" : "+v"(fr), "+v"(fq));
        const int row0 = u.pm * BM + wr * 64 + fr;
        if (u.pn < 32) {
            const int col0 = u.pn * BM + wc * 32 + 8 * fq, lane = fq * 16 + fr; const bool isq = u.pn < 16;
            const float* gs = (isq ? qg : kg) + wc * 32 + 8 * fq; const float sc = isq ? QS : 1.f;
            const f32x4 g0 = *(const f32x4*)gs * sc, g1 = *(const f32x4*)(gs + 4) * sc;
#pragma unroll
            for (int ai = 0; ai < 2; ++ai)
#pragma unroll
                for (int m = 0; m < 4; ++m) { const int rowin = ai * 64 + m * 16 + fr; const float rs = rsc.get(u, wr * 64 + fr + ai * HALF + m * 16);
#pragma unroll
                    for (int bj = 0; bj < 2; ++bj) { const f32x4 v0 = acc[ai][bj][m][0] * rs, v1 = acc[ai][bj][m][1] * rs;
                        float ss = ((v0[0] * v0[0] + v0[1] * v0[1]) + (v0[2] * v0[2] + v0[3] * v0[3])) + ((v1[0] * v1[0] + v1[1] * v1[1]) + (v1[2] * v1[2] + v1[3] * v1[3]));
                        ss += ::shx(ss, 16, lane); ss += ::shx(ss, 32, lane);
                        if (fq == 0) qkt[(((wr * 128 + rowin) * 2 + bj) << 2) + wc] = ss; } }
            asm volatile("s_waitcnt lgkmcnt(0)" ::: "memory"); __builtin_amdgcn_s_barrier(); asm volatile("" ::: "memory");
#pragma unroll
            for (int ai = 0; ai < 2; ++ai)
#pragma unroll
                for (int m = 0; m < 4; ++m) { const int rowin = ai * 64 + m * 16 + fr; const float rs = rsc.get(u, wr * 64 + fr + ai * HALF + m * 16);
                    bf16_t* rowp = P + (((size_t)(u.pn >> 4) * 32 + (u.pn & 15) * 2) * 16384 + (size_t)(row0 + ai * HALF + m * 16)) * 128 + wc * 32 + 8 * fq;
#pragma unroll
                    for (int bj = 0; bj < 2; ++bj) { const f32x4 t = *(const PG8_LAS f32x4*)(qkt + (((wr * 128 + rowin) * 2 + bj) << 2));
                        const float r2 = rs * rsqrtf(((t[0] + t[1]) + (t[2] + t[3])) * (1.f / 128.f) + 1e-6f);
                        const f32x4 v0 = acc[ai][bj][m][0] * r2 * g0, v1 = acc[ai][bj][m][1] * r2 * g1;
                        u32x4 w; w.x = cvt_pk_bf16(v0[0], v0[1]); w.y = cvt_pk_bf16(v0[2], v0[3]); w.z = cvt_pk_bf16(v1[0], v1[1]); w.w = cvt_pk_bf16(v1[2], v1[3]);
                        STORE_NT((u32x4*)(rowp + (size_t)bj * ((size_t)16384 * 128)), w); } }
        } else if (u.pn < 64) {
            const int col0 = u.pn * BM + wc * 32 + 8 * fq; const bool gate = u.pn >= 48;
#pragma unroll
            for (int ai = 0; ai < 2; ++ai)
#pragma unroll
                for (int m = 0; m < 4; ++m) { bf16_t* rowp = P + (((size_t)(u.pn >> 4) * 32 + (u.pn & 15) * 2) * 16384 + (size_t)(row0 + ai * HALF + m * 16)) * 128 + wc * 32 + 8 * fq; const float rs = rsc.get(u, wr * 64 + fr + ai * HALF + m * 16);
#pragma unroll
                    for (int bj = 0; bj < 2; ++bj) { f32x4 v0 = acc[ai][bj][m][0] * rs, v1 = acc[ai][bj][m][1] * rs;
                        if (gate) {
#pragma unroll
                            for (int j = 0; j < 4; ++j) { v0[j] = sigm(v0[j]); v1[j] = sigm(v1[j]); } }
                        u32x4 w; w.x = cvt_pk_bf16(v0[0], v0[1]); w.y = cvt_pk_bf16(v0[2], v0[3]); w.z = cvt_pk_bf16(v1[0], v1[1]); w.w = cvt_pk_bf16(v1[2], v1[3]);
                        STORE_NT((u32x4*)(rowp + (size_t)bj * ((size_t)16384 * 128)), w); } }
        } else if (wc == 0) {
            const f32x4 b0 = *(const f32x4*)(fbias + 8 * fq), b1 = *(const f32x4*)(fbias + 8 * fq + 4);
            const int lane = fq * 16 + fr;
#pragma unroll
            for (int ai = 0; ai < 2; ++ai) {
                f32x4 s0 = {0.f, 0.f, 0.f, 0.f}, s1 = {0.f, 0.f, 0.f, 0.f};
#pragma unroll
                for (int m = 0; m < 4; ++m) { float* rowp = logf + (size_t)(row0 + ai * HALF + m * 16) * 32 + 8 * fq; const float rs = rsc.get(u, wr * 64 + fr + ai * HALF + m * 16);
                    f32x4 v0 = acc[ai][0][m][0] * rs + b0, v1 = acc[ai][0][m][1] * rs + b1;
#pragma unroll
                    for (int j = 0; j < 4; ++j) { v0[j] = lsig(v0[j]); v1[j] = lsig(v1[j]); }
                    *(f32x4*)rowp = v0; *(f32x4*)(rowp + 4) = v1; s0 += v0; s1 += v1; }
#pragma unroll
                for (int j = 0; j < 4; ++j) {
#pragma unroll
                    for (int o = 1; o < 16; o <<= 1) { s0[j] += ::shx(s0[j], o, lane); s1[j] += ::shx(s1[j], o, lane); } }
                if (fr == 0) { float* cp = cs + (size_t)(u.pm * 4 + ai * 2 + wr) * 32 + 8 * fq; *(f32x4*)cp = s0; *(f32x4*)(cp + 4) = s1; }
                asm volatile("" ::: "memory"); }
        }
    }
};
struct EpiHgrn {
    static constexpr bool PERM = true, AFTER_DRAIN = false;
    bf16_t* P; int ldc; _Float16* G; const float* lb; RowScale rsc;
    __device__ __forceinline__ void operator()(const f32x4 (&acc)[2][2][4][2], const Unit& u, int wr, int wc, int fr_, int fq_) const {
        int fr = fr_, fq = fq_; asm volatile("" : "+v"(fr), "+v"(fq));
        constexpr size_t HSTR = (size_t)16384 * 128;
        const int row0 = u.pm * BM + wr * 64 + fr, col0 = u.pn * BM + wc * 32 + 8 * fq; const int kind = u.pn >> 4, hd0 = (u.pn & 15) * 2, dcol = wc * 32 + 8 * fq;
        if (kind == 1) {
            const int gc0 = col0 - 4096;
            f32x4 l0[2], l1[2];
#pragma unroll
            for (int bj = 0; bj < 2; ++bj) { l0[bj] = *(const f32x4*)(lb + gc0 + bj * HALF); l1[bj] = *(const f32x4*)(lb + gc0 + bj * HALF + 4); }
#pragma unroll
            for (int ai = 0; ai < 2; ++ai)
#pragma unroll
                for (int m = 0; m < 4; ++m) { const size_t r = (size_t)(row0 + ai * HALF + m * 16); bf16_t* rowp = P + (((size_t)1 * 32 + hd0) * 16384 + r) * 128 + dcol; _Float16* gp = G + ((size_t)hd0 * 16384 + r) * 128 + dcol; const float rs = rsc.get(u, wr * 64 + fr + ai * HALF + m * 16);
#pragma unroll
                    for (int bj = 0; bj < 2; ++bj) { f32x4 v0 = acc[ai][bj][m][0] * rs, v1 = acc[ai][bj][m][1] * rs, g0, g1;
#pragma unroll
                        for (int j = 0; j < 4; ++j) { const float f0 = l0[bj][j] + (1.f - l0[bj][j]) * sigm(v0[j]), f1 = l1[bj][j] + (1.f - l1[bj][j]) * sigm(v1[j]);
                            g0[j] = log2f(f0); g1[j] = log2f(f1); v0[j] = 1.f - f0; v1[j] = 1.f - f1; }
                        u32x4 w; w.x = cvt_pk_bf16(v0[0], v0[1]); w.y = cvt_pk_bf16(v0[2], v0[3]); w.z = cvt_pk_bf16(v1[0], v1[1]); w.w = cvt_pk_bf16(v1[2], v1[3]);
                        STORE_NT((u32x4*)(rowp + (size_t)bj * HSTR), w); { typedef _Float16 h2 __attribute__((ext_vector_type(2))); typedef float f2 __attribute__((ext_vector_type(2)));
                          u32x4 gw; gw.x = __builtin_bit_cast(unsigned, __builtin_convertvector((f2){g0[0], g0[1]}, h2)); gw.y = __builtin_bit_cast(unsigned, __builtin_convertvector((f2){g0[2], g0[3]}, h2));
                          gw.z = __builtin_bit_cast(unsigned, __builtin_convertvector((f2){g1[0], g1[1]}, h2)); gw.w = __builtin_bit_cast(unsigned, __builtin_convertvector((f2){g1[2], g1[3]}, h2));
                          STORE_NT((u32x4*)(gp + (size_t)bj * HSTR), gw); } } }
        } else {
            const bool act = kind != 2;
#pragma unroll
            for (int ai = 0; ai < 2; ++ai)
#pragma unroll
                for (int m = 0; m < 4; ++m) { bf16_t* rowp = P + (((size_t)kind * 32 + hd0) * 16384 + (size_t)(row0 + ai * HALF + m * 16)) * 128 + dcol; const float rs = rsc.get(u, wr * 64 + fr + ai * HALF + m * 16);
#pragma unroll
                    for (int bj = 0; bj < 2; ++bj) { f32x4 v0 = acc[ai][bj][m][0] * rs, v1 = acc[ai][bj][m][1] * rs;
                        if (act) {
#pragma unroll
                            for (int j = 0; j < 4; ++j) { v0[j] = v0[j] * sigm(v0[j]); v1[j] = v1[j] * sigm(v1[j]); } }
                        u32x4 w; w.x = cvt_pk_bf16(v0[0], v0[1]); w.y = cvt_pk_bf16(v0[2], v0[3]); w.z = cvt_pk_bf16(v1[0], v1[1]); w.w = cvt_pk_bf16(v1[2], v1[3]);
                        STORE_NT((u32x4*)(rowp + (size_t)bj * HSTR), w); } }
        }
    }
};
template <class Epi, class Sched, bool ALIGN_EPI = false, bool SP2 = false>
__device__ __forceinline__ void gemm_phase(PG8_LAS unsigned char* lds, const Gemm g, const Sched& S, const Epi& E) {
    const int tid = opaque_tid(), wid = __builtin_amdgcn_readfirstlane(tid >> 6), lane = tid & 63, wr = wid >> 2, wc = wid & 3, fr = lane & 15, fq = lane >> 4;
    const int K = g.K, nt = K / BK;
    unsigned voffA[2], voffB[2];
    static_assert(Epi::PERM, "the weights are stored with the PERM row order baked in");
#pragma unroll
    for (int i = 0; i < 2; ++i) { voffA[i] = (unsigned)(tid * 16 + i * 8192); voffB[i] = voffA[i]; }
    const size_t kstep = (size_t)BM * BK * 2, hstep = (size_t)HALF * BK * 2;
    const size_t tstep = (size_t)BM * K * 2;
    const size_t kstepB = kstep, hstepB = hstep;
    const unsigned ldsw = (unsigned)wid * 1024u;
    const int aoff = lds_byte(wr * 64 + fr, fq * 8), boff = lds_byte(wc * 32 + fr, fq * 8);
#define PG8_SA(b, h) (((b) * 2 + (h)) * HTB)
#define PG8_SB(b, h) ((4 + (b) * 2 + (h)) * HTB)
#define PG8_STAGE(bufoff, gbase, voff) do { _Pragma("unroll") for (int _i = 0; _i < 2; ++_i) \
        __builtin_amdgcn_global_load_lds((const unsigned*)((const char*)(gbase) + (voff)[_i]), (PG8_LAS unsigned*)(lds + (bufoff) + ldsw + _i * 8192), 16, 0, 0); } while (0)
#define PG8_LDA(dst, b, h) do { _Pragma("unroll") for (int m = 0; m < 4; ++m) _Pragma("unroll") for (int k = 0; k < 2; ++k) dst[m][k] = *(const PG8_LAS bf16x8*)(lds + PG8_SA(b, h) + aoff + m * 2048 + k * 1024); } while (0)
#define PG8_LDB(dst, b, h) do { _Pragma("unroll") for (int n = 0; n < 2; ++n) _Pragma("unroll") for (int k = 0; k < 2; ++k) dst[n][k] = *(const PG8_LAS bf16x8*)(lds + PG8_SB(b, h) + boff + n * 2048 + k * 1024); } while (0)
#ifndef PG8_PRIO
#define PG8_PRIO 1
#endif
#define PG8_MMA(ai, bj, At, Bt) do { if (PG8_PRIO) __builtin_amdgcn_s_setprio(1); _Pragma("unroll") for (int m = 0; m < 4; ++m) _Pragma("unroll") for (int n = 0; n < 2; ++n) _Pragma("unroll") for (int k = 0; k < 2; ++k) \
        acc[ai][bj][m][n] = __builtin_amdgcn_mfma_f32_16x16x32_bf16(Bt[n][k], At[m][k], acc[ai][bj][m][n], 0, 0, 0); if (PG8_PRIO) __builtin_amdgcn_s_setprio(0); } while (0)
#define PG8_WAIT_V(n) asm volatile("s_waitcnt vmcnt(" #n ")" ::: "memory")
#define PG8_WAIT_L(n) asm volatile("s_waitcnt lgkmcnt(" #n ")" ::: "memory")
#define PG8_BAR __builtin_amdgcn_s_barrier()
#define PG8_SCHED __builtin_amdgcn_sched_barrier(0)
    Unit cur, nxt; int ui = 0;
    if (!S.next(0, cur)) return;
    f32x4 acc[2][2][4][2];
#pragma unroll
    for (int a = 0; a < 2; ++a)
#pragma unroll
        for (int b = 0; b < 2; ++b)
#pragma unroll
            for (int m = 0; m < 4; ++m)
#pragma unroll
                for (int n = 0; n < 2; ++n) acc[a][b][m][n] = (f32x4){0.f, 0.f, 0.f, 0.f};
    bf16x8 At[4][2], B0[2][2], B1[2][2];
    const char* cA = (const char*)g.A + (size_t)cur.pm * tstep; const char* cB = (const char*)g.Bt + (size_t)cur.pn * tstep;
    S.a_ready(cur);
    if constexpr (SP2) {
        PG8_STAGE(PG8_SB(0, 0), cB, voffB); PG8_STAGE(PG8_SB(0, 1), cB + hstepB, voffB); PG8_STAGE(PG8_SA(0, 0), cA, voffA); PG8_STAGE(PG8_SA(0, 1), cA + hstep, voffA);
        if (wr == 1) PG8_BAR;
        PG8_WAIT_V(2); PG8_BAR;
        PG8_STAGE(PG8_SB(1, 0), cB + kstepB, voffB); PG8_STAGE(PG8_SA(1, 0), cA + kstep, voffA); PG8_STAGE(PG8_SB(1, 1), cB + hstepB + kstepB, voffB);
        PG8_WAIT_V(6); PG8_BAR;
    } else {
        PG8_STAGE(PG8_SB(0, 0), cB, voffB); PG8_STAGE(PG8_SA(0, 0), cA, voffA); PG8_STAGE(PG8_SB(0, 1), cB + hstepB, voffB); PG8_STAGE(PG8_SA(0, 1), cA + hstep, voffA);
        if (wr == 1) PG8_BAR;
        PG8_WAIT_V(4); PG8_BAR;
        PG8_STAGE(PG8_SB(1, 0), cB + kstepB, voffB); PG8_STAGE(PG8_SA(1, 0), cA + kstep, voffA); PG8_STAGE(PG8_SB(1, 1), cB + hstepB + kstepB, voffB);
        PG8_WAIT_V(6); PG8_BAR;
    }
    for (;;) {
        const bool has_next = S.next(ui + 1, nxt);
        const char* nA = has_next ? (const char*)g.A + (size_t)nxt.pm * tstep : cA; const char* nB = has_next ? (const char*)g.Bt + (size_t)nxt.pn * tstep : cB;
        for (int t = 0; t < nt; t += 2) {
            const bool last = (t == nt - 2);
            const char* a1 = cA + (size_t)(t + 1) * kstep;
            const char* a2 = last ? nA : cA + (size_t)(t + 2) * kstep; const char* b2 = last ? nB : cB + (size_t)(t + 2) * kstepB;
            const char* a3 = a2 + kstep; const char* b3 = b2 + kstepB;
            if (last && has_next) S.a_ready(nxt);
            if constexpr (SP2) {
            PG8_LDB(B0, 0, 0); PG8_LDB(B1, 0, 1); PG8_SCHED; PG8_LDA(At, 0, 0); PG8_STAGE(PG8_SA(1, 1), a1 + hstep, voffA);
            PG8_WAIT_V(8); PG8_WAIT_L(0); PG8_BAR; PG8_MMA(0, 0, At, B0); PG8_MMA(0, 1, At, B1); PG8_BAR; PG8_SCHED;
            PG8_LDA(At, 0, 1); PG8_STAGE(PG8_SB(0, 0), b2, voffB); PG8_STAGE(PG8_SB(0, 1), b2 + hstepB, voffB); PG8_STAGE(PG8_SA(0, 0), a2, voffA);
            PG8_WAIT_V(8); PG8_WAIT_L(0); PG8_BAR; PG8_MMA(1, 0, At, B0); PG8_MMA(1, 1, At, B1); PG8_BAR; PG8_SCHED;
            PG8_LDB(B0, 1, 0); PG8_LDB(B1, 1, 1); PG8_SCHED; PG8_LDA(At, 1, 0); PG8_STAGE(PG8_SA(0, 1), a2 + hstep, voffA);
            PG8_WAIT_V(8); PG8_WAIT_L(0); PG8_BAR; PG8_MMA(0, 0, At, B0); PG8_MMA(0, 1, At, B1); PG8_BAR; PG8_SCHED;
            PG8_LDA(At, 1, 1); PG8_STAGE(PG8_SB(1, 0), b3, voffB); PG8_STAGE(PG8_SB(1, 1), b3 + hstepB, voffB); PG8_STAGE(PG8_SA(1, 0), a3, voffA);
            PG8_WAIT_V(8); PG8_WAIT_L(0); PG8_BAR; PG8_MMA(1, 0, At, B0); PG8_MMA(1, 1, At, B1); PG8_BAR; PG8_SCHED;
            } else {
            PG8_LDB(B0, 0, 0); PG8_SCHED; PG8_LDA(At, 0, 0); PG8_STAGE(PG8_SA(1, 1), a1 + hstep, voffA);
            PG8_WAIT_L(8); PG8_BAR; PG8_WAIT_L(0); PG8_MMA(0, 0, At, B0); PG8_BAR; PG8_SCHED;
            PG8_LDB(B1, 0, 1); PG8_STAGE(PG8_SB(0, 0), b2, voffB);
            PG8_BAR; PG8_WAIT_L(0); PG8_MMA(0, 1, At, B1); PG8_BAR;
            PG8_LDA(At, 0, 1); PG8_STAGE(PG8_SA(0, 0), a2, voffA);
            PG8_BAR; PG8_WAIT_L(0); PG8_MMA(1, 0, At, B0); PG8_BAR; PG8_SCHED;
            PG8_STAGE(PG8_SB(0, 1), b2 + hstepB, voffB);
            PG8_WAIT_V(6); PG8_BAR; PG8_MMA(1, 1, At, B1); PG8_BAR;
            PG8_LDB(B0, 1, 0); PG8_SCHED; PG8_LDA(At, 1, 0); PG8_STAGE(PG8_SA(0, 1), a2 + hstep, voffA);
            PG8_WAIT_L(8); PG8_BAR; PG8_WAIT_L(0); PG8_MMA(0, 0, At, B0); PG8_BAR; PG8_SCHED;
            PG8_LDB(B1, 1, 1); PG8_STAGE(PG8_SB(1, 0), b3, voffB);
            PG8_BAR; PG8_WAIT_L(0); PG8_MMA(0, 1, At, B1); PG8_BAR;
            PG8_LDA(At, 1, 1); PG8_STAGE(PG8_SA(1, 0), a3, voffA);
            PG8_BAR; PG8_WAIT_L(0); PG8_MMA(1, 0, At, B0); PG8_BAR; PG8_SCHED;
            PG8_STAGE(PG8_SB(1, 1), b3 + hstepB, voffB);
            PG8_WAIT_V(6); PG8_BAR; PG8_MMA(1, 1, At, B1); PG8_BAR;
            }
        }
        if constexpr (ALIGN_EPI) { if (wr == 0) PG8_BAR; }
        if constexpr (!Epi::AFTER_DRAIN) { E(acc, cur, wr, wc, fr, fq); S.done(cur); }
        if (!has_next) break;
#pragma unroll
        for (int a = 0; a < 2; ++a)
#pragma unroll
            for (int b = 0; b < 2; ++b)
#pragma unroll
                for (int m = 0; m < 4; ++m)
#pragma unroll
                    for (int n = 0; n < 2; ++n) acc[a][b][m][n] = (f32x4){0.f, 0.f, 0.f, 0.f};
        cur = nxt; cA = nA; cB = nB; ++ui;
        if constexpr (ALIGN_EPI) { if (wr == 1) PG8_BAR; }
    }
    PG8_WAIT_V(0);
    if constexpr (!ALIGN_EPI) { if (wr == 0) PG8_BAR; }
    PG8_BAR;
    if constexpr (Epi::AFTER_DRAIN) { E.fused(acc, cur, wr, wc, fr, fq, lds, wid, lane); S.done(cur); }
#undef PG8_SA
#undef PG8_SB
#undef PG8_STAGE
#undef PG8_LDA
#undef PG8_LDB
#undef PG8_MMA
#undef PG8_WAIT_V
#undef PG8_WAIT_L
#undef PG8_BAR
#undef PG8_SCHED
}
}
#define XB_TMO      128
#define XB_XCNT(j)  (256  + 64 * (j))
#define XB_XSUB(j)  (1280 + 64 * (j))
#define XB_XGEN(j)  (2304 + 64 * (j))
#define XB_TOP      3328
#define XB_TOPGEN   3392
#define XCD_BAR_WORDS 3456
#define XB_SPIN_CAP (1u << 18)
#define LAS __attribute__((address_space(3)))

__device__ __forceinline__ unsigned xb_ld(unsigned* p)              { return __hip_atomic_load((__attribute__((address_space(1))) unsigned*)p, __ATOMIC_RELAXED, __HIP_MEMORY_SCOPE_AGENT); }
__device__ __forceinline__ unsigned xb_add(unsigned* p, unsigned v) { return __hip_atomic_fetch_add((__attribute__((address_space(1))) unsigned*)p, v, __ATOMIC_RELAXED, __HIP_MEMORY_SCOPE_AGENT); }
__device__ __forceinline__ unsigned xb_xcc_id() { return (unsigned)__builtin_amdgcn_s_getreg((3 << 11) | 20) & 0xFu; }
#define XB_SPIN(cond, bar) do { unsigned _sp = 0; while (cond) { __builtin_amdgcn_s_sleep(1); \
    if ((++_sp & 255u) == 0u) { if (xb_ld(&(bar)[XB_TMO])) break; if (_sp > XB_SPIN_CAP) { atomicAdd(&(bar)[XB_TMO], 1u); break; } } } } while (0)

struct XcdBarrier {
    unsigned* bar; unsigned x;
    volatile LAS unsigned* st;
};

__device__ __forceinline__ XcdBarrier xcd_barrier_post(unsigned* bar, volatile LAS unsigned* st) {
    XcdBarrier b; b.bar = bar; b.x = xb_xcc_id(); b.st = st;
    if (threadIdx.x == 0) (void)xb_add(&bar[XB_XCNT(b.x)], 1u);
    return b;
}
__device__ __forceinline__ void xcd_barrier_complete(unsigned* bar, unsigned x, unsigned& nloc, unsigned& nx) {
    const unsigned G = gridDim.x * gridDim.y * gridDim.z;
    unsigned sum, cnt, mine, sp = 0u;
    for (;;) {
        sum = 0u; cnt = 0u; mine = 0u;
#pragma unroll
        for (unsigned j = 0; j < 16; ++j) { const unsigned c = xb_ld(&bar[XB_XCNT(j)]); sum += c; cnt += (c > 0u) ? 1u : 0u; mine = (j == x) ? c : mine; }
        if (sum == G) break;
        __builtin_amdgcn_s_sleep(1);
        if ((++sp & 255u) == 0u) { if (xb_ld(&bar[XB_TMO])) break; if (sp > XB_SPIN_CAP) { atomicAdd(&bar[XB_TMO], 1u); break; } }
    }
    nloc = mine > 0u ? mine : 1u; nx = cnt > 0u ? cnt : 1u;
}

__device__ __forceinline__ void xcd_barrier(const XcdBarrier& b) {
    asm volatile("s_waitcnt vmcnt(0)" ::: "memory");
    __syncthreads();
    if (threadIdx.x == 0) {
        unsigned* bar = b.bar;
        __builtin_amdgcn_s_waitcnt(0);
        unsigned nloc = b.st[0], nx = b.st[1];
        if (nloc == 0u) { xcd_barrier_complete(bar, b.x, nloc, nx); b.st[0] = nloc; b.st[1] = nx; }
        const unsigned old = xb_add(&bar[XB_XSUB(b.x)], 1u);
        const unsigned gen = old / nloc;
        if (old + 1u == (gen + 1u) * nloc) {
            __builtin_amdgcn_fence(__ATOMIC_RELEASE, "agent");
            asm volatile("s_waitcnt vmcnt(0)" ::: "memory");
            const unsigned og = xb_add(&bar[XB_TOP], 1u);
            const unsigned tg = og / nx;
            if (og + 1u == (tg + 1u) * nx) xb_add(&bar[XB_TOPGEN], 1u);
            else XB_SPIN(xb_ld(&bar[XB_TOPGEN]) == tg, bar);
            __builtin_amdgcn_fence(__ATOMIC_ACQUIRE, "agent");
            xb_add(&bar[XB_XGEN(b.x)], 1u);
            asm volatile("s_waitcnt vmcnt(0)" ::: "memory");
        } else {
            XB_SPIN(xb_ld(&bar[XB_XGEN(b.x)]) == gen, bar);
            __builtin_amdgcn_fence(__ATOMIC_ACQUIRE, "agent");
            asm volatile("s_waitcnt vmcnt(0)" ::: "memory");
        }
    }
    __syncthreads();
}

#define XB_LSUB(j)  (8192 + 64 * (j))
#define XB_LGEN(j)  (9216 + 64 * (j))
#define XB_XID      10240
__device__ __forceinline__ void xcd_local_barrier(const XcdBarrier& b) {
    asm volatile("s_waitcnt vmcnt(0)" ::: "memory");
    __syncthreads();
    if (threadIdx.x == 0) {
        unsigned* bar = b.bar;
        __builtin_amdgcn_s_waitcnt(0);
        unsigned nloc = b.st[0]; if (nloc == 0u) nloc = 1u;
        const unsigned old = xb_add(&bar[XB_LSUB(b.x)], 1u);
        const unsigned gen = old / nloc;
        if (old + 1u == (gen + 1u) * nloc) xb_add(&bar[XB_LGEN(b.x)], 1u);
        else XB_SPIN(xb_ld(&bar[XB_LGEN(b.x)]) == gen, bar);
        __builtin_amdgcn_fence(__ATOMIC_ACQUIRE, "agent");
        asm volatile("s_waitcnt vmcnt(0)" ::: "memory");
    }
    __syncthreads();
}
__device__ __forceinline__ int xcd_groups_local(unsigned* bar) {
    int ok = 1;
    if (gridDim.x != 256u) ok = 0;
    else if (threadIdx.x < 256u) { const unsigned v = xb_ld(&bar[XB_XID + threadIdx.x]), ref = xb_ld(&bar[XB_XID + (threadIdx.x & 7u)]); ok = (v != 0u && v == ref) ? 1 : 0; }
    return __syncthreads_and(ok);
}
constexpr int NWAVES = 8;
__device__ __forceinline__ float wave_sum(float v, int lane) {
#pragma unroll
    for (int o = 1; o < 64; o <<= 1) v += shx(v, o, lane);
    return v;
}
struct TileRegs { f32x4 v[4][8]; };
__device__ __forceinline__ void tile_load(const float* W, int N, int k0, int n0, int lane, TileRegs& t) {
    const int half = lane >> 5, nn = lane & 31, n = 4 * nn;
    const bool ok = n0 + n < N;
    const float* src = W + (size_t)k0 * N + n0 + n;
#pragma unroll
    for (int j = 0; j < 4; ++j)
#pragma unroll
        for (int r = 0; r < 8; ++r)
            t.v[j][r] = ok ? __builtin_nontemporal_load((const f32x4*)(src + (size_t)(8 * (2 * j + half) + r) * N)) : (f32x4){0.f, 0.f, 0.f, 0.f};
}
__device__ __forceinline__ void tile_to_lds(LAS unsigned* T, int lane, const TileRegs& t) {
    const int half = lane >> 5, nn = lane & 31, n = 4 * nn, sw = nn & 7;
#pragma unroll
    for (int j = 0; j < 4; ++j) { const int ch = (2 * j + half) ^ sw;
#pragma unroll
        for (int e = 0; e < 4; ++e)
            *(LAS v4u*)(T + (n + e) * 32 + 4 * ch) = (v4u){cvtpk(t.v[j][0][e], t.v[j][1][e]), cvtpk(t.v[j][2][e], t.v[j][3][e]), cvtpk(t.v[j][4][e], t.v[j][5][e]), cvtpk(t.v[j][6][e], t.v[j][7][e])}; }
    LDS_WAIT(); asm volatile("" ::: "memory");
}
__device__ __forceinline__ void tile_store(int K, int N, bf16* WT, const LAS unsigned* T, int k0, int n0, int lane) {
#pragma unroll 4
    for (int j = 0; j < 16; ++j) { const int idx = lane + 64 * j, c = idx & 7, nr = idx >> 3;
        const v4u w = *(const LAS v4u*)(T + nr * 32 + 4 * (c ^ ((nr >> 2) & 7)));
        if (n0 + nr < N) *(v4u*)(WT + tiled_off_w((size_t)(n0 + nr), k0 + 8 * c, K >> 6)) = w; }
    LDS_WAIT(); asm volatile("" ::: "memory");
}
__device__ __forceinline__ void transpose_matrix(const float* W, int K, int N, bf16* WT, LAS float* scr, int gw, int ngw, int lane, int i_lo, int i_hi) {
    const int nnt = (N + 127) / 128, nitems = (K / 64) * nnt;
    TileRegs t;
    if (i_lo < i_hi && gw + i_lo * ngw < nitems) { const int it = gw + i_lo * ngw, kb = it / nnt, nb = it - kb * nnt; tile_load(W, N, 64 * kb, 128 * nb, lane, t); }
    for (int i = i_lo; i < i_hi; ++i) { const int it = gw + i * ngw; if (it >= nitems) break; const int kb = it / nnt, nb = it - kb * nnt;
        tile_to_lds((LAS unsigned*)scr, lane, t);
        const int itn = it + ngw; if (i + 1 < i_hi && itn < nitems) { const int kbn = itn / nnt, nbn = itn - kbn * nnt; tile_load(W, N, 64 * kbn, 128 * nbn, lane, t); }
        tile_store(K, N, WT, (const LAS unsigned*)scr, 64 * kb, 128 * nb, lane); }
}
struct ConvArgs { const float* fox_w_in; const float* fox_w_out; const float* hgrn_w_in; const float* hgrn_w_out; const float* up; const float* down; };
__device__ __forceinline__ void conv_pick(unsigned char* ws, const ConvArgs& a, int q, const float*& src, bf16*& dst, int& K, int& N) {
    const int L = q >> 2, k = q & 3, j = L >> 1; const bool fox = (L & 1) == 0;
    if (k == 0) { K = DM; if (fox) { src = a.fox_w_in + (size_t)j * DM * FOX_IN; N = FOX_IN; dst = (bf16*)(ws + WS_WFIN) + (size_t)j * FOX_INP * DM; } else { src = a.hgrn_w_in + (size_t)j * DM * HG_IN; N = HG_IN; dst = (bf16*)(ws + WS_WHIN) + (size_t)j * HG_IN * DM; } }
    else if (k == 1) { K = DM; N = DM; if (fox) { src = a.fox_w_out + (size_t)j * DM * DM; dst = (bf16*)(ws + WS_WFOUT) + (size_t)j * DM * DM; } else { src = a.hgrn_w_out + (size_t)j * DM * DM; dst = (bf16*)(ws + WS_WHOUT) + (size_t)j * DM * DM; } }
    else if (k == 2) { K = DM; N = DFF; src = a.up + (size_t)L * DM * DFF; dst = (bf16*)(ws + WS_WUP) + (size_t)L * DFF * DM; }
    else { K = DFF; N = DM; src = a.down + (size_t)L * DFF * DM; dst = (bf16*)(ws + WS_WDN) + (size_t)L * DM * DFF; }
}
__device__ __forceinline__ void conv_weights(LAS unsigned char* lds, unsigned char* ws, const ConvArgs& a, int q, int vcu, int G, int part, int g) {
    const int tid = opaque_tid(), lane = tid & 63, wave = tid >> 6;
    LAS float* scr = (LAS float*)(lds + wave * 16384);
    const int gw = vcu * NWAVES + wave, ngw = G * NWAVES;
    const int L = q >> 2, k = q & 3; const bool fox = (L & 1) == 0;
    const float* src; bf16* dst; int K, N;
    conv_pick(ws, a, q, src, dst, K, N);
    const int cnt = ((K / 64) * ((N + 127) / 128) + ngw - 1) / ngw, cut = (g * cnt + 1) / 3;
    transpose_matrix(src, K, N, dst, scr, gw, ngw, lane, part == 2 ? cut : 0, part == 1 ? cut : cnt);
    if (k == 0 && fox && (part == 0 || (part == 1) == (g >= 2))) {
        const size_t n16 = (size_t)(FOX_INP - FOX_IN) * DM * 2 / 16; v4u zz = {0u, 0u, 0u, 0u}; asm volatile("" : "+v"(zz));
        for (size_t i = (size_t)(vcu * 512 + tid); i < n16; i += (size_t)G * 512) { const int kt = (int)(i / (224 * 8)), rem = (int)(i % (224 * 8)), nl = 32 + (rem >> 3), c = rem & 7;
            *(v4u*)(dst + tiled_off_w((size_t)(16384 + nl), 64 * kt + 8 * c, DM >> 6)) = zz; } }
    __syncthreads();
}
__device__ __forceinline__ void conv_tiles(LAS unsigned char* lds, unsigned char* ws, const ConvArgs& a, int q, int vcu, int G, int i_lo, int i_hi) {
    const int tid = opaque_tid(), lane = tid & 63, wave = tid >> 6;
    LAS float* scr = (LAS float*)(lds + wave * 16384);
    const float* src; bf16* dst; int K, N;
    conv_pick(ws, a, q, src, dst, K, N);
    transpose_matrix(src, K, N, dst, scr, vcu * NWAVES + wave, G * NWAVES, lane, i_lo, i_hi);
    __syncthreads();
}
#ifndef ATT_ALL
#define ATT_ALL 1
#endif
__device__ __forceinline__ void conv_chunk(LAS unsigned char* lds, unsigned char* ws, const ConvArgs& a, int qbase, int c, int vcu, int G) {
    int base = qbase; if (c >= 7) { c -= 7; base += 4; }
    if (c == 0) conv_tiles(lds, ws, a, base, vcu, G, 0, 1);
    else if (c == 7) conv_tiles(lds, ws, a, base + 3, vcu, G, 4, 5);
    else { const int il = 2 * ((c - 1) & 1); conv_tiles(lds, ws, a, base + 1 + ((c - 1) >> 1), vcu, G, il, il + 2); }
}
__device__ __forceinline__ int att_chunks(int qbase, int qend) { const int nm = qend - qbase;
    return nm <= 0 ? 0 : nm <= 4 ? 7 : nm == 8 ? 15 : 12; }
__device__ __forceinline__ void prologue_phase(LAS unsigned char* lds, unsigned char* ws, const ConvArgs& a, const float* lb_logits, int vcu, int G) {
    conv_weights(lds, ws, a, 0, vcu, G, 0, 0);
    const int tid = opaque_tid();
    for (int c = vcu * 512 + tid; c < DM; c += G * 512) {
        float l[4], mx = -1e30f; for (int i = 0; i < 4; ++i) { l[i] = lb_logits[i * DM + c]; mx = fmaxf(mx, l[i]); }
        float s = 0.f; for (int i = 0; i < 4; ++i) { l[i] = expf(l[i] - mx); s += l[i]; }
        float* LB = (float*)(ws + WS_LB); float cum = 0.f; const float p0 = l[0] / s;
        for (int i = 0; i < 4; ++i) { cum += l[i] / s; LB[i * DM + c] = cum - p0; }
    }
}
struct RowRegs { f32x4 v[16]; };
__device__ __forceinline__ int row_of(int sidx) { return ((sidx & 0x700) << 3) | (((sidx >> 11) & 7) << 8) | (sidx & 255); }
__device__ __forceinline__ void row_load(const float* src, int row, int lane, RowRegs& r) {
    const f32x4* xr = (const f32x4*)(src + (size_t)row * DM) + lane;
#pragma unroll
    for (int j = 0; j < 16; ++j) r.v[j] = xr[64 * j];
}
template <bool TO_F32>
__device__ __forceinline__ void rms_row(const RowRegs& r, const f32x4 (&g)[16], void* dst, int row, int lane) {
    float ss = 0.f;
#pragma unroll
    for (int j = 0; j < 16; ++j) ss += (r.v[j].x * r.v[j].x + r.v[j].y * r.v[j].y) + (r.v[j].z * r.v[j].z + r.v[j].w * r.v[j].w);
    const float rstd = rsqrtf(wave_sum(ss, lane) * (1.f / DM) + NORM_EPS);
#pragma unroll
    for (int j = 0; j < 16; ++j) { const f32x4 o = r.v[j] * rstd * g[j];
        if constexpr (TO_F32) __builtin_nontemporal_store(o, (f32x4*)((float*)dst + (size_t)row * DM) + lane + 64 * j);
        else { v2u w; w.x = cvtpk(o.x, o.y); w.y = cvtpk(o.z, o.w); ((v2u*)((bf16*)dst + (size_t)row * DM) + lane)[64 * j] = w; } }
}
template <bool TO_F32>
__device__ __forceinline__ void rms_phase(const float* src, const float* gain, void* dst, int vcu, int G) {
    const int tid = opaque_tid(), lane = tid & 63, wave = tid >> 6;
    const int gw = vcu * NWAVES + wave, ngw = G * NWAVES;
    f32x4 g[16];
#pragma unroll
    for (int j = 0; j < 16; ++j) g[j] = ((const f32x4*)gain + lane)[64 * j];
    RowRegs ra, rb;
    if (gw < SEQ) row_load(src, row_of(gw), lane, ra);
    for (int row = gw; row < SEQ; row += 2 * ngw) {
        if (row + ngw < SEQ) row_load(src, row_of(row + ngw), lane, rb);
        rms_row<TO_F32>(ra, g, dst, row_of(row), lane);
        if (row + 2 * ngw < SEQ) row_load(src, row_of(row + 2 * ngw), lane, ra);
        if (row + ngw < SEQ) rms_row<TO_F32>(rb, g, dst, row_of(row + ngw), lane);
    }
}
__device__ __forceinline__ void rms0_row(const RowRegs& r, const f32x4 (&g)[16], bf16* dst, float* part, int row, int lane) {
    float ss = 0.f;
#pragma unroll
    for (int j = 0; j < 16; ++j) { const f32x4 v = r.v[j]; ss += (v.x * v.x + v.y * v.y) + (v.z * v.z + v.w * v.w); const f32x4 o = v * g[j];
        v2u w; w.x = cvtpk(o.x, o.y); w.y = cvtpk(o.z, o.w); *(v2u*)(dst + tiled_off((size_t)row, 4 * (lane + 64 * j), DM >> 6)) = w; }
    ss = wave_sum(ss, lane);
    part[(size_t)row * 64 + lane] = lane == 0 ? ss : 0.f;
}
__device__ __forceinline__ void rms0_phase(const float* src, const float* gain, bf16* dst, float* part, int vcu, int G) {
    const int tid = opaque_tid(), lane = tid & 63, wave = tid >> 6;
    const int gw = vcu * NWAVES + wave, ngw = G * NWAVES;
    f32x4 g[16];
#pragma unroll
    for (int j = 0; j < 16; ++j) g[j] = ((const f32x4*)gain + lane)[64 * j];
    RowRegs ra, rb;
    if (gw < SEQ) row_load(src, row_of(gw), lane, ra);
    for (int row = gw; row < SEQ; row += 2 * ngw) {
        if (row + ngw < SEQ) row_load(src, row_of(row + ngw), lane, rb);
        rms0_row(ra, g, dst, part, row_of(row), lane);
        if (row + 2 * ngw < SEQ) row_load(src, row_of(row + 2 * ngw), lane, ra);
        if (row + ngw < SEQ) rms0_row(rb, g, dst, part, row_of(row + ngw), lane);
    }
}
__device__ __forceinline__ void fz_phase(LAS unsigned char* lds, const bf16* XN, const bf16* WF, const float* part, const float* fbias, float* LOGF, float* CS, int vcu, int G) {
    const int tid = opaque_tid(), lane = tid & 63, wave = __builtin_amdgcn_readfirstlane(tid >> 6), r = lane & 15, q = lane >> 4, rt = wave & 3, kh = wave >> 2;
    LAS float* red = (LAS float*)lds;
    LAS float* csw = red + 4 * 8 * 64;
    for (int blk = vcu; blk < SEQ / 64; blk += G) {
        const int row0 = blk * 64 + 16 * rt;
        const size_t khoff = (size_t)kh * 32 * 32768;
        const char* pa = (const char*)(XN + tiled_off((size_t)(row0 + r), 8 * q, DM >> 6)) + khoff;
        const char* px = (const char*)(WF + tiled_off((size_t)(16384 + r), 8 * q, DM >> 6)) + khoff;
        const char* py = (const char*)(WF + tiled_off((size_t)(16384 + 16 + r), 8 * q, DM >> 6)) + khoff;
        f32x4 acc1 = {0.f, 0.f, 0.f, 0.f}, acc2 = {0.f, 0.f, 0.f, 0.f};
        bf16x8 A0[4], X0[4], Y0[4], A1[4], X1[4], Y1[4], A2[4], X2[4], Y2[4];
#define FZ_LOAD(A_, X_, Y_, b_) do { _Pragma("unroll") for (int s_ = 0; s_ < 4; ++s_) { const size_t o_ = (size_t)(2 * (b_) + (s_ >> 1)) * 32768 + (size_t)(s_ & 1) * 1024; \
            A_[s_] = *(const bf16x8*)(pa + o_); X_[s_] = *(const bf16x8*)(px + o_); Y_[s_] = *(const bf16x8*)(py + o_); } } while (0)
#define FZ_MMA(A_, X_, Y_) do { _Pragma("unroll") for (int s_ = 0; s_ < 4; ++s_) { acc1 = __builtin_amdgcn_mfma_f32_16x16x32_bf16(X_[s_], A_[s_], acc1, 0, 0, 0); acc2 = __builtin_amdgcn_mfma_f32_16x16x32_bf16(Y_[s_], A_[s_], acc2, 0, 0, 0); } } while (0)
        FZ_LOAD(A0, X0, Y0, 0); FZ_LOAD(A1, X1, Y1, 1);
#pragma unroll 1
        for (int b = 0; b < 15; b += 3) {
            FZ_LOAD(A2, X2, Y2, b + 2); FZ_MMA(A0, X0, Y0);
            FZ_LOAD(A0, X0, Y0, b + 3); FZ_MMA(A1, X1, Y1);
            if (b + 4 < 16) FZ_LOAD(A1, X1, Y1, b + 4);
            FZ_MMA(A2, X2, Y2);
        }
        FZ_MMA(A0, X0, Y0);
#undef FZ_LOAD
#undef FZ_MMA
        if (kh == 1) {
#pragma unroll
            for (int i = 0; i < 4; ++i) { red[(rt * 8 + i) * 64 + lane] = acc1[i]; red[(rt * 8 + 4 + i) * 64 + lane] = acc2[i]; } }
        __syncthreads();
        if (kh == 0) {
#pragma unroll
            for (int i = 0; i < 4; ++i) { acc1[i] += red[(rt * 8 + i) * 64 + lane]; acc2[i] += red[(rt * 8 + 4 + i) * 64 + lane]; }
            const f32x4* pp = (const f32x4*)(part + (size_t)(row0 + r) * 64 + 16 * q);
            const f32x4 a = (pp[0] + pp[1]) + (pp[2] + pp[3]); float ssq = (a.x + a.y) + (a.z + a.w); ssq += shx(ssq, 16, lane); ssq += shx(ssq, 32, lane);
            const float rs = rsqrtf(ssq * (1.f / DM) + NORM_EPS);
            const f32x4 b0 = *(const f32x4*)(fbias + 8 * q), b1 = *(const f32x4*)(fbias + 8 * q + 4);
            f32x4 v0 = acc1 * rs + b0, v1 = acc2 * rs + b1;
#pragma unroll
            for (int jj = 0; jj < 4; ++jj) { v0[jj] = pg8::lsig(v0[jj]); v1[jj] = pg8::lsig(v1[jj]); }
            float* rowp = LOGF + (size_t)(row0 + r) * 32 + 8 * q; *(f32x4*)rowp = v0; *(f32x4*)(rowp + 4) = v1;
#pragma unroll
            for (int jj = 0; jj < 4; ++jj) {
#pragma unroll
                for (int o = 1; o < 16; o <<= 1) { v0[jj] += shx(v0[jj], o, lane); v1[jj] += shx(v1[jj], o, lane); } }
            if (r == 0) { *(LAS f32x4*)(csw + rt * 32 + 8 * q) = v0; *(LAS f32x4*)(csw + rt * 32 + 8 * q + 4) = v1; }
        }
        __syncthreads();
        if (tid < 32) CS[(size_t)blk * 32 + tid] = (csw[tid] + csw[32 + tid]) + (csw[64 + tid] + csw[96 + tid]);
        __syncthreads();
    }
}
__device__ __forceinline__ void rstd_table(LAS float* tab, const float* part, int pm0) {
    const int tid = opaque_tid(), lane = tid & 63, row = tid >> 1, half = tid & 1;
    const f32x4* p = (const f32x4*)(part + (size_t)(pm0 * 256 + row) * 64 + half * 32); f32x4 a = {0.f, 0.f, 0.f, 0.f};
#pragma unroll
    for (int i = 0; i < 8; ++i) a += p[i];
    float s = (a.x + a.y) + (a.z + a.w); s += shx(s, 1, lane);
    if (half == 0) tab[row] = rsqrtf(s * (1.f / DM) + NORM_EPS);
    __syncthreads();
}
__device__ __forceinline__ void fox_thin_phase(LAS unsigned char* lds, const float* LOGF, const float* CS, float* KB, int vcu, int G) {
    const int tid = opaque_tid(), lane = tid & 63, wave = tid >> 6;
    LAS float* red = (LAS float*)lds;
    LAS float* pre = red + 16 * 32;
    LAS float* tile = pre + 32;
    for (int blk = vcu; blk < SEQ / 64; blk += G) {
        const int r0 = blk * 64;
        { const int h = tid & 31, part = tid >> 5; float a = 0.f;
#pragma unroll 4
          for (int c = part; c < blk; c += 16) a += CS[c * 32 + h];
          red[part * 32 + h] = a; }
        { const int row = tid >> 3, c4 = tid & 7; const f32x4 v = *(const f32x4*)(LOGF + (size_t)(r0 + row) * 32 + 4 * c4);
          tile[row * 33 + 4 * c4 + 0] = v.x; tile[row * 33 + 4 * c4 + 1] = v.y; tile[row * 33 + 4 * c4 + 2] = v.z; tile[row * 33 + 4 * c4 + 3] = v.w; }
        __syncthreads();
        if (tid < 32) { float s = 0.f;
#pragma unroll
            for (int p = 0; p < 16; ++p) s += red[p * 32 + tid];
            float c = s;
            for (int r = 0; r < 64; ++r) { c += tile[r * 33 + tid]; tile[r * 33 + tid] = -c * LOG2E; } }
        __syncthreads();
        { const int h = tid >> 4, r4 = (tid & 15) * 4;
          const f32x4 o = {tile[(r4 + 0) * 33 + h], tile[(r4 + 1) * 33 + h], tile[(r4 + 2) * 33 + h], tile[(r4 + 3) * 33 + h]};
          *(f32x4*)(KB + (size_t)h * SEQ + r0 + r4) = o; }
        __syncthreads();
    }
}
__device__ __forceinline__ void jl_phase(LAS unsigned char* lds, const float* KB, const float* qg, const float* kg, int* JL, int vcu, int G) {
    const int tid = opaque_tid(), lane = tid & 63, wave = tid >> 6;
    LAS int* cnt = (LAS int*)lds;
    float gq = fmaxf(fabsf(qg[lane]), fabsf(qg[lane + 64])), gk = fmaxf(fabsf(kg[lane]), fabsf(kg[lane + 64]));
#pragma unroll
    for (int o = 1; o < 64; o <<= 1) { gq = fmaxf(gq, shx(gq, o, lane)); gk = fmaxf(gk, shx(gk, o, lane)); }
    const float TH = 48.f + 2.f * (128.f * gq * gk * QSCALE * 1.02f);
    for (int id = vcu; id < 2048; id += G) {
        const int h = id & 31, qb = 63 - (id >> 5);
        const float* kb = KB + (size_t)h * SEQ;
        const float lim = kb[qb * 256] - TH;
        const bool pred = (tid < 4 * qb) && (kb[64 * tid + 63] < lim);
        const unsigned long long bal = __ballot(pred);
        if (lane == 0) cnt[wave] = __popcll(bal);
        __syncthreads();
        if (tid == 0) { int s = 0; for (int w = 0; w < 8; ++w) s += cnt[w]; JL[id] = s; }
        __syncthreads();
    }
}
namespace fa {
constexpr int D = 128, NW = 8, QBLK = 32, KVBLK = 64, QB = NW * QBLK;
constexpr int LDQ = 128, LDO = 4096;
constexpr int SHM_V = KVBLK * D * 2, SHM_K = KVBLK * D * 2;
constexpr int OFF_WS = 2 * SHM_V + 2 * SHM_K, OFF_KB = OFF_WS + NW * 64 * 4;
constexpr int LDS_BYTES = OFF_KB + 2 * 64 * 4;
constexpr int OFF_OST = LDS_BYTES + 16 + 112;
constexpr int LDS_END = OFF_OST + NW * 8 * 132 * 4;
#define KSWZ(row, colB) ((row) * 256 + ((colB) ^ (((row) & 7) << 4)))
#define SBAR() __builtin_amdgcn_sched_barrier(0)
__device__ __forceinline__ int v_st(int k, int c) { const int kk = (k & ~0xC) | ((k & 4) << 1) | ((k & 8) >> 1); return ((kk >> 3) * 4 + (c >> 5)) * 512 + ((kk & 7) * 32 + (c & 31)) * 2; }
__device__ __forceinline__ int v_rd_base(int lane) { return ((lane & 3) << 3) | (((lane >> 2) & 3) << 6) | (((lane >> 4) & 1) << 5) | (((lane >> 5) & 1) << 8); }
constexpr int v_rd_off(int d0, int ks, int half) { return d0 * 512 + ks * 4096 + half * 2048; }
__device__ __forceinline__ int crow(int r, int hi) { return (r & 3) + 8 * (r >> 2) + 4 * hi; }
__device__ __forceinline__ bf16x8 ld8(const bf16* p) { return *reinterpret_cast<const bf16x8*>(p); }
__device__ __forceinline__ void mask_tile(f32x16& p0, f32x16& p1, int dq) {
    const float NEG = -__builtin_inff();
#pragma unroll
    for (int r = 0; r < 16; ++r) {
        const int c = (r & 3) + 8 * (r >> 2);
        if (dq - c < 0) p0[r] = NEG;
        if (dq - c - 32 < 0) p1[r] = NEG;
    }
}
__device__ __forceinline__ void partialSM(f32x16& p0, f32x16& p1, float mt) {
#pragma unroll
    for (int r = 0; r < 16; ++r) p0[r] = __builtin_amdgcn_exp2f(p0[r] - mt);
#pragma unroll
    for (int r = 0; r < 16; ++r) p1[r] = p1[r] - mt;
}
__device__ __forceinline__ void finishSM(f32x16& p0, f32x16& p1, float& l_reg, bf16x8& pa0, bf16x8& pa1, bf16x8& pa2, bf16x8& pa3) {
#pragma unroll
    for (int r = 0; r < 16; ++r) p1[r] = __builtin_amdgcn_exp2f(p1[r]);
    float ps = 0;
#pragma unroll
    for (int r = 0; r < 16; ++r) ps += p0[r];
#pragma unroll
    for (int r = 0; r < 16; ++r) ps += p1[r];
    { auto rr = __builtin_amdgcn_permlane32_swap(__float_as_uint(ps), __float_as_uint(ps), false, false);
      ps = __uint_as_float(rr[0]) + __uint_as_float(rr[1]); }
    l_reg += ps;
#define PK4(P, B_, OUT) do { unsigned a0 = cvtpk(P[B_+0], P[B_+1]), a1 = cvtpk(P[B_+2], P[B_+3]);                          \
        unsigned b0 = cvtpk(P[B_+4], P[B_+5]), b1 = cvtpk(P[B_+6], P[B_+7]);                                             \
        auto r0 = __builtin_amdgcn_permlane32_swap(a0, b0, false, false); auto r1 = __builtin_amdgcn_permlane32_swap(a1, b1, false, false); \
        v4u w = {r0[0], r1[0], r0[1], r1[1]}; OUT = *reinterpret_cast<bf16x8*>(&w); } while (0)
    PK4(p0, 0, pa0); PK4(p0, 8, pa1); PK4(p1, 0, pa2); PK4(p1, 8, pa3);
#undef PK4
}
template <int KB>
__device__ __forceinline__ void qkt(f32x16& p0, f32x16& p1, const char* K_lds, const float* kbl, int r32, int hi, const bf16x8* qr) {
#ifdef X_NOBIAS
    p0 = f32x16{}; p1 = f32x16{};
#else
    { const float* kb = kbl + KB * 64 + 4 * hi;
      const f32x4 a0 = *(const f32x4*)(kb), a1 = *(const f32x4*)(kb + 8), a2 = *(const f32x4*)(kb + 16), a3 = *(const f32x4*)(kb + 24);
      const f32x4 b0 = *(const f32x4*)(kb + 32), b1 = *(const f32x4*)(kb + 40), b2 = *(const f32x4*)(kb + 48), b3 = *(const f32x4*)(kb + 56);
      p0 = f32x16{a0[0], a0[1], a0[2], a0[3], a1[0], a1[1], a1[2], a1[3], a2[0], a2[1], a2[2], a2[3], a3[0], a3[1], a3[2], a3[3]};
      p1 = f32x16{b0[0], b0[1], b0[2], b0[3], b1[0], b1[1], b1[2], b1[3], b2[0], b2[1], b2[2], b2[3], b3[0], b3[1], b3[2], b3[3]}; }
#endif
    const char* kb4[4];
#pragma unroll
    for (int dd = 0; dd < 4; ++dd) kb4[dd] = K_lds + KB * SHM_K + KSWZ(r32, (dd * 16 + hi * 8) * 2);
#pragma unroll
    for (int d0 = 0; d0 < 8; ++d0) { const char* a = kb4[d0 & 3] + (d0 >> 2) * 128;
        bf16x8 b0 = *reinterpret_cast<const bf16x8*>(a);
        bf16x8 b1 = *reinterpret_cast<const bf16x8*>(a + 32 * 256);
        p0 = __builtin_amdgcn_mfma_f32_32x32x16_bf16(b0, qr[d0], p0, 0, 0, 0);
        p1 = __builtin_amdgcn_mfma_f32_32x32x16_bf16(b1, qr[d0], p1, 0, 0, 0); }
}
template <int VB>
__device__ __forceinline__ void pv_tile(f32x16* o, int vb0, bf16x8 pa0, bf16x8 pa1, bf16x8 pa2, bf16x8 pa3) {
#define TRRD(dst, off) asm volatile("ds_read_b64_tr_b16 %0, %1 offset:%2" : "=&v"(dst) : "v"(vb0), "i"(off) : "memory")
#define PV_D0(d0) do { s16x4 l0, l1, l2, l3, h0, h1, h2, h3; constexpr int b_ = VB * SHM_V + v_rd_off(d0, 0, 0); \
        TRRD(l0, b_); TRRD(h0, b_ + 2048); TRRD(l1, b_ + 4096); TRRD(h1, b_ + 6144); TRRD(l2, b_ + 8192); TRRD(h2, b_ + 10240); TRRD(l3, b_ + 12288); TRRD(h3, b_ + 14336); \
        asm volatile("s_waitcnt lgkmcnt(0)" ::: "memory"); SBAR();   \
        o[d0] = __builtin_amdgcn_mfma_f32_32x32x16_bf16(pa0, (bf16x8){l0[0], l0[1], l0[2], l0[3], h0[0], h0[1], h0[2], h0[3]}, o[d0], 0, 0, 0);   \
        o[d0] = __builtin_amdgcn_mfma_f32_32x32x16_bf16(pa1, (bf16x8){l1[0], l1[1], l1[2], l1[3], h1[0], h1[1], h1[2], h1[3]}, o[d0], 0, 0, 0);   \
        o[d0] = __builtin_amdgcn_mfma_f32_32x32x16_bf16(pa2, (bf16x8){l2[0], l2[1], l2[2], l2[3], h2[0], h2[1], h2[2], h2[3]}, o[d0], 0, 0, 0);   \
        o[d0] = __builtin_amdgcn_mfma_f32_32x32x16_bf16(pa3, (bf16x8){l3[0], l3[1], l3[2], l3[3], h3[0], h3[1], h3[2], h3[3]}, o[d0], 0, 0, 0); } while (0)
    PV_D0(0); PV_D0(1); PV_D0(2); PV_D0(3);
#undef PV_D0
#undef TRRD
}
struct BlockRef { const bf16* Q; const bf16* K; const bf16* V; const float* KBp; const bf16* G; bf16* O; int P0; int j0; int hcol; };
struct Seam { bf16x8 qr[8]; bf16x8 st_v0, st_v1, st_k0, st_k1; float st_b; };
#define ROWP(p, k0, rr) ((const char*)(p) + (size_t)((k0) + (rr)) * (LDQ * 2))
#define LD8V(base, off) (*reinterpret_cast<const bf16x8*>((base) + (off)))
#define VMW() asm volatile("s_waitcnt vmcnt(0)" ::: "memory")
#define VMWN(n) asm volatile("s_waitcnt vmcnt(%0)" :: "i"(n) : "memory")
#define SLOAD_H(Kp, Vp, Bp, k0) do { S.st_v0 = LD8V(ROWP(Vp, k0, 0), voff); S.st_v1 = LD8V(ROWP(Vp, k0, 32), voff);              \
                         S.st_k0 = LD8V(ROWP(Kp, k0, 0), voff); S.st_k1 = LD8V(ROWP(Kp, k0, 32), voff); \
                         if (tid < 64) S.st_b = *(const float*)((const char*)((Bp) + (k0)) + (unsigned)(tid * 4)); } while (0)
#define SWRITE_HK(bf) do { *(bf16x8*)(K_lds + (bf) * SHM_K + kws) = S.st_k0; *(bf16x8*)(K_lds + (bf) * SHM_K + kws + 32 * 256) = S.st_k1; if (tid < 64) kbl[(bf) * 64 + tid] = S.st_b; } while (0)
#define SWRITE_HV(bf) do { *(bf16x8*)(V_lds + (bf) * SHM_V + vst0) = S.st_v0; *(bf16x8*)(V_lds + (bf) * SHM_V + vst1) = S.st_v1; } while (0)
#define SWRITE_H(bf) do { SWRITE_HV(bf); SWRITE_HK(bf); } while (0)
__device__ __forceinline__ void fox_prime(const BlockRef& cur, char* lds, Seam& S) {
    const int tid = opaque_tid(), wid = __builtin_amdgcn_readfirstlane(tid >> 6), lane = tid & 63, r32 = lane & 31, hi = lane >> 5;
    const int sr = tid >> 4, sc = (tid & 15) * 8, kws = KSWZ(sr, sc * 2); char* K_lds = lds + 2 * SHM_V; float* kbl = (float*)(lds + OFF_KB);
    const unsigned voff = (unsigned)(sr * LDQ + sc) * 2u, qoff = (unsigned)(r32 * LDQ + hi * 8) * 2u;
    { const char* qb_ = (const char*)(cur.Q + (size_t)(wid * QBLK) * LDQ);
#pragma unroll
      for (int d0 = 0; d0 < 8; ++d0) S.qr[d0] = LD8V(qb_ + d0 * 32, qoff); }
    SLOAD_H(cur.K, cur.V, cur.KBp, cur.j0 * KVBLK); VMW(); SWRITE_HK(0);
    __syncthreads();
}
__device__ __forceinline__ void fox_block(const BlockRef& cur, const BlockRef& nxt, char* lds, Seam& S, float Bq) {
    const int tid = opaque_tid(), wid = __builtin_amdgcn_readfirstlane(tid >> 6), lane = tid & 63, r32 = lane & 31, hi = lane >> 5;
    const int j_lo = cur.j0, NT = (cur.P0 + QB - 1) / KVBLK + 1 - j_lo;
    const int qlo = cur.P0 + wid * QBLK, qm = qlo + r32 - 4 * hi;
    char* V_lds = lds; char* K_lds = lds + 2 * SHM_V; float* kbl = (float*)(lds + OFF_KB);
    float* ws = (float*)(lds + OFF_WS) + wid * 64; float* li_l = ws;
    float l_reg = 0; f32x16 o[4] = {};
    const float mt = cur.KBp[qlo + r32] + Bq;
    const int sr = tid >> 4, sc = (tid & 15) * 8, vst0 = v_st(sr, sc), vst1 = v_st(32 + sr, sc), kws = KSWZ(sr, sc * 2);
    const unsigned voff = (unsigned)(sr * LDQ + sc) * 2u;
    const int vb0 = (int)(uintptr_t)V_lds + v_rd_base(lane);
    const bf16* Kh = cur.K; const bf16* Vh = cur.V; const float* Bh = cur.KBp;
#define KBASE(t) ((j_lo + (t)) * KVBLK)
#define MASKT(P0_, P1_, t) do { const int kb_ = KBASE(t); if (kb_ + KVBLK - 1 > qlo) mask_tile(P0_, P1_, qm - kb_); } while (0)
    constexpr int NQL = 8;
#define SEAM_K0() do { VMWN(NQL); SWRITE_HK(0); SBAR(); } while (0)
    f32x16 pA0, pA1, pB0, pB1; bf16x8 pa0, pa1, pa2, pa3;
    SWRITE_HV(0); SBAR();
    if (NT > 1) { SLOAD_H(Kh, Vh, Bh, KBASE(1)); }
    SBAR(); qkt<0>(pA0, pA1, K_lds, kbl, r32, hi, S.qr);
    MASKT(pA0, pA1, 0); partialSM(pA0, pA1, mt);
    if (NT > 1) { VMW(); SWRITE_H(1); }
    __syncthreads();
#define HALF_STEP(PX0, PX1, PY0, PY1, t, KB, VB, SB) do {                                                      \
        if ((t) + 1 < NT) { SLOAD_H(Kh, Vh, Bh, KBASE((t) + 1)); }        \
        SBAR(); qkt<KB>(PX0, PX1, K_lds, kbl, r32, hi, S.qr);                                             \
        finishSM(PY0, PY1, l_reg, pa0, pa1, pa2, pa3); SBAR();                                                           \
        pv_tile<VB>(o, vb0, pa0, pa1, pa2, pa3); MASKT(PX0, PX1, (t)); partialSM(PX0, PX1, mt);                                        \
        __syncthreads();                                                                                                      \
        if ((t) + 1 < NT) { VMW(); SWRITE_H(SB); }                                                                          \
        __syncthreads(); } while (0)
    for (int t = 1; t + 1 < NT; t += 2) {
        HALF_STEP(pB0, pB1, pA0, pA1, t, 1, 0, 0);
        HALF_STEP(pA0, pA1, pB0, pB1, t + 1, 0, 1, 1);
    }
    const bool even = (NT & 1) == 0;
    if (even) { SBAR(); qkt<1>(pB0, pB1, K_lds, kbl, r32, hi, S.qr); SBAR(); }
    SLOAD_H(nxt.K, nxt.V, nxt.KBp, nxt.j0 * KVBLK); SBAR();
    { const int l2 = opaque_tid() & 63; const unsigned qoff = (unsigned)((l2 & 31) * LDQ + (l2 >> 5) * 8) * 2u;
      const char* qb_ = (const char*)(nxt.Q + (size_t)(wid * QBLK) * LDQ);
#pragma unroll
      for (int d0 = 0; d0 < 8; ++d0) S.qr[d0] = LD8V(qb_ + d0 * 32, qoff); }
    SBAR();
    finishSM(pA0, pA1, l_reg, pa0, pa1, pa2, pa3); SBAR();
    pv_tile<0>(o, vb0, pa0, pa1, pa2, pa3);
    if (even) { MASKT(pB0, pB1, NT - 1); partialSM(pB0, pB1, mt); __syncthreads();
        finishSM(pB0, pB1, l_reg, pa0, pa1, pa2, pa3); SBAR(); pv_tile<1>(o, vb0, pa0, pa1, pa2, pa3); }
    SBAR(); SEAM_K0();
    if (hi == 0) li_l[r32] = l_reg; asm volatile("s_waitcnt lgkmcnt(0)" ::: "memory");
    { const int l3 = opaque_tid() & 63, er = l3 >> 4, ec = l3 & 15;
      const bf16* Gp = cur.G + (size_t)(wid * QBLK + er) * LDQ + 8 * ec;
      bf16* Op = cur.O; const size_t orow0 = (size_t)(cur.P0 + wid * QBLK + er); const int ocol = cur.hcol + 8 * ec;
      v4u gt[4][2];
#pragma unroll
      for (int ps = 0; ps < 4; ++ps)
#pragma unroll
          for (int k = 0; k < 2; ++k) gt[ps][k] = *(const v4u*)(Gp + (size_t)(8 * ps + 4 * k) * LDQ);
      float* ost = (float*)(lds + OFF_OST) + wid * (8 * 132);
      const int wofs = (4 * (l3 >> 5)) * 132 + (l3 & 31);
#pragma unroll
      for (int ps = 0; ps < 4; ++ps) {
#pragma unroll
          for (int rr = 0; rr < 4; ++rr) { const int r = 4 * ps + rr; const float rl = __builtin_amdgcn_rcpf(li_l[crow(r, hi)]);
#pragma unroll
              for (int d0 = 0; d0 < 4; ++d0) ost[wofs + rr * 132 + d0 * 32] = o[d0][r] * rl; }
          asm volatile("s_waitcnt lgkmcnt(0)" ::: "memory");
#pragma unroll
          for (int k = 0; k < 2; ++k) { const float* sp = ost + (er + 4 * k) * 132 + 8 * ec; const f32x4 x0 = *(const f32x4*)sp, x1 = *(const f32x4*)(sp + 4); const v4u g = gt[ps][k];
              v4u w; w.x = cvtpk(x0[0] * bflo(g.x), x0[1] * bfhi(g.x)); w.y = cvtpk(x0[2] * bflo(g.y), x0[3] * bfhi(g.y)); w.z = cvtpk(x1[0] * bflo(g.z), x1[1] * bfhi(g.z)); w.w = cvtpk(x1[2] * bflo(g.w), x1[3] * bfhi(g.w));
              *(v4u*)(Op + tiled_off(orow0 + 8 * ps + 4 * k, ocol, LDO >> 6)) = w; }
          asm volatile("s_waitcnt lgkmcnt(0)" ::: "memory"); } }
    __syncthreads();
#undef KBASE
#undef MASKT
#undef SEAM_K0
#undef HALF_STEP
}
__device__ __forceinline__ void fox_rewrite_k0(char* lds, const Seam& S) {
    const int tid = opaque_tid(); const int sr = tid >> 4, sc = (tid & 15) * 8, kws = KSWZ(sr, sc * 2); char* K_lds = lds + 2 * SHM_V; float* kbl = (float*)(lds + OFF_KB);
    SWRITE_HK(0); __syncthreads();
}
#undef ROWP
#undef LD8V
#undef VMWN
#undef SLOAD_H
#undef SWRITE_HK
#undef SWRITE_HV
#undef SWRITE_H
__device__ __forceinline__ BlockRef mk_ref(const bf16* PROJ, const float* KBg, bf16* MO, const int* JL, int id) {
    const int bh = id & 31, qb = 63 - (id >> 5);
    BlockRef r; r.Q = PROJ + ((size_t)bh * SEQ + qb * QB) * D; r.K = PROJ + ((size_t)(32 + bh) * SEQ) * D; r.V = PROJ + ((size_t)(64 + bh) * SEQ) * D; r.KBp = KBg + (size_t)bh * SEQ;
    r.G = PROJ + ((size_t)(96 + bh) * SEQ + qb * QB) * D; r.O = MO; r.hcol = bh * D; r.P0 = qb * QB; r.j0 = JL[id]; return r;
}
__device__ __forceinline__ void attn_phase(char* lds, const bf16* PROJ, const float* KBg, bf16* MO, const int* JL, unsigned* qctr, const float* qg, const float* kg, unsigned char* ws, const ConvArgs& ca, int qbase, int qend, int vcu, int G) {
    constexpr int total = 32 * 64;
    const int tid = opaque_tid();
    float Bq;
    { const int l_ = tid & 63; float gq = fmaxf(fabsf(qg[l_]), fabsf(qg[l_ + 64])), gk = fmaxf(fabsf(kg[l_]), fabsf(kg[l_ + 64]));
#pragma unroll
      for (int o_ = 1; o_ < 64; o_ <<= 1) { gq = fmaxf(gq, shx(gq, o_, l_)); gk = fmaxf(gk, shx(gk, o_, l_)); }
      Bq = 128.f * gq * gk * QSCALE * 1.02f; }
    volatile int* slot = (volatile int*)(lds + LDS_BYTES);
    if (tid == 0) slot[0] = (int)__hip_atomic_fetch_add((GAS unsigned*)qctr, 1u, __ATOMIC_RELAXED, __HIP_MEMORY_SCOPE_AGENT);
    __syncthreads();
    int id = __builtin_amdgcn_readfirstlane(slot[0]);
    const int nchunks = att_chunks(qbase, qend);
    int cc = 0;
    if (id < total) {
        BlockRef cur = mk_ref(PROJ, KBg, MO, JL, id);
        Seam S;
        fox_prime(cur, lds, S);
        for (;;) {
            if (tid == 0) slot[1] = (int)__hip_atomic_fetch_add((GAS unsigned*)qctr, 1u, __ATOMIC_RELAXED, __HIP_MEMORY_SCOPE_AGENT);
            __syncthreads();
            const int idn = __builtin_amdgcn_readfirstlane(slot[1]);
            const bool last = idn >= total;
            const BlockRef nxt = last ? cur : mk_ref(PROJ, KBg, MO, JL, idn);
            fox_block(cur, nxt, lds, S, Bq);
            if (last) break;
            cur = nxt;
            if (cc < nchunks) { __syncthreads(); conv_chunk((LAS unsigned char*)lds, ws, ca, qbase, cc, vcu, G); ++cc; if (nchunks > 7 && cc < nchunks) { conv_chunk((LAS unsigned char*)lds, ws, ca, qbase, cc, vcu, G); ++cc; } fox_rewrite_k0(lds, S); }
        }
    }
    __syncthreads();
#pragma unroll 1
    for (; cc < nchunks; ++cc) conv_chunk((LAS unsigned char*)lds, ws, ca, qbase, cc, vcu, G);
}
#undef VMW
}
namespace hg {
constexpr int CH = 64, NCH = SEQ / CH;
constexpr size_t AOFF = (size_t)32 * SEQ * DH / 2;
constexpr int PK = 144;
constexpr int PQ = 272;
__device__ __forceinline__ f32x4 mma(bf16x8 bfrag, bf16x8 afrag, f32x4 acc) { return __builtin_amdgcn_mfma_f32_16x16x32_bf16(bfrag, afrag, acc, 0, 0, 0); }
__device__ __forceinline__ bf16x8 ldsfrag(const LAS unsigned char* base, int row, int pitch, int kbyte) { return *(const LAS bf16x8*)(base + row * pitch + kbyte); }

__device__ __forceinline__ int hg_units(int vcu, int G) { return G == 256 ? 32 : (vcu < NCH * NH ? (NCH * NH - 1 - vcu) / G + 1 : 0); }
__device__ __forceinline__ int hg_unit(int vcu, int G, int i) { return G == 256 ? (((32 * (vcu >> 5) + 31 - i) << 5) | (vcu & 31)) : NCH * NH - 1 - (vcu + i * G); }
typedef float f32x2 __attribute__((ext_vector_type(2)));
typedef _Float16 f16x2 __attribute__((ext_vector_type(2)));
__device__ __forceinline__ float ex2(float x) { return __builtin_amdgcn_exp2f(x); }
__device__ __forceinline__ unsigned ldg2(const _Float16* p) { return *(const unsigned*)p; }
__device__ __forceinline__ f32x2 h2f(unsigned w) { const f16x2 h = __builtin_bit_cast(f16x2, w); return (f32x2){(float)h[0], (float)h[1]}; }
__device__ __forceinline__ void b1_phase(LAS unsigned char* lds, const bf16* PROJ, const _Float16* Gg, bf16* UT, float* DEC, int vcu, int G) {
    const int tid = opaque_tid(), lane = tid & 63, wave = __builtin_amdgcn_readfirstlane(tid >> 6), cp = tid & 63, seg = wave, r = lane & 15, q = lane >> 4;
    LAS unsigned char* KT = lds;
    LAS unsigned char* VT = lds + 128 * PK;
    LAS float* segtot = (LAS float*)(lds + 2 * 128 * PK);
    unsigned nb[8], nk[8], nv[8];
#define B1_LOAD(u_) do { const int c_ = (u_) >> 5, h_ = (u_) & 31; const int rw_ = c_ * CH + 8 * seg; \
        _Pragma("unroll") for (int j = 0; j < 8; ++j) { nb[j] = ldg2(Gg + ((size_t)h_ * SEQ + rw_ + j) * DH + 2 * cp); const unsigned* p_ = (const unsigned*)(PROJ + (((size_t)32 + h_) * SEQ + rw_ + j) * DH + 2 * cp); nk[j] = p_[0]; nv[j] = p_[AOFF]; } } while (0)
    const int nun = hg_units(vcu, G);
    if (nun > 0) B1_LOAD(hg_unit(vcu, G, 0));
    for (int iu = 0; iu < nun; ++iu) {
        const int u = hg_unit(vcu, G, iu);
        f32x2 b[8]; unsigned kk[8], vv[8];
#pragma unroll
        for (int j = 0; j < 8; ++j) { b[j] = h2f(nb[j]); kk[j] = nk[j]; vv[j] = nv[j]; }
#pragma unroll
        for (int j = 1; j < 8; ++j) b[j] += b[j - 1];
        *(LAS f32x2*)(segtot + seg * 128 + 2 * cp) = b[7];
        __syncthreads();
        f32x2 off = {0.f, 0.f}, total = {0.f, 0.f};
#pragma unroll
        for (int s2 = 0; s2 < 8; ++s2) { const f32x2 t = *(const LAS f32x2*)(segtot + s2 * 128 + 2 * cp); total += t; if (s2 < seg) off += t; }
        const f32x2 rem = total - off;
        unsigned k0w[4], k1w[4], v0w[4], v1w[4];
#pragma unroll
        for (int i = 0; i < 4; ++i) { const int ja = 2 * i, jb = 2 * i + 1;
            k0w[i] = cvtpk(bflo(kk[ja]) * ex2(rem.x - b[ja].x), bflo(kk[jb]) * ex2(rem.x - b[jb].x)); k1w[i] = cvtpk(bfhi(kk[ja]) * ex2(rem.y - b[ja].y), bfhi(kk[jb]) * ex2(rem.y - b[jb].y));
            v0w[i] = (vv[ja] & 0xffffu) | (vv[jb] << 16); v1w[i] = (vv[ja] >> 16) | (vv[jb] & 0xffff0000u); }
        *(LAS v4u*)(KT + (2 * cp) * PK + 16 * seg) = (v4u){k0w[0], k0w[1], k0w[2], k0w[3]}; *(LAS v4u*)(KT + (2 * cp + 1) * PK + 16 * seg) = (v4u){k1w[0], k1w[1], k1w[2], k1w[3]};
        *(LAS v4u*)(VT + (2 * cp) * PK + 16 * seg) = (v4u){v0w[0], v0w[1], v0w[2], v0w[3]}; *(LAS v4u*)(VT + (2 * cp + 1) * PK + 16 * seg) = (v4u){v1w[0], v1w[1], v1w[2], v1w[3]};
        if (seg == 0) *(f32x2*)(DEC + (size_t)u * 128 + 2 * cp) = (f32x2){ex2(total.x), ex2(total.y)};
        if (iu + 1 < nun) B1_LOAD(hg_unit(vcu, G, iu + 1));
        __syncthreads();
        const bf16x8 a0 = ldsfrag(VT, 16 * wave + r, PK, 16 * q), a1 = ldsfrag(VT, 16 * wave + r, PK, 64 + 16 * q);
        bf16* up = UT + ((size_t)u * 128 + 16 * wave + r) * 128 + 4 * q;
#pragma unroll
        for (int nt = 0; nt < 8; ++nt) { f32x4 acc = {0.f, 0.f, 0.f, 0.f};
            acc = mma(ldsfrag(KT, 16 * nt + r, PK, 16 * q), a0, acc); acc = mma(ldsfrag(KT, 16 * nt + r, PK, 64 + 16 * q), a1, acc);
            v2u w; w.x = cvtpk(acc[0], acc[1]); w.y = cvtpk(acc[2], acc[3]); *(v2u*)(up + 16 * nt) = w; }
    }
#undef B1_LOAD
}
__device__ __forceinline__ void b2_phase(const bf16* UT, const float* DEC, bf16* ST, int vcu, int G) {
    constexpr int BT = 8;
    for (int gid = vcu * 512 + opaque_tid(); gid < NH * 128 * 32; gid += G * 512) {
        const int h = gid >> 12, dv = (gid >> 5) & 127, dk4 = (gid & 31) * 4;
        f32x4 st = {0.f, 0.f, 0.f, 0.f};
        const size_t eo = ((size_t)h * 128 + dv) * 128 + dk4, estep = (size_t)NH * 128 * 128;
        const size_t dofs = (size_t)h * 128 + dk4, dstep = (size_t)NH * 128;
        v2u uwa[BT], uwb[BT]; f32x4 dda[BT], ddb[BT];
#define B2_LOAD(uw_, dd_, c0_) do { _Pragma("unroll") for (int i = 0; i < BT; ++i) { uw_[i] = *(const v2u*)(UT + eo + (size_t)((c0_) + i) * estep); dd_[i] = *(const f32x4*)(DEC + dofs + (size_t)((c0_) + i) * dstep); } } while (0)
#define B2_RUN(uw_, dd_, c0_) do { _Pragma("unroll") for (int i = 0; i < BT; ++i) { const f32x4 uu = {bflo(uw_[i].x), bfhi(uw_[i].x), bflo(uw_[i].y), bfhi(uw_[i].y)}; \
            v2u w; w.x = cvtpk(st.x, st.y); w.y = cvtpk(st.z, st.w); *(v2u*)(ST + eo + (size_t)((c0_) + i) * estep) = w; st = dd_[i] * st + uu; } } while (0)
        B2_LOAD(uwa, dda, 0);
        for (int c = 0; c < NCH; c += 2 * BT) {
            B2_LOAD(uwb, ddb, c + BT);
            B2_RUN(uwa, dda, c);
            if (c + 2 * BT < NCH) B2_LOAD(uwa, dda, c + 2 * BT);
            B2_RUN(uwb, ddb, c + BT);
        }
#undef B2_LOAD
#undef B2_RUN
    }
}
constexpr int B3_QT = 0, B3_QH = B3_QT + 64 * PQ, B3_KH = B3_QH + 64 * PQ  , B3_VT = B3_KH + 160 * PQ, B3_P = B3_VT + 128 * PK, B3_SEG = B3_P + 64 * PK, B3_RS = B3_SEG + 4096, B3_END = B3_RS + 512;
__device__ __forceinline__ int kh_base(int I) { return 16 * (I * (I + 1) / 2); }
__device__ __forceinline__ void b3_phase(LAS unsigned char* lds, const bf16* PROJ, const _Float16* Gg, const bf16* ST, const float* ogain, bf16* MO, int vcu, int G) {
    const int tid = opaque_tid(), lane = tid & 63, wave = __builtin_amdgcn_readfirstlane(tid >> 6), cp = tid & 63, seg = wave, r = lane & 15, q = lane >> 4;
    LAS unsigned char* QT = lds + B3_QT; LAS unsigned char* QH = lds + B3_QH; LAS unsigned char* KH = lds + B3_KH; LAS unsigned char* VT = lds + B3_VT; LAS unsigned char* PP = lds + B3_P;
    LAS float* segtot = (LAS float*)(lds + B3_SEG); LAS float* rs = (LAS float*)(lds + B3_RS);
    unsigned nb[8], nq[8], nk[8], nv[8];
#define B3_LOAD(u_) do { const int c_ = (u_) >> 5, h_ = (u_) & 31; const int rw_ = c_ * CH + 8 * seg; \
        _Pragma("unroll") for (int j = 0; j < 8; ++j) { nb[j] = ldg2(Gg + ((size_t)h_ * SEQ + rw_ + j) * DH + 2 * cp); const unsigned* p_ = (const unsigned*)(PROJ + ((size_t)h_ * SEQ + rw_ + j) * DH + 2 * cp); nq[j] = p_[0]; nk[j] = p_[AOFF]; nv[j] = p_[2 * AOFF]; } } while (0)
    f32x4 og[4];
#pragma unroll
    for (int nt = 0; nt < 4; ++nt) og[nt] = *(const f32x4*)(ogain + 64 * (wave >> 2) + 16 * nt + 4 * q);
    const int nun = hg_units(vcu, G);
    if (nun > 0) B3_LOAD(hg_unit(vcu, G, 0));
    for (int iu = 0; iu < nun; ++iu) {
        const int u = hg_unit(vcu, G, iu);
        const int c = u >> 5, h = u & 31;
        const int mt = wave & 3, nh = wave >> 2;
        const size_t orow = (size_t)(c * CH + 16 * mt + r);
        v2u gtv[4];
#pragma unroll
        for (int nt = 0; nt < 4; ++nt) gtv[nt] = *(const v2u*)(PROJ + (((size_t)96 + h) * SEQ + orow) * DH + 64 * nh + 16 * nt + 4 * q);
        f32x2 b[8]; unsigned qq[8], kk[8], vv[8];
#pragma unroll
        for (int j = 0; j < 8; ++j) { b[j] = h2f(nb[j]); qq[j] = nq[j]; kk[j] = nk[j]; vv[j] = nv[j]; }
#pragma unroll
        for (int j = 1; j < 8; ++j) b[j] += b[j - 1];
        *(LAS f32x2*)(segtot + seg * 128 + 2 * cp) = b[7];
        __syncthreads();
        f32x2 st[8];
#pragma unroll
        for (int s2 = 0; s2 < 8; ++s2) st[s2] = *(const LAS f32x2*)(segtot + s2 * 128 + 2 * cp);
        const int I0 = seg >> 1;
        f32x2 off = {0.f, 0.f};
#pragma unroll
        for (int s2 = 0; s2 < 8; ++s2) if (s2 < seg) off += st[s2];
        f32x2 lsb[8];
        { f32x2 hb = {0.f, 0.f};
#pragma unroll
          for (int s2 = 0; s2 < 8; s2 += 2) if (s2 + 1 == seg) hb = st[s2];
#pragma unroll
          for (int j = 0; j < 8; ++j) lsb[j] = hb + b[j]; }
        f32x2 hbq = off;
#pragma unroll
        for (int s2 = 0; s2 < 8; s2 += 2) if (s2 + 1 == seg) hbq -= st[s2];
        const float eq0 = ex2(hbq.x), eq1 = ex2(hbq.y);
        f32x2 em[8];
#pragma unroll
        for (int j = 0; j < 8; ++j) { const float q0 = bflo(qq[j]), q1 = bfhi(qq[j]); const int row = 8 * seg + j;
            const float h0 = q0 * ex2(lsb[j].x), h1 = q1 * ex2(lsb[j].y); em[j] = (f32x2){ex2(-lsb[j].x), ex2(-lsb[j].y)};
            *(LAS unsigned*)(QT + row * PQ + 4 * cp) = cvtpk(h0 * eq0, h1 * eq1);
            *(LAS unsigned*)(QH + row * PQ + 4 * cp) = cvtpk(h0, h1); }
        { f32x2 d = {0.f, 0.f};
#pragma unroll
          for (int I = 0; I < 4; ++I) { if (I >= I0) {
                const float ed0 = ex2(d.x), ed1 = ex2(d.y);
#pragma unroll
                for (int j = 0; j < 8; ++j) *(LAS unsigned*)(KH + (kh_base(I) + 8 * seg + j) * PQ + 4 * cp) = cvtpk(bflo(kk[j]) * em[j].x * ed0, bfhi(kk[j]) * em[j].y * ed1);
                d += st[2 * I] + st[2 * I + 1]; } } }
        { unsigned v0w[4], v1w[4];
#pragma unroll
          for (int i = 0; i < 4; ++i) { const int ja = 2 * i, jb = 2 * i + 1; v0w[i] = (vv[ja] & 0xffffu) | (vv[jb] << 16); v1w[i] = (vv[ja] >> 16) | (vv[jb] & 0xffff0000u); }
          *(LAS v4u*)(VT + (2 * cp) * PK + 16 * seg) = (v4u){v0w[0], v0w[1], v0w[2], v0w[3]}; *(LAS v4u*)(VT + (2 * cp + 1) * PK + 16 * seg) = (v4u){v1w[0], v1w[1], v1w[2], v1w[3]}; }
        bf16x8 sf[4][4];
        { const bf16* stp = ST + ((size_t)u * 128 + 64 * nh + r) * 128 + 8 * q;
#pragma unroll
          for (int nt = 0; nt < 4; ++nt)
#pragma unroll
              for (int ks = 0; ks < 4; ++ks) sf[nt][ks] = *(const bf16x8*)(stp + (size_t)(16 * nt) * 128 + 32 * ks); }
        if (iu + 1 < nun) B3_LOAD(hg_unit(vcu, G, iu + 1));
        __syncthreads();
#pragma unroll
        for (int tt = 0; tt < 2; ++tt) { const int tile = wave * 2 + tt, I = tile >> 2, J = tile & 3;
            f32x4 acc = {0.f, 0.f, 0.f, 0.f};
            if (J <= I) {
#pragma unroll
                for (int ks = 0; ks < 4; ++ks) acc = mma(ldsfrag(KH, kh_base(I) + 16 * J + r, PQ, 64 * ks + 16 * q), ldsfrag(QH, 16 * I + r, PQ, 64 * ks + 16 * q), acc);
                if (J == I) {
#pragma unroll
                    for (int i = 0; i < 4; ++i) if (4 * q + i > r) acc[i] = 0.f; }
            }
            v2u w; w.x = cvtpk(acc[0], acc[1]); w.y = cvtpk(acc[2], acc[3]);
            *(LAS v2u*)(PP + (16 * I + r) * PK + (16 * J + 4 * q) * 2) = w; }
        __syncthreads();
        f32x4 acc[4];
        const bf16x8 pa0 = ldsfrag(PP, 16 * mt + r, PK, 16 * q), pa1 = ldsfrag(PP, 16 * mt + r, PK, 64 + 16 * q);
        bf16x8 qa[4];
#pragma unroll
        for (int ks = 0; ks < 4; ++ks) qa[ks] = ldsfrag(QT, 16 * mt + r, PQ, 64 * ks + 16 * q);
#pragma unroll
        for (int nt = 0; nt < 4; ++nt) { f32x4 a = {0.f, 0.f, 0.f, 0.f};
            a = mma(ldsfrag(VT, 64 * nh + 16 * nt + r, PK, 16 * q), pa0, a); a = mma(ldsfrag(VT, 64 * nh + 16 * nt + r, PK, 64 + 16 * q), pa1, a);
#pragma unroll
            for (int ks = 0; ks < 4; ++ks) a = mma(sf[nt][ks], qa[ks], a);
            acc[nt] = a; }
        float ss = 0.f;
#pragma unroll
        for (int nt = 0; nt < 4; ++nt) ss += (acc[nt][0] * acc[nt][0] + acc[nt][1] * acc[nt][1]) + (acc[nt][2] * acc[nt][2] + acc[nt][3] * acc[nt][3]);
        ss += shx(ss, 16, lane); ss += shx(ss, 32, lane);
        if (q == 0) rs[nh * 64 + 16 * mt + r] = ss;
        __syncthreads();
        const float rstd = rsqrtf((rs[16 * mt + r] + rs[64 + 16 * mt + r]) * (1.f / 128.f) + NORM_EPS);
#pragma unroll
        for (int nt = 0; nt < 4; ++nt) { const int dv = 64 * nh + 16 * nt + 4 * q;
            const f32x4 g = og[nt]; const v2u gt = gtv[nt];
            v2u w; w.x = cvtpk(acc[nt][0] * rstd * g.x * bflo(gt.x), acc[nt][1] * rstd * g.y * bfhi(gt.x)); w.y = cvtpk(acc[nt][2] * rstd * g.z * bflo(gt.y), acc[nt][3] * rstd * g.w * bfhi(gt.y));
            *(v2u*)(MO + tiled_off(orow, h * DH + dv, DM >> 6)) = w; }
    }
#undef B3_LOAD
}
}
constexpr int RING_BYTES = 131072;
constexpr int MISC_OFF = RING_BYTES + 320;
constexpr int LDS_BYTES = 147456;
#ifndef DOWN_WGM
#define DOWN_WGM 2
#endif
constexpr int CW_BAR = 4096;
constexpr int CW_Q = 8192;
static_assert(fa::LDS_END <= RING_BYTES && fa::OFF_OST % 16 == 0 && hg::B3_END <= RING_BYTES, "phase scratch fits the ring region");
static_assert(WS_END <= (size_t)4096 * MiB, "workspace map");

constexpr int PH_FINAL = 49, PH_END = 50;
struct Args { const float* in[15]; float* out; unsigned char* ws; int ph_lo, ph_hi; };
static_assert(sizeof(Args) == 15 * 8 + 8 + 8 + 4 + 4, "Args has no padding bytes");

__global__ void __launch_bounds__(NWAVES * 64, 2) trunk_fwd(Args args) {
    extern __shared__ __attribute__((aligned(16))) unsigned char lds_raw[];
    LAS unsigned char* lds = (LAS unsigned char*)lds_raw;
    volatile LAS unsigned* MISC = (volatile LAS unsigned*)(lds + MISC_OFF);
    const int tid = threadIdx.x;
    const int G = gridDim.x, bx = blockIdx.x;
    const int vcu = (G % 8 == 0) ? (bx % 8) * (G / 8) + bx / 8 : bx;
    for (int u = tid; u < (LDS_BYTES - RING_BYTES) / 4; u += NWAVES * 64) ((LAS unsigned*)(lds + RING_BYTES))[u] = 0u;
    __syncthreads();
    if ((tid & 63) == 0) ((volatile LAS int*)(lds + WAVE_TAB_OFF))[hw_wave_slot()] = tid >> 6;
    __syncthreads();
    const int lo = args.ph_lo, hi = args.ph_hi;
#if MK_PER_PHASE
#define GRID_BAR(p) do { } while (0)
#else
    XcdBarrier bar = xcd_barrier_post((unsigned*)(args.ws + WS_CTL) + CW_BAR, MISC + 8);
    if (tid == 0) ((GAS unsigned*)((unsigned*)(args.ws + WS_CTL) + CW_BAR))[XB_XID + bx] = bar.x + 1u;
#ifndef LOCAL_SEAMS
#define LOCAL_SEAMS 1
#endif
#define LOCAL_BAR(p) do { if ((p) + 1 < hi) { XcdBarrier b_ = bar; asm volatile("" : "+s"(b_.bar), "+s"(b_.x)); if (LOCAL_SEAMS && MISC[10]) xcd_local_barrier(b_); else xcd_barrier(b_); } } while (0)
#define GRID_BAR(p) do { if ((p) + 1 < hi) { XcdBarrier b_ = bar; asm volatile("" : "+s"(b_.bar), "+s"(b_.x)); xcd_barrier(b_); } } while (0)
#endif
#ifndef ONLY_SITE
#define ONLY_SITE -1
#endif
#define EN(s) (ONLY_SITE == -1 || ONLY_SITE == (s))
#ifndef DUP_SITE
#define DUP_SITE -1
#endif
#define DUP(s) (DUP_SITE == (s))
#define IN(k) (lo <= (k) && (k) < hi)
#ifndef STAGGER_US
#define STAGGER_US 0
#endif
#define STAGGER() do { if (STAGGER_US > 0) { const unsigned long long t0_ = __builtin_amdgcn_s_memrealtime(), dl_ = (unsigned long long)(bx & 7) * (STAGGER_US * 100ull); while (__builtin_amdgcn_s_memrealtime() - t0_ < dl_) __builtin_amdgcn_s_sleep(4); } } while (0)
#define OPQ(v) ({ int o_ = (v); asm volatile("" : "+s"(o_)); o_; })
#define WSP() ({ GAS unsigned char* w_ = (GAS unsigned char*)args.ws; asm volatile("" : "+s"(w_)); (unsigned char*)w_; })
#define INP(i) ({ const GAS float* p_ = (const GAS float*)args.in[i]; asm volatile("" : "+s"(p_)); (const float*)p_; })
    LAS float* RTAB = (LAS float*)(lds + RING_BYTES + 1024);
#define P_H ((float*)(WSP() + WS_H))
#define P_XN ((bf16*)(WSP() + WS_XN))
#define P_MO ((bf16*)(WSP() + WS_MO))
#define P_PROJ ((bf16*)(WSP() + WS_PROJ))
#define P_G ((_Float16*)(WSP() + WS_G))
#define P_UT ((bf16*)(WSP() + WS_UT))
#define P_ST ((bf16*)(WSP() + WS_ST))
#define P_LOGF ((float*)(WSP() + WS_LOGF))
#define P_KB ((float*)(WSP() + WS_KB))
#define P_DEC ((float*)(WSP() + WS_DEC))
#define P_LB ((const float*)(WSP() + WS_LB))
#define P_JL ((int*)(WSP() + WS_LB + 512 * 1024))
#define P_CS ((float*)(WSP() + WS_LB + 768 * 1024))
#define P_PART ((float*)(WSP() + WS_PART))

    if (EN(0) && IN(0)) {
        ConvArgs ca{INP(1), INP(2), INP(6), INP(7), INP(12), INP(13)};
        prologue_phase(lds, WSP(), ca, INP(9), OPQ(vcu), OPQ(G));
        GRID_BAR(0);
        if (LOCAL_SEAMS && 1 < hi) { const int ok_ = xcd_groups_local((unsigned*)(WSP() + WS_CTL) + CW_BAR); if (tid == 0) MISC[10] = (unsigned)ok_; __syncthreads(); }
    }
#ifndef FZ_PHASE
#define FZ_PHASE 1
#endif
#ifndef ATT_HOST
#define ATT_HOST 1
#endif
#define HOSTED(m) (ATT_HOST && (ATT_ALL || (((m) - 1) & 7) < 4))
#define CONV_PRE(q) do { if ((q) + 1 < 4 * DEPTH && !HOSTED((q) + 1) && (bx & 3)) { ConvArgs ca_{INP(1), INP(2), INP(6), INP(7), INP(12), INP(13)}; conv_weights(lds, WSP(), ca_, OPQ((q) + 1), OPQ(vcu), OPQ(G), 1, OPQ(bx & 3)); } } while (0)
#define CONV_POST(q) do { if ((q) + 1 < 4 * DEPTH && !HOSTED((q) + 1) && (bx & 3) != 3) { ConvArgs ca_{INP(1), INP(2), INP(6), INP(7), INP(12), INP(13)}; conv_weights(lds, WSP(), ca_, OPQ((q) + 1), OPQ(vcu), OPQ(G), 2, OPQ(bx & 3)); } } while (0)
    for (int L = 0; L < DEPTH; ++L) {
        const int pb = 1 + 12 * L, j = L >> 1; const bool fox = (L & 1) == 0;
        if (EN(1) && L == 0 && IN(pb + 0)) { rms0_phase(INP(0), INP(10), P_XN, P_PART, OPQ(vcu), OPQ(G)); LOCAL_BAR(pb + 0); }
        if (fox) {
            if (EN(2) && IN(pb + 1)) {
                unsigned char* w = WSP();
                pg8::Gemm g{(const bf16*)(w + WS_XN), (const bf16*)(w + WS_WFIN) + (size_t)j * FOX_INP * DM, SEQ, FZ_PHASE ? 4 * DM : FOX_INP, DM}; pg8::StaticOrder S; S.init(SEQ, FZ_PHASE ? 4 * DM : FOX_INP, OPQ(G), OPQ(bx));
                pg8::Unit u0; S.next(0, u0); rstd_table(RTAB, (const float*)(w + WS_PART), u0.pm);
                pg8::EpiFox E{(bf16*)(w + WS_PROJ), 16384, (float*)(w + WS_LOGF), INP(5) + j * NH, (float*)(w + WS_LB + 768 * 1024), pg8::RowScale{RTAB, u0.pm, (const float*)(w + WS_PART)}, INP(3) + j * DH, INP(4) + j * DH, (LAS float*)(lds + RING_BYTES + 4096), QSCALE};
                CONV_PRE(4 * L); pg8::gemm_phase<pg8::EpiFox, pg8::StaticOrder, true, true>(lds, g, S, E); CONV_POST(4 * L);
                if (!FZ_PHASE) GRID_BAR(pb + 1);
            }
            if (FZ_PHASE && EN(15) && IN(pb + 1)) { unsigned char* w = WSP(); __syncthreads();
                int fzb = vcu; if (G == 256) { pg8::StaticOrder S; S.init(SEQ, 4 * DM, OPQ(G), OPQ(bx)); pg8::Unit u0; S.next(0, u0); fzb = u0.pm * 4 + ((bx >> 3) >> 3); }
                fz_phase(lds, (const bf16*)(w + WS_XN), (const bf16*)(w + WS_WFIN) + (size_t)OPQ(j) * FOX_INP * DM, (const float*)(w + WS_PART), INP(5) + OPQ(j) * NH, (float*)(w + WS_LOGF), (float*)(w + WS_LB + 768 * 1024), OPQ(fzb), OPQ(G));
                GRID_BAR(pb + 1); }
            if (EN(3) && IN(pb + 2)) { fox_thin_phase(lds, P_LOGF, P_CS, P_KB, OPQ(vcu), OPQ(G)); GRID_BAR(pb + 2); }
            if (EN(14) && IN(pb + 3)) { jl_phase(lds, P_KB, INP(3) + j * DH, INP(4) + j * DH, P_JL, OPQ(vcu), OPQ(G)); GRID_BAR(pb + 3); }
            if (EN(4) && IN(pb + 4)) { unsigned char* w = WSP(); ConvArgs ca_{INP(1), INP(2), INP(6), INP(7), INP(12), INP(13)}; fa::attn_phase((char*)lds_raw, (const bf16*)(w + WS_PROJ), (const float*)(w + WS_KB), (bf16*)(w + WS_MO), (const int*)(w + WS_LB + 512 * 1024), (unsigned*)(w + WS_CTL) + CW_Q + 64 * j, INP(3) + j * DH, INP(4) + j * DH, w, ca_, OPQ(4 * L + 1), OPQ(ATT_HOST ? (ATT_ALL ? (4 * L + 9 < 4 * DEPTH ? 4 * L + 9 : 4 * DEPTH) : 4 * L + 5) : 4 * L + 1), OPQ(vcu), OPQ(G)); GRID_BAR(pb + 4);
                if (DUP(4)) { fa::attn_phase((char*)lds_raw, (const bf16*)(w + WS_PROJ), (const float*)(w + WS_KB), (bf16*)(w + WS_MO), (const int*)(w + WS_LB + 512 * 1024), (unsigned*)(w + WS_CTL) + CW_Q + 64 * (j + 2), INP(3) + j * DH, INP(4) + j * DH, w, ca_, OPQ(4 * L + 1), OPQ(4 * L + 1), OPQ(vcu), OPQ(G)); GRID_BAR(pb + 4); } }
        } else {
            if (EN(5) && IN(pb + 1)) {
                unsigned char* w = WSP();
                pg8::Gemm g{(const bf16*)(w + WS_XN), (const bf16*)(w + WS_WHIN) + (size_t)j * HG_IN * DM, SEQ, HG_IN, DM}; pg8::StaticOrder S; S.init(SEQ, HG_IN, OPQ(G), OPQ(bx));
                pg8::Unit u0; S.next(0, u0); rstd_table(RTAB, (const float*)(w + WS_PART), u0.pm);
                pg8::EpiHgrn E{(bf16*)(w + WS_PROJ), 16384, (_Float16*)(w + WS_G), (const float*)(w + WS_LB) + (size_t)L * DM, pg8::RowScale{RTAB, u0.pm, (const float*)(w + WS_PART)}};
                CONV_PRE(4 * L); pg8::gemm_phase<pg8::EpiHgrn, pg8::StaticOrder, true, true>(lds, g, S, E); CONV_POST(4 * L);
                LOCAL_BAR(pb + 1);
            }
            if (EN(6) && IN(pb + 2)) { hg::b1_phase(lds, P_PROJ, P_G, P_UT, P_DEC, OPQ(vcu), OPQ(G)); GRID_BAR(pb + 2); }
            if (EN(7) && IN(pb + 3)) { hg::b2_phase(P_UT, P_DEC, P_ST, OPQ(vcu), OPQ(G)); GRID_BAR(pb + 3); }
            if (EN(8) && IN(pb + 4)) { hg::b3_phase(lds, P_PROJ, P_G, P_ST, INP(8) + j * DH, P_MO, OPQ(vcu), OPQ(G)); LOCAL_BAR(pb + 4); }
            if (DUP(6)) { hg::b1_phase(lds, P_PROJ, P_G, P_UT, P_DEC, OPQ(vcu), OPQ(G)); GRID_BAR(pb + 2); hg::b2_phase(P_UT, P_DEC, P_ST, OPQ(vcu), OPQ(G)); GRID_BAR(pb + 3); hg::b3_phase(lds, P_PROJ, P_G, P_ST, INP(8) + j * DH, P_MO, OPQ(vcu), OPQ(G)); GRID_BAR(pb + 4); }
        }
        if (EN(9) && IN(pb + 5)) {
            unsigned char* w = WSP();
            const bf16* W = fox ? (const bf16*)(w + WS_WFOUT) + (size_t)j * DM * DM : (const bf16*)(w + WS_WHOUT) + (size_t)j * DM * DM;
            pg8::Gemm g{(const bf16*)(w + WS_MO), W, SEQ, DM, DM}; pg8::StaticOrder S; S.init(SEQ, DM, OPQ(G), OPQ(bx));
            pg8::EpiRes E{L == 0 ? INP(0) : (const float*)(w + WS_H), (float*)(w + WS_H), DM, (bf16*)(w + WS_XN), INP(11) + (size_t)L * DM, (float*)(w + WS_PART)};
            CONV_PRE(4 * L + 1); pg8::gemm_phase<pg8::EpiRes, pg8::StaticOrder, true, true>(lds, g, S, E); CONV_POST(4 * L + 1);
            LOCAL_BAR(pb + 5);
        }
        if (EN(11) && IN(pb + 7)) {
            unsigned char* w = WSP();
            pg8::Gemm g{(const bf16*)(w + WS_XN), (const bf16*)(w + WS_WUP) + (size_t)L * DFF * DM, SEQ, DFF, DM}; pg8::StaticOrder S; S.init(SEQ, DFF, OPQ(G), OPQ(bx));
            pg8::Unit u0; S.next(0, u0); rstd_table(RTAB, (const float*)(w + WS_PART), u0.pm);
            pg8::EpiSqRelu E{(bf16*)(w + WS_HID), DFF, pg8::RowScale{RTAB, u0.pm, (const float*)(w + WS_PART)}};
            CONV_PRE(4 * L + 2); pg8::gemm_phase<pg8::EpiSqRelu, pg8::StaticOrder, true, true>(lds, g, S, E); CONV_POST(4 * L + 2);
            LOCAL_BAR(pb + 7);
        }
        if (EN(12) && IN(pb + 8)) {
            unsigned char* w = WSP();
            pg8::Gemm g{(const bf16*)(w + WS_HID), (const bf16*)(w + WS_WDN) + (size_t)L * DM * DFF, SEQ, DM, DFF}; pg8::StaticOrder S; S.init(SEQ, DM, OPQ(G), OPQ(bx), DOWN_WGM);
            pg8::EpiRes E{(const float*)(w + WS_H), (float*)(w + WS_H), DM, L + 1 < DEPTH ? (bf16*)(w + WS_XN) : nullptr, INP(10) + (size_t)(L + 1 < DEPTH ? L + 1 : 0) * DM, (float*)(w + WS_PART)};
            CONV_PRE(4 * L + 3); pg8::gemm_phase<pg8::EpiRes, pg8::StaticOrder, true, true>(lds, g, S, E); CONV_POST(4 * L + 3);
            LOCAL_BAR(pb + 8);
        }
    }
    if (EN(13) && IN(PH_FINAL)) rms_phase<true>(P_H, INP(14), args.out, OPQ(vcu), OPQ(G));
#undef IN
#undef GRID_BAR
}

extern "C" void kernel_launch(void* const* d_in, const int* in_sizes, int n_in, void* d_out, int out_size, void* d_ws, size_t ws_size, hipStream_t stream) {
    static int grid = 0;
    if (grid == 0) {
        if (n_in != 15 || in_sizes[0] != SEQ * DM || out_size != SEQ * DM || ws_size < WS_END) { fprintf(stderr, "kernel_launch: unexpected shapes (n_in %d, in0 %d, out %d, ws %zu < %zu)\n", n_in, n_in > 0 ? in_sizes[0] : -1, out_size, ws_size, (size_t)WS_END); grid = -1; return; }
        int dev = 0, cus = 0, per_cu = 0;
        if (hipGetDevice(&dev) != hipSuccess || hipDeviceGetAttribute(&cus, hipDeviceAttributeMultiprocessorCount, dev) != hipSuccess) { grid = -1; return; }
        if (hipFuncSetAttribute((const void*)trunk_fwd, hipFuncAttributeMaxDynamicSharedMemorySize, LDS_BYTES) != hipSuccess) { fprintf(stderr, "kernel_launch: hipFuncSetAttribute failed\n"); grid = -1; return; }
        if (hipOccupancyMaxActiveBlocksPerMultiprocessor(&per_cu, (const void*)trunk_fwd, NWAVES * 64, LDS_BYTES) != hipSuccess || per_cu < 1) fprintf(stderr, "kernel_launch: occupancy query says %d\n", per_cu);
        (void)hipGetLastError();
        grid = cus;
    }
    if (grid < 0) return;
    if (hipMemsetAsync((char*)d_ws + WS_CTL, 0, CTL_ZERO_BYTES, stream) != hipSuccess) return;
    Args a{};
    for (int i = 0; i < 15; ++i) a.in[i] = (const float*)d_in[i];
    a.out = (float*)d_out; a.ws = (unsigned char*)d_ws;
#if MK_PER_PHASE
    for (int p = 0; p < PH_END; ++p) {
        bool valid = (p == 0) || (p == PH_FINAL);
        if (p >= 1 && p < PH_FINAL) { const int L = (p - 1) / 12, k = (p - 1) % 12; const bool fox = (L & 1) == 0; valid = (k <= 8) && (k != 6) && (k != 0 || L == 0); }
        if (!valid) continue;
        a.ph_lo = p; a.ph_hi = p + 1;
        hipLaunchKernelGGL(trunk_fwd, dim3(grid), dim3(NWAVES * 64), LDS_BYTES, stream, a);
    }
#else
    a.ph_lo = 0; a.ph_hi = PH_END;
    hipLaunchKernelGGL(trunk_fwd, dim3(grid), dim3(NWAVES * 64), LDS_BYTES, stream, a);
#endif
}
```
